# Optimizing an MI355X kernel written in HIP

```python
import jax, jax.numpy as jnp
from jax import lax
import numpy as np

D_MODEL = 1024
BATCH = 16
SEQ = 2048
DEPTH = 1

HEAD_DIM = 64
A_HEADS = 8
A_KV_HEADS = 8
B_HEADS = 8
B_KV_HEADS = 2
N_ATTN_HEADS = A_HEADS + B_HEADS
MOBA_BLOCK = 256
MOBA_TOPK = 3
MOBA_QCHUNK = 128
SWA_WINDOW = 128
D_FF = 4 * D_MODEL
EPS = 1e-6
NEG = -1e30
SCALE = HEAD_DIM ** -0.5

W_QA = A_HEADS * HEAD_DIM
W_KA = A_KV_HEADS * HEAD_DIM
W_VA = A_KV_HEADS * HEAD_DIM
W_QB = B_HEADS * HEAD_DIM
W_KB = B_KV_HEADS * HEAD_DIM
W_VB = B_KV_HEADS * HEAD_DIM
W_GATE = D_MODEL
IN_WIDTH = W_QA + W_KA + W_VA + W_QB + W_KB + W_VB + 2 * W_GATE

kernel_name = "hybrid_moba_swa_gated_block"


def _rmsnorm(x, g):
    xf = x.astype(jnp.float32)
    y = xf * lax.rsqrt(jnp.mean(xf * xf, axis=-1, keepdims=True) + EPS)
    return (y * g.astype(jnp.float32)).astype(x.dtype)


def _alibi_slopes(n):
    return jnp.exp2(-(8.0 / n) * jnp.arange(1, n + 1, dtype=jnp.float32))


def _moba(q, k, v, slopes):
    B, S, H, hd = q.shape
    nb = -(-S // MOBA_BLOCK)
    pad = nb * MOBA_BLOCK - S
    padw = ((0, 0), (0, pad), (0, 0), (0, 0))
    kt = jnp.pad(k, padw).reshape(B, nb, MOBA_BLOCK, H, hd).transpose(0, 3, 1, 2, 4)
    vt = jnp.pad(v, padw).reshape(B, nb, MOBA_BLOCK, H, hd).transpose(0, 3, 1, 2, 4)
    qh = q.transpose(0, 2, 1, 3)

    kmean = jnp.mean(kt.astype(jnp.float32), axis=3)
    gs = jnp.einsum('bhsd,bhnd->bhsn', qh.astype(jnp.float32), kmean)
    qblk = jnp.arange(S) // MOBA_BLOCK
    past = jnp.arange(nb)[None, :] < qblk[:, None]
    gs = jnp.where(past, gs, -jnp.inf)
    ksel = min(MOBA_TOPK, nb)
    _, idx = lax.top_k(gs, ksel)

    nc = S // MOBA_QCHUNK
    qc = qh.reshape(B, H, nc, MOBA_QCHUNK, hd).transpose(0, 2, 1, 3, 4).reshape(B * nc, H, MOBA_QCHUNK, hd)
    ic = idx.reshape(B, H, nc, MOBA_QCHUNK, ksel).transpose(0, 2, 1, 3, 4).reshape(B * nc, H, MOBA_QCHUNK, ksel)
    b_ids = jnp.repeat(jnp.arange(B), nc)
    c_ids = jnp.tile(jnp.arange(nc), B)

    def chunk(args):
        qq, ii, b, c = args
        kb_b = kt[b]
        vb_b = vt[b]
        t = c * MOBA_QCHUNK + jnp.arange(MOBA_QCHUNK)
        own = (c * MOBA_QCHUNK) // MOBA_BLOCK
        gather = jax.vmap(lambda kh, ih: kh[ih])
        k_sel = gather(kb_b, ii)
        v_sel = gather(vb_b, ii)
        s_sel = jnp.einsum('hqd,hqkpd->hqkp', qq, k_sel).astype(jnp.float32) * SCALE
        pos_sel = ii[..., None] * MOBA_BLOCK + jnp.arange(MOBA_BLOCK)
        d_sel = (t[None, :, None, None] - pos_sel).astype(jnp.float32)
        slot_ok = (jnp.arange(ksel) < own)[None, None, :, None]
        s_sel = jnp.where(slot_ok, s_sel - slopes[:, None, None, None] * d_sel, NEG)
        k_own = lax.dynamic_index_in_dim(kb_b, own, axis=1, keepdims=False)
        v_own = lax.dynamic_index_in_dim(vb_b, own, axis=1, keepdims=False)
        s_own = jnp.einsum('hqd,hpd->hqp', qq, k_own).astype(jnp.float32) * SCALE
        d_own = t[:, None] - (own * MOBA_BLOCK + jnp.arange(MOBA_BLOCK))[None, :]
        s_own = jnp.where((d_own >= 0)[None], s_own - slopes[:, None, None] * d_own.astype(jnp.float32)[None], NEG)
        H_, QC = qq.shape[0], qq.shape[1]
        scores = jnp.concatenate([s_sel.reshape(H_, QC, ksel * MOBA_BLOCK), s_own], axis=-1)
        p = jax.nn.softmax(scores, axis=-1).astype(qq.dtype)
        p_sel = p[..., :ksel * MOBA_BLOCK].reshape(H_, QC, ksel, MOBA_BLOCK)
        p_own = p[..., ksel * MOBA_BLOCK:]
        return (jnp.einsum('hqkp,hqkpd->hqd', p_sel, v_sel)
                + jnp.einsum('hqp,hpd->hqd', p_own, v_own))

    o = lax.map(chunk, (qc, ic, b_ids, c_ids))
    return o.reshape(B, nc, H, MOBA_QCHUNK, hd).transpose(0, 1, 3, 2, 4).reshape(B, S, H * hd)


def _swa(q, k, v, slopes, sinks):
    B, S, Hq, hd = q.shape
    Hkv = k.shape[2]
    G = Hq // Hkv
    W = SWA_WINDOW
    nblk = S // W
    qb = q.reshape(B, nblk, W, Hkv, G, hd)
    kb = k.reshape(B, nblk, W, Hkv, hd)
    vb = v.reshape(B, nblk, W, Hkv, hd)
    shift = lambda a: jnp.concatenate([jnp.zeros_like(a[:, :1]), a[:, :-1]], axis=1)
    kc = jnp.concatenate([shift(kb), kb], axis=2)
    vc = jnp.concatenate([shift(vb), vb], axis=2)
    s = jnp.einsum('bnqhgd,bnkhd->bhgnqk', qb, kc).astype(jnp.float32) * SCALE
    dist = jnp.arange(W)[:, None] - jnp.arange(2 * W)[None, :] + W
    kpos = jnp.arange(nblk)[:, None] * W - W + jnp.arange(2 * W)[None, :]
    valid = ((dist >= 0) & (dist < W))[None, :, :] & (kpos >= 0)[:, None, :]
    sl = slopes.reshape(Hkv, G)[:, :, None, None, None]
    s = jnp.where(valid, s - sl * dist.astype(jnp.float32), NEG)
    sink = sinks.astype(jnp.float32).reshape(Hkv, G)[None, :, :, None, None, None]
    m = jnp.maximum(jnp.max(s, axis=-1, keepdims=True), sink)
    e = jnp.exp(s - m)
    p = e / (jnp.sum(e, axis=-1, keepdims=True) + jnp.exp(sink - m))
    o = jnp.einsum('bhgnqk,bnkhd->bnqhgd', p.astype(v.dtype), vc)
    return o.reshape(B, S, Hq * hd)


def setup_inputs(seed: int = 0) -> dict:
    key = jax.random.key(seed)
    ks = jax.random.split(key, 16)
    f = jnp.float32
    nrm = lambda k, shape, fan: jax.random.normal(k, shape, f) * fan ** -0.5
    gain = lambda k, shape: 1.0 + 0.1 * jax.random.normal(k, shape, f)
    return {
        "x": jax.random.normal(ks[0], (BATCH, SEQ, D_MODEL), f),
        "norm_attn": gain(ks[1], (DEPTH, D_MODEL)),
        "w_in": nrm(ks[2], (DEPTH, D_MODEL, IN_WIDTH), D_MODEL),
        "q_norm_a": gain(ks[3], (DEPTH, HEAD_DIM)),
        "k_norm_a": gain(ks[4], (DEPTH, HEAD_DIM)),
        "q_norm_b": gain(ks[5], (DEPTH, HEAD_DIM)),
        "k_norm_b": gain(ks[6], (DEPTH, HEAD_DIM)),
        "sinks_b": 0.5 * jax.random.normal(ks[7], (DEPTH, B_HEADS), f),
        "w_branch_a": nrm(ks[8], (DEPTH, A_HEADS * HEAD_DIM, D_MODEL), A_HEADS * HEAD_DIM),
        "w_branch_b": nrm(ks[9], (DEPTH, B_HEADS * HEAD_DIM, D_MODEL), B_HEADS * HEAD_DIM),
        "w_out": nrm(ks[10], (DEPTH, D_MODEL, D_MODEL), D_MODEL),
        "norm_mlp": gain(ks[11], (DEPTH, D_MODEL)),
        "w_up": nrm(ks[12], (DEPTH, D_MODEL, D_FF), D_MODEL),
        "w_down": nrm(ks[13], (DEPTH, D_FF, D_MODEL), D_FF),
    }


def reference(x, norm_attn, w_in, q_norm_a, k_norm_a, q_norm_b, k_norm_b, sinks_b,
              w_branch_a, w_branch_b, w_out, norm_mlp, w_up, w_down):
    B, S, _ = x.shape
    slopes = _alibi_slopes(N_ATTN_HEADS)
    slopes_b = slopes[:B_HEADS]
    slopes_a = slopes[B_HEADS:]
    widths = (W_QA, W_KA, W_VA, W_QB, W_KB, W_VB, W_GATE)
    splits = []
    acc = 0
    for w in widths:
        acc += w
        splits.append(acc)
    for l in range(DEPTH):
        h = _rmsnorm(x, norm_attn[l])
        proj = h @ w_in[l]
        qa, ka, va, qb, kb, vb, ga, gb = jnp.split(proj, splits, axis=-1)
        qa = _rmsnorm(qa.reshape(B, S, A_HEADS, HEAD_DIM), q_norm_a[l])
        ka = _rmsnorm(ka.reshape(B, S, A_KV_HEADS, HEAD_DIM), k_norm_a[l])
        va = va.reshape(B, S, A_KV_HEADS, HEAD_DIM)
        qb = _rmsnorm(qb.reshape(B, S, B_HEADS, HEAD_DIM), q_norm_b[l])
        kb = _rmsnorm(kb.reshape(B, S, B_KV_HEADS, HEAD_DIM), k_norm_b[l])
        vb = vb.reshape(B, S, B_KV_HEADS, HEAD_DIM)
        oa = _moba(qa, ka, va, slopes_a)
        ob = _swa(qb, kb, vb, slopes_b, sinks_b[l])
        mixed = (jax.nn.sigmoid(ga) * (oa @ w_branch_a[l])
                 + jax.nn.sigmoid(gb) * (ob @ w_branch_b[l]))
        x = x + mixed @ w_out[l]
        h2 = _rmsnorm(x, norm_mlp[l])
        x = x + jnp.square(jax.nn.relu(h2 @ w_up[l])) @ w_down[l]
    return x
```

```cpp
#include <hip/hip_runtime.h>
#include <cstdio>
#include <cstdint>
namespace pg8 {
#define PG8_LAS __attribute__((address_space(3)))
typedef unsigned short bf16_t;
typedef short bf16x8 __attribute__((ext_vector_type(8)));
typedef float f32x4 __attribute__((ext_vector_type(4)));
typedef unsigned u32x4 __attribute__((ext_vector_type(4)));
constexpr int BM = 256, BK = 64, HALF = 128, HTB = HALF * BK * 2  , STAGE_BYTES = 8 * HTB, NXCD = 8, WGM = 8;

__host__ __device__ __forceinline__ int lds_byte(int r, int c) { const int st = (r >> 4) * 2 + (c >> 5), rr = r & 15, cc = c & 31, ob = rr * 64 + cc * 2; return st * 1024 + (ob ^ (((ob >> 9) & 1) << 5)); }
__host__ __device__ __forceinline__ void stage_rc(int b, int& R, int& C) { const int st = b / 1024, sb = b % 1024, swz = sb ^ (((sb >> 9) & 1) << 5); R = (st >> 1) * 16 + swz / 64; C = (st & 1) * 32 + (swz % 64) / 2; }
__host__ __device__ __forceinline__ int perm32(int rho) { const int n = rho >> 4, i = rho & 15; return 8 * (i >> 2) + 4 * n + (i & 3); }

struct Unit { int pm, pn; };
struct Gemm { const bf16_t* A; const bf16_t* Bt; int M, N, K; };

struct StaticOrder {
    int nM, nN, nwg, G, c;
    __host__ __device__ void init(int M, int N, int G_, int c_) { nM = M / BM; nN = N / BM; nwg = nM * nN; G = G_; c = c_; }
    __host__ __device__ bool next(int i, Unit& u) const {
        const long L = (long)i * G + c; if (L >= nwg) return false;
        int wgid = (int)L; { const int q = nwg / NXCD, r = nwg % NXCD, xcd = wgid % NXCD, off = wgid / NXCD; wgid = (xcd < r ? xcd * (q + 1) : r * (q + 1) + (xcd - r) * q) + off; }
        const int nig = WGM * nN, gid = wgid / nig, fm = gid * WGM, gsz = (nM - fm) < WGM ? (nM - fm) : WGM;
        u.pm = fm + ((wgid % nig) % gsz); u.pn = (wgid % nig) / gsz; return true;
    }
    __device__ __forceinline__ void a_ready(const Unit&) const {}
    __device__ __forceinline__ void done(const Unit&) const {}
};

__device__ __forceinline__ unsigned cvt_pk_bf16(float lo, float hi) { unsigned r; asm volatile("v_cvt_pk_bf16_f32 %0, %1, %2" : "=v"(r) : "v"(lo), "v"(hi)); return r; }
typedef unsigned u32x2 __attribute__((ext_vector_type(2)));
__device__ __forceinline__ float bf_lo(unsigned w) { return __uint_as_float(w << 16); }
__device__ __forceinline__ float bf_hi(unsigned w) { return __uint_as_float(w & 0xffff0000u); }
constexpr float kLog2e = 1.4426950408889634f;
constexpr float kC2 = 0.125f * 1.4426950408889634f;

struct EpiIn {
    static constexpr bool PERM = true, AFTER_DRAIN = false; static constexpr int MID_TILE = 0;
    bf16_t *Q, *KA, *VA, *KB, *VB, *GA, *GB; const float *qna, *kna, *qnb, *knb; float* kmean;
    __device__ __forceinline__ void mid(f32x4 (&)[2][2][4][2], const Unit&, int, int, int, int) const {}
    __device__ __forceinline__ void operator()(const f32x4 (&acc)[2][2][4][2], const Unit& u, int wr, int wc, int fr, int fq) const {
        const int pn = u.pn;
        bf16_t* dst; int pitch; bool norm = false, sig = false, km = false; float scale = 1.f; const float* gain = qna;
        if (pn < 2)       { dst = Q + (4 * pn + wc) * 64; pitch = 1024; norm = true; gain = qna; scale = kC2; }
        else if (pn < 4)  { dst = KA + (4 * (pn - 2) + wc) * 64; pitch = 512; norm = true; gain = kna; km = true; }
        else if (pn < 6)  { dst = VA + (4 * (pn - 4) + wc) * 64; pitch = 512; }
        else if (pn < 8)  { dst = Q + 512 + (4 * (pn - 6) + wc) * 64; pitch = 1024; norm = true; gain = qnb; scale = kC2; }
        else if (pn == 8) { pitch = 128; if (wc < 2) { dst = KB + wc * 64; norm = true; gain = knb; } else { dst = VB + (wc - 2) * 64; } }
        else if (pn < 13) { dst = GA + (pn - 9) * 256 + wc * 64; pitch = 1024; sig = true; }
        else              { dst = GB + (pn - 13) * 256 + wc * 64; pitch = 1024; sig = true; }
        const int rowb = u.pm * BM + wr * 64 + fr;
        f32x4 g[2][2], cs[2][2];
#pragma unroll
        for (int bj = 0; bj < 2; ++bj)
#pragma unroll
            for (int n = 0; n < 2; ++n) { g[bj][n] = norm ? *(const f32x4*)(gain + 32 * bj + 8 * fq + 4 * n) : (f32x4){1.f, 1.f, 1.f, 1.f}; cs[bj][n] = (f32x4){0.f, 0.f, 0.f, 0.f}; }
#pragma unroll
        for (int ai = 0; ai < 2; ++ai)
#pragma unroll
            for (int m = 0; m < 4; ++m) {
                const int row = rowb + ai * HALF + m * 16;
                f32x4 v[2][2];
#pragma unroll
                for (int bj = 0; bj < 2; ++bj)
#pragma unroll
                    for (int n = 0; n < 2; ++n) v[bj][n] = acc[ai][bj][m][n];
                if (norm) {
                    float ss = 0.f;
#pragma unroll
                    for (int bj = 0; bj < 2; ++bj)
#pragma unroll
                        for (int n = 0; n < 2; ++n) { const f32x4 x = v[bj][n]; ss += (x[0] * x[0] + x[1] * x[1]) + (x[2] * x[2] + x[3] * x[3]); }
                    ss += __shfl_xor(ss, 16); ss += __shfl_xor(ss, 32);
                    const float rs = __builtin_amdgcn_rsqf(ss * (1.0f / 64.0f) + 1e-6f) * scale;
#pragma unroll
                    for (int bj = 0; bj < 2; ++bj)
#pragma unroll
                        for (int n = 0; n < 2; ++n) v[bj][n] = v[bj][n] * rs * g[bj][n];
                } else if (sig) {
#pragma unroll
                    for (int bj = 0; bj < 2; ++bj)
#pragma unroll
                        for (int n = 0; n < 2; ++n)
#pragma unroll
                            for (int e = 0; e < 4; ++e) v[bj][n][e] = __builtin_fmaxf(__builtin_amdgcn_rcpf(1.0f + __builtin_amdgcn_exp2f(-kLog2e * v[bj][n][e])), 1e-20f);
                }
                if (km) {
#pragma unroll
                    for (int bj = 0; bj < 2; ++bj)
#pragma unroll
                        for (int n = 0; n < 2; ++n) cs[bj][n] += v[bj][n];
                }
#pragma unroll
                for (int bj = 0; bj < 2; ++bj) {
                    u32x4 w; w.x = cvt_pk_bf16(v[bj][0][0], v[bj][0][1]); w.y = cvt_pk_bf16(v[bj][0][2], v[bj][0][3]); w.z = cvt_pk_bf16(v[bj][1][0], v[bj][1][1]); w.w = cvt_pk_bf16(v[bj][1][2], v[bj][1][3]);
                    *(u32x4*)(dst + (size_t)row * pitch + 32 * bj + 8 * fq) = w;
                }
            }
        if (km) {
            float* kmp = kmean + ((size_t)u.pm * 8 + (4 * (pn - 2) + wc)) * 64;
#pragma unroll
            for (int bj = 0; bj < 2; ++bj)
#pragma unroll
                for (int n = 0; n < 2; ++n)
#pragma unroll
                    for (int e = 0; e < 4; ++e) {
                        float s = cs[bj][n][e];
                        s += __shfl_xor(s, 1); s += __shfl_xor(s, 2); s += __shfl_xor(s, 4); s += __shfl_xor(s, 8);
                        if (fr == 0) atomicAdd(kmp + 32 * bj + 8 * fq + 4 * n + e, s * (1.0f / 256.0f));
                    }
        }
    }
};

struct EpiMix {
    static constexpr bool PERM = true, AFTER_DRAIN = false; static constexpr int MID_TILE = 8;
    const bf16_t *GA, *GB; bf16_t* MIX;
    __device__ __forceinline__ void mid(f32x4 (&acc)[2][2][4][2], const Unit& u, int wr, int wc, int fr, int fq) const {
        int rowb = u.pm * BM + wr * 64 + fr, col0 = u.pn * BM + wc * 32 + 8 * fq;
        asm volatile("" : "+v"(rowb), "+v"(col0));
#pragma unroll
        for (int ai = 0; ai < 2; ++ai)
#pragma unroll
            for (int m = 0; m < 4; ++m) { const size_t off = (size_t)(rowb + ai * HALF + m * 16) * 1024 + col0;
#pragma unroll
                for (int bj = 0; bj < 2; ++bj) {
                    const u32x4 a = *(const u32x4*)(GA + off + bj * HALF), b = *(const u32x4*)(GB + off + bj * HALF);
                    f32x4 r0, r1;
                    r0[0] = bf_lo(a.x) * __builtin_amdgcn_rcpf(bf_lo(b.x)); r0[1] = bf_hi(a.x) * __builtin_amdgcn_rcpf(bf_hi(b.x));
                    r0[2] = bf_lo(a.y) * __builtin_amdgcn_rcpf(bf_lo(b.y)); r0[3] = bf_hi(a.y) * __builtin_amdgcn_rcpf(bf_hi(b.y));
                    r1[0] = bf_lo(a.z) * __builtin_amdgcn_rcpf(bf_lo(b.z)); r1[1] = bf_hi(a.z) * __builtin_amdgcn_rcpf(bf_hi(b.z));
                    r1[2] = bf_lo(a.w) * __builtin_amdgcn_rcpf(bf_lo(b.w)); r1[3] = bf_hi(a.w) * __builtin_amdgcn_rcpf(bf_hi(b.w));
                    acc[ai][bj][m][0] *= r0; acc[ai][bj][m][1] *= r1;
                    asm volatile("" ::: "memory");
                } }
    }
    __device__ __forceinline__ void operator()(const f32x4 (&acc)[2][2][4][2], const Unit& u, int wr, int wc, int fr, int fq) const {
        const int rowb = u.pm * BM + wr * 64 + fr, col0 = u.pn * BM + wc * 32 + 8 * fq;
#pragma unroll
        for (int ai = 0; ai < 2; ++ai)
#pragma unroll
            for (int m = 0; m < 4; ++m) { const size_t off = (size_t)(rowb + ai * HALF + m * 16) * 1024 + col0;
#pragma unroll
                for (int bj = 0; bj < 2; ++bj) {
                    const u32x4 b = *(const u32x4*)(GB + off + bj * HALF);
                    const f32x4 v0 = acc[ai][bj][m][0], v1 = acc[ai][bj][m][1];
                    u32x4 w; w.x = cvt_pk_bf16(v0[0] * bf_lo(b.x), v0[1] * bf_hi(b.x)); w.y = cvt_pk_bf16(v0[2] * bf_lo(b.y), v0[3] * bf_hi(b.y));
                    w.z = cvt_pk_bf16(v1[0] * bf_lo(b.z), v1[1] * bf_hi(b.z)); w.w = cvt_pk_bf16(v1[2] * bf_lo(b.w), v1[3] * bf_hi(b.w));
                    *(u32x4*)(MIX + off + bj * HALF) = w;
                }
                if (m & 1) asm volatile("" ::: "memory"); }
    }
};

struct EpiX1 {
    static constexpr bool PERM = false, AFTER_DRAIN = false; static constexpr int MID_TILE = 0;
    const float* x; float* out; bf16_t* A2; const float* g2; float* rowsq;
    __device__ __forceinline__ void mid(f32x4 (&)[2][2][4][2], const Unit&, int, int, int, int) const {}
    __device__ __forceinline__ void operator()(const f32x4 (&acc)[2][2][4][2], const Unit& u, int wr, int wc, int fr, int fq) const {
        const int rowb = u.pm * BM + wr * 64 + fr, col0 = u.pn * BM + wc * 32 + 4 * fq;
        f32x4 gv[2][2];
#pragma unroll
        for (int bj = 0; bj < 2; ++bj)
#pragma unroll
            for (int n = 0; n < 2; ++n) gv[bj][n] = *(const f32x4*)(g2 + col0 + bj * HALF + n * 16);
#pragma unroll
        for (int ai = 0; ai < 2; ++ai)
#pragma unroll
            for (int m = 0; m < 4; ++m) { const int row = rowb + ai * HALF + m * 16; const size_t off = (size_t)row * 1024 + col0; float ss = 0.f;
#pragma unroll
                for (int bj = 0; bj < 2; ++bj)
#pragma unroll
                    for (int n = 0; n < 2; ++n) {
                        const f32x4 x1 = *(const f32x4*)(x + off + bj * HALF + n * 16) + acc[ai][bj][m][n];
                        *(f32x4*)(out + off + bj * HALF + n * 16) = x1;
                        ss += (x1[0] * x1[0] + x1[1] * x1[1]) + (x1[2] * x1[2] + x1[3] * x1[3]);
                        const f32x4 a = x1 * gv[bj][n]; u32x2 w; w.x = cvt_pk_bf16(a[0], a[1]); w.y = cvt_pk_bf16(a[2], a[3]);
                        *(u32x2*)(A2 + off + bj * HALF + n * 16) = w;
                    }
                ss += __shfl_xor(ss, 16); ss += __shfl_xor(ss, 32);
                if (fq == 0) atomicAdd(rowsq + row, ss);
                if (m & 1) asm volatile("" ::: "memory"); }
    }
};

struct EpiUp {
    static constexpr bool PERM = true, AFTER_DRAIN = false; static constexpr int MID_TILE = 0;
    bf16_t* H; const float* rowsq;
    __device__ __forceinline__ void mid(f32x4 (&)[2][2][4][2], const Unit&, int, int, int, int) const {}
    __device__ __forceinline__ void operator()(const f32x4 (&acc)[2][2][4][2], const Unit& u, int wr, int wc, int fr, int fq) const {
        const int rowb = u.pm * BM + wr * 64 + fr, col0 = u.pn * BM + wc * 32 + 8 * fq;
#pragma unroll
        for (int ai = 0; ai < 2; ++ai)
#pragma unroll
            for (int m = 0; m < 4; ++m) { const int row = rowb + ai * HALF + m * 16;
                const float r = __builtin_amdgcn_rsqf(rowsq[row] * (1.0f / 1024.0f) + 1e-6f);
                bf16_t* rowp = H + (size_t)row * 4096 + col0;
#pragma unroll
                for (int bj = 0; bj < 2; ++bj) {
                    f32x4 v0 = acc[ai][bj][m][0] * r, v1 = acc[ai][bj][m][1] * r;
#pragma unroll
                    for (int e = 0; e < 4; ++e) { const float a = __builtin_fmaxf(v0[e], 0.f), b = __builtin_fmaxf(v1[e], 0.f); v0[e] = a * a; v1[e] = b * b; }
                    u32x4 w; w.x = cvt_pk_bf16(v0[0], v0[1]); w.y = cvt_pk_bf16(v0[2], v0[3]); w.z = cvt_pk_bf16(v1[0], v1[1]); w.w = cvt_pk_bf16(v1[2], v1[3]);
                    *(u32x4*)(rowp + bj * HALF) = w;
                } }
    }
};

struct EpiDown {
    static constexpr bool PERM = false, AFTER_DRAIN = false; static constexpr int MID_TILE = 0;
    float* out;
    __device__ __forceinline__ void mid(f32x4 (&)[2][2][4][2], const Unit&, int, int, int, int) const {}
    __device__ __forceinline__ void operator()(const f32x4 (&acc)[2][2][4][2], const Unit& u, int wr, int wc, int fr, int fq) const {
        const int rowb = u.pm * BM + wr * 64 + fr, col0 = u.pn * BM + wc * 32 + 4 * fq;
#pragma unroll
        for (int ai = 0; ai < 2; ++ai)
#pragma unroll
            for (int m = 0; m < 4; ++m) { float* rowp = out + (size_t)(rowb + ai * HALF + m * 16) * 1024 + col0;
#pragma unroll
                for (int bj = 0; bj < 2; ++bj)
#pragma unroll
                    for (int n = 0; n < 2; ++n) { float* p = rowp + bj * HALF + n * 16; *(f32x4*)p = *(const f32x4*)p + acc[ai][bj][m][n]; }
                if (m & 1) asm volatile("" ::: "memory"); }
    }
};

template <class Epi, class Sched, bool ALIGN_EPI = false, bool SP2 = false>
__device__ __forceinline__ void gemm_phase(PG8_LAS unsigned char* lds, const Gemm g, const Sched& S, const Epi& E) {
    const int tid = threadIdx.x, wid = __builtin_amdgcn_readfirstlane(tid >> 6), lane = tid & 63, wr = wid >> 2, wc = wid & 3, fr = lane & 15, fq = lane >> 4;
    const int K = g.K, nt = K / BK;
    unsigned voffA[2], voffB[2];
#pragma unroll
    for (int i = 0; i < 2; ++i) { int R, C; stage_rc(tid * 16 + i * 8192, R, C); const int Rb = Epi::PERM ? ((R & ~31) + perm32(R & 31)) : R;
        voffA[i] = (unsigned)(R * K + C) * 2u; voffB[i] = (unsigned)(Rb * K + C) * 2u; }
    const size_t kstep = (size_t)(BK * 2);
    const size_t hstep = (size_t)HALF * K * 2;
    const size_t tstep = 2 * hstep;
    const unsigned ldsw = (unsigned)wid * 1024u;
    const int aoff = lds_byte(wr * 64 + fr, fq * 8), boff = lds_byte(wc * 32 + fr, fq * 8);
#define PG8_SA(b, h) (((b) * 2 + (h)) * HTB)
#define PG8_SB(b, h) ((4 + (b) * 2 + (h)) * HTB)
#define PG8_STAGE(bufoff, gbase, voff) do { _Pragma("unroll") for (int _i = 0; _i < 2; ++_i) \
        __builtin_amdgcn_global_load_lds((const unsigned*)((const char*)(gbase) + (voff)[_i]), (PG8_LAS unsigned*)(lds + (bufoff) + ldsw + _i * 8192), 16, 0, 0); } while (0)
#define PG8_LDA(dst, b, h) do { _Pragma("unroll") for (int m = 0; m < 4; ++m) _Pragma("unroll") for (int k = 0; k < 2; ++k) dst[m][k] = *(const PG8_LAS bf16x8*)(lds + PG8_SA(b, h) + aoff + m * 2048 + k * 1024); } while (0)
#define PG8_LDB(dst, b, h) do { _Pragma("unroll") for (int n = 0; n < 2; ++n) _Pragma("unroll") for (int k = 0; k < 2; ++k) dst[n][k] = *(const PG8_LAS bf16x8*)(lds + PG8_SB(b, h) + boff + n * 2048 + k * 1024); } while (0)
#define PG8_MMA(ai, bj, At, Bt) do { __builtin_amdgcn_s_setprio(1); _Pragma("unroll") for (int m = 0; m < 4; ++m) _Pragma("unroll") for (int n = 0; n < 2; ++n) _Pragma("unroll") for (int k = 0; k < 2; ++k) \
        acc[ai][bj][m][n] = __builtin_amdgcn_mfma_f32_16x16x32_bf16(Bt[n][k], At[m][k], acc[ai][bj][m][n], 0, 0, 0); __builtin_amdgcn_s_setprio(0); } while (0)
#define PG8_WAIT_V(n) asm volatile("s_waitcnt vmcnt(" #n ")" ::: "memory")
#define PG8_WAIT_L(n) asm volatile("s_waitcnt lgkmcnt(" #n ")" ::: "memory")
#define PG8_BAR __builtin_amdgcn_s_barrier()
#define PG8_SCHED __builtin_amdgcn_sched_barrier(0)
    Unit cur, nxt; int ui = 0;
    if (!S.next(0, cur)) return;
    f32x4 acc[2][2][4][2];
#pragma unroll
    for (int a = 0; a < 2; ++a)
#pragma unroll
        for (int b = 0; b < 2; ++b)
#pragma unroll
            for (int m = 0; m < 4; ++m)
#pragma unroll
                for (int n = 0; n < 2; ++n) acc[a][b][m][n] = (f32x4){0.f, 0.f, 0.f, 0.f};
    bf16x8 At[4][2], B0[2][2], B1[2][2];
    const char* cA = (const char*)g.A + (size_t)cur.pm * tstep; const char* cB = (const char*)g.Bt + (size_t)cur.pn * tstep;
    S.a_ready(cur);
    if constexpr (SP2) {
        PG8_STAGE(PG8_SB(0, 0), cB, voffB); PG8_STAGE(PG8_SB(0, 1), cB + hstep, voffB); PG8_STAGE(PG8_SA(0, 0), cA, voffA); PG8_STAGE(PG8_SA(0, 1), cA + hstep, voffA);
        if (wr == 1) PG8_BAR;
        PG8_WAIT_V(2); PG8_BAR;
        PG8_STAGE(PG8_SB(1, 0), cB + kstep, voffB); PG8_STAGE(PG8_SA(1, 0), cA + kstep, voffA); PG8_STAGE(PG8_SB(1, 1), cB + hstep + kstep, voffB);
        PG8_WAIT_V(6); PG8_BAR;
    } else {
        PG8_STAGE(PG8_SB(0, 0), cB, voffB); PG8_STAGE(PG8_SA(0, 0), cA, voffA); PG8_STAGE(PG8_SB(0, 1), cB + hstep, voffB); PG8_STAGE(PG8_SA(0, 1), cA + hstep, voffA);
        if (wr == 1) PG8_BAR;
        PG8_WAIT_V(4); PG8_BAR;
        PG8_STAGE(PG8_SB(1, 0), cB + kstep, voffB); PG8_STAGE(PG8_SA(1, 0), cA + kstep, voffA); PG8_STAGE(PG8_SB(1, 1), cB + hstep + kstep, voffB);
        PG8_WAIT_V(6); PG8_BAR;
    }
    for (;;) {
        const bool has_next = S.next(ui + 1, nxt);
        const char* nA = has_next ? (const char*)g.A + (size_t)nxt.pm * tstep : cA; const char* nB = has_next ? (const char*)g.Bt + (size_t)nxt.pn * tstep : cB;
        for (int t = 0; t < nt; t += 2) {
            if constexpr (Epi::MID_TILE > 0) { if (t == Epi::MID_TILE) { PG8_SCHED; E.mid(acc, cur, wr, wc, fr, fq); PG8_SCHED; } }
            const bool last = (t == nt - 2);
            const char* a1 = cA + (size_t)(t + 1) * kstep;
            const char* a2 = last ? nA : cA + (size_t)(t + 2) * kstep; const char* b2 = last ? nB : cB + (size_t)(t + 2) * kstep;
            const char* a3 = a2 + kstep; const char* b3 = b2 + kstep;
            if (last && has_next) S.a_ready(nxt);
            if constexpr (SP2) {
            PG8_LDB(B0, 0, 0); PG8_LDB(B1, 0, 1); PG8_SCHED; PG8_LDA(At, 0, 0); PG8_STAGE(PG8_SA(1, 1), a1 + hstep, voffA);
            PG8_WAIT_V(8); PG8_WAIT_L(0); PG8_BAR; PG8_MMA(0, 0, At, B0); PG8_MMA(0, 1, At, B1); PG8_BAR; PG8_SCHED;
            PG8_LDA(At, 0, 1); PG8_STAGE(PG8_SB(0, 0), b2, voffB); PG8_STAGE(PG8_SB(0, 1), b2 + hstep, voffB); PG8_STAGE(PG8_SA(0, 0), a2, voffA);
            PG8_WAIT_V(8); PG8_WAIT_L(0); PG8_BAR; PG8_MMA(1, 0, At, B0); PG8_MMA(1, 1, At, B1); PG8_BAR; PG8_SCHED;
            PG8_LDB(B0, 1, 0); PG8_LDB(B1, 1, 1); PG8_SCHED; PG8_LDA(At, 1, 0); PG8_STAGE(PG8_SA(0, 1), a2 + hstep, voffA);
            PG8_WAIT_V(8); PG8_WAIT_L(0); PG8_BAR; PG8_MMA(0, 0, At, B0); PG8_MMA(0, 1, At, B1); PG8_BAR; PG8_SCHED;
            PG8_LDA(At, 1, 1); PG8_STAGE(PG8_SB(1, 0), b3, voffB); PG8_STAGE(PG8_SB(1, 1), b3 + hstep, voffB); PG8_STAGE(PG8_SA(1, 0), a3, voffA);
            PG8_WAIT_V(8); PG8_WAIT_L(0); PG8_BAR; PG8_MMA(1, 0, At, B0); PG8_MMA(1, 1, At, B1); PG8_BAR; PG8_SCHED;
            } else {
            PG8_LDB(B0, 0, 0); PG8_SCHED; PG8_LDA(At, 0, 0); PG8_STAGE(PG8_SA(1, 1), a1 + hstep, voffA);
            PG8_WAIT_L(8); PG8_BAR; PG8_WAIT_L(0); PG8_MMA(0, 0, At, B0); PG8_BAR; PG8_SCHED;
            PG8_LDB(B1, 0, 1); PG8_STAGE(PG8_SB(0, 0), b2, voffB);
            PG8_BAR; PG8_WAIT_L(0); PG8_MMA(0, 1, At, B1); PG8_BAR;
            PG8_LDA(At, 0, 1); PG8_STAGE(PG8_SA(0, 0), a2, voffA);
            PG8_BAR; PG8_WAIT_L(0); PG8_MMA(1, 0, At, B0); PG8_BAR; PG8_SCHED;
            PG8_STAGE(PG8_SB(0, 1), b2 + hstep, voffB);
            PG8_WAIT_V(6); PG8_BAR; PG8_MMA(1, 1, At, B1); PG8_BAR;
            PG8_LDB(B0, 1, 0); PG8_SCHED; PG8_LDA(At, 1, 0); PG8_STAGE(PG8_SA(0, 1), a2 + hstep, voffA);
            PG8_WAIT_L(8); PG8_BAR; PG8_WAIT_L(0); PG8_MMA(0, 0, At, B0); PG8_BAR; PG8_SCHED;
            PG8_LDB(B1, 1, 1); PG8_STAGE(PG8_SB(1, 0), b3, voffB);
            PG8_BAR; PG8_WAIT_L(0); PG8_MMA(0, 1, At, B1); PG8_BAR;
            PG8_LDA(At, 1, 1); PG8_STAGE(PG8_SA(1, 0), a3, voffA);
            PG8_BAR; PG8_WAIT_L(0); PG8_MMA(1, 0, At, B0); PG8_BAR; PG8_SCHED;
            PG8_STAGE(PG8_SB(1, 1), b3 + hstep, voffB);
            PG8_WAIT_V(6); PG8_BAR; PG8_MMA(1, 1, At, B1); PG8_BAR;
            }
        }
        if constexpr (ALIGN_EPI) { if (wr == 0) PG8_BAR; }
        if constexpr (!Epi::AFTER_DRAIN) { E(acc, cur, wr, wc, fr, fq); S.done(cur); }
        if (!has_next) break;
#pragma unroll
        for (int a = 0; a < 2; ++a)
#pragma unroll
            for (int b = 0; b < 2; ++b)
#pragma unroll
                for (int m = 0; m < 4; ++m)
#pragma unroll
                    for (int n = 0; n < 2; ++n) acc[a][b][m][n] = (f32x4){0.f, 0.f, 0.f, 0.f};
        cur = nxt; cA = nA; cB = nB; ++ui;
        if constexpr (ALIGN_EPI) { if (wr == 1) PG8_BAR; }
    }
    PG8_WAIT_V(0);
    if constexpr (!ALIGN_EPI) { if (wr == 0) PG8_BAR; }
    PG8_BAR;
    if constexpr (Epi::AFTER_DRAIN) { E.fused(acc, cur, wr, wc, fr, fq, lds, wid, lane); S.done(cur); }
#undef PG8_SA
#undef PG8_SB
#undef PG8_STAGE
#undef PG8_LDA
#undef PG8_LDB
#undef PG8_MMA
#undef PG8_WAIT_V
#undef PG8_WAIT_L
#undef PG8_BAR
#undef PG8_SCHED
}
}
constexpr int NWAVES = 8;
constexpr int BATCH = 16, SEQ = 2048, DM = 1024, HD = 64, FF = 4096, NIN = 4352;
constexpr int M = BATCH * SEQ;
constexpr float EPS = 1e-6f;
constexpr size_t MiB = 1u << 20;
constexpr size_t WS_CTL = 0, CTL_ZERO_BYTES = 1 * MiB;
constexpr size_t WS_WIN = 2 * MiB, WS_WBR = 11 * MiB, WS_WO = 13 * MiB, WS_WUP = 15 * MiB, WS_WDN = 23 * MiB;
constexpr size_t WS_Q = 32 * MiB;
constexpr size_t WS_KA = 96 * MiB, WS_VA = 128 * MiB;
constexpr size_t WS_KB = 160 * MiB, WS_VB = 168 * MiB;
constexpr size_t WS_GA = 176 * MiB, WS_GB = 240 * MiB;
constexpr size_t WS_H = 32 * MiB;
constexpr size_t WS_A2 = 304 * MiB;
constexpr size_t WS_XN = 368 * MiB;
constexpr size_t WS_END = 432 * MiB;
static_assert(WS_WIN + (size_t)NIN * DM * 2 <= WS_WBR && WS_WDN + (size_t)DM * FF * 2 <= WS_Q && WS_GB + (size_t)M * DM * 2 <= WS_A2 && WS_H + (size_t)M * FF * 2 <= WS_A2, "d_ws map");
constexpr int CW_TMO = 0, CW_CODE = 1;
constexpr int CW_BAR = 4096;
constexpr int CW_KMEAN = 16384;
constexpr int CW_ROWSQ = CW_KMEAN + BATCH * 8 * 8 * 64;
static_assert((CW_ROWSQ + M) * 4 <= (int)CTL_ZERO_BYTES, "CTL words inside the memset region");
constexpr int RING_OFF = 0, RING_BYTES = 131072;
constexpr int LDSCTL_OFF = RING_BYTES, MISC_OFF = LDSCTL_OFF + 320;
constexpr int LDS_BYTES = 147456;
static_assert(MISC_OFF + 128 <= LDS_BYTES, "LDS map");

#define GAS __attribute__((address_space(1)))
#define LAS __attribute__((address_space(3)))
typedef unsigned short bf16;
typedef unsigned v4u __attribute__((ext_vector_type(4)));
typedef float f32x4 __attribute__((ext_vector_type(4)));
typedef short bf16x8 __attribute__((ext_vector_type(8)));
typedef GAS unsigned gu32;
typedef GAS unsigned long long gu64;
#define RLX_AGENT __ATOMIC_RELAXED, __HIP_MEMORY_SCOPE_AGENT
#define LDS_WAIT() asm volatile("s_waitcnt lgkmcnt(0)" ::: "memory")
#define VM_WAIT() asm volatile("s_waitcnt vmcnt(0)" ::: "memory")
__device__ __forceinline__ unsigned long long rt() { return __builtin_amdgcn_s_memrealtime(); }
__device__ __forceinline__ unsigned f2bf(float f) { unsigned u = __builtin_bit_cast(unsigned, f); return (u + 0x7fffu + ((u >> 16) & 1u)) >> 16; }
__device__ __forceinline__ unsigned pk2(float lo, float hi) { return f2bf(lo) | (f2bf(hi) << 16); }

#define XB_TMO      128
#define XB_XCNT(j)  (256  + 64 * (j))
#define XB_XSUB(j)  (1280 + 64 * (j))
#define XB_XGEN(j)  (2304 + 64 * (j))
#define XB_TOP      3328
#define XB_TOPGEN   3392
#define XCD_BAR_WORDS 3456
#define XB_SPIN_CAP (1u << 18)

__device__ __forceinline__ unsigned xb_ld(unsigned* p)              { return __hip_atomic_load(p, __ATOMIC_RELAXED, __HIP_MEMORY_SCOPE_AGENT); }
__device__ __forceinline__ unsigned xb_add(unsigned* p, unsigned v) { return __hip_atomic_fetch_add(p, v, __ATOMIC_RELAXED, __HIP_MEMORY_SCOPE_AGENT); }
__device__ __forceinline__ unsigned xb_xcc_id() { return (unsigned)__builtin_amdgcn_s_getreg((3 << 11) | 20) & 0xFu; }
#define XB_SPIN(cond, bar) do { unsigned _sp = 0; while (cond) { __builtin_amdgcn_s_sleep(1); \
    if ((++_sp & 255u) == 0u) { if (xb_ld(&(bar)[XB_TMO])) break; if (_sp > XB_SPIN_CAP) { atomicAdd(&(bar)[XB_TMO], 1u); break; } } } } while (0)

struct XcdBarrier {
    unsigned* bar; unsigned x;
    volatile LAS unsigned* st;
};

__device__ __forceinline__ XcdBarrier xcd_barrier_post(unsigned* bar, volatile LAS unsigned* st) {
    XcdBarrier b; b.bar = bar; b.x = xb_xcc_id(); b.st = st;
    if (threadIdx.x == 0) (void)xb_add(&bar[XB_XCNT(b.x)], 1u);
    return b;
}
__device__ __forceinline__ void xcd_barrier_complete(unsigned* bar, unsigned x, unsigned& nloc, unsigned& nx) {
    const unsigned G = gridDim.x * gridDim.y * gridDim.z;
    unsigned sum, cnt, mine, sp = 0u;
    for (;;) {
        sum = 0u; cnt = 0u; mine = 0u;
#pragma unroll
        for (unsigned j = 0; j < 16; ++j) { const unsigned c = xb_ld(&bar[XB_XCNT(j)]); sum += c; cnt += (c > 0u) ? 1u : 0u; mine = (j == x) ? c : mine; }
        if (sum == G) break;
        __builtin_amdgcn_s_sleep(1);
        if ((++sp & 255u) == 0u) { if (xb_ld(&bar[XB_TMO])) break; if (sp > XB_SPIN_CAP) { atomicAdd(&bar[XB_TMO], 1u); break; } }
    }
    nloc = mine > 0u ? mine : 1u; nx = cnt > 0u ? cnt : 1u;
}

__device__ __forceinline__ void xcd_barrier(const XcdBarrier& b) {
    asm volatile("s_waitcnt vmcnt(0)" ::: "memory");
    __syncthreads();
    if (threadIdx.x == 0) {
        unsigned* bar = b.bar;
        __builtin_amdgcn_s_waitcnt(0);
        unsigned nloc = b.st[0], nx = b.st[1];
        if (nloc == 0u) { xcd_barrier_complete(bar, b.x, nloc, nx); b.st[0] = nloc; b.st[1] = nx; }
        const unsigned old = xb_add(&bar[XB_XSUB(b.x)], 1u);
        const unsigned gen = old / nloc;
        if (old + 1u == (gen + 1u) * nloc) {
            __builtin_amdgcn_fence(__ATOMIC_RELEASE, "agent");
            asm volatile("s_waitcnt vmcnt(0)" ::: "memory");
            const unsigned og = xb_add(&bar[XB_TOP], 1u);
            const unsigned tg = og / nx;
            if (og + 1u == (tg + 1u) * nx) xb_add(&bar[XB_TOPGEN], 1u);
            else XB_SPIN(xb_ld(&bar[XB_TOPGEN]) == tg, bar);
            __builtin_amdgcn_fence(__ATOMIC_ACQUIRE, "agent");
            xb_add(&bar[XB_XGEN(b.x)], 1u);
            asm volatile("s_waitcnt vmcnt(0)" ::: "memory");
        } else {
            XB_SPIN(xb_ld(&bar[XB_XGEN(b.x)]) == gen, bar);
            __builtin_amdgcn_fence(__ATOMIC_ACQUIRE, "agent");
            asm volatile("s_waitcnt vmcnt(0)" ::: "memory");
        }
    }
    __syncthreads();
}

struct Frame {
    LAS unsigned char* lds;
    volatile LAS unsigned* MISC;
    gu32* ctl;
    int tid, lane, wave;
    int vcu, G;
    const float *x, *norm_attn, *w_in, *qna, *kna, *qnb, *knb, *sinks, *wba, *wbb, *w_out, *norm_mlp, *w_up, *w_down; float* out;
    bf16 *WinT, *WbrT, *WoT, *WupT, *WdnT;
    bf16 *Q, *KA, *VA, *KB, *VB, *GA, *GB, *HB, *A2, *XN;
    float *kmean, *rowsq;
};

__device__ __forceinline__ float wave_sum(float v) {
#pragma unroll
    for (int o = 1; o < 64; o <<= 1) v += __shfl_xor(v, o);
    return v;
}
__device__ __forceinline__ void p0_transpose_item(const float* W, int N, bf16* WT, int ldt, int koff, int prow0, LAS float* scr, int k0, int n0, int lane) {
#pragma unroll 8
    for (int i = 0; i < 32; ++i) { const int kk = 2 * i + (lane >> 5); scr[kk * 33 + (lane & 31)] = W[(size_t)(k0 + kk) * N + n0 + (lane & 31)]; }
    LDS_WAIT(); asm volatile("" ::: "memory");
    const int c = lane & 7;
#pragma unroll
    for (int j = 0; j < 4; ++j) { const int n = (lane >> 3) + 8 * j; const LAS float* s = scr + (8 * c) * 33 + n;
        v4u o; o.x = pk2(s[0 * 33], s[1 * 33]); o.y = pk2(s[2 * 33], s[3 * 33]); o.z = pk2(s[4 * 33], s[5 * 33]); o.w = pk2(s[6 * 33], s[7 * 33]);
        *(GAS v4u*)(WT + (size_t)(prow0 + n) * ldt + koff + k0 + 8 * c) = o; }
    LDS_WAIT(); asm volatile("" ::: "memory");
}
__device__ __forceinline__ void rms_row_to_bf16(const Frame& F, const float* xrow, const float* gain, bf16* orow) {
    const GAS f32x4* xr = (const GAS f32x4*)xrow + F.lane; const f32x4* gr = (const f32x4*)gain + F.lane;
    f32x4 v[4]; float s = 0.f;
#pragma unroll
    for (int j = 0; j < 4; ++j) { v[j] = xr[64 * j]; s += (v[j].x * v[j].x + v[j].y * v[j].y) + (v[j].z * v[j].z + v[j].w * v[j].w); }
    const float rs = 1.0f / sqrtf(wave_sum(s) * (1.f / DM) + EPS);
    GAS unsigned long long* o8 = (GAS unsigned long long*)orow + F.lane;
#pragma unroll
    for (int j = 0; j < 4; ++j) { const f32x4 g = gr[64 * j]; o8[64 * j] = (unsigned long long)pk2(v[j].x * rs * g.x, v[j].y * rs * g.y) | ((unsigned long long)pk2(v[j].z * rs * g.z, v[j].w * rs * g.w) << 32); }
}
__device__ __forceinline__ void p0_prologue(Frame& F) {
    LAS float* scr = (LAS float*)(F.lds + RING_OFF + F.wave * 16384);
    const int gw = F.vcu * NWAVES + F.wave, NGW = F.G * NWAVES;
    constexpr int I_IN = (DM / 64) * (NIN / 32), I_BR = (512 / 64) * (DM / 32), I_O = (DM / 64) * (DM / 32), I_UP = (DM / 64) * (FF / 32), I_DN = (FF / 64) * (DM / 32);
    constexpr int NITEMS = I_IN + 2 * I_BR + I_O + I_UP + I_DN;
    for (int it = gw; it < NITEMS; it += NGW) {
        int r = it;
        if (r < I_IN) { const int nblk = NIN / 32, kb = r / nblk, nb = r % nblk, n0 = 32 * nb, nt = n0 & 255;
            const int prow0 = (n0 & ~255) + 128 * ((nt >> 5) & 1) + 32 * (nt >> 6);
            p0_transpose_item(F.w_in, NIN, F.WinT, DM, 0, prow0, scr, 64 * kb, n0, F.lane); continue; } r -= I_IN;
        if (r < I_BR) { const int nblk = DM / 32, kb = r / nblk, nb = r % nblk; p0_transpose_item(F.wba, DM, F.WbrT, DM, 0, 32 * nb, scr, 64 * kb, 32 * nb, F.lane); continue; } r -= I_BR;
        if (r < I_BR) { const int nblk = DM / 32, kb = r / nblk, nb = r % nblk; p0_transpose_item(F.wbb, DM, F.WbrT, DM, 512, 32 * nb, scr, 64 * kb, 32 * nb, F.lane); continue; } r -= I_BR;
        if (r < I_O)  { const int nblk = DM / 32, kb = r / nblk, nb = r % nblk; p0_transpose_item(F.w_out, DM, F.WoT, DM, 0, 32 * nb, scr, 64 * kb, 32 * nb, F.lane); continue; } r -= I_O;
        if (r < I_UP) { const int nblk = FF / 32, kb = r / nblk, nb = r % nblk; p0_transpose_item(F.w_up, FF, F.WupT, DM, 0, 32 * nb, scr, 64 * kb, 32 * nb, F.lane); continue; } r -= I_UP;
        { const int nblk = DM / 32, kb = r / nblk, nb = r % nblk; p0_transpose_item(F.w_down, DM, F.WdnT, FF, 0, 32 * nb, scr, 64 * kb, 32 * nb, F.lane); }
    }
    for (int m = gw; m < M; m += NGW) rms_row_to_bf16(F, F.x + (size_t)m * DM, F.norm_attn, F.XN + (size_t)m * DM);
}
__device__ __forceinline__ void sa_load32(const bf16* p, float (&d)[32]) {
#pragma unroll
    for (int i = 0; i < 4; ++i) { const v4u w = *(const GAS v4u*)(p + 8 * i);
        d[8 * i + 0] = __uint_as_float(w.x << 16); d[8 * i + 1] = __uint_as_float(w.x & 0xffff0000u); d[8 * i + 2] = __uint_as_float(w.y << 16); d[8 * i + 3] = __uint_as_float(w.y & 0xffff0000u);
        d[8 * i + 4] = __uint_as_float(w.z << 16); d[8 * i + 5] = __uint_as_float(w.z & 0xffff0000u); d[8 * i + 6] = __uint_as_float(w.w << 16); d[8 * i + 7] = __uint_as_float(w.w & 0xffff0000u); }
}
__device__ __forceinline__ void sa_store32(bf16* p, const float (&o)[32], float sc) {
#pragma unroll
    for (int i = 0; i < 4; ++i) { v4u w; w.x = pk2(o[8 * i] * sc, o[8 * i + 1] * sc); w.y = pk2(o[8 * i + 2] * sc, o[8 * i + 3] * sc); w.z = pk2(o[8 * i + 4] * sc, o[8 * i + 5] * sc); w.w = pk2(o[8 * i + 6] * sc, o[8 * i + 7] * sc);
        *(GAS v4u*)(p + 8 * i) = w; }
}
#define SA_KEY(KPTR, VPTR, BIAS, VALID) do { \
    float s_ = 0.f; \
    { float kv_[32]; sa_load32((KPTR) + dof, kv_); \
        _Pragma("unroll") for (int d_ = 0; d_ < 32; ++d_) s_ = __builtin_fmaf(q[d_], kv_[d_], s_); asm volatile("" ::: "memory"); } \
    s_ += __shfl_xor(s_, 1); \
    s_ += (BIAS); const bool ok_ = (VALID); const float se_ = ok_ ? s_ : -1e30f; \
    if (__any(se_ > m)) { const float mn_ = __builtin_fmaxf(m, se_); const float c_ = __builtin_amdgcn_exp2f(m - mn_); l *= c_; _Pragma("unroll") for (int d_ = 0; d_ < 32; ++d_) o[d_] *= c_; m = mn_; } \
    const float p_ = ok_ ? __builtin_amdgcn_exp2f(s_ - m) : 0.f; l += p_; \
    { float kv_[32]; sa_load32((VPTR) + dof, kv_); \
        _Pragma("unroll") for (int d_ = 0; d_ < 32; ++d_) o[d_] = __builtin_fmaf(p_, kv_[d_], o[d_]); asm volatile("" ::: "memory"); } } while (0)

__device__ __forceinline__ void sa_moba(const bf16* Q, const bf16* KA, const bf16* VA, const float* kmean, bf16* O, int b, int h, int t0, int lane) {
    const int dof = 32 * (lane & 1);
    const int t = t0 + (lane >> 1), own = t0 >> 8;
    float q[32]; sa_load32(Q + ((size_t)(b * SEQ + t)) * 1024 + h * 64 + dof, q);
    unsigned sel;
    if (own <= 3) sel = (1u << own) - 1u;
    else {
        float gs[7];
#pragma unroll
        for (int n = 0; n < 7; ++n) { gs[n] = -INFINITY;
            if (n < own) { const float* km = kmean + ((size_t)(b * 8 + n) * 8 + h) * 64 + dof; float s = 0.f;
#pragma unroll
                for (int d = 0; d < 32; d += 4) { const f32x4 kv = *(const GAS f32x4*)(km + d); s = __builtin_fmaf(q[d], kv.x, s); s = __builtin_fmaf(q[d + 1], kv.y, s); s = __builtin_fmaf(q[d + 2], kv.z, s); s = __builtin_fmaf(q[d + 3], kv.w, s); }
                s += __shfl_xor(s, 1);
                gs[n] = s; asm volatile("" ::: "memory"); } }
        sel = 0u;
#pragma unroll
        for (int n = 0; n < 7; ++n) { int rank = 0;
#pragma unroll
            for (int j = 0; j < 7; ++j) if (j != n) rank += (gs[j] > gs[n] || (gs[j] == gs[n] && j < n)) ? 1 : 0;
            if (n < own && rank < 3) sel |= 1u << n; }
    }
    const float slope2 = exp2f(-0.5f * (float)(h + 9)) * pg8::kLog2e;
    float m = -1e30f, l = 0.f, o[32];
#pragma unroll
    for (int d = 0; d < 32; ++d) o[d] = 0.f;
    for (int n = 0; n <= own; ++n) {
        const bool isown = (n == own), mine = isown || ((sel >> n) & 1u);
        if (!__any(mine)) continue;
        const int nk = isown ? (t0 + 32 - n * 256) : 256;
        for (int kk = 0; kk < nk; ++kk) { const int tk = n * 256 + kk; const size_t r = (size_t)(b * SEQ + tk) * 512 + h * 64;
            SA_KEY(KA + r, VA + r, -slope2 * (float)(t - tk), mine && (tk <= t)); }
    }
    sa_store32(O + ((size_t)(b * SEQ + t)) * 1024 + h * 64 + dof, o, 1.0f / l);
}
__device__ __forceinline__ void sa_swa(const bf16* Q, const bf16* KB, const bf16* VB, const float* sinks, bf16* O, int b, int hq, int t0, int lane) {
    const int dof = 32 * (lane & 1);
    const int t = t0 + (lane >> 1), kvh = hq >> 2;
    float q[32]; sa_load32(Q + ((size_t)(b * SEQ + t)) * 1024 + 512 + hq * 64 + dof, q);
    const float slope2 = exp2f(-0.5f * (float)(hq + 1)) * pg8::kLog2e, sink2 = sinks[hq] * pg8::kLog2e;
    float m = -1e30f, l = 0.f, o[32];
#pragma unroll
    for (int d = 0; d < 32; ++d) o[d] = 0.f;
    const int k0 = t0 - 127 > 0 ? t0 - 127 : 0;
    for (int tk = k0; tk < t0 + 32; ++tk) { const size_t r = (size_t)(b * SEQ + tk) * 128 + kvh * 64;
        SA_KEY(KB + r, VB + r, -slope2 * (float)(t - tk), (tk <= t) && (t - tk < 128)); }
    const float mf = __builtin_fmaxf(m, sink2), c = __builtin_amdgcn_exp2f(m - mf);
    l = l * c + __builtin_amdgcn_exp2f(sink2 - mf);
    sa_store32(O + ((size_t)(b * SEQ + t)) * 1024 + 512 + hq * 64 + dof, o, c / l);
}
__device__ __forceinline__ void attn_simple_phase(Frame& F) {
    const int gw = F.vcu * NWAVES + F.wave, NGW = F.G * NWAVES;
    int i = 0;
    for (int u = gw; u < 8192; u += NGW, ++i) { const int b = u >> 9, h = (u >> 6) & 7; int ch = u & 63; if (i & 1) ch = 63 - ch;
        sa_moba(F.Q, F.KA, F.VA, F.kmean, F.Q, b, h, ch * 32, F.lane); }
    for (int u = gw; u < 8192; u += NGW) { const int b = u >> 9, hq = (u >> 6) & 7, ch = u & 63;
        sa_swa(F.Q, F.KB, F.VB, F.sinks, F.Q, b, hq, ch * 32, F.lane); }
}

struct Args { const float* in[14]; float* out; unsigned char* ws; };
__global__ void __launch_bounds__(NWAVES * 64, 2) fwd_megakernel(Args args) {
    extern __shared__ __attribute__((aligned(16))) unsigned char lds[];
    Frame F;
    F.lds = (LAS unsigned char*)lds;
    F.MISC = (volatile LAS unsigned*)(F.lds + MISC_OFF);
    F.tid = threadIdx.x; F.lane = F.tid & 63; F.wave = __builtin_amdgcn_readfirstlane(F.tid >> 6);
    F.G = gridDim.x; { const int bx = blockIdx.x; F.vcu = (F.G % 8 == 0) ? (bx % 8) * (F.G / 8) + bx / 8 : bx; }
    unsigned char* ws = args.ws;
    F.ctl = (gu32*)(ws + WS_CTL);
    F.x = args.in[0]; F.norm_attn = args.in[1]; F.w_in = args.in[2]; F.qna = args.in[3]; F.kna = args.in[4]; F.qnb = args.in[5]; F.knb = args.in[6]; F.sinks = args.in[7];
    F.wba = args.in[8]; F.wbb = args.in[9]; F.w_out = args.in[10]; F.norm_mlp = args.in[11]; F.w_up = args.in[12]; F.w_down = args.in[13]; F.out = args.out;
    F.WinT = (bf16*)(ws + WS_WIN); F.WbrT = (bf16*)(ws + WS_WBR); F.WoT = (bf16*)(ws + WS_WO); F.WupT = (bf16*)(ws + WS_WUP); F.WdnT = (bf16*)(ws + WS_WDN);
    F.Q = (bf16*)(ws + WS_Q); F.KA = (bf16*)(ws + WS_KA); F.VA = (bf16*)(ws + WS_VA); F.KB = (bf16*)(ws + WS_KB); F.VB = (bf16*)(ws + WS_VB);
    F.GA = (bf16*)(ws + WS_GA); F.GB = (bf16*)(ws + WS_GB); F.HB = (bf16*)(ws + WS_H); F.A2 = (bf16*)(ws + WS_A2); F.XN = (bf16*)(ws + WS_XN);
    F.kmean = (float*)(ws + WS_CTL) + CW_KMEAN; F.rowsq = (float*)(ws + WS_CTL) + CW_ROWSQ;
    for (int u = F.tid; u < (LDS_BYTES - LDSCTL_OFF) / 4; u += NWAVES * 64) ((LAS unsigned*)(F.lds + LDSCTL_OFF))[u] = 0u;
    __syncthreads();
    XcdBarrier bar = xcd_barrier_post((unsigned*)(F.ctl + CW_BAR), F.MISC + 8);
#define GRID_BAR() xcd_barrier(bar)

#ifndef SKIP_P0
    p0_prologue(F);
#endif
    GRID_BAR();
#ifndef SKIP_P1
    {   pg8::Gemm g{F.XN, F.WinT, M, NIN, DM}; pg8::StaticOrder S; S.init(M, NIN, F.G, (int)blockIdx.x);
        pg8::EpiIn E{F.Q, F.KA, F.VA, F.KB, F.VB, F.GA, F.GB, F.qna, F.kna, F.qnb, F.knb, F.kmean};
        pg8::gemm_phase<pg8::EpiIn, pg8::StaticOrder, true, true>(F.lds + RING_OFF, g, S, E); }
#endif
    GRID_BAR();
#ifndef SKIP_P2
    attn_simple_phase(F);
#endif
    GRID_BAR();
#ifndef SKIP_P3
    {   pg8::Gemm g{F.Q, F.WbrT, M, DM, DM}; pg8::StaticOrder S; S.init(M, DM, F.G, (int)blockIdx.x);
        pg8::EpiMix E{F.GA, F.GB, F.XN};
        pg8::gemm_phase<pg8::EpiMix, pg8::StaticOrder, true, true>(F.lds + RING_OFF, g, S, E); }
#endif
    GRID_BAR();
#ifndef SKIP_P4
    {   pg8::Gemm g{F.XN, F.WoT, M, DM, DM}; pg8::StaticOrder S; S.init(M, DM, F.G, (int)blockIdx.x);
        pg8::EpiX1 E{F.x, F.out, F.A2, F.norm_mlp, F.rowsq};
        pg8::gemm_phase<pg8::EpiX1, pg8::StaticOrder, true, true>(F.lds + RING_OFF, g, S, E); }
#endif
    GRID_BAR();
#ifndef SKIP_P5
    {   pg8::Gemm g{F.A2, F.WupT, M, FF, DM}; pg8::StaticOrder S; S.init(M, FF, F.G, (int)blockIdx.x);
        pg8::EpiUp E{F.HB, F.rowsq};
        pg8::gemm_phase<pg8::EpiUp, pg8::StaticOrder, true, true>(F.lds + RING_OFF, g, S, E); }
#endif
    GRID_BAR();
#ifndef SKIP_P6
    {   pg8::Gemm g{F.HB, F.WdnT, M, DM, FF}; pg8::StaticOrder S; S.init(M, DM, F.G, (int)blockIdx.x);
        pg8::EpiDown E{F.out};
        pg8::gemm_phase<pg8::EpiDown, pg8::StaticOrder, true, true>(F.lds + RING_OFF, g, S, E); }
#endif
}

extern "C" void kernel_launch(void* const* d_in, const int* in_sizes, int n_in, void* d_out, int out_size, void* d_ws, size_t ws_size, hipStream_t stream) {
    static int grid = 0;
    if (grid == 0) {
        if (n_in != 14 || in_sizes[0] != M * DM || out_size != M * DM || ws_size < WS_END) { fprintf(stderr, "kernel_launch: unexpected shapes: n_in %d, in0 %d, out %d, ws %zu (need %zu); nothing launched\n", n_in, n_in > 0 ? in_sizes[0] : -1, out_size, ws_size, (size_t)WS_END); grid = -1; return; }
        int dev = 0, cus = 0, per_cu = 0;
        if (hipGetDevice(&dev) != hipSuccess || hipDeviceGetAttribute(&cus, hipDeviceAttributeMultiprocessorCount, dev) != hipSuccess) { fprintf(stderr, "kernel_launch: device query failed\n"); grid = -1; return; }
        if (hipFuncSetAttribute((const void*)fwd_megakernel, hipFuncAttributeMaxDynamicSharedMemorySize, LDS_BYTES) != hipSuccess) { fprintf(stderr, "kernel_launch: hipFuncSetAttribute failed\n"); grid = -1; return; }
        if (hipOccupancyMaxActiveBlocksPerMultiprocessor(&per_cu, (const void*)fwd_megakernel, NWAVES * 64, LDS_BYTES) != hipSuccess || per_cu < 1)
            fprintf(stderr, "kernel_launch: note: occupancy query reports %d workgroups per CU\n", per_cu);
        (void)hipGetLastError();
        grid = cus;
    }
    if (grid < 0) return;
    if (hipMemsetAsync((char*)d_ws + WS_CTL, 0, CTL_ZERO_BYTES, stream) != hipSuccess) { fprintf(stderr, "kernel_launch: hipMemsetAsync failed\n"); return; }
    Args a{};
    for (int i = 0; i < 14; ++i) a.in[i] = (const float*)d_in[i];
    a.out = (float*)d_out; a.ws = (unsigned char*)d_ws;
    hipLaunchKernelGGL(fwd_megakernel, dim3(grid), dim3(NWAVES * 64), LDS_BYTES, stream, a);
    const hipError_t le = hipPeekAtLastError();
    if (le != hipSuccess) fprintf(stderr, "kernel_launch: launch failed: %s\n", hipGetErrorName(le));
}
```

```cpp
#include <hip/hip_runtime.h>
#include <cstdio>
#include <cstdint>
namespace pg8 {
#define PG8_LAS __attribute__((address_space(3)))
typedef unsigned short bf16_t;
typedef short bf16x8 __attribute__((ext_vector_type(8)));
typedef float f32x4 __attribute__((ext_vector_type(4)));
typedef unsigned u32x4 __attribute__((ext_vector_type(4)));
constexpr int BM = 256, BK = 64, HALF = 128, HTB = HALF * BK * 2  , STAGE_BYTES = 8 * HTB, NXCD = 8, WGM = 8;

__host__ __device__ __forceinline__ int lds_byte(int r, int c) { const int st = (r >> 4) * 2 + (c >> 5), rr = r & 15, cc = c & 31, ob = rr * 64 + cc * 2; return st * 1024 + (ob ^ (((ob >> 9) & 1) << 5)); }
__host__ __device__ __forceinline__ void stage_rc(int b, int& R, int& C) { const int st = b / 1024, sb = b % 1024, swz = sb ^ (((sb >> 9) & 1) << 5); R = (st >> 1) * 16 + swz / 64; C = (st & 1) * 32 + (swz % 64) / 2; }
__host__ __device__ __forceinline__ int perm32(int rho) { const int n = rho >> 4, i = rho & 15; return 8 * (i >> 2) + 4 * n + (i & 3); }

struct Unit { int pm, pn; };
struct Gemm { const bf16_t* A; const bf16_t* Bt; int M, N, K; };

struct StaticOrder {
    int nM, nN, nwg, G, c;
    __host__ __device__ void init(int M, int N, int G_, int c_) { nM = M / BM; nN = N / BM; nwg = nM * nN; G = G_; c = c_; }
    __host__ __device__ bool next(int i, Unit& u) const {
        const long L = (long)i * G + c; if (L >= nwg) return false;
        int wgid = (int)L; { const int q = nwg / NXCD, r = nwg % NXCD, xcd = wgid % NXCD, off = wgid / NXCD; wgid = (xcd < r ? xcd * (q + 1) : r * (q + 1) + (xcd - r) * q) + off; }
        const int nig = WGM * nN, gid = wgid / nig, fm = gid * WGM, gsz = (nM - fm) < WGM ? (nM - fm) : WGM;
        u.pm = fm + ((wgid % nig) % gsz); u.pn = (wgid % nig) / gsz; return true;
    }
    __device__ __forceinline__ void a_ready(const Unit&) const {}
    __device__ __forceinline__ void done(const Unit&) const {}
};

__device__ __forceinline__ unsigned cvt_pk_bf16(float lo, float hi) { unsigned r; asm volatile("v_cvt_pk_bf16_f32 %0, %1, %2" : "=v"(r) : "v"(lo), "v"(hi)); return r; }
typedef unsigned u32x2 __attribute__((ext_vector_type(2)));
__device__ __forceinline__ float bf_lo(unsigned w) { return __uint_as_float(w << 16); }
__device__ __forceinline__ float bf_hi(unsigned w) { return __uint_as_float(w & 0xffff0000u); }
constexpr float kLog2e = 1.4426950408889634f;
constexpr float kC2 = 0.125f * 1.4426950408889634f;

struct EpiIn {
    static constexpr bool PERM = true, AFTER_DRAIN = false; static constexpr int MID_TILE = 0;
    bf16_t *Q, *KA, *VA, *KB, *VB, *GA, *GB; const float *qna, *kna, *qnb, *knb; float* kmean;
    __device__ __forceinline__ void mid(f32x4 (&)[2][2][4][2], const Unit&, int, int, int, int) const {}
    __device__ __forceinline__ void operator()(const f32x4 (&acc)[2][2][4][2], const Unit& u, int wr, int wc, int fr, int fq) const {
        const int pn = u.pn;
        bf16_t* dst; int pitch; bool norm = false, sig = false, km = false; float scale = 1.f; const float* gain = qna;
        if (pn < 2)       { dst = Q + (4 * pn + wc) * 64; pitch = 1024; norm = true; gain = qna; scale = kC2; }
        else if (pn < 4)  { dst = KA + (4 * (pn - 2) + wc) * 64; pitch = 512; norm = true; gain = kna; km = true; }
        else if (pn < 6)  { dst = VA + (4 * (pn - 4) + wc) * 64; pitch = 512; }
        else if (pn < 8)  { dst = Q + 512 + (4 * (pn - 6) + wc) * 64; pitch = 1024; norm = true; gain = qnb; scale = kC2; }
        else if (pn == 8) { pitch = 128; if (wc < 2) { dst = KB + wc * 64; norm = true; gain = knb; } else { dst = VB + (wc - 2) * 64; } }
        else if (pn < 13) { dst = GA + (pn - 9) * 256 + wc * 64; pitch = 1024; sig = true; }
        else              { dst = GB + (pn - 13) * 256 + wc * 64; pitch = 1024; sig = true; }
        const int rowb = u.pm * BM + wr * 64 + fr;
        f32x4 g[2][2], cs[2][2];
#pragma unroll
        for (int bj = 0; bj < 2; ++bj)
#pragma unroll
            for (int n = 0; n < 2; ++n) { g[bj][n] = norm ? *(const f32x4*)(gain + 32 * bj + 8 * fq + 4 * n) : (f32x4){1.f, 1.f, 1.f, 1.f}; cs[bj][n] = (f32x4){0.f, 0.f, 0.f, 0.f}; }
#pragma unroll
        for (int ai = 0; ai < 2; ++ai)
#pragma unroll
            for (int m = 0; m < 4; ++m) {
                const int row = rowb + ai * HALF + m * 16;
                f32x4 v[2][2];
#pragma unroll
                for (int bj = 0; bj < 2; ++bj)
#pragma unroll
                    for (int n = 0; n < 2; ++n) v[bj][n] = acc[ai][bj][m][n];
                if (norm) {
                    float ss = 0.f;
#pragma unroll
                    for (int bj = 0; bj < 2; ++bj)
#pragma unroll
                        for (int n = 0; n < 2; ++n) { const f32x4 x = v[bj][n]; ss += (x[0] * x[0] + x[1] * x[1]) + (x[2] * x[2] + x[3] * x[3]); }
                    ss += __shfl_xor(ss, 16); ss += __shfl_xor(ss, 32);
                    const float rs = __builtin_amdgcn_rsqf(ss * (1.0f / 64.0f) + 1e-6f) * scale;
#pragma unroll
                    for (int bj = 0; bj < 2; ++bj)
#pragma unroll
                        for (int n = 0; n < 2; ++n) v[bj][n] = v[bj][n] * rs * g[bj][n];
                } else if (sig) {
#pragma unroll
                    for (int bj = 0; bj < 2; ++bj)
#pragma unroll
                        for (int n = 0; n < 2; ++n)
#pragma unroll
                            for (int e = 0; e < 4; ++e) v[bj][n][e] = __builtin_fmaxf(__builtin_amdgcn_rcpf(1.0f + __builtin_amdgcn_exp2f(-kLog2e * v[bj][n][e])), 1e-20f);
                }
                if (km) {
#pragma unroll
                    for (int bj = 0; bj < 2; ++bj)
#pragma unroll
                        for (int n = 0; n < 2; ++n) cs[bj][n] += v[bj][n];
                }
#pragma unroll
                for (int bj = 0; bj < 2; ++bj) {
                    u32x4 w; w.x = cvt_pk_bf16(v[bj][0][0], v[bj][0][1]); w.y = cvt_pk_bf16(v[bj][0][2], v[bj][0][3]); w.z = cvt_pk_bf16(v[bj][1][0], v[bj][1][1]); w.w = cvt_pk_bf16(v[bj][1][2], v[bj][1][3]);
                    *(u32x4*)(dst + (size_t)row * pitch + 32 * bj + 8 * fq) = w;
                }
            }
        if (km) {
            float* kmp = kmean + ((size_t)u.pm * 8 + (4 * (pn - 2) + wc)) * 64;
#pragma unroll
            for (int bj = 0; bj < 2; ++bj)
#pragma unroll
                for (int n = 0; n < 2; ++n)
#pragma unroll
                    for (int e = 0; e < 4; ++e) {
                        float s = cs[bj][n][e];
                        s += __shfl_xor(s, 1); s += __shfl_xor(s, 2); s += __shfl_xor(s, 4); s += __shfl_xor(s, 8);
                        if (fr == 0) atomicAdd(kmp + 32 * bj + 8 * fq + 4 * n + e, s * (1.0f / 256.0f));
                    }
        }
    }
};

struct EpiMix {
    static constexpr bool PERM = true, AFTER_DRAIN = false; static constexpr int MID_TILE = 8;
    const bf16_t *GA, *GB; bf16_t* MIX;
    __device__ __forceinline__ void mid(f32x4 (&acc)[2][2][4][2], const Unit& u, int wr, int wc, int fr, int fq) const {
        int rowb = u.pm * BM + wr * 64 + fr, col0 = u.pn * BM + wc * 32 + 8 * fq;
        asm volatile("" : "+v"(rowb), "+v"(col0));
#pragma unroll
        for (int ai = 0; ai < 2; ++ai)
#pragma unroll
            for (int m = 0; m < 4; ++m) { const size_t off = (size_t)(rowb + ai * HALF + m * 16) * 1024 + col0;
#pragma unroll
                for (int bj = 0; bj < 2; ++bj) {
                    const u32x4 a = *(const u32x4*)(GA + off + bj * HALF), b = *(const u32x4*)(GB + off + bj * HALF);
                    f32x4 r0, r1;
                    r0[0] = bf_lo(a.x) * __builtin_amdgcn_rcpf(bf_lo(b.x)); r0[1] = bf_hi(a.x) * __builtin_amdgcn_rcpf(bf_hi(b.x));
                    r0[2] = bf_lo(a.y) * __builtin_amdgcn_rcpf(bf_lo(b.y)); r0[3] = bf_hi(a.y) * __builtin_amdgcn_rcpf(bf_hi(b.y));
                    r1[0] = bf_lo(a.z) * __builtin_amdgcn_rcpf(bf_lo(b.z)); r1[1] = bf_hi(a.z) * __builtin_amdgcn_rcpf(bf_hi(b.z));
                    r1[2] = bf_lo(a.w) * __builtin_amdgcn_rcpf(bf_lo(b.w)); r1[3] = bf_hi(a.w) * __builtin_amdgcn_rcpf(bf_hi(b.w));
                    acc[ai][bj][m][0] *= r0; acc[ai][bj][m][1] *= r1;
                    asm volatile("" ::: "memory");
                } }
    }
    __device__ __forceinline__ void operator()(const f32x4 (&acc)[2][2][4][2], const Unit& u, int wr, int wc, int fr, int fq) const {
        const int rowb = u.pm * BM + wr * 64 + fr, col0 = u.pn * BM + wc * 32 + 8 * fq;
#pragma unroll
        for (int ai = 0; ai < 2; ++ai)
#pragma unroll
            for (int m = 0; m < 4; ++m) { const size_t off = (size_t)(rowb + ai * HALF + m * 16) * 1024 + col0;
#pragma unroll
                for (int bj = 0; bj < 2; ++bj) {
                    const u32x4 b = *(const u32x4*)(GB + off + bj * HALF);
                    const f32x4 v0 = acc[ai][bj][m][0], v1 = acc[ai][bj][m][1];
                    u32x4 w; w.x = cvt_pk_bf16(v0[0] * bf_lo(b.x), v0[1] * bf_hi(b.x)); w.y = cvt_pk_bf16(v0[2] * bf_lo(b.y), v0[3] * bf_hi(b.y));
                    w.z = cvt_pk_bf16(v1[0] * bf_lo(b.z), v1[1] * bf_hi(b.z)); w.w = cvt_pk_bf16(v1[2] * bf_lo(b.w), v1[3] * bf_hi(b.w));
                    *(u32x4*)(MIX + off + bj * HALF) = w;
                }
                if (m & 1) asm volatile("" ::: "memory"); }
    }
};

struct EpiX1 {
    static constexpr bool PERM = false, AFTER_DRAIN = false; static constexpr int MID_TILE = 0;
    const float* x; float* out; bf16_t* A2; const float* g2; float* rowsq;
    __device__ __forceinline__ void mid(f32x4 (&)[2][2][4][2], const Unit&, int, int, int, int) const {}
    __device__ __forceinline__ void operator()(const f32x4 (&acc)[2][2][4][2], const Unit& u, int wr, int wc, int fr, int fq) const {
        const int rowb = u.pm * BM + wr * 64 + fr, col0 = u.pn * BM + wc * 32 + 4 * fq;
        f32x4 gv[2][2];
#pragma unroll
        for (int bj = 0; bj < 2; ++bj)
#pragma unroll
            for (int n = 0; n < 2; ++n) gv[bj][n] = *(const f32x4*)(g2 + col0 + bj * HALF + n * 16);
#pragma unroll
        for (int ai = 0; ai < 2; ++ai)
#pragma unroll
            for (int m = 0; m < 4; ++m) { const int row = rowb + ai * HALF + m * 16; const size_t off = (size_t)row * 1024 + col0; float ss = 0.f;
#pragma unroll
                for (int bj = 0; bj < 2; ++bj)
#pragma unroll
                    for (int n = 0; n < 2; ++n) {
                        const f32x4 x1 = *(const f32x4*)(x + off + bj * HALF + n * 16) + acc[ai][bj][m][n];
                        *(f32x4*)(out + off + bj * HALF + n * 16) = x1;
                        ss += (x1[0] * x1[0] + x1[1] * x1[1]) + (x1[2] * x1[2] + x1[3] * x1[3]);
                        const f32x4 a = x1 * gv[bj][n]; u32x2 w; w.x = cvt_pk_bf16(a[0], a[1]); w.y = cvt_pk_bf16(a[2], a[3]);
                        *(u32x2*)(A2 + off + bj * HALF + n * 16) = w;
                    }
                ss += __shfl_xor(ss, 16); ss += __shfl_xor(ss, 32);
                if (fq == 0) atomicAdd(rowsq + row, ss);
                if (m & 1) asm volatile("" ::: "memory"); }
    }
};

struct EpiUp {
    static constexpr bool PERM = true, AFTER_DRAIN = false; static constexpr int MID_TILE = 0;
    bf16_t* H; const float* rowsq;
    __device__ __forceinline__ void mid(f32x4 (&)[2][2][4][2], const Unit&, int, int, int, int) const {}
    __device__ __forceinline__ void operator()(const f32x4 (&acc)[2][2][4][2], const Unit& u, int wr, int wc, int fr, int fq) const {
        const int rowb = u.pm * BM + wr * 64 + fr, col0 = u.pn * BM + wc * 32 + 8 * fq;
#pragma unroll
        for (int ai = 0; ai < 2; ++ai)
#pragma unroll
            for (int m = 0; m < 4; ++m) { const int row = rowb + ai * HALF + m * 16;
                const float r = __builtin_amdgcn_rsqf(rowsq[row] * (1.0f / 1024.0f) + 1e-6f);
                bf16_t* rowp = H + (size_t)row * 4096 + col0;
#pragma unroll
                for (int bj = 0; bj < 2; ++bj) {
                    f32x4 v0 = acc[ai][bj][m][0] * r, v1 = acc[ai][bj][m][1] * r;
#pragma unroll
                    for (int e = 0; e < 4; ++e) { const float a = __builtin_fmaxf(v0[e], 0.f), b = __builtin_fmaxf(v1[e], 0.f); v0[e] = a * a; v1[e] = b * b; }
                    u32x4 w; w.x = cvt_pk_bf16(v0[0], v0[1]); w.y = cvt_pk_bf16(v0[2], v0[3]); w.z = cvt_pk_bf16(v1[0], v1[1]); w.w = cvt_pk_bf16(v1[2], v1[3]);
                    *(u32x4*)(rowp + bj * HALF) = w;
                } }
    }
};

struct EpiDown {
    static constexpr bool PERM = false, AFTER_DRAIN = false; static constexpr int MID_TILE = 0;
    float* out; float mul;
    __device__ __forceinline__ void mid(f32x4 (&)[2][2][4][2], const Unit&, int, int, int, int) const {}
    __device__ __forceinline__ void operator()(const f32x4 (&acc)[2][2][4][2], const Unit& u, int wr, int wc, int fr, int fq) const {
        const int rowb = u.pm * BM + wr * 64 + fr, col0 = u.pn * BM + wc * 32 + 4 * fq;
#pragma unroll
        for (int ai = 0; ai < 2; ++ai)
#pragma unroll
            for (int m = 0; m < 4; ++m) { float* rowp = out + (size_t)(rowb + ai * HALF + m * 16) * 1024 + col0;
#pragma unroll
                for (int bj = 0; bj < 2; ++bj)
#pragma unroll
                    for (int n = 0; n < 2; ++n) { float* p = rowp + bj * HALF + n * 16; *(f32x4*)p = (*(const f32x4*)p + acc[ai][bj][m][n]) * mul; }
                if (m & 1) asm volatile("" ::: "memory"); }
    }
};

template <class Epi, class Sched, bool ALIGN_EPI = false, bool SP2 = false>
__device__ __forceinline__ void gemm_phase(PG8_LAS unsigned char* lds, const Gemm g, const Sched& S, const Epi& E) {
    const int tid = threadIdx.x, wid = __builtin_amdgcn_readfirstlane(tid >> 6), lane = tid & 63, wr = wid >> 2, wc = wid & 3, fr = lane & 15, fq = lane >> 4;
    const int K = g.K, nt = K / BK;
    unsigned voffA[2], voffB[2];
#pragma unroll
    for (int i = 0; i < 2; ++i) { int R, C; stage_rc(tid * 16 + i * 8192, R, C); const int Rb = Epi::PERM ? ((R & ~31) + perm32(R & 31)) : R;
        voffA[i] = (unsigned)(R * K + C) * 2u; voffB[i] = (unsigned)(Rb * K + C) * 2u; }
    const size_t kstep = (size_t)(BK * 2);
    const size_t hstep = (size_t)HALF * K * 2;
    const size_t tstep = 2 * hstep;
    const unsigned ldsw = (unsigned)wid * 1024u;
    const int aoff = lds_byte(wr * 64 + fr, fq * 8), boff = lds_byte(wc * 32 + fr, fq * 8);
#define PG8_SA(b, h) (((b) * 2 + (h)) * HTB)
#define PG8_SB(b, h) ((4 + (b) * 2 + (h)) * HTB)
#define PG8_STAGE(bufoff, gbase, voff) do { _Pragma("unroll") for (int _i = 0; _i < 2; ++_i) \
        __builtin_amdgcn_global_load_lds((const unsigned*)((const char*)(gbase) + (voff)[_i]), (PG8_LAS unsigned*)(lds + (bufoff) + ldsw + _i * 8192), 16, 0, 0); } while (0)
#define PG8_LDA(dst, b, h) do { _Pragma("unroll") for (int m = 0; m < 4; ++m) _Pragma("unroll") for (int k = 0; k < 2; ++k) dst[m][k] = *(const PG8_LAS bf16x8*)(lds + PG8_SA(b, h) + aoff + m * 2048 + k * 1024); } while (0)
#define PG8_LDB(dst, b, h) do { _Pragma("unroll") for (int n = 0; n < 2; ++n) _Pragma("unroll") for (int k = 0; k < 2; ++k) dst[n][k] = *(const PG8_LAS bf16x8*)(lds + PG8_SB(b, h) + boff + n * 2048 + k * 1024); } while (0)
#define PG8_MMA(ai, bj, At, Bt) do { __builtin_amdgcn_s_setprio(1); _Pragma("unroll") for (int m = 0; m < 4; ++m) _Pragma("unroll") for (int n = 0; n < 2; ++n) _Pragma("unroll") for (int k = 0; k < 2; ++k) \
        acc[ai][bj][m][n] = __builtin_amdgcn_mfma_f32_16x16x32_bf16(Bt[n][k], At[m][k], acc[ai][bj][m][n], 0, 0, 0); __builtin_amdgcn_s_setprio(0); } while (0)
#define PG8_WAIT_V(n) asm volatile("s_waitcnt vmcnt(" #n ")" ::: "memory")
#define PG8_WAIT_L(n) asm volatile("s_waitcnt lgkmcnt(" #n ")" ::: "memory")
#define PG8_BAR __builtin_amdgcn_s_barrier()
#define PG8_SCHED __builtin_amdgcn_sched_barrier(0)
    Unit cur, nxt; int ui = 0;
    if (!S.next(0, cur)) return;
    f32x4 acc[2][2][4][2];
#pragma unroll
    for (int a = 0; a < 2; ++a)
#pragma unroll
        for (int b = 0; b < 2; ++b)
#pragma unroll
            for (int m = 0; m < 4; ++m)
#pragma unroll
                for (int n = 0; n < 2; ++n) acc[a][b][m][n] = (f32x4){0.f, 0.f, 0.f, 0.f};
    bf16x8 At[4][2], B0[2][2], B1[2][2];
    const char* cA = (const char*)g.A + (size_t)cur.pm * tstep; const char* cB = (const char*)g.Bt + (size_t)cur.pn * tstep;
    S.a_ready(cur);
    if constexpr (SP2) {
        PG8_STAGE(PG8_SB(0, 0), cB, voffB); PG8_STAGE(PG8_SB(0, 1), cB + hstep, voffB); PG8_STAGE(PG8_SA(0, 0), cA, voffA); PG8_STAGE(PG8_SA(0, 1), cA + hstep, voffA);
        if (wr == 1) PG8_BAR;
        PG8_WAIT_V(2); PG8_BAR;
        PG8_STAGE(PG8_SB(1, 0), cB + kstep, voffB); PG8_STAGE(PG8_SA(1, 0), cA + kstep, voffA); PG8_STAGE(PG8_SB(1, 1), cB + hstep + kstep, voffB);
        PG8_WAIT_V(6); PG8_BAR;
    } else {
        PG8_STAGE(PG8_SB(0, 0), cB, voffB); PG8_STAGE(PG8_SA(0, 0), cA, voffA); PG8_STAGE(PG8_SB(0, 1), cB + hstep, voffB); PG8_STAGE(PG8_SA(0, 1), cA + hstep, voffA);
        if (wr == 1) PG8_BAR;
        PG8_WAIT_V(4); PG8_BAR;
        PG8_STAGE(PG8_SB(1, 0), cB + kstep, voffB); PG8_STAGE(PG8_SA(1, 0), cA + kstep, voffA); PG8_STAGE(PG8_SB(1, 1), cB + hstep + kstep, voffB);
        PG8_WAIT_V(6); PG8_BAR;
    }
    for (;;) {
        const bool has_next = S.next(ui + 1, nxt);
        const char* nA = has_next ? (const char*)g.A + (size_t)nxt.pm * tstep : cA; const char* nB = has_next ? (const char*)g.Bt + (size_t)nxt.pn * tstep : cB;
        for (int t = 0; t < nt; t += 2) {
            if constexpr (Epi::MID_TILE > 0) { if (t == Epi::MID_TILE) { PG8_SCHED; E.mid(acc, cur, wr, wc, fr, fq); PG8_SCHED; } }
            const bool last = (t == nt - 2);
            const char* a1 = cA + (size_t)(t + 1) * kstep;
            const char* a2 = last ? nA : cA + (size_t)(t + 2) * kstep; const char* b2 = last ? nB : cB + (size_t)(t + 2) * kstep;
            const char* a3 = a2 + kstep; const char* b3 = b2 + kstep;
            if (last && has_next) S.a_ready(nxt);
            if constexpr (SP2) {
            PG8_LDB(B0, 0, 0); PG8_LDB(B1, 0, 1); PG8_SCHED; PG8_LDA(At, 0, 0); PG8_STAGE(PG8_SA(1, 1), a1 + hstep, voffA);
            PG8_WAIT_V(8); PG8_WAIT_L(0); PG8_BAR; PG8_MMA(0, 0, At, B0); PG8_MMA(0, 1, At, B1); PG8_BAR; PG8_SCHED;
            PG8_LDA(At, 0, 1); PG8_STAGE(PG8_SB(0, 0), b2, voffB); PG8_STAGE(PG8_SB(0, 1), b2 + hstep, voffB); PG8_STAGE(PG8_SA(0, 0), a2, voffA);
            PG8_WAIT_V(8); PG8_WAIT_L(0); PG8_BAR; PG8_MMA(1, 0, At, B0); PG8_MMA(1, 1, At, B1); PG8_BAR; PG8_SCHED;
            PG8_LDB(B0, 1, 0); PG8_LDB(B1, 1, 1); PG8_SCHED; PG8_LDA(At, 1, 0); PG8_STAGE(PG8_SA(0, 1), a2 + hstep, voffA);
            PG8_WAIT_V(8); PG8_WAIT_L(0); PG8_BAR; PG8_MMA(0, 0, At, B0); PG8_MMA(0, 1, At, B1); PG8_BAR; PG8_SCHED;
            PG8_LDA(At, 1, 1); PG8_STAGE(PG8_SB(1, 0), b3, voffB); PG8_STAGE(PG8_SB(1, 1), b3 + hstep, voffB); PG8_STAGE(PG8_SA(1, 0), a3, voffA);
            PG8_WAIT_V(8); PG8_WAIT_L(0); PG8_BAR; PG8_MMA(1, 0, At, B0); PG8_MMA(1, 1, At, B1); PG8_BAR; PG8_SCHED;
            } else {
            PG8_LDB(B0, 0, 0); PG8_SCHED; PG8_LDA(At, 0, 0); PG8_STAGE(PG8_SA(1, 1), a1 + hstep, voffA);
            PG8_WAIT_L(8); PG8_BAR; PG8_WAIT_L(0); PG8_MMA(0, 0, At, B0); PG8_BAR; PG8_SCHED;
            PG8_LDB(B1, 0, 1); PG8_STAGE(PG8_SB(0, 0), b2, voffB);
            PG8_BAR; PG8_WAIT_L(0); PG8_MMA(0, 1, At, B1); PG8_BAR;
            PG8_LDA(At, 0, 1); PG8_STAGE(PG8_SA(0, 0), a2, voffA);
            PG8_BAR; PG8_WAIT_L(0); PG8_MMA(1, 0, At, B0); PG8_BAR; PG8_SCHED;
            PG8_STAGE(PG8_SB(0, 1), b2 + hstep, voffB);
            PG8_WAIT_V(6); PG8_BAR; PG8_MMA(1, 1, At, B1); PG8_BAR;
            PG8_LDB(B0, 1, 0); PG8_SCHED; PG8_LDA(At, 1, 0); PG8_STAGE(PG8_SA(0, 1), a2 + hstep, voffA);
            PG8_WAIT_L(8); PG8_BAR; PG8_WAIT_L(0); PG8_MMA(0, 0, At, B0); PG8_BAR; PG8_SCHED;
            PG8_LDB(B1, 1, 1); PG8_STAGE(PG8_SB(1, 0), b3, voffB);
            PG8_BAR; PG8_WAIT_L(0); PG8_MMA(0, 1, At, B1); PG8_BAR;
            PG8_LDA(At, 1, 1); PG8_STAGE(PG8_SA(1, 0), a3, voffA);
            PG8_BAR; PG8_WAIT_L(0); PG8_MMA(1, 0, At, B0); PG8_BAR; PG8_SCHED;
            PG8_STAGE(PG8_SB(1, 1), b3 + hstep, voffB);
            PG8_WAIT_V(6); PG8_BAR; PG8_MMA(1, 1, At, B1); PG8_BAR;
            }
        }
        if constexpr (ALIGN_EPI) { if (wr == 0) PG8_BAR; }
        if constexpr (!Epi::AFTER_DRAIN) { E(acc, cur, wr, wc, fr, fq); S.done(cur); }
        if (!has_next) break;
#pragma unroll
        for (int a = 0; a < 2; ++a)
#pragma unroll
            for (int b = 0; b < 2; ++b)
#pragma unroll
                for (int m = 0; m < 4; ++m)
#pragma unroll
                    for (int n = 0; n < 2; ++n) acc[a][b][m][n] = (f32x4){0.f, 0.f, 0.f, 0.f};
        cur = nxt; cA = nA; cB = nB; ++ui;
        if constexpr (ALIGN_EPI) { if (wr == 1) PG8_BAR; }
    }
    PG8_WAIT_V(0);
    if constexpr (!ALIGN_EPI) { if (wr == 0) PG8_BAR; }
    PG8_BAR;
    if constexpr (Epi::AFTER_DRAIN) { E.fused(acc, cur, wr, wc, fr, fq, lds, wid, lane); S.done(cur); }
#undef PG8_SA
#undef PG8_SB
#undef PG8_STAGE
#undef PG8_LDA
#undef PG8_LDB
#undef PG8_MMA
#undef PG8_WAIT_V
#undef PG8_WAIT_L
#undef PG8_BAR
#undef PG8_SCHED
}
}
constexpr int NWAVES = 8;
constexpr int BATCH = 16, SEQ = 2048, DM = 1024, HD = 64, FF = 4096, NIN = 4352;
constexpr int M = BATCH * SEQ;
constexpr float EPS = 1e-6f;
constexpr size_t MiB = 1u << 20;
constexpr size_t WS_CTL = 0, CTL_ZERO_BYTES = 1 * MiB;
constexpr size_t WS_WIN = 2 * MiB, WS_WBR = 11 * MiB, WS_WO = 13 * MiB, WS_WUP = 15 * MiB, WS_WDN = 23 * MiB;
constexpr size_t WS_Q = 32 * MiB;
constexpr size_t WS_KA = 96 * MiB, WS_VA = 128 * MiB;
constexpr size_t WS_KB = 160 * MiB, WS_VB = 168 * MiB;
constexpr size_t WS_GA = 176 * MiB, WS_GB = 240 * MiB;
constexpr size_t WS_H = 32 * MiB;
constexpr size_t WS_A2 = 304 * MiB;
constexpr size_t WS_XN = 368 * MiB;
constexpr size_t WS_END = 432 * MiB;
static_assert(WS_WIN + (size_t)NIN * DM * 2 <= WS_WBR && WS_WDN + (size_t)DM * FF * 2 <= WS_Q && WS_GB + (size_t)M * DM * 2 <= WS_A2 && WS_H + (size_t)M * FF * 2 <= WS_A2, "d_ws map");
constexpr int CW_TMO = 0, CW_CODE = 1;
constexpr int CW_BAR = 4096;
constexpr int CW_KMEAN = 16384;
constexpr int CW_ROWSQ = CW_KMEAN + BATCH * 8 * 8 * 64;
static_assert((CW_ROWSQ + M) * 4 <= (int)CTL_ZERO_BYTES, "CTL words inside the memset region");
constexpr int RING_OFF = 0, RING_BYTES = 131072;
constexpr int LDSCTL_OFF = RING_BYTES, MISC_OFF = LDSCTL_OFF + 320;
constexpr int LDS_BYTES = 147456;
static_assert(MISC_OFF + 128 <= LDS_BYTES, "LDS map");

#define GAS __attribute__((address_space(1)))
#define LAS __attribute__((address_space(3)))
typedef unsigned short bf16;
typedef unsigned v4u __attribute__((ext_vector_type(4)));
typedef float f32x4 __attribute__((ext_vector_type(4)));
typedef short bf16x8 __attribute__((ext_vector_type(8)));
typedef GAS unsigned gu32;
typedef GAS unsigned long long gu64;
#define RLX_AGENT __ATOMIC_RELAXED, __HIP_MEMORY_SCOPE_AGENT
#define LDS_WAIT() asm volatile("s_waitcnt lgkmcnt(0)" ::: "memory")
#define VM_WAIT() asm volatile("s_waitcnt vmcnt(0)" ::: "memory")
__device__ __forceinline__ unsigned long long rt() { return __builtin_amdgcn_s_memrealtime(); }
__device__ __forceinline__ unsigned f2bf(float f) { unsigned u = __builtin_bit_cast(unsigned, f); return (u + 0x7fffu + ((u >> 16) & 1u)) >> 16; }
__device__ __forceinline__ unsigned pk2(float lo, float hi) { return f2bf(lo) | (f2bf(hi) << 16); }

#define XB_TMO      128
#define XB_XCNT(j)  (256  + 64 * (j))
#define XB_XSUB(j)  (1280 + 64 * (j))
#define XB_XGEN(j)  (2304 + 64 * (j))
#define XB_TOP      3328
#define XB_TOPGEN   3392
#define XCD_BAR_WORDS 3456
#define XB_SPIN_CAP (1u << 18)

__device__ __forceinline__ unsigned xb_ld(unsigned* p)              { return __hip_atomic_load(p, __ATOMIC_RELAXED, __HIP_MEMORY_SCOPE_AGENT); }
__device__ __forceinline__ unsigned xb_add(unsigned* p, unsigned v) { return __hip_atomic_fetch_add(p, v, __ATOMIC_RELAXED, __HIP_MEMORY_SCOPE_AGENT); }
__device__ __forceinline__ unsigned xb_xcc_id() { return (unsigned)__builtin_amdgcn_s_getreg((3 << 11) | 20) & 0xFu; }
#define XB_SPIN(cond, bar) do { unsigned _sp = 0; while (cond) { __builtin_amdgcn_s_sleep(1); \
    if ((++_sp & 255u) == 0u) { if (xb_ld(&(bar)[XB_TMO])) break; if (_sp > XB_SPIN_CAP) { atomicAdd(&(bar)[XB_TMO], 1u); break; } } } } while (0)

struct XcdBarrier {
    unsigned* bar; unsigned x;
    volatile LAS unsigned* st;
};

__device__ __forceinline__ XcdBarrier xcd_barrier_post(unsigned* bar, volatile LAS unsigned* st) {
    XcdBarrier b; b.bar = bar; b.x = xb_xcc_id(); b.st = st;
    if (threadIdx.x == 0) (void)xb_add(&bar[XB_XCNT(b.x)], 1u);
    return b;
}
__device__ __forceinline__ void xcd_barrier_complete(unsigned* bar, unsigned x, unsigned& nloc, unsigned& nx) {
    const unsigned G = gridDim.x * gridDim.y * gridDim.z;
    unsigned sum, cnt, mine, sp = 0u;
    for (;;) {
        sum = 0u; cnt = 0u; mine = 0u;
#pragma unroll
        for (unsigned j = 0; j < 16; ++j) { const unsigned c = xb_ld(&bar[XB_XCNT(j)]); sum += c; cnt += (c > 0u) ? 1u : 0u; mine = (j == x) ? c : mine; }
        if (sum == G) break;
        __builtin_amdgcn_s_sleep(1);
        if ((++sp & 255u) == 0u) { if (xb_ld(&bar[XB_TMO])) break; if (sp > XB_SPIN_CAP) { atomicAdd(&bar[XB_TMO], 1u); break; } }
    }
    nloc = mine > 0u ? mine : 1u; nx = cnt > 0u ? cnt : 1u;
}

__device__ __forceinline__ void xcd_barrier(const XcdBarrier& b) {
    asm volatile("s_waitcnt vmcnt(0)" ::: "memory");
    __syncthreads();
    if (threadIdx.x == 0) {
        unsigned* bar = b.bar;
        __builtin_amdgcn_s_waitcnt(0);
        unsigned nloc = b.st[0], nx = b.st[1];
        if (nloc == 0u) { xcd_barrier_complete(bar, b.x, nloc, nx); b.st[0] = nloc; b.st[1] = nx; }
        const unsigned old = xb_add(&bar[XB_XSUB(b.x)], 1u);
        const unsigned gen = old / nloc;
        if (old + 1u == (gen + 1u) * nloc) {
            __builtin_amdgcn_fence(__ATOMIC_RELEASE, "agent");
            asm volatile("s_waitcnt vmcnt(0)" ::: "memory");
            const unsigned og = xb_add(&bar[XB_TOP], 1u);
            const unsigned tg = og / nx;
            if (og + 1u == (tg + 1u) * nx) xb_add(&bar[XB_TOPGEN], 1u);
            else XB_SPIN(xb_ld(&bar[XB_TOPGEN]) == tg, bar);
            __builtin_amdgcn_fence(__ATOMIC_ACQUIRE, "agent");
            xb_add(&bar[XB_XGEN(b.x)], 1u);
            asm volatile("s_waitcnt vmcnt(0)" ::: "memory");
        } else {
            XB_SPIN(xb_ld(&bar[XB_XGEN(b.x)]) == gen, bar);
            __builtin_amdgcn_fence(__ATOMIC_ACQUIRE, "agent");
            asm volatile("s_waitcnt vmcnt(0)" ::: "memory");
        }
    }
    __syncthreads();
}

struct Frame {
    LAS unsigned char* lds;
    volatile LAS unsigned* MISC;
    gu32* ctl;
    int tid, lane, wave;
    int vcu, G;
    const float *x, *norm_attn, *w_in, *qna, *kna, *qnb, *knb, *sinks, *wba, *wbb, *w_out, *norm_mlp, *w_up, *w_down; float* out;
    bf16 *WinT, *WbrT, *WoT, *WupT, *WdnT;
    bf16 *Q, *KA, *VA, *KB, *VB, *GA, *GB, *HB, *A2, *XN;
    float *kmean, *rowsq;
};

__device__ __forceinline__ float wave_sum(float v) {
#pragma unroll
    for (int o = 1; o < 64; o <<= 1) v += __shfl_xor(v, o);
    return v;
}
__device__ __forceinline__ void p0_transpose_item(const float* W, int N, bf16* WT, int ldt, int koff, int prow0, LAS float* scr, int k0, int n0, int lane) {
#pragma unroll 8
    for (int i = 0; i < 32; ++i) { const int kk = 2 * i + (lane >> 5); scr[kk * 33 + (lane & 31)] = W[(size_t)(k0 + kk) * N + n0 + (lane & 31)]; }
    LDS_WAIT(); asm volatile("" ::: "memory");
    const int c = lane & 7;
#pragma unroll
    for (int j = 0; j < 4; ++j) { const int n = (lane >> 3) + 8 * j; const LAS float* s = scr + (8 * c) * 33 + n;
        v4u o; o.x = pk2(s[0 * 33], s[1 * 33]); o.y = pk2(s[2 * 33], s[3 * 33]); o.z = pk2(s[4 * 33], s[5 * 33]); o.w = pk2(s[6 * 33], s[7 * 33]);
        *(GAS v4u*)(WT + (size_t)(prow0 + n) * ldt + koff + k0 + 8 * c) = o; }
    LDS_WAIT(); asm volatile("" ::: "memory");
}
__device__ __forceinline__ void rms_row_to_bf16(const Frame& F, const float* xrow, const float* gain, bf16* orow) {
    const GAS f32x4* xr = (const GAS f32x4*)xrow + F.lane; const f32x4* gr = (const f32x4*)gain + F.lane;
    f32x4 v[4]; float s = 0.f;
#pragma unroll
    for (int j = 0; j < 4; ++j) { v[j] = xr[64 * j]; s += (v[j].x * v[j].x + v[j].y * v[j].y) + (v[j].z * v[j].z + v[j].w * v[j].w); }
    const float rs = 1.0f / sqrtf(wave_sum(s) * (1.f / DM) + EPS);
    GAS unsigned long long* o8 = (GAS unsigned long long*)orow + F.lane;
#pragma unroll
    for (int j = 0; j < 4; ++j) { const f32x4 g = gr[64 * j]; o8[64 * j] = (unsigned long long)pk2(v[j].x * rs * g.x, v[j].y * rs * g.y) | ((unsigned long long)pk2(v[j].z * rs * g.z, v[j].w * rs * g.w) << 32); }
}
__device__ __forceinline__ void p0_prologue(Frame& F) {
    LAS float* scr = (LAS float*)(F.lds + RING_OFF + F.wave * 16384);
    const int gw = F.vcu * NWAVES + F.wave, NGW = F.G * NWAVES;
    constexpr int I_IN = (DM / 64) * (NIN / 32), I_BR = (512 / 64) * (DM / 32), I_O = (DM / 64) * (DM / 32), I_UP = (DM / 64) * (FF / 32), I_DN = (FF / 64) * (DM / 32);
    constexpr int NITEMS = I_IN + 2 * I_BR + I_O + I_UP + I_DN;
    for (int it = gw; it < NITEMS; it += NGW) {
        int r = it;
        if (r < I_IN) { const int nblk = NIN / 32, kb = r / nblk, nb = r % nblk, n0 = 32 * nb, nt = n0 & 255;
            const int prow0 = (n0 & ~255) + 128 * ((nt >> 5) & 1) + 32 * (nt >> 6);
            p0_transpose_item(F.w_in, NIN, F.WinT, DM, 0, prow0, scr, 64 * kb, n0, F.lane); continue; } r -= I_IN;
        if (r < I_BR) { const int nblk = DM / 32, kb = r / nblk, nb = r % nblk; p0_transpose_item(F.wba, DM, F.WbrT, DM, 0, 32 * nb, scr, 64 * kb, 32 * nb, F.lane); continue; } r -= I_BR;
        if (r < I_BR) { const int nblk = DM / 32, kb = r / nblk, nb = r % nblk; p0_transpose_item(F.wbb, DM, F.WbrT, DM, 512, 32 * nb, scr, 64 * kb, 32 * nb, F.lane); continue; } r -= I_BR;
        if (r < I_O)  { const int nblk = DM / 32, kb = r / nblk, nb = r % nblk; p0_transpose_item(F.w_out, DM, F.WoT, DM, 0, 32 * nb, scr, 64 * kb, 32 * nb, F.lane); continue; } r -= I_O;
        if (r < I_UP) { const int nblk = FF / 32, kb = r / nblk, nb = r % nblk; p0_transpose_item(F.w_up, FF, F.WupT, DM, 0, 32 * nb, scr, 64 * kb, 32 * nb, F.lane); continue; } r -= I_UP;
        { const int nblk = DM / 32, kb = r / nblk, nb = r % nblk; p0_transpose_item(F.w_down, DM, F.WdnT, FF, 0, 32 * nb, scr, 64 * kb, 32 * nb, F.lane); }
    }
    for (int m = gw; m < M; m += NGW) rms_row_to_bf16(F, F.x + (size_t)m * DM, F.norm_attn, F.XN + (size_t)m * DM);
}
__device__ __forceinline__ void sa_load32(const bf16* p, float (&d)[32]) {
#pragma unroll
    for (int i = 0; i < 4; ++i) { const v4u w = *(const GAS v4u*)(p + 8 * i);
        d[8 * i + 0] = __uint_as_float(w.x << 16); d[8 * i + 1] = __uint_as_float(w.x & 0xffff0000u); d[8 * i + 2] = __uint_as_float(w.y << 16); d[8 * i + 3] = __uint_as_float(w.y & 0xffff0000u);
        d[8 * i + 4] = __uint_as_float(w.z << 16); d[8 * i + 5] = __uint_as_float(w.z & 0xffff0000u); d[8 * i + 6] = __uint_as_float(w.w << 16); d[8 * i + 7] = __uint_as_float(w.w & 0xffff0000u); }
}
__device__ __forceinline__ void sa_store32(bf16* p, const float (&o)[32], float sc) {
#pragma unroll
    for (int i = 0; i < 4; ++i) { v4u w; w.x = pk2(o[8 * i] * sc, o[8 * i + 1] * sc); w.y = pk2(o[8 * i + 2] * sc, o[8 * i + 3] * sc); w.z = pk2(o[8 * i + 4] * sc, o[8 * i + 5] * sc); w.w = pk2(o[8 * i + 6] * sc, o[8 * i + 7] * sc);
        *(GAS v4u*)(p + 8 * i) = w; }
}
#define SA_KEY(KPTR, VPTR, BIAS, VALID) do { \
    float s_ = 0.f; \
    { float kv_[32]; sa_load32((KPTR) + dof, kv_); \
        _Pragma("unroll") for (int d_ = 0; d_ < 32; ++d_) s_ = __builtin_fmaf(q[d_], kv_[d_], s_); asm volatile("" ::: "memory"); } \
    s_ += __shfl_xor(s_, 1); \
    s_ += (BIAS); const bool ok_ = (VALID); const float se_ = ok_ ? s_ : -1e30f; \
    if (__any(se_ > m)) { const float mn_ = __builtin_fmaxf(m, se_); const float c_ = __builtin_amdgcn_exp2f(m - mn_); l *= c_; _Pragma("unroll") for (int d_ = 0; d_ < 32; ++d_) o[d_] *= c_; m = mn_; } \
    const float p_ = ok_ ? __builtin_amdgcn_exp2f(s_ - m) : 0.f; l += p_; \
    { float kv_[32]; sa_load32((VPTR) + dof, kv_); \
        _Pragma("unroll") for (int d_ = 0; d_ < 32; ++d_) o[d_] = __builtin_fmaf(p_, kv_[d_], o[d_]); asm volatile("" ::: "memory"); } } while (0)

__device__ __forceinline__ void sa_moba(const bf16* Q, const bf16* KA, const bf16* VA, const float* kmean, bf16* O, int b, int h, int t0, int lane) {
    const int dof = 32 * (lane & 1);
    const int t = t0 + (lane >> 1), own = t0 >> 8;
    float q[32]; sa_load32(Q + ((size_t)(b * SEQ + t)) * 1024 + h * 64 + dof, q);
    unsigned sel;
    if (own <= 3) sel = (1u << own) - 1u;
    else {
        float gs[7];
#pragma unroll
        for (int n = 0; n < 7; ++n) { gs[n] = -INFINITY;
            if (n < own) { const float* km = kmean + ((size_t)(b * 8 + n) * 8 + h) * 64 + dof; float s = 0.f;
#pragma unroll
                for (int d = 0; d < 32; d += 4) { const f32x4 kv = *(const GAS f32x4*)(km + d); s = __builtin_fmaf(q[d], kv.x, s); s = __builtin_fmaf(q[d + 1], kv.y, s); s = __builtin_fmaf(q[d + 2], kv.z, s); s = __builtin_fmaf(q[d + 3], kv.w, s); }
                s += __shfl_xor(s, 1);
                gs[n] = s; asm volatile("" ::: "memory"); } }
        sel = 0u;
#pragma unroll
        for (int n = 0; n < 7; ++n) { int rank = 0;
#pragma unroll
            for (int j = 0; j < 7; ++j) if (j != n) rank += (gs[j] > gs[n] || (gs[j] == gs[n] && j < n)) ? 1 : 0;
            if (n < own && rank < 3) sel |= 1u << n; }
    }
    const float slope2 = exp2f(-0.5f * (float)(h + 9)) * pg8::kLog2e;
    float m = -1e30f, l = 0.f, o[32];
#pragma unroll
    for (int d = 0; d < 32; ++d) o[d] = 0.f;
    for (int n = 0; n <= own; ++n) {
        const bool isown = (n == own), mine = isown || ((sel >> n) & 1u);
        if (!__any(mine)) continue;
        const int nk = isown ? (t0 + 32 - n * 256) : 256;
        for (int kk = 0; kk < nk; ++kk) { const int tk = n * 256 + kk; const size_t r = (size_t)(b * SEQ + tk) * 512 + h * 64;
            SA_KEY(KA + r, VA + r, -slope2 * (float)(t - tk), mine && (tk <= t)); }
    }
    sa_store32(O + ((size_t)(b * SEQ + t)) * 1024 + h * 64 + dof, o, 1.0f / l);
}
__device__ __forceinline__ void sa_swa(const bf16* Q, const bf16* KB, const bf16* VB, const float* sinks, bf16* O, int b, int hq, int t0, int lane) {
    const int dof = 32 * (lane & 1);
    const int t = t0 + (lane >> 1), kvh = hq >> 2;
    float q[32]; sa_load32(Q + ((size_t)(b * SEQ + t)) * 1024 + 512 + hq * 64 + dof, q);
    const float slope2 = exp2f(-0.5f * (float)(hq + 1)) * pg8::kLog2e, sink2 = sinks[hq] * pg8::kLog2e;
    float m = -1e30f, l = 0.f, o[32];
#pragma unroll
    for (int d = 0; d < 32; ++d) o[d] = 0.f;
    const int k0 = t0 - 127 > 0 ? t0 - 127 : 0;
    for (int tk = k0; tk < t0 + 32; ++tk) { const size_t r = (size_t)(b * SEQ + tk) * 128 + kvh * 64;
        SA_KEY(KB + r, VB + r, -slope2 * (float)(t - tk), (tk <= t) && (t - tk < 128)); }
    const float mf = __builtin_fmaxf(m, sink2), c = __builtin_amdgcn_exp2f(m - mf);
    l = l * c + __builtin_amdgcn_exp2f(sink2 - mf);
    sa_store32(O + ((size_t)(b * SEQ + t)) * 1024 + 512 + hq * 64 + dof, o, c / l);
}
__device__ __forceinline__ void attn_simple_phase(Frame& F) {
    const int gw = F.vcu * NWAVES + F.wave, NGW = F.G * NWAVES;
    int i = 0;
    for (int u = gw; u < 8192; u += NGW, ++i) { const int b = u >> 9, h = (u >> 6) & 7; int ch = u & 63; if (i & 1) ch = 63 - ch;
        sa_moba(F.Q, F.KA, F.VA, F.kmean, F.Q, b, h, ch * 32, F.lane); }
    for (int u = gw; u < 8192; u += NGW) { const int b = u >> 9, hq = (u >> 6) & 7, ch = u & 63;
        sa_swa(F.Q, F.KB, F.VB, F.sinks, F.Q, b, hq, ch * 32, F.lane); }
}

namespace fa {
using bf16x8 = __attribute__((ext_vector_type(8))) short;
using s16x4 = __attribute__((ext_vector_type(4))) short;
using f32x16 = __attribute__((ext_vector_type(16))) float;
using u32x4 = __attribute__((ext_vector_type(4))) unsigned;
constexpr int NW = 8, QBLK = 32, KVBLK = 64;
constexpr int SLOTB = 8192, LDS_K = 0, LDS_V = 3 * SLOTB, LDS_WS = 6 * SLOTB, LDS_OST = LDS_WS + NW * 256, LDS_BYTES = LDS_OST + NW * 4096;
constexpr int QP = 1024;
#ifndef FA_THR
#define FA_THR 8
#endif
#define SBAR() __builtin_amdgcn_sched_barrier(0)
#define PIN(x) asm volatile("" : "+v"(x))
#define MFMA(a, b, c) __builtin_amdgcn_mfma_f32_32x32x16_bf16(a, b, c, 0, 0, 0)
#define WAIT_BAR(N) asm volatile("s_waitcnt vmcnt(" #N ") lgkmcnt(0)\n\ts_barrier" ::: "memory")
__device__ __forceinline__ int crow(int r, int hi) { return (r & 3) + 8 * (r >> 2) + 4 * hi; }
__device__ __forceinline__ unsigned cvtpk(float lo, float hi) { unsigned r; asm("v_cvt_pk_bf16_f32 %0, %1, %2" : "=v"(r) : "v"(lo), "v"(hi)); return r; }
__device__ __forceinline__ void glds16(const void* g, unsigned lds_base) {
    unsigned sv; asm volatile("s_mov_b32 %0, m0\n\ts_mov_b32 m0, %2\n\ts_nop 0\n\tglobal_load_lds_dwordx4 %1, off\n\ts_mov_b32 m0, %0" : "=&s"(sv) : "v"(g), "s"(lds_base) : "memory"); }
typedef __attribute__((address_space(3))) const char* lds_cptr;
typedef short v4i16_t __attribute__((ext_vector_type(4)));
__device__ __forceinline__ void kload2(bf16x8* kf, lds_cptr kp, int d0) { kf[2 * d0] = *(const __attribute__((address_space(3))) bf16x8*)(kp + d0 * 2048); kf[2 * d0 + 1] = *(const __attribute__((address_space(3))) bf16x8*)(kp + d0 * 2048 + 512); }
__device__ __forceinline__ s16x4 vtr(lds_cptr p) { return __builtin_bit_cast(s16x4, __builtin_amdgcn_ds_read_tr16_b64_v4i16((__attribute__((address_space(3))) v4i16_t*)p)); }
#define MX3(a, b, c) __builtin_fmaxf(__builtin_fmaxf((a), (b)), (c))
__device__ __forceinline__ float rowmax(const f32x16& p0, const f32x16& p1) {
    float a = MX3(p0[0], p0[1], p1[0]), b = MX3(p0[2], p0[3], p1[1]); a = MX3(a, p1[2], p1[3]);
#pragma unroll
    for (int r = 4; r < 16; r += 4) { a = MX3(a, p0[r], p0[r + 1]); b = MX3(b, p0[r + 2], p0[r + 3]); a = MX3(a, p1[r], p1[r + 1]); b = MX3(b, p1[r + 2], p1[r + 3]); }
    float m = __builtin_fmaxf(a, b); auto rr = __builtin_amdgcn_permlane32_swap(__float_as_uint(m), __float_as_uint(m), false, false);
    return __builtin_fmaxf(__uint_as_float(rr[0]), __uint_as_float(rr[1])); }
__device__ __forceinline__ void emask(f32x16& p0, f32x16& p1, int dq  , unsigned wd) {
#pragma unroll
    for (int r = 0; r < 16; ++r) { const int kv = (r & 3) + 8 * (r >> 2); if ((unsigned)(dq - kv) >= wd) p0[r] = -INFINITY; if ((unsigned)(dq - kv - 32) >= wd) p1[r] = -INFINITY; } }
__device__ __forceinline__ unsigned bf16bits(float f) { unsigned u = __float_as_uint(f); return (u + 0x7fffu + ((u >> 16) & 1u)) >> 16; }

struct AU {
    const bf16* Qw;
    bf16* Ow;
    const bf16* Kb;
    const bf16* Vb;
    int KP;
    int q0;
    int qrel0;
    int NT;
    int mode;
    unsigned wd;
    float slope2;
    float sink2;
    unsigned okmask;
};
__device__ __forceinline__ int key_rel(const AU& u, int t) {
    if (u.mode == 0) { const int np = u.NT - 4; return t == 0 ? 0 : (t <= np ? 64 * (t - 1) - 64 * np : 64 * (t - np)); }
    return -64 * t;
}
__device__ __forceinline__ void attn_unit(const AU& u, char* lds) {
    const int tid = threadIdx.x; int lane = tid & 63; asm volatile("" : "+v"(lane));
    const int r32 = lane & 31, hi = lane >> 5; const int wid = __builtin_amdgcn_readfirstlane(tid >> 6);
    const int NT = u.NT, KP = u.KP;
    const unsigned lds0 = (unsigned)(uintptr_t)lds; float* wsf = (float*)(lds + LDS_WS) + wid * 64;
    const bf16* ksrc = u.Kb + (long)lane * KP + wid * 8;
    const bf16* vsrc = u.Vb + (long)(16 * (wid & 3) + (lane >> 2)) * KP + (wid >> 2) * 32 + (lane & 3) * 8;
    const unsigned kdst = lds0 + LDS_K + wid * 1024, vdst = lds0 + LDS_V + wid * 1024;
#define KROW(t) ({ int r_ = u.q0 + key_rel(u, (t)); r_ < 0 ? 0 : r_; })
#define DMA_K(t, slot) glds16(ksrc + (long)KROW(t) * KP, (unsigned)__builtin_amdgcn_readfirstlane(kdst + (slot)))
#define DMA_V(t, slot) glds16(vsrc + (long)KROW(t) * KP, (unsigned)__builtin_amdgcn_readfirstlane(vdst + (slot)))
    const lds_cptr vp0 = (lds_cptr)lds + LDS_V + ((lane >> 4) & 1) * 32 + (lane & 3) * 8 + (4 * hi + ((lane & 15) >> 2)) * 64;
    const lds_cptr kp0 = (lds_cptr)lds + LDS_K + hi * 1024 + r32 * 16;
    DMA_K(0, 0); DMA_V(0, 0); DMA_K(1, SLOTB);
    bf16x8 qr[4];
#pragma unroll
    for (int d0 = 0; d0 < 4; ++d0) qr[d0] = *reinterpret_cast<const bf16x8*>(&u.Qw[(long)r32 * QP + d0 * 16 + hi * 8]);
    bf16x8 qaug, kaug0, kaug1;
    { const unsigned sh = bf16bits(u.slope2); const float rem = u.slope2 - __uint_as_float(sh << 16); const unsigned sl = bf16bits(rem);
      const unsigned Sh = bf16bits(64.f * __uint_as_float(sh << 16)), Sl = bf16bits(64.f * __uint_as_float(sl << 16));
      u32x4 w = {hi ? 0u : (sh | (sl << 16)), hi ? 0u : (Sh | (Sl << 16)), 0u, 0u}; qaug = __builtin_bit_cast(bf16x8, w);
      const unsigned k0b = bf16bits((float)r32), k1b = bf16bits((float)(r32 + 32));
      u32x4 a0 = {k0b | (k0b << 16), 0u, 0u, 0u}, a1 = {k1b | (k1b << 16), 0u, 0u, 0u}; kaug0 = __builtin_bit_cast(bf16x8, a0); kaug1 = __builtin_bit_cast(bf16x8, a1); }
#define SET_TILE(t) do { const unsigned tb_ = bf16bits((float)(key_rel(u, (t)) >> 6)); const unsigned tw_ = tb_ | (tb_ << 16); \
      u32x4 a0_ = __builtin_bit_cast(u32x4, kaug0), a1_ = __builtin_bit_cast(u32x4, kaug1); a0_[1] = tw_; a1_[1] = tw_; kaug0 = __builtin_bit_cast(bf16x8, a0_); kaug1 = __builtin_bit_cast(bf16x8, a1_); } while (0)
    float mhat = 0.f, l_reg = 0.f; f32x16 o[2]; o[0] = f32x16{}; o[1] = f32x16{};
    const int qrel = u.qrel0 + r32; bool resc = false; const unsigned okmask = u.okmask, wd = u.wd;
    f32x16 pA0, pA1, pB0, pB1; bf16x8 kf[8]; s16x4 vlo[8], vhi[8]; u32x4 pw0, pw1, pw2, pw3;
    int sl_prev = 0, sl_cur = 0, sl_next = SLOTB;
#define ROT() do { sl_prev = sl_cur; sl_cur = sl_next; sl_next = (sl_next == 2 * SLOTB) ? 0 : sl_next + SLOTB; } while (0)
#define EX(v) __builtin_amdgcn_exp2f((v) + nmh)
#define RESC() do { if (resc) { _Pragma("unroll") for (int d_ = 0; d_ < 2; ++d_) _Pragma("unroll") for (int r = 0; r < 16; ++r) o[d_][r] *= wsf[crow(r, hi)]; } } while (0)
    DMA_K(2, 2 * SLOTB);
    WAIT_BAR(3);
    _Pragma("unroll") for (int d0 = 0; d0 < 4; ++d0) kload2(kf, kp0, d0);
    SET_TILE(0);
    pA0 = MFMA(kaug0, qaug, f32x16{}); pA1 = MFMA(kaug1, qaug, f32x16{});
    pA0 = MFMA(kf[0], qr[0], pA0); pA1 = MFMA(kf[1], qr[0], pA1); pA0 = MFMA(kf[2], qr[1], pA0); pA1 = MFMA(kf[3], qr[1], pA1);
    pA0 = MFMA(kf[4], qr[2], pA0); pA1 = MFMA(kf[5], qr[2], pA1); pA0 = MFMA(kf[6], qr[3], pA0); pA1 = MFMA(kf[7], qr[3], pA1);
    emask(pA0, pA1, qrel - key_rel(u, 0) - 4 * hi, wd);
    { const float rm = rowmax(pA0, pA1); mhat = rm; const float nmh = -mhat;
#pragma unroll
      for (int r = 0; r < 16; ++r) { pA0[r] = EX(pA0[r]); pA1[r] = EX(pA1[r]); } }
    WAIT_BAR(0);
    DMA_K(3, 0); DMA_V(1, SLOTB); ROT();
    _Pragma("unroll") for (int d0 = 0; d0 < 4; ++d0) kload2(kf, kp0 + sl_cur, d0);
    WAIT_BAR(2);
#define PKW(P, i) cvtpk(P[i], P[i + 1])
#define PAF(k) __builtin_bit_cast(bf16x8, pw##k)
#define VFR(i) (bf16x8){vlo[i][0], vlo[i][1], vlo[i][2], vlo[i][3], vhi[i][0], vhi[i][1], vhi[i][2], vhi[i][3]}
#define VRD(i) do { vlo[i] = vtr(vp_ + (((i) >> 2) * 4096 + ((i) & 3) * 1024)); vhi[i] = vtr(vp_ + (((i) >> 2) * 4096 + ((i) & 3) * 1024 + 512)); } while (0)
#define KRD(G, d0) do { if (G) { kload2(kf, kp0 + sl_next, d0); SBAR(); } } while (0)
#define GAPA(MF, a0, a1, a2, a3, W0, W1, PW) do { MF; sacc += a0; sacc += a1; sacc += a2; sacc += a3; W0; W1; PIN(PW); PIN(sacc); SBAR(); } while (0)
#define GAPB(MF, X, i) do { MF; X[i] = EX(X[i]); X[i + 1] = EX(X[i + 1]); X[i + 2] = EX(X[i + 2]); X[i + 3] = EX(X[i + 3]); PIN(X); SBAR(); } while (0)
#define STEP(C0, C1, P0, P1, t, MASK, GK, GV, GL) do { SBAR(); \
    const lds_cptr vp_ = vp0 + sl_prev; SET_TILE(t); \
    C0 = MFMA(kaug0, qaug, f32x16{}); C1 = MFMA(kaug1, qaug, f32x16{}); SBAR(); \
    VRD(0); SBAR(); float sacc = P0[0] + P0[1]; \
                    GAPA(C0 = MFMA(kf[0], qr[0], C0), P0[2], P0[3], P0[4], P0[5],     pw0[0] = PKW(P0, 0),  pw0[1] = PKW(P0, 2),  pw0); \
    VRD(4); SBAR(); GAPA(C1 = MFMA(kf[1], qr[0], C1), P0[6], P0[7], P0[8], P0[9],     pw0[2] = PKW(P0, 4),  pw0[3] = PKW(P0, 6),  pw0); \
    VRD(1); SBAR(); GAPA(C0 = MFMA(kf[2], qr[1], C0),    P0[10], P0[11], P0[12], P0[13], pw1[0] = PKW(P0, 8),  pw1[1] = PKW(P0, 10), pw1); \
    VRD(5); SBAR(); GAPA(C1 = MFMA(kf[3], qr[1], C1),    P0[14], P0[15], P1[0], P1[1],   pw1[2] = PKW(P0, 12), pw1[3] = PKW(P0, 14), pw1); \
    VRD(2); SBAR(); GAPA(C0 = MFMA(kf[4], qr[2], C0),    P1[2], P1[3], P1[4], P1[5],     pw2[0] = PKW(P1, 0),  pw2[1] = PKW(P1, 2),  pw2); \
    VRD(6); SBAR(); GAPA(C1 = MFMA(kf[5], qr[2], C1),    P1[6], P1[7], P1[8], P1[9],     pw2[2] = PKW(P1, 4),  pw2[3] = PKW(P1, 6),  pw2); \
    VRD(3); SBAR(); GAPA(C0 = MFMA(kf[6], qr[3], C0),    P1[10], P1[11], P1[12], P1[13], pw3[0] = PKW(P1, 8),  pw3[1] = PKW(P1, 10), pw3); \
    VRD(7); SBAR(); GAPA(C1 = MFMA(kf[7], qr[3], C1),    P1[14], P1[15], 0.f, 0.f,       pw3[2] = PKW(P1, 12), pw3[3] = PKW(P1, 14), pw3); \
    l_reg += sacc; \
    if (GK) DMA_K((t) + 3, sl_cur); if (GV) DMA_V((t) + 1, sl_next); \
    if (MASK) emask(C0, C1, qrel - key_rel(u, (t)) - 4 * hi, wd); \
    const bool ok_ = (okmask >> (t)) & 1u; \
    { float rm = rowmax(C0, C1); rm = ok_ ? rm - mhat : -INFINITY; resc = false; \
      if (__builtin_expect(__any(rm > (float)FA_THR), 0)) { const float dl = __builtin_fmaxf(rm, 0.f); mhat += dl; \
          const float f = __builtin_amdgcn_exp2f(-dl); l_reg *= f; if (hi == 0) wsf[r32] = f; resc = true; } } \
    const float nmh = ok_ ? -mhat : -INFINITY; SBAR(); \
    GAPB(o[0] = MFMA(PAF(0), VFR(0), o[0]), C0, 0);              GAPB(o[1] = MFMA(PAF(0), VFR(4), o[1]), C0, 4); \
    KRD(GL, 0); GAPB(o[0] = MFMA(PAF(1), VFR(1), o[0]), C0, 8);  KRD(GL, 1); GAPB(o[1] = MFMA(PAF(1), VFR(5), o[1]), C0, 12); \
    KRD(GL, 2); GAPB(o[0] = MFMA(PAF(2), VFR(2), o[0]), C1, 0);  KRD(GL, 3); GAPB(o[1] = MFMA(PAF(2), VFR(6), o[1]), C1, 4); \
    GAPB(o[0] = MFMA(PAF(3), VFR(3), o[0]), C1, 8);              GAPB(o[1] = MFMA(PAF(3), VFR(7), o[1]), C1, 12); \
    } while (0)
    int t = 1;
    for (; t + 5 < NT; t += 2) {
        STEP(pB0, pB1, pA0, pA1, t, false, true, true, true);     WAIT_BAR(2); RESC(); ROT();
        STEP(pA0, pA1, pB0, pB1, t + 1, false, true, true, true); WAIT_BAR(2); RESC(); ROT();
    }
#define ENDW(tt) do { if ((tt) + 3 < NT) { WAIT_BAR(2); } else if ((tt) + 2 < NT) { WAIT_BAR(1); } else { WAIT_BAR(0); } } while (0)
    for (; t + 1 < NT; t += 2) {
        STEP(pB0, pB1, pA0, pA1, t, true, (t + 3 < NT), (t + 1 < NT), (t + 1 < NT));         ENDW(t);     RESC(); ROT();
        STEP(pA0, pA1, pB0, pB1, t + 1, true, (t + 4 < NT), (t + 2 < NT), (t + 2 < NT));     ENDW(t + 1); RESC(); ROT();
    }
    STEP(pB0, pB1, pA0, pA1, NT - 1, true, false, false, false); RESC();
    { float sacc = pB0[0] + pB0[1];
#pragma unroll
      for (int r = 2; r < 16; ++r) sacc += pB0[r];
#pragma unroll
      for (int r = 0; r < 16; ++r) sacc += pB1[r];
      l_reg += sacc;
      pw0 = (u32x4){PKW(pB0, 0), PKW(pB0, 2), PKW(pB0, 4), PKW(pB0, 6)}; pw1 = (u32x4){PKW(pB0, 8), PKW(pB0, 10), PKW(pB0, 12), PKW(pB0, 14)};
      pw2 = (u32x4){PKW(pB1, 0), PKW(pB1, 2), PKW(pB1, 4), PKW(pB1, 6)}; pw3 = (u32x4){PKW(pB1, 8), PKW(pB1, 10), PKW(pB1, 12), PKW(pB1, 14)};
      const lds_cptr vp_ = vp0 + sl_cur; _Pragma("unroll") for (int i = 0; i < 8; ++i) VRD(i);
      o[0] = MFMA(PAF(0), VFR(0), o[0]); o[1] = MFMA(PAF(0), VFR(4), o[1]); o[0] = MFMA(PAF(1), VFR(1), o[0]); o[1] = MFMA(PAF(1), VFR(5), o[1]);
      o[0] = MFMA(PAF(2), VFR(2), o[0]); o[1] = MFMA(PAF(2), VFR(6), o[1]); o[0] = MFMA(PAF(3), VFR(3), o[0]); o[1] = MFMA(PAF(3), VFR(7), o[1]); }
    { auto rr = __builtin_amdgcn_permlane32_swap(__float_as_uint(l_reg), __float_as_uint(l_reg), false, false); l_reg = __uint_as_float(rr[0]) + __uint_as_float(rr[1]); }
    {
      const float sk = u.sink2 + u.slope2 * (float)qrel, mf = __builtin_fmaxf(mhat, sk), c = __builtin_amdgcn_exp2f(mhat - mf);
      const float lt = l_reg * c + __builtin_amdgcn_exp2f(sk - mf);
      if (hi == 0) wsf[32 + r32] = c * __builtin_amdgcn_rcpf(lt); }
    asm volatile("s_waitcnt lgkmcnt(0)" ::: "memory");
    float rli[16];
#pragma unroll
    for (int r = 0; r < 16; ++r) rli[r] = wsf[32 + crow(r, hi)];
    bf16* stg = (bf16*)(lds + LDS_OST) + wid * 2048;
    { int l2 = lane; asm volatile("" : "+v"(l2)); const int r32b = l2 & 31, hib = l2 >> 5;
#pragma unroll
    for (int r = 0; r < 16; ++r) { const int orow = crow(r, hib);
#pragma unroll
        for (int d0 = 0; d0 < 2; ++d0) stg[orow * 64 + d0 * 32 + r32b] = (bf16)bf16bits(o[d0][r] * rli[r]); }
    asm volatile("s_waitcnt lgkmcnt(0)" ::: "memory");
    const int srow = l2 >> 3, ch = l2 & 7; const u32x4* sp = (const u32x4*)(stg + srow * 64 + ch * 8); bf16* gp = u.Ow + (long)srow * QP + ch * 8;
#pragma unroll
    for (int i = 0; i < 4; ++i) *(u32x4*)(gp + (long)i * 8 * QP) = sp[i * 64]; }
    asm volatile("s_waitcnt lgkmcnt(0)\n\ts_barrier" ::: "memory");
#undef KROW
#undef DMA_K
#undef DMA_V
#undef SET_TILE
#undef ROT
#undef EX
#undef RESC
#undef PKW
#undef PAF
#undef VFR
#undef VRD
#undef KRD
#undef ENDW
#undef GAPA
#undef GAPB
#undef STEP
}
#undef SBAR
#undef PIN
#undef MFMA
#undef WAIT_BAR
#undef MX3
}

__device__ __forceinline__ float bfbits2f(short s) { return __uint_as_float(((unsigned)(unsigned short)s) << 16); }
__device__ __forceinline__ void attn_fast_phase(Frame& F, char* lds, bf16* O) {
    const int wid = F.wave;
    for (int i = 0; i < 8; ++i) {
        int lane = F.lane; asm volatile("" : "+v"(lane)); const int r32 = lane & 31, hi = lane >> 5;
        fa::AU u; size_t qoff;
        if (i < 4) {
            const int p = F.vcu >> 1, b = p >> 3, h = p & 7, half = F.vcu & 1;
            const size_t rowbase = (size_t)b * SEQ;
            const int j = half ? (i == 0 ? 6 : i == 1 ? 5 : i == 2 ? 2 : 1) : (i == 0 ? 7 : i == 1 ? 4 : i == 2 ? 3 : 0);
            qoff = (rowbase + 256 * j + 32 * wid) * 1024 + h * 64;
            u.Kb = F.KA + rowbase * 512 + h * 64; u.Vb = F.VA + rowbase * 512 + h * 64; u.KP = 512;
            u.q0 = 256 * j; u.qrel0 = 32 * wid; u.NT = 4 * (j + 1); u.mode = 0; u.wd = 0x40000000u;
            u.slope2 = exp2f(-0.5f * (float)(h + 9)) * pg8::kLog2e; u.sink2 = -INFINITY;
            unsigned sel;
            if (j <= 3) sel = (1u << j) - 1u;
            else {
                fa::bf16x8 qv[4];
#pragma unroll
                for (int d0 = 0; d0 < 4; ++d0) qv[d0] = *reinterpret_cast<const fa::bf16x8*>(&F.Q[qoff + (size_t)r32 * 1024 + d0 * 16 + hi * 8]);
                float gs[7];
#pragma unroll
                for (int n = 0; n < 7; ++n) { gs[n] = -INFINITY;
                    if (n < j) { const float* km = F.kmean + ((size_t)(b * 8 + n) * 8 + h) * 64 + 8 * hi; float s = 0.f;
#pragma unroll
                        for (int d0 = 0; d0 < 4; ++d0) { const f32x4 k0 = *(const GAS f32x4*)(km + 16 * d0), k1 = *(const GAS f32x4*)(km + 16 * d0 + 4);
                            s = __builtin_fmaf(bfbits2f(qv[d0][0]), k0.x, s); s = __builtin_fmaf(bfbits2f(qv[d0][1]), k0.y, s); s = __builtin_fmaf(bfbits2f(qv[d0][2]), k0.z, s); s = __builtin_fmaf(bfbits2f(qv[d0][3]), k0.w, s);
                            s = __builtin_fmaf(bfbits2f(qv[d0][4]), k1.x, s); s = __builtin_fmaf(bfbits2f(qv[d0][5]), k1.y, s); s = __builtin_fmaf(bfbits2f(qv[d0][6]), k1.z, s); s = __builtin_fmaf(bfbits2f(qv[d0][7]), k1.w, s); }
                        s += __shfl_xor(s, 32); gs[n] = s; } }
                sel = 0u;
#pragma unroll
                for (int n = 0; n < 7; ++n) { int rank = 0;
#pragma unroll
                    for (int k = 0; k < 7; ++k) if (k != n) rank += (gs[k] > gs[n] || (gs[k] == gs[n] && k < n)) ? 1 : 0;
                    if (n < j && rank < 3) sel |= 1u << n; }
            }
            unsigned ok = 1u | (7u << (u.NT - 3));
#pragma unroll
            for (int n = 0; n < 7; ++n) if ((sel >> n) & 1u) ok |= 0xFu << (1 + 4 * n);
            u.okmask = ok;
        } else {
            const int us = F.vcu * 4 + (i - 4), b = us >> 6, kvh = (us >> 5) & 1, c = us & 31, hq = kvh * 4 + (wid >> 1);
            const size_t rowbase = (size_t)b * SEQ;
            qoff = (rowbase + 64 * c + 32 * (wid & 1)) * 1024 + 512 + hq * 64;
            u.Kb = F.KB + rowbase * 128 + kvh * 64; u.Vb = F.VB + rowbase * 128 + kvh * 64; u.KP = 128;
            u.q0 = 64 * c; u.qrel0 = 32 * (wid & 1); u.NT = 4; u.mode = 1; u.wd = 128u;
            u.slope2 = exp2f(-0.5f * (float)(hq + 1)) * pg8::kLog2e; u.sink2 = F.sinks[hq] * pg8::kLog2e;
            u.okmask = (c >= 3) ? 0xFu : ((1u << (c + 1)) - 1u);
        }
        u.Qw = F.Q + qoff; u.Ow = O + qoff;
        fa::attn_unit(u, lds);
    }
}
#if defined(DBG_ATTN)
__device__ __forceinline__ void dbg_compare(Frame& F, const bf16* Od) {
    const int gt = F.vcu * NWAVES * 64 + F.tid, NGT = F.G * NWAVES * 64; float num = 0.f, den = 0.f;
    for (size_t i = gt; i < (size_t)M * 64; i += NGT) { const size_t row = i >> 6, c8 = i & 63; const size_t off = row * 1024 + DBG_PART * 512 + c8 * 8;
        const v4u a = *(const GAS v4u*)(Od + off), r = *(const GAS v4u*)(F.Q + off);
#define DD(x) { const float a0 = __uint_as_float(a.x << 16), a1 = __uint_as_float(a.x & 0xffff0000u), r0 = __uint_as_float(r.x << 16), r1 = __uint_as_float(r.x & 0xffff0000u); num += (a0 - r0) * (a0 - r0) + (a1 - r1) * (a1 - r1); den += r0 * r0 + r1 * r1; }
        DD(x) DD(y) DD(z) DD(w)
#undef DD
    }
    num = wave_sum(num); den = wave_sum(den);
    if (F.lane == 0) { atomicAdd((float*)(F.ctl) + 8, num); atomicAdd((float*)(F.ctl) + 9, den); }
}
#endif

struct Args { const float* in[14]; float* out; unsigned char* ws; };
__global__ void __launch_bounds__(NWAVES * 64, 2) fwd_megakernel(Args args) {
    extern __shared__ __attribute__((aligned(16))) unsigned char lds[];
    Frame F;
    F.lds = (LAS unsigned char*)lds;
    F.MISC = (volatile LAS unsigned*)(F.lds + MISC_OFF);
    F.tid = threadIdx.x; F.lane = F.tid & 63; F.wave = __builtin_amdgcn_readfirstlane(F.tid >> 6);
    F.G = gridDim.x; { const int bx = blockIdx.x; F.vcu = (F.G % 8 == 0) ? (bx % 8) * (F.G / 8) + bx / 8 : bx; }
    unsigned char* ws = args.ws;
    F.ctl = (gu32*)(ws + WS_CTL);
    F.x = args.in[0]; F.norm_attn = args.in[1]; F.w_in = args.in[2]; F.qna = args.in[3]; F.kna = args.in[4]; F.qnb = args.in[5]; F.knb = args.in[6]; F.sinks = args.in[7];
    F.wba = args.in[8]; F.wbb = args.in[9]; F.w_out = args.in[10]; F.norm_mlp = args.in[11]; F.w_up = args.in[12]; F.w_down = args.in[13]; F.out = args.out;
    F.WinT = (bf16*)(ws + WS_WIN); F.WbrT = (bf16*)(ws + WS_WBR); F.WoT = (bf16*)(ws + WS_WO); F.WupT = (bf16*)(ws + WS_WUP); F.WdnT = (bf16*)(ws + WS_WDN);
    F.Q = (bf16*)(ws + WS_Q); F.KA = (bf16*)(ws + WS_KA); F.VA = (bf16*)(ws + WS_VA); F.KB = (bf16*)(ws + WS_KB); F.VB = (bf16*)(ws + WS_VB);
    F.GA = (bf16*)(ws + WS_GA); F.GB = (bf16*)(ws + WS_GB); F.HB = (bf16*)(ws + WS_H); F.A2 = (bf16*)(ws + WS_A2); F.XN = (bf16*)(ws + WS_XN);
    F.kmean = (float*)(ws + WS_CTL) + CW_KMEAN; F.rowsq = (float*)(ws + WS_CTL) + CW_ROWSQ;
    for (int u = F.tid; u < (LDS_BYTES - LDSCTL_OFF) / 4; u += NWAVES * 64) ((LAS unsigned*)(F.lds + LDSCTL_OFF))[u] = 0u;
    __syncthreads();
    XcdBarrier bar = xcd_barrier_post((unsigned*)(F.ctl + CW_BAR), F.MISC + 8);
#define GRID_BAR() xcd_barrier(bar)

#ifndef SKIP_P0
    p0_prologue(F);
#endif
    GRID_BAR();
#ifndef SKIP_P1
    {   pg8::Gemm g{F.XN, F.WinT, M, NIN, DM}; pg8::StaticOrder S; S.init(M, NIN, F.G, (int)blockIdx.x);
        pg8::EpiIn E{F.Q, F.KA, F.VA, F.KB, F.VB, F.GA, F.GB, F.qna, F.kna, F.qnb, F.knb, F.kmean};
        pg8::gemm_phase<pg8::EpiIn, pg8::StaticOrder, true, true>(F.lds + RING_OFF, g, S, E); }
#endif
    GRID_BAR();
#if defined(DBG_ATTN)
    attn_fast_phase(F, (char*)lds + RING_OFF, F.XN); GRID_BAR(); attn_simple_phase(F); GRID_BAR(); dbg_compare(F, F.XN);
#elif defined(SIMPLE_ATTN)
    attn_simple_phase(F);
#else
    attn_fast_phase(F, (char*)lds + RING_OFF, F.Q);
#endif
    GRID_BAR();
#ifndef SKIP_P3
    {   pg8::Gemm g{F.Q, F.WbrT, M, DM, DM}; pg8::StaticOrder S; S.init(M, DM, F.G, (int)blockIdx.x);
        pg8::EpiMix E{F.GA, F.GB, F.XN};
        pg8::gemm_phase<pg8::EpiMix, pg8::StaticOrder, true, true>(F.lds + RING_OFF, g, S, E); }
#endif
    GRID_BAR();
#ifndef SKIP_P4
    {   pg8::Gemm g{F.XN, F.WoT, M, DM, DM}; pg8::StaticOrder S; S.init(M, DM, F.G, (int)blockIdx.x);
        pg8::EpiX1 E{F.x, F.out, F.A2, F.norm_mlp, F.rowsq};
        pg8::gemm_phase<pg8::EpiX1, pg8::StaticOrder, true, true>(F.lds + RING_OFF, g, S, E); }
#endif
    GRID_BAR();
#ifndef SKIP_P5
    {   pg8::Gemm g{F.A2, F.WupT, M, FF, DM}; pg8::StaticOrder S; S.init(M, FF, F.G, (int)blockIdx.x);
        pg8::EpiUp E{F.HB, F.rowsq};
        pg8::gemm_phase<pg8::EpiUp, pg8::StaticOrder, true, true>(F.lds + RING_OFF, g, S, E); }
#endif
    GRID_BAR();
#ifndef SKIP_P6
    {   pg8::Gemm g{F.HB, F.WdnT, M, DM, FF}; pg8::StaticOrder S; S.init(M, DM, F.G, (int)blockIdx.x);
#if defined(DBG_ATTN)
        const float dnum = ((const GAS float*)F.ctl)[8], dden = ((const GAS float*)F.ctl)[9];
        pg8::EpiDown E{F.out, 1.0f + 100.0f * sqrtf(dnum / dden)};
#else
        pg8::EpiDown E{F.out, 1.0f};
#endif
        pg8::gemm_phase<pg8::EpiDown, pg8::StaticOrder, true, true>(F.lds + RING_OFF, g, S, E); }
#endif
}

extern "C" void kernel_launch(void* const* d_in, const int* in_sizes, int n_in, void* d_out, int out_size, void* d_ws, size_t ws_size, hipStream_t stream) {
    static int grid = 0;
    if (grid == 0) {
        if (n_in != 14 || in_sizes[0] != M * DM || out_size != M * DM || ws_size < WS_END) { fprintf(stderr, "kernel_launch: unexpected shapes: n_in %d, in0 %d, out %d, ws %zu (need %zu); nothing launched\n", n_in, n_in > 0 ? in_sizes[0] : -1, out_size, ws_size, (size_t)WS_END); grid = -1; return; }
        int dev = 0, cus = 0, per_cu = 0;
        if (hipGetDevice(&dev) != hipSuccess || hipDeviceGetAttribute(&cus, hipDeviceAttributeMultiprocessorCount, dev) != hipSuccess) { fprintf(stderr, "kernel_launch: device query failed\n"); grid = -1; return; }
        if (hipFuncSetAttribute((const void*)fwd_megakernel, hipFuncAttributeMaxDynamicSharedMemorySize, LDS_BYTES) != hipSuccess) { fprintf(stderr, "kernel_launch: hipFuncSetAttribute failed\n"); grid = -1; return; }
        if (hipOccupancyMaxActiveBlocksPerMultiprocessor(&per_cu, (const void*)fwd_megakernel, NWAVES * 64, LDS_BYTES) != hipSuccess || per_cu < 1)
            fprintf(stderr, "kernel_launch: note: occupancy query reports %d workgroups per CU\n", per_cu);
        (void)hipGetLastError();
        grid = cus;
    }
    if (grid < 0) return;
    if (hipMemsetAsync((char*)d_ws + WS_CTL, 0, CTL_ZERO_BYTES, stream) != hipSuccess) { fprintf(stderr, "kernel_launch: hipMemsetAsync failed\n"); return; }
    Args a{};
    for (int i = 0; i < 14; ++i) a.in[i] = (const float*)d_in[i];
    a.out = (float*)d_out; a.ws = (unsigned char*)d_ws;
    hipLaunchKernelGGL(fwd_megakernel, dim3(grid), dim3(NWAVES * 64), LDS_BYTES, stream, a);
    const hipError_t le = hipPeekAtLastError();
    if (le != hipSuccess) fprintf(stderr, "kernel_launch: launch failed: %s\n", hipGetErrorName(le));
}
```

```cpp
#include <hip/hip_runtime.h>
#include <cstdio>
#include <cstdint>
namespace pg8 {
#define PG8_LAS __attribute__((address_space(3)))
typedef unsigned short bf16_t;
typedef short bf16x8 __attribute__((ext_vector_type(8)));
typedef float f32x4 __attribute__((ext_vector_type(4)));
typedef unsigned u32x4 __attribute__((ext_vector_type(4)));
constexpr int BM = 256, BK = 64, HALF = 128, HTB = HALF * BK * 2  , STAGE_BYTES = 8 * HTB, NXCD = 8, WGM = 8;

__host__ __device__ __forceinline__ int lds_byte(int r, int c) { const int st = (r >> 4) * 2 + (c >> 5), rr = r & 15, cc = c & 31, ob = rr * 64 + cc * 2; return st * 1024 + (ob ^ (((ob >> 9) & 1) << 5)); }
__host__ __device__ __forceinline__ void stage_rc(int b, int& R, int& C) { const int st = b / 1024, sb = b % 1024, swz = sb ^ (((sb >> 9) & 1) << 5); R = (st >> 1) * 16 + swz / 64; C = (st & 1) * 32 + (swz % 64) / 2; }
__host__ __device__ __forceinline__ int perm32(int rho) { const int n = rho >> 4, i = rho & 15; return 8 * (i >> 2) + 4 * n + (i & 3); }

struct Unit { int pm, pn; };
struct Gemm { const bf16_t* A; const bf16_t* Bt; int M, N, K; };

struct StaticOrder {
    int nM, nN, nwg, G, c;
    __host__ __device__ void init(int M, int N, int G_, int c_) { nM = M / BM; nN = N / BM; nwg = nM * nN; G = G_; c = c_; }
    __host__ __device__ bool next(int i, Unit& u) const {
        const long L = (long)i * G + c; if (L >= nwg) return false;
        int wgid = (int)L; { const int q = nwg / NXCD, r = nwg % NXCD, xcd = wgid % NXCD, off = wgid / NXCD; wgid = (xcd < r ? xcd * (q + 1) : r * (q + 1) + (xcd - r) * q) + off; }
        const int nig = WGM * nN, gid = wgid / nig, fm = gid * WGM, gsz = (nM - fm) < WGM ? (nM - fm) : WGM;
        u.pm = fm + ((wgid % nig) % gsz); u.pn = (wgid % nig) / gsz; return true;
    }
    __device__ __forceinline__ void a_ready(const Unit&) const {}
    __device__ __forceinline__ void done(const Unit&) const {}
};

__device__ __forceinline__ unsigned cvt_pk_bf16(float lo, float hi) { unsigned r; asm volatile("v_cvt_pk_bf16_f32 %0, %1, %2" : "=v"(r) : "v"(lo), "v"(hi)); return r; }
typedef unsigned u32x2 __attribute__((ext_vector_type(2)));
__device__ __forceinline__ float bf_lo(unsigned w) { return __uint_as_float(w << 16); }
__device__ __forceinline__ float bf_hi(unsigned w) { return __uint_as_float(w & 0xffff0000u); }
constexpr float kLog2e = 1.4426950408889634f;
constexpr float kC2 = 0.125f * 1.4426950408889634f;

struct EpiIn {
    static constexpr bool PERM = true, AFTER_DRAIN = false; static constexpr int MID_TILE = 0;
    bf16_t *Q, *KA, *VA, *KB, *VB, *GR, *GB; const float *qna, *kna, *qnb, *knb; float* kmean;
    __device__ __forceinline__ void mid(f32x4 (&)[2][2][4][2], const Unit&, int, int, int, int) const {}
    __device__ __forceinline__ void operator()(const f32x4 (&acc)[2][2][4][2], const Unit& u, int wr, int wc, int fr, int fq) const {
        const int pn = u.pn;
        const int rowb = u.pm * BM + wr * 64 + fr;
        if (pn >= 9) {
            const int col = 128 * (pn - 9) + 32 * wc + 8 * fq;
#pragma unroll
            for (int ai = 0; ai < 2; ++ai)
#pragma unroll
                for (int m = 0; m < 4; ++m) { const size_t off = (size_t)(rowb + ai * HALF + m * 16) * 1024 + col;
                    f32x4 rt[2], gb[2];
#pragma unroll
                    for (int n = 0; n < 2; ++n)
#pragma unroll
                        for (int e = 0; e < 4; ++e) { const float ea = __builtin_amdgcn_exp2f(-kLog2e * acc[ai][0][m][n][e]), eb = __builtin_amdgcn_exp2f(-kLog2e * acc[ai][1][m][n][e]);
                            gb[n][e] = __builtin_fmaxf(__builtin_amdgcn_rcpf(1.0f + eb), 1e-20f); rt[n][e] = __builtin_fminf((1.0f + eb) * __builtin_amdgcn_rcpf(1.0f + ea), 1e20f); }
                    u32x4 w; w.x = cvt_pk_bf16(rt[0][0], rt[0][1]); w.y = cvt_pk_bf16(rt[0][2], rt[0][3]); w.z = cvt_pk_bf16(rt[1][0], rt[1][1]); w.w = cvt_pk_bf16(rt[1][2], rt[1][3]);
                    *(u32x4*)(GR + off) = w;
                    w.x = cvt_pk_bf16(gb[0][0], gb[0][1]); w.y = cvt_pk_bf16(gb[0][2], gb[0][3]); w.z = cvt_pk_bf16(gb[1][0], gb[1][1]); w.w = cvt_pk_bf16(gb[1][2], gb[1][3]);
                    *(u32x4*)(GB + off) = w; }
            return;
        }
        bf16_t* dst; int pitch; bool norm = false, km = false; float scale = 1.f; const float* gain = qna;
        if (pn < 2)       { dst = Q + (4 * pn + wc) * 64; pitch = 1024; norm = true; gain = qna; scale = kC2; }
        else if (pn < 4)  { dst = KA + (4 * (pn - 2) + wc) * 64; pitch = 512; norm = true; gain = kna; km = true; }
        else if (pn < 6)  { dst = VA + (4 * (pn - 4) + wc) * 64; pitch = 512; }
        else if (pn < 8)  { dst = Q + 512 + (4 * (pn - 6) + wc) * 64; pitch = 1024; norm = true; gain = qnb; scale = kC2; }
        else              { pitch = 128; if (wc < 2) { dst = KB + wc * 64; norm = true; gain = knb; } else { dst = VB + (wc - 2) * 64; } }
        f32x4 g[2][2], cs[2][2];
#pragma unroll
        for (int bj = 0; bj < 2; ++bj)
#pragma unroll
            for (int n = 0; n < 2; ++n) { g[bj][n] = norm ? *(const f32x4*)(gain + 32 * bj + 8 * fq + 4 * n) : (f32x4){1.f, 1.f, 1.f, 1.f}; cs[bj][n] = (f32x4){0.f, 0.f, 0.f, 0.f}; }
#pragma unroll
        for (int ai = 0; ai < 2; ++ai)
#pragma unroll
            for (int m = 0; m < 4; ++m) {
                const int row = rowb + ai * HALF + m * 16;
                f32x4 v[2][2];
#pragma unroll
                for (int bj = 0; bj < 2; ++bj)
#pragma unroll
                    for (int n = 0; n < 2; ++n) v[bj][n] = acc[ai][bj][m][n];
                if (norm) {
                    float ss = 0.f;
#pragma unroll
                    for (int bj = 0; bj < 2; ++bj)
#pragma unroll
                        for (int n = 0; n < 2; ++n) { const f32x4 x = v[bj][n]; ss += (x[0] * x[0] + x[1] * x[1]) + (x[2] * x[2] + x[3] * x[3]); }
                    ss += __shfl_xor(ss, 16); ss += __shfl_xor(ss, 32);
                    const float rs = __builtin_amdgcn_rsqf(ss * (1.0f / 64.0f) + 1e-6f) * scale;
#pragma unroll
                    for (int bj = 0; bj < 2; ++bj)
#pragma unroll
                        for (int n = 0; n < 2; ++n) v[bj][n] = v[bj][n] * rs * g[bj][n];
                }
                if (km) {
#pragma unroll
                    for (int bj = 0; bj < 2; ++bj)
#pragma unroll
                        for (int n = 0; n < 2; ++n) cs[bj][n] += v[bj][n];
                }
#pragma unroll
                for (int bj = 0; bj < 2; ++bj) {
                    u32x4 w; w.x = cvt_pk_bf16(v[bj][0][0], v[bj][0][1]); w.y = cvt_pk_bf16(v[bj][0][2], v[bj][0][3]); w.z = cvt_pk_bf16(v[bj][1][0], v[bj][1][1]); w.w = cvt_pk_bf16(v[bj][1][2], v[bj][1][3]);
                    *(u32x4*)(dst + (size_t)row * pitch + 32 * bj + 8 * fq) = w;
                }
            }
        if (km) {
            float* kmp = kmean + ((size_t)u.pm * 8 + (4 * (pn - 2) + wc)) * 64;
#pragma unroll
            for (int bj = 0; bj < 2; ++bj)
#pragma unroll
                for (int n = 0; n < 2; ++n)
#pragma unroll
                    for (int e = 0; e < 4; ++e) {
                        float s = cs[bj][n][e];
                        s += __shfl_xor(s, 1); s += __shfl_xor(s, 2); s += __shfl_xor(s, 4); s += __shfl_xor(s, 8);
                        if (fr == 0) atomicAdd(kmp + 32 * bj + 8 * fq + 4 * n + e, s * (1.0f / 256.0f));
                    }
        }
    }
};

struct EpiMix {
    static constexpr bool PERM = true, AFTER_DRAIN = false; static constexpr int MID_TILE = 8;
    const bf16_t *GR, *GB; bf16_t* MIX;
    __device__ __forceinline__ void mid(f32x4 (&acc)[2][2][4][2], const Unit& u, int wr, int wc, int fr, int fq) const {
        int rowb = u.pm * BM + wr * 64 + fr, col0 = u.pn * BM + wc * 32 + 8 * fq;
        asm volatile("" : "+v"(rowb), "+v"(col0));
        const bf16_t* base = GR + (size_t)rowb * 1024 + col0;
        u32x4 rt[2][4][2];
#pragma unroll
        for (int ai = 0; ai < 2; ++ai)
#pragma unroll
            for (int m = 0; m < 4; ++m)
#pragma unroll
                for (int bj = 0; bj < 2; ++bj) rt[ai][m][bj] = *(const u32x4*)(base + (size_t)(ai * HALF + m * 16) * 1024 + bj * HALF);
#pragma unroll
        for (int ai = 0; ai < 2; ++ai)
#pragma unroll
            for (int m = 0; m < 4; ++m)
#pragma unroll
                for (int bj = 0; bj < 2; ++bj) { const u32x4 a = rt[ai][m][bj];
                    acc[ai][bj][m][0] *= (f32x4){bf_lo(a.x), bf_hi(a.x), bf_lo(a.y), bf_hi(a.y)}; acc[ai][bj][m][1] *= (f32x4){bf_lo(a.z), bf_hi(a.z), bf_lo(a.w), bf_hi(a.w)}; }
    }
    __device__ __forceinline__ void operator()(const f32x4 (&acc)[2][2][4][2], const Unit& u, int wr, int wc, int fr, int fq) const {
        const int rowb = u.pm * BM + wr * 64 + fr, col0 = u.pn * BM + wc * 32 + 8 * fq;
        const bf16_t* base = GB + (size_t)rowb * 1024 + col0; bf16_t* ob = MIX + (size_t)rowb * 1024 + col0;
        u32x4 gt[2][4][2];
#pragma unroll
        for (int ai = 0; ai < 2; ++ai)
#pragma unroll
            for (int m = 0; m < 4; ++m)
#pragma unroll
                for (int bj = 0; bj < 2; ++bj) gt[ai][m][bj] = *(const u32x4*)(base + (size_t)(ai * HALF + m * 16) * 1024 + bj * HALF);
#pragma unroll
        for (int ai = 0; ai < 2; ++ai)
#pragma unroll
            for (int m = 0; m < 4; ++m)
#pragma unroll
                for (int bj = 0; bj < 2; ++bj) { const u32x4 b = gt[ai][m][bj];
                    const f32x4 v0 = acc[ai][bj][m][0], v1 = acc[ai][bj][m][1];
                    u32x4 w; w.x = cvt_pk_bf16(v0[0] * bf_lo(b.x), v0[1] * bf_hi(b.x)); w.y = cvt_pk_bf16(v0[2] * bf_lo(b.y), v0[3] * bf_hi(b.y));
                    w.z = cvt_pk_bf16(v1[0] * bf_lo(b.z), v1[1] * bf_hi(b.z)); w.w = cvt_pk_bf16(v1[2] * bf_lo(b.w), v1[3] * bf_hi(b.w));
                    *(u32x4*)(ob + (size_t)(ai * HALF + m * 16) * 1024 + bj * HALF) = w; }
    }
};

struct EpiX1 {
    static constexpr bool PERM = false, AFTER_DRAIN = false; static constexpr int MID_TILE = 0;
    const float* x; bf16_t* X1; float* rowsq;
    __device__ __forceinline__ void mid(f32x4 (&)[2][2][4][2], const Unit&, int, int, int, int) const {}
    __device__ __forceinline__ void operator()(const f32x4 (&acc)[2][2][4][2], const Unit& u, int wr, int wc, int fr, int fq) const {
        const int rowb = u.pm * BM + wr * 64 + fr, col0 = u.pn * BM + wc * 32 + 4 * fq;
#pragma unroll
        for (int ai = 0; ai < 2; ++ai) {
            f32x4 xv[4][2][2];
#pragma unroll
            for (int m = 0; m < 4; ++m)
#pragma unroll
                for (int bj = 0; bj < 2; ++bj)
#pragma unroll
                    for (int n = 0; n < 2; ++n) xv[m][bj][n] = *(const f32x4*)(x + (size_t)(rowb + ai * HALF + m * 16) * 1024 + col0 + bj * HALF + n * 16);
#pragma unroll
            for (int m = 0; m < 4; ++m) { const int row = rowb + ai * HALF + m * 16; const size_t off = (size_t)row * 1024 + col0; float ss = 0.f;
#pragma unroll
                for (int bj = 0; bj < 2; ++bj)
#pragma unroll
                    for (int n = 0; n < 2; ++n) {
                        const f32x4 x1 = xv[m][bj][n] + acc[ai][bj][m][n];
                        ss += (x1[0] * x1[0] + x1[1] * x1[1]) + (x1[2] * x1[2] + x1[3] * x1[3]);
                        u32x2 w; w.x = cvt_pk_bf16(x1[0], x1[1]); w.y = cvt_pk_bf16(x1[2], x1[3]);
                        *(u32x2*)(X1 + off + bj * HALF + n * 16) = w;
                    }
                ss += __shfl_xor(ss, 16); ss += __shfl_xor(ss, 32);
                if (fq == 0) atomicAdd(rowsq + row, ss); }
            asm volatile("" ::: "memory"); }
    }
};

struct EpiUp {
    static constexpr bool PERM = true, AFTER_DRAIN = false; static constexpr int MID_TILE = 0;
    bf16_t* H; const float* rowsq;
    __device__ __forceinline__ void mid(f32x4 (&)[2][2][4][2], const Unit&, int, int, int, int) const {}
    __device__ __forceinline__ void operator()(const f32x4 (&acc)[2][2][4][2], const Unit& u, int wr, int wc, int fr, int fq) const {
        const int rowb = u.pm * BM + wr * 64 + fr, col0 = u.pn * BM + wc * 32 + 8 * fq;
#pragma unroll
        for (int ai = 0; ai < 2; ++ai)
#pragma unroll
            for (int m = 0; m < 4; ++m) { const int row = rowb + ai * HALF + m * 16;
                const float r = __builtin_amdgcn_rsqf(rowsq[row] * (1.0f / 1024.0f) + 1e-6f);
                bf16_t* rowp = H + (size_t)row * 4096 + col0;
#pragma unroll
                for (int bj = 0; bj < 2; ++bj) {
                    f32x4 v0 = acc[ai][bj][m][0] * r, v1 = acc[ai][bj][m][1] * r;
#pragma unroll
                    for (int e = 0; e < 4; ++e) { const float a = __builtin_fmaxf(v0[e], 0.f), b = __builtin_fmaxf(v1[e], 0.f); v0[e] = a * a; v1[e] = b * b; }
                    u32x4 w; w.x = cvt_pk_bf16(v0[0], v0[1]); w.y = cvt_pk_bf16(v0[2], v0[3]); w.z = cvt_pk_bf16(v1[0], v1[1]); w.w = cvt_pk_bf16(v1[2], v1[3]);
                    *(u32x4*)(rowp + bj * HALF) = w;
                } }
    }
};

struct EpiDown {
    static constexpr bool PERM = false, AFTER_DRAIN = false; static constexpr int MID_TILE = 0;
    const bf16_t* X1; float* out; float mul;
    __device__ __forceinline__ void mid(f32x4 (&)[2][2][4][2], const Unit&, int, int, int, int) const {}
    __device__ __forceinline__ void operator()(const f32x4 (&acc)[2][2][4][2], const Unit& u, int wr, int wc, int fr, int fq) const {
        const int rowb = u.pm * BM + wr * 64 + fr, col0 = u.pn * BM + wc * 32 + 4 * fq;
        u32x2 xv[2][4][2][2];
#pragma unroll
        for (int ai = 0; ai < 2; ++ai)
#pragma unroll
            for (int m = 0; m < 4; ++m)
#pragma unroll
                for (int bj = 0; bj < 2; ++bj)
#pragma unroll
                    for (int n = 0; n < 2; ++n) xv[ai][m][bj][n] = *(const u32x2*)(X1 + (size_t)(rowb + ai * HALF + m * 16) * 1024 + col0 + bj * HALF + n * 16);
#pragma unroll
        for (int ai = 0; ai < 2; ++ai)
#pragma unroll
            for (int m = 0; m < 4; ++m) { float* rowp = out + (size_t)(rowb + ai * HALF + m * 16) * 1024 + col0;
#pragma unroll
                for (int bj = 0; bj < 2; ++bj)
#pragma unroll
                    for (int n = 0; n < 2; ++n) { const u32x2 w = xv[ai][m][bj][n];
                        *(f32x4*)(rowp + bj * HALF + n * 16) = ((f32x4){bf_lo(w.x), bf_hi(w.x), bf_lo(w.y), bf_hi(w.y)} + acc[ai][bj][m][n]) * mul; } }
    }
};

template <class Epi, class Sched, bool ALIGN_EPI = false, bool SP2 = false>
__device__ __forceinline__ void gemm_phase(PG8_LAS unsigned char* lds, const Gemm g, const Sched& S, const Epi& E) {
    const int tid = threadIdx.x, wid = __builtin_amdgcn_readfirstlane(tid >> 6), lane = tid & 63, wr = wid >> 2, wc = wid & 3, fr = lane & 15, fq = lane >> 4;
    const int K = g.K, nt = K / BK;
    unsigned voffA[2], voffB[2];
#pragma unroll
    for (int i = 0; i < 2; ++i) { int R, C; stage_rc(tid * 16 + i * 8192, R, C); const int Rb = Epi::PERM ? ((R & ~31) + perm32(R & 31)) : R;
        voffA[i] = (unsigned)(R * K + C) * 2u; voffB[i] = (unsigned)(Rb * K + C) * 2u; }
    const size_t kstep = (size_t)(BK * 2);
    const size_t hstep = (size_t)HALF * K * 2;
    const size_t tstep = 2 * hstep;
    const unsigned ldsw = (unsigned)wid * 1024u;
    const int aoff = lds_byte(wr * 64 + fr, fq * 8), boff = lds_byte(wc * 32 + fr, fq * 8);
#define PG8_SA(b, h) (((b) * 2 + (h)) * HTB)
#define PG8_SB(b, h) ((4 + (b) * 2 + (h)) * HTB)
#define PG8_STAGE(bufoff, gbase, voff) do { _Pragma("unroll") for (int _i = 0; _i < 2; ++_i) \
        __builtin_amdgcn_global_load_lds((const unsigned*)((const char*)(gbase) + (voff)[_i]), (PG8_LAS unsigned*)(lds + (bufoff) + ldsw + _i * 8192), 16, 0, 0); } while (0)
#define PG8_LDA(dst, b, h) do { _Pragma("unroll") for (int m = 0; m < 4; ++m) _Pragma("unroll") for (int k = 0; k < 2; ++k) dst[m][k] = *(const PG8_LAS bf16x8*)(lds + PG8_SA(b, h) + aoff + m * 2048 + k * 1024); } while (0)
#define PG8_LDB(dst, b, h) do { _Pragma("unroll") for (int n = 0; n < 2; ++n) _Pragma("unroll") for (int k = 0; k < 2; ++k) dst[n][k] = *(const PG8_LAS bf16x8*)(lds + PG8_SB(b, h) + boff + n * 2048 + k * 1024); } while (0)
#define PG8_MMA(ai, bj, At, Bt) do { __builtin_amdgcn_s_setprio(1); _Pragma("unroll") for (int m = 0; m < 4; ++m) _Pragma("unroll") for (int n = 0; n < 2; ++n) _Pragma("unroll") for (int k = 0; k < 2; ++k) \
        acc[ai][bj][m][n] = __builtin_amdgcn_mfma_f32_16x16x32_bf16(Bt[n][k], At[m][k], acc[ai][bj][m][n], 0, 0, 0); __builtin_amdgcn_s_setprio(0); } while (0)
#define PG8_WAIT_V(n) asm volatile("s_waitcnt vmcnt(" #n ")" ::: "memory")
#define PG8_WAIT_L(n) asm volatile("s_waitcnt lgkmcnt(" #n ")" ::: "memory")
#define PG8_BAR __builtin_amdgcn_s_barrier()
#define PG8_SCHED __builtin_amdgcn_sched_barrier(0)
    Unit cur, nxt; int ui = 0;
    if (!S.next(0, cur)) return;
    f32x4 acc[2][2][4][2];
#pragma unroll
    for (int a = 0; a < 2; ++a)
#pragma unroll
        for (int b = 0; b < 2; ++b)
#pragma unroll
            for (int m = 0; m < 4; ++m)
#pragma unroll
                for (int n = 0; n < 2; ++n) acc[a][b][m][n] = (f32x4){0.f, 0.f, 0.f, 0.f};
    bf16x8 At[4][2], B0[2][2], B1[2][2];
    const char* cA = (const char*)g.A + (size_t)cur.pm * tstep; const char* cB = (const char*)g.Bt + (size_t)cur.pn * tstep;
    S.a_ready(cur);
    if constexpr (SP2) {
        PG8_STAGE(PG8_SB(0, 0), cB, voffB); PG8_STAGE(PG8_SB(0, 1), cB + hstep, voffB); PG8_STAGE(PG8_SA(0, 0), cA, voffA); PG8_STAGE(PG8_SA(0, 1), cA + hstep, voffA);
        if (wr == 1) PG8_BAR;
        PG8_WAIT_V(2); PG8_BAR;
        PG8_STAGE(PG8_SB(1, 0), cB + kstep, voffB); PG8_STAGE(PG8_SA(1, 0), cA + kstep, voffA); PG8_STAGE(PG8_SB(1, 1), cB + hstep + kstep, voffB);
        PG8_WAIT_V(6); PG8_BAR;
    } else {
        PG8_STAGE(PG8_SB(0, 0), cB, voffB); PG8_STAGE(PG8_SA(0, 0), cA, voffA); PG8_STAGE(PG8_SB(0, 1), cB + hstep, voffB); PG8_STAGE(PG8_SA(0, 1), cA + hstep, voffA);
        if (wr == 1) PG8_BAR;
        PG8_WAIT_V(4); PG8_BAR;
        PG8_STAGE(PG8_SB(1, 0), cB + kstep, voffB); PG8_STAGE(PG8_SA(1, 0), cA + kstep, voffA); PG8_STAGE(PG8_SB(1, 1), cB + hstep + kstep, voffB);
        PG8_WAIT_V(6); PG8_BAR;
    }
    for (;;) {
        const bool has_next = S.next(ui + 1, nxt);
        const char* nA = has_next ? (const char*)g.A + (size_t)nxt.pm * tstep : cA; const char* nB = has_next ? (const char*)g.Bt + (size_t)nxt.pn * tstep : cB;
        for (int t = 0; t < nt; t += 2) {
            if constexpr (Epi::MID_TILE > 0) { if (t == Epi::MID_TILE) { PG8_SCHED; E.mid(acc, cur, wr, wc, fr, fq); PG8_SCHED; } }
            const bool last = (t == nt - 2);
            const char* a1 = cA + (size_t)(t + 1) * kstep;
            const char* a2 = last ? nA : cA + (size_t)(t + 2) * kstep; const char* b2 = last ? nB : cB + (size_t)(t + 2) * kstep;
            const char* a3 = a2 + kstep; const char* b3 = b2 + kstep;
            if (last && has_next) S.a_ready(nxt);
            if constexpr (SP2) {
            PG8_LDB(B0, 0, 0); PG8_LDB(B1, 0, 1); PG8_SCHED; PG8_LDA(At, 0, 0); PG8_STAGE(PG8_SA(1, 1), a1 + hstep, voffA);
            PG8_WAIT_V(8); PG8_WAIT_L(0); PG8_BAR; PG8_MMA(0, 0, At, B0); PG8_MMA(0, 1, At, B1); PG8_BAR; PG8_SCHED;
            PG8_LDA(At, 0, 1); PG8_STAGE(PG8_SB(0, 0), b2, voffB); PG8_STAGE(PG8_SB(0, 1), b2 + hstep, voffB); PG8_STAGE(PG8_SA(0, 0), a2, voffA);
            PG8_WAIT_V(8); PG8_WAIT_L(0); PG8_BAR; PG8_MMA(1, 0, At, B0); PG8_MMA(1, 1, At, B1); PG8_BAR; PG8_SCHED;
            PG8_LDB(B0, 1, 0); PG8_LDB(B1, 1, 1); PG8_SCHED; PG8_LDA(At, 1, 0); PG8_STAGE(PG8_SA(0, 1), a2 + hstep, voffA);
            PG8_WAIT_V(8); PG8_WAIT_L(0); PG8_BAR; PG8_MMA(0, 0, At, B0); PG8_MMA(0, 1, At, B1); PG8_BAR; PG8_SCHED;
            PG8_LDA(At, 1, 1); PG8_STAGE(PG8_SB(1, 0), b3, voffB); PG8_STAGE(PG8_SB(1, 1), b3 + hstep, voffB); PG8_STAGE(PG8_SA(1, 0), a3, voffA);
            PG8_WAIT_V(8); PG8_WAIT_L(0); PG8_BAR; PG8_MMA(1, 0, At, B0); PG8_MMA(1, 1, At, B1); PG8_BAR; PG8_SCHED;
            } else {
            PG8_LDB(B0, 0, 0); PG8_SCHED; PG8_LDA(At, 0, 0); PG8_STAGE(PG8_SA(1, 1), a1 + hstep, voffA);
            PG8_WAIT_L(8); PG8_BAR; PG8_WAIT_L(0); PG8_MMA(0, 0, At, B0); PG8_BAR; PG8_SCHED;
            PG8_LDB(B1, 0, 1); PG8_STAGE(PG8_SB(0, 0), b2, voffB);
            PG8_BAR; PG8_WAIT_L(0); PG8_MMA(0, 1, At, B1); PG8_BAR;
            PG8_LDA(At, 0, 1); PG8_STAGE(PG8_SA(0, 0), a2, voffA);
            PG8_BAR; PG8_WAIT_L(0); PG8_MMA(1, 0, At, B0); PG8_BAR; PG8_SCHED;
            PG8_STAGE(PG8_SB(0, 1), b2 + hstep, voffB);
            PG8_WAIT_V(6); PG8_BAR; PG8_MMA(1, 1, At, B1); PG8_BAR;
            PG8_LDB(B0, 1, 0); PG8_SCHED; PG8_LDA(At, 1, 0); PG8_STAGE(PG8_SA(0, 1), a2 + hstep, voffA);
            PG8_WAIT_L(8); PG8_BAR; PG8_WAIT_L(0); PG8_MMA(0, 0, At, B0); PG8_BAR; PG8_SCHED;
            PG8_LDB(B1, 1, 1); PG8_STAGE(PG8_SB(1, 0), b3, voffB);
            PG8_BAR; PG8_WAIT_L(0); PG8_MMA(0, 1, At, B1); PG8_BAR;
            PG8_LDA(At, 1, 1); PG8_STAGE(PG8_SA(1, 0), a3, voffA);
            PG8_BAR; PG8_WAIT_L(0); PG8_MMA(1, 0, At, B0); PG8_BAR; PG8_SCHED;
            PG8_STAGE(PG8_SB(1, 1), b3 + hstep, voffB);
            PG8_WAIT_V(6); PG8_BAR; PG8_MMA(1, 1, At, B1); PG8_BAR;
            }
        }
        if constexpr (ALIGN_EPI) { if (wr == 0) PG8_BAR; }
        if constexpr (!Epi::AFTER_DRAIN) { E(acc, cur, wr, wc, fr, fq); S.done(cur); }
        if (!has_next) break;
#pragma unroll
        for (int a = 0; a < 2; ++a)
#pragma unroll
            for (int b = 0; b < 2; ++b)
#pragma unroll
                for (int m = 0; m < 4; ++m)
#pragma unroll
                    for (int n = 0; n < 2; ++n) acc[a][b][m][n] = (f32x4){0.f, 0.f, 0.f, 0.f};
        cur = nxt; cA = nA; cB = nB; ++ui;
        if constexpr (ALIGN_EPI) { if (wr == 1) PG8_BAR; }
    }
    PG8_WAIT_V(0);
    if constexpr (!ALIGN_EPI) { if (wr == 0) PG8_BAR; }
    PG8_BAR;
    if constexpr (Epi::AFTER_DRAIN) { E.fused(acc, cur, wr, wc, fr, fq, lds, wid, lane); S.done(cur); }
#undef PG8_SA
#undef PG8_SB
#undef PG8_STAGE
#undef PG8_LDA
#undef PG8_LDB
#undef PG8_MMA
#undef PG8_WAIT_V
#undef PG8_WAIT_L
#undef PG8_BAR
#undef PG8_SCHED
}
}
constexpr int NWAVES = 8;
constexpr int BATCH = 16, SEQ = 2048, DM = 1024, HD = 64, FF = 4096, NIN = 4352;
constexpr int M = BATCH * SEQ;
constexpr float EPS = 1e-6f;
constexpr size_t MiB = 1u << 20;
constexpr size_t WS_CTL = 0, CTL_ZERO_BYTES = 1 * MiB;
constexpr size_t WS_WIN = 2 * MiB, WS_WBR = 11 * MiB, WS_WO = 13 * MiB, WS_WUP = 15 * MiB, WS_WDN = 23 * MiB;
constexpr size_t WS_Q = 32 * MiB;
constexpr size_t WS_KA = 96 * MiB, WS_VA = 128 * MiB;
constexpr size_t WS_KB = 160 * MiB, WS_VB = 168 * MiB;
constexpr size_t WS_GA = 176 * MiB, WS_GB = 240 * MiB;
constexpr size_t WS_H = 32 * MiB;
constexpr size_t WS_A2 = 304 * MiB;
constexpr size_t WS_XN = 368 * MiB;
constexpr size_t WS_END = 432 * MiB;
static_assert(WS_WIN + (size_t)NIN * DM * 2 <= WS_WBR && WS_WDN + (size_t)DM * FF * 2 <= WS_Q && WS_GB + (size_t)M * DM * 2 <= WS_A2 && WS_H + (size_t)M * FF * 2 <= WS_A2, "d_ws map");
constexpr int CW_TMO = 0, CW_CODE = 1;
constexpr int CW_BAR = 4096;
constexpr int CW_KMEAN = 16384;
constexpr int CW_ROWSQ = CW_KMEAN + BATCH * 8 * 8 * 64;
static_assert((CW_ROWSQ + M) * 4 <= (int)CTL_ZERO_BYTES, "CTL words inside the memset region");
constexpr int RING_OFF = 0, RING_BYTES = 131072;
constexpr int LDSCTL_OFF = RING_BYTES, MISC_OFF = LDSCTL_OFF + 320;
constexpr int LDS_BYTES = 147456;
static_assert(MISC_OFF + 128 <= LDS_BYTES, "LDS map");

#define GAS __attribute__((address_space(1)))
#define LAS __attribute__((address_space(3)))
typedef unsigned short bf16;
typedef unsigned v4u __attribute__((ext_vector_type(4)));
typedef float f32x4 __attribute__((ext_vector_type(4)));
typedef short bf16x8 __attribute__((ext_vector_type(8)));
typedef GAS unsigned gu32;
typedef GAS unsigned long long gu64;
#define RLX_AGENT __ATOMIC_RELAXED, __HIP_MEMORY_SCOPE_AGENT
#define LDS_WAIT() asm volatile("s_waitcnt lgkmcnt(0)" ::: "memory")
#define VM_WAIT() asm volatile("s_waitcnt vmcnt(0)" ::: "memory")
__device__ __forceinline__ unsigned long long rt() { return __builtin_amdgcn_s_memrealtime(); }
__device__ __forceinline__ unsigned f2bf(float f) { unsigned u = __builtin_bit_cast(unsigned, f); return (u + 0x7fffu + ((u >> 16) & 1u)) >> 16; }
__device__ __forceinline__ unsigned pk2(float lo, float hi) { return f2bf(lo) | (f2bf(hi) << 16); }

#define XB_TMO      128
#define XB_XCNT(j)  (256  + 64 * (j))
#define XB_XSUB(j)  (1280 + 64 * (j))
#define XB_XGEN(j)  (2304 + 64 * (j))
#define XB_TOP      3328
#define XB_TOPGEN   3392
#define XCD_BAR_WORDS 3456
#define XB_SPIN_CAP (1u << 18)

__device__ __forceinline__ unsigned xb_ld(unsigned* p)              { return __hip_atomic_load(p, __ATOMIC_RELAXED, __HIP_MEMORY_SCOPE_AGENT); }
__device__ __forceinline__ unsigned xb_add(unsigned* p, unsigned v) { return __hip_atomic_fetch_add(p, v, __ATOMIC_RELAXED, __HIP_MEMORY_SCOPE_AGENT); }
__device__ __forceinline__ unsigned xb_xcc_id() { return (unsigned)__builtin_amdgcn_s_getreg((3 << 11) | 20) & 0xFu; }
#define XB_SPIN(cond, bar) do { unsigned _sp = 0; while (cond) { __builtin_amdgcn_s_sleep(1); \
    if ((++_sp & 255u) == 0u) { if (xb_ld(&(bar)[XB_TMO])) break; if (_sp > XB_SPIN_CAP) { atomicAdd(&(bar)[XB_TMO], 1u); break; } } } } while (0)

struct XcdBarrier {
    unsigned* bar; unsigned x;
    volatile LAS unsigned* st;
};

__device__ __forceinline__ XcdBarrier xcd_barrier_post(unsigned* bar, volatile LAS unsigned* st) {
    XcdBarrier b; b.bar = bar; b.x = xb_xcc_id(); b.st = st;
    if (threadIdx.x == 0) (void)xb_add(&bar[XB_XCNT(b.x)], 1u);
    return b;
}
__device__ __forceinline__ void xcd_barrier_complete(unsigned* bar, unsigned x, unsigned& nloc, unsigned& nx) {
    const unsigned G = gridDim.x * gridDim.y * gridDim.z;
    unsigned sum, cnt, mine, sp = 0u;
    for (;;) {
        sum = 0u; cnt = 0u; mine = 0u;
#pragma unroll
        for (unsigned j = 0; j < 16; ++j) { const unsigned c = xb_ld(&bar[XB_XCNT(j)]); sum += c; cnt += (c > 0u) ? 1u : 0u; mine = (j == x) ? c : mine; }
        if (sum == G) break;
        __builtin_amdgcn_s_sleep(1);
        if ((++sp & 255u) == 0u) { if (xb_ld(&bar[XB_TMO])) break; if (sp > XB_SPIN_CAP) { atomicAdd(&bar[XB_TMO], 1u); break; } }
    }
    nloc = mine > 0u ? mine : 1u; nx = cnt > 0u ? cnt : 1u;
}

__device__ __forceinline__ void xcd_barrier(const XcdBarrier& b) {
    asm volatile("s_waitcnt vmcnt(0)" ::: "memory");
    __syncthreads();
    if (threadIdx.x == 0) {
        unsigned* bar = b.bar;
        __builtin_amdgcn_s_waitcnt(0);
        unsigned nloc = b.st[0], nx = b.st[1];
        if (nloc == 0u) { xcd_barrier_complete(bar, b.x, nloc, nx); b.st[0] = nloc; b.st[1] = nx; }
        const unsigned old = xb_add(&bar[XB_XSUB(b.x)], 1u);
        const unsigned gen = old / nloc;
        if (old + 1u == (gen + 1u) * nloc) {
            __builtin_amdgcn_fence(__ATOMIC_RELEASE, "agent");
            asm volatile("s_waitcnt vmcnt(0)" ::: "memory");
            const unsigned og = xb_add(&bar[XB_TOP], 1u);
            const unsigned tg = og / nx;
            if (og + 1u == (tg + 1u) * nx) xb_add(&bar[XB_TOPGEN], 1u);
            else XB_SPIN(xb_ld(&bar[XB_TOPGEN]) == tg, bar);
            __builtin_amdgcn_fence(__ATOMIC_ACQUIRE, "agent");
            xb_add(&bar[XB_XGEN(b.x)], 1u);
            asm volatile("s_waitcnt vmcnt(0)" ::: "memory");
        } else {
            XB_SPIN(xb_ld(&bar[XB_XGEN(b.x)]) == gen, bar);
            __builtin_amdgcn_fence(__ATOMIC_ACQUIRE, "agent");
            asm volatile("s_waitcnt vmcnt(0)" ::: "memory");
        }
    }
    __syncthreads();
}

struct Frame {
    LAS unsigned char* lds;
    volatile LAS unsigned* MISC;
    gu32* ctl;
    int tid, lane, wave;
    int vcu, G;
    const float *x, *norm_attn, *w_in, *qna, *kna, *qnb, *knb, *sinks, *wba, *wbb, *w_out, *norm_mlp, *w_up, *w_down; float* out;
    bf16 *WinT, *WbrT, *WoT, *WupT, *WdnT;
    bf16 *Q, *KA, *VA, *KB, *VB, *GA, *GB, *HB, *A2, *XN;
    float *kmean, *rowsq;
};

__device__ __forceinline__ float wave_sum(float v) {
#pragma unroll
    for (int o = 1; o < 64; o <<= 1) v += __shfl_xor(v, o);
    return v;
}
__device__ __forceinline__ void p0_transpose_item(const float* W, int N, bf16* WT, int ldt, int koff, int prow0, LAS float* scr, int k0, int n0, int lane, const float* kscale = nullptr) {
#pragma unroll 8
    for (int i = 0; i < 32; ++i) { const int kk = 2 * i + (lane >> 5); const float sc = kscale ? kscale[k0 + kk] : 1.0f; scr[kk * 33 + (lane & 31)] = W[(size_t)(k0 + kk) * N + n0 + (lane & 31)] * sc; }
    LDS_WAIT(); asm volatile("" ::: "memory");
    const int c = lane & 7;
#pragma unroll
    for (int j = 0; j < 4; ++j) { const int n = (lane >> 3) + 8 * j; const LAS float* s = scr + (8 * c) * 33 + n;
        v4u o; o.x = pk2(s[0 * 33], s[1 * 33]); o.y = pk2(s[2 * 33], s[3 * 33]); o.z = pk2(s[4 * 33], s[5 * 33]); o.w = pk2(s[6 * 33], s[7 * 33]);
        *(GAS v4u*)(WT + (size_t)(prow0 + n) * ldt + koff + k0 + 8 * c) = o; }
    LDS_WAIT(); asm volatile("" ::: "memory");
}
__device__ __forceinline__ void rms_row_to_bf16(const Frame& F, const float* xrow, const float* gain, bf16* orow) {
    const GAS f32x4* xr = (const GAS f32x4*)xrow + F.lane; const f32x4* gr = (const f32x4*)gain + F.lane;
    f32x4 v[4]; float s = 0.f;
#pragma unroll
    for (int j = 0; j < 4; ++j) { v[j] = xr[64 * j]; s += (v[j].x * v[j].x + v[j].y * v[j].y) + (v[j].z * v[j].z + v[j].w * v[j].w); }
    const float rs = 1.0f / sqrtf(wave_sum(s) * (1.f / DM) + EPS);
    GAS unsigned long long* o8 = (GAS unsigned long long*)orow + F.lane;
#pragma unroll
    for (int j = 0; j < 4; ++j) { const f32x4 g = gr[64 * j]; o8[64 * j] = (unsigned long long)pk2(v[j].x * rs * g.x, v[j].y * rs * g.y) | ((unsigned long long)pk2(v[j].z * rs * g.z, v[j].w * rs * g.w) << 32); }
}
__device__ __forceinline__ void p0_prologue(Frame& F) {
    LAS float* scr = (LAS float*)(F.lds + RING_OFF + F.wave * 16384);
    const int gw = F.vcu * NWAVES + F.wave, NGW = F.G * NWAVES;
    constexpr int I_IN = (DM / 64) * (NIN / 32), I_BR = (512 / 64) * (DM / 32), I_O = (DM / 64) * (DM / 32), I_UP = (DM / 64) * (FF / 32), I_DN = (FF / 64) * (DM / 32);
    constexpr int NITEMS = I_IN + 2 * I_BR + I_O + I_UP + I_DN;
    for (int it = gw; it < NITEMS; it += NGW) {
        int r = it;
        if (r < I_IN) { const int nblk = NIN / 32, kb = r / nblk, nb = r % nblk, n0 = 32 * nb, nt = n0 & 255;
            int prow0 = (n0 & ~255) + 128 * ((nt >> 5) & 1) + 32 * (nt >> 6);
            if (n0 >= 2304) { const int isb = n0 >= 3328 ? 1 : 0, c0 = n0 - (isb ? 3328 : 2304); prow0 = 256 * (9 + (c0 >> 7)) + 128 * isb + 32 * ((c0 & 127) >> 5); }
            p0_transpose_item(F.w_in, NIN, F.WinT, DM, 0, prow0, scr, 64 * kb, n0, F.lane); continue; } r -= I_IN;
        if (r < I_BR) { const int nblk = DM / 32, kb = r / nblk, nb = r % nblk; p0_transpose_item(F.wba, DM, F.WbrT, DM, 0, 32 * nb, scr, 64 * kb, 32 * nb, F.lane); continue; } r -= I_BR;
        if (r < I_BR) { const int nblk = DM / 32, kb = r / nblk, nb = r % nblk; p0_transpose_item(F.wbb, DM, F.WbrT, DM, 512, 32 * nb, scr, 64 * kb, 32 * nb, F.lane); continue; } r -= I_BR;
        if (r < I_O)  { const int nblk = DM / 32, kb = r / nblk, nb = r % nblk; p0_transpose_item(F.w_out, DM, F.WoT, DM, 0, 32 * nb, scr, 64 * kb, 32 * nb, F.lane); continue; } r -= I_O;
        if (r < I_UP) { const int nblk = FF / 32, kb = r / nblk, nb = r % nblk; p0_transpose_item(F.w_up, FF, F.WupT, DM, 0, 32 * nb, scr, 64 * kb, 32 * nb, F.lane, F.norm_mlp); continue; } r -= I_UP;
        { const int nblk = DM / 32, kb = r / nblk, nb = r % nblk; p0_transpose_item(F.w_down, DM, F.WdnT, FF, 0, 32 * nb, scr, 64 * kb, 32 * nb, F.lane); }
    }
    for (int m = gw; m < M; m += NGW) rms_row_to_bf16(F, F.x + (size_t)m * DM, F.norm_attn, F.XN + (size_t)m * DM);
}
__device__ __forceinline__ void sa_load32(const bf16* p, float (&d)[32]) {
#pragma unroll
    for (int i = 0; i < 4; ++i) { const v4u w = *(const GAS v4u*)(p + 8 * i);
        d[8 * i + 0] = __uint_as_float(w.x << 16); d[8 * i + 1] = __uint_as_float(w.x & 0xffff0000u); d[8 * i + 2] = __uint_as_float(w.y << 16); d[8 * i + 3] = __uint_as_float(w.y & 0xffff0000u);
        d[8 * i + 4] = __uint_as_float(w.z << 16); d[8 * i + 5] = __uint_as_float(w.z & 0xffff0000u); d[8 * i + 6] = __uint_as_float(w.w << 16); d[8 * i + 7] = __uint_as_float(w.w & 0xffff0000u); }
}
__device__ __forceinline__ void sa_store32(bf16* p, const float (&o)[32], float sc) {
#pragma unroll
    for (int i = 0; i < 4; ++i) { v4u w; w.x = pk2(o[8 * i] * sc, o[8 * i + 1] * sc); w.y = pk2(o[8 * i + 2] * sc, o[8 * i + 3] * sc); w.z = pk2(o[8 * i + 4] * sc, o[8 * i + 5] * sc); w.w = pk2(o[8 * i + 6] * sc, o[8 * i + 7] * sc);
        *(GAS v4u*)(p + 8 * i) = w; }
}
#define SA_KEY(KPTR, VPTR, BIAS, VALID) do { \
    float s_ = 0.f; \
    { float kv_[32]; sa_load32((KPTR) + dof, kv_); \
        _Pragma("unroll") for (int d_ = 0; d_ < 32; ++d_) s_ = __builtin_fmaf(q[d_], kv_[d_], s_); asm volatile("" ::: "memory"); } \
    s_ += __shfl_xor(s_, 1); \
    s_ += (BIAS); const bool ok_ = (VALID); const float se_ = ok_ ? s_ : -1e30f; \
    if (__any(se_ > m)) { const float mn_ = __builtin_fmaxf(m, se_); const float c_ = __builtin_amdgcn_exp2f(m - mn_); l *= c_; _Pragma("unroll") for (int d_ = 0; d_ < 32; ++d_) o[d_] *= c_; m = mn_; } \
    const float p_ = ok_ ? __builtin_amdgcn_exp2f(s_ - m) : 0.f; l += p_; \
    { float kv_[32]; sa_load32((VPTR) + dof, kv_); \
        _Pragma("unroll") for (int d_ = 0; d_ < 32; ++d_) o[d_] = __builtin_fmaf(p_, kv_[d_], o[d_]); asm volatile("" ::: "memory"); } } while (0)

__device__ __forceinline__ void sa_moba(const bf16* Q, const bf16* KA, const bf16* VA, const float* kmean, bf16* O, int b, int h, int t0, int lane) {
    const int dof = 32 * (lane & 1);
    const int t = t0 + (lane >> 1), own = t0 >> 8;
    float q[32]; sa_load32(Q + ((size_t)(b * SEQ + t)) * 1024 + h * 64 + dof, q);
    unsigned sel;
    if (own <= 3) sel = (1u << own) - 1u;
    else {
        float gs[7];
#pragma unroll
        for (int n = 0; n < 7; ++n) { gs[n] = -INFINITY;
            if (n < own) { const float* km = kmean + ((size_t)(b * 8 + n) * 8 + h) * 64 + dof; float s = 0.f;
#pragma unroll
                for (int d = 0; d < 32; d += 4) { const f32x4 kv = *(const GAS f32x4*)(km + d); s = __builtin_fmaf(q[d], kv.x, s); s = __builtin_fmaf(q[d + 1], kv.y, s); s = __builtin_fmaf(q[d + 2], kv.z, s); s = __builtin_fmaf(q[d + 3], kv.w, s); }
                s += __shfl_xor(s, 1);
                gs[n] = s; asm volatile("" ::: "memory"); } }
        sel = 0u;
#pragma unroll
        for (int n = 0; n < 7; ++n) { int rank = 0;
#pragma unroll
            for (int j = 0; j < 7; ++j) if (j != n) rank += (gs[j] > gs[n] || (gs[j] == gs[n] && j < n)) ? 1 : 0;
            if (n < own && rank < 3) sel |= 1u << n; }
    }
    const float slope2 = exp2f(-0.5f * (float)(h + 9)) * pg8::kLog2e;
    float m = -1e30f, l = 0.f, o[32];
#pragma unroll
    for (int d = 0; d < 32; ++d) o[d] = 0.f;
    for (int n = 0; n <= own; ++n) {
        const bool isown = (n == own), mine = isown || ((sel >> n) & 1u);
        if (!__any(mine)) continue;
        const int nk = isown ? (t0 + 32 - n * 256) : 256;
        for (int kk = 0; kk < nk; ++kk) { const int tk = n * 256 + kk; const size_t r = (size_t)(b * SEQ + tk) * 512 + h * 64;
            SA_KEY(KA + r, VA + r, -slope2 * (float)(t - tk), mine && (tk <= t)); }
    }
    sa_store32(O + ((size_t)(b * SEQ + t)) * 1024 + h * 64 + dof, o, 1.0f / l);
}
__device__ __forceinline__ void sa_swa(const bf16* Q, const bf16* KB, const bf16* VB, const float* sinks, bf16* O, int b, int hq, int t0, int lane) {
    const int dof = 32 * (lane & 1);
    const int t = t0 + (lane >> 1), kvh = hq >> 2;
    float q[32]; sa_load32(Q + ((size_t)(b * SEQ + t)) * 1024 + 512 + hq * 64 + dof, q);
    const float slope2 = exp2f(-0.5f * (float)(hq + 1)) * pg8::kLog2e, sink2 = sinks[hq] * pg8::kLog2e;
    float m = -1e30f, l = 0.f, o[32];
#pragma unroll
    for (int d = 0; d < 32; ++d) o[d] = 0.f;
    const int k0 = t0 - 127 > 0 ? t0 - 127 : 0;
    for (int tk = k0; tk < t0 + 32; ++tk) { const size_t r = (size_t)(b * SEQ + tk) * 128 + kvh * 64;
        SA_KEY(KB + r, VB + r, -slope2 * (float)(t - tk), (tk <= t) && (t - tk < 128)); }
    const float mf = __builtin_fmaxf(m, sink2), c = __builtin_amdgcn_exp2f(m - mf);
    l = l * c + __builtin_amdgcn_exp2f(sink2 - mf);
    sa_store32(O + ((size_t)(b * SEQ + t)) * 1024 + 512 + hq * 64 + dof, o, c / l);
}
__device__ __forceinline__ void attn_simple_phase(Frame& F) {
    const int gw = F.vcu * NWAVES + F.wave, NGW = F.G * NWAVES;
    int i = 0;
    for (int u = gw; u < 8192; u += NGW, ++i) { const int b = u >> 9, h = (u >> 6) & 7; int ch = u & 63; if (i & 1) ch = 63 - ch;
        sa_moba(F.Q, F.KA, F.VA, F.kmean, F.Q, b, h, ch * 32, F.lane); }
    for (int u = gw; u < 8192; u += NGW) { const int b = u >> 9, hq = (u >> 6) & 7, ch = u & 63;
        sa_swa(F.Q, F.KB, F.VB, F.sinks, F.Q, b, hq, ch * 32, F.lane); }
}

namespace fa {
using bf16x8 = __attribute__((ext_vector_type(8))) short;
using s16x4 = __attribute__((ext_vector_type(4))) short;
using f32x16 = __attribute__((ext_vector_type(16))) float;
using u32x4 = __attribute__((ext_vector_type(4))) unsigned;
constexpr int NW = 8, QBLK = 32, KVBLK = 64;
constexpr int SLOTB = 8192, LDS_K = 0, LDS_V = 3 * SLOTB, LDS_WS = 6 * SLOTB, LDS_OST = LDS_WS + NW * 256, LDS_BYTES = LDS_OST + NW * 4096;
constexpr int QP = 1024;
#ifndef FA_THR
#define FA_THR 8
#endif
#define SBAR() __builtin_amdgcn_sched_barrier(0)
#define PIN(x) asm volatile("" : "+v"(x))
#define MFMA(a, b, c) __builtin_amdgcn_mfma_f32_32x32x16_bf16(a, b, c, 0, 0, 0)
#define WAIT_BAR(N) asm volatile("s_waitcnt vmcnt(" #N ") lgkmcnt(0)\n\ts_barrier" ::: "memory")
__device__ __forceinline__ int crow(int r, int hi) { return (r & 3) + 8 * (r >> 2) + 4 * hi; }
__device__ __forceinline__ unsigned cvtpk(float lo, float hi) { unsigned r; asm("v_cvt_pk_bf16_f32 %0, %1, %2" : "=v"(r) : "v"(lo), "v"(hi)); return r; }
__device__ __forceinline__ void glds16(const void* g, unsigned lds_base) {
    unsigned sv; asm volatile("s_mov_b32 %0, m0\n\ts_mov_b32 m0, %2\n\ts_nop 0\n\tglobal_load_lds_dwordx4 %1, off\n\ts_mov_b32 m0, %0" : "=&s"(sv) : "v"(g), "s"(lds_base) : "memory"); }
typedef __attribute__((address_space(3))) const char* lds_cptr;
typedef short v4i16_t __attribute__((ext_vector_type(4)));
__device__ __forceinline__ void kload2(bf16x8* kf, lds_cptr kp, int d0) { kf[2 * d0] = *(const __attribute__((address_space(3))) bf16x8*)(kp + d0 * 2048); kf[2 * d0 + 1] = *(const __attribute__((address_space(3))) bf16x8*)(kp + d0 * 2048 + 512); }
__device__ __forceinline__ s16x4 vtr(lds_cptr p) { return __builtin_bit_cast(s16x4, __builtin_amdgcn_ds_read_tr16_b64_v4i16((__attribute__((address_space(3))) v4i16_t*)p)); }
#define MX3(a, b, c) __builtin_fmaxf(__builtin_fmaxf((a), (b)), (c))
__device__ __forceinline__ float rowmax(const f32x16& p0, const f32x16& p1) {
    float a = MX3(p0[0], p0[1], p1[0]), b = MX3(p0[2], p0[3], p1[1]); a = MX3(a, p1[2], p1[3]);
#pragma unroll
    for (int r = 4; r < 16; r += 4) { a = MX3(a, p0[r], p0[r + 1]); b = MX3(b, p0[r + 2], p0[r + 3]); a = MX3(a, p1[r], p1[r + 1]); b = MX3(b, p1[r + 2], p1[r + 3]); }
    float m = __builtin_fmaxf(a, b); auto rr = __builtin_amdgcn_permlane32_swap(__float_as_uint(m), __float_as_uint(m), false, false);
    return __builtin_fmaxf(__uint_as_float(rr[0]), __uint_as_float(rr[1])); }
__device__ __forceinline__ void emask(f32x16& p0, f32x16& p1, int dq  , unsigned wd) {
#pragma unroll
    for (int r = 0; r < 16; ++r) { const int kv = (r & 3) + 8 * (r >> 2); if ((unsigned)(dq - kv) >= wd) p0[r] = -INFINITY; if ((unsigned)(dq - kv - 32) >= wd) p1[r] = -INFINITY; } }
__device__ __forceinline__ unsigned bf16bits(float f) { unsigned u = __float_as_uint(f); return (u + 0x7fffu + ((u >> 16) & 1u)) >> 16; }

struct AU {
    const bf16* Qw;
    bf16* Ow;
    const bf16* Kb;
    const bf16* Vb;
    int KP;
    int q0;
    int qrel0;
    int NT;
    int mode;
    unsigned wd;
    float slope2;
    float sink2;
    unsigned okmask;
};
__device__ __forceinline__ int key_rel(const AU& u, int t) {
    if (u.mode == 0) { const int np = u.NT - 4; return t == 0 ? 0 : (t <= np ? 64 * (t - 1) - 64 * np : 64 * (t - np)); }
    return -64 * t;
}
__device__ __forceinline__ void attn_unit(const AU& u, char* lds) {
    const int tid = threadIdx.x; int lane = tid & 63; asm volatile("" : "+v"(lane));
    const int r32 = lane & 31, hi = lane >> 5; const int wid = __builtin_amdgcn_readfirstlane(tid >> 6);
    const int NT = u.NT, KP = u.KP;
    const unsigned lds0 = (unsigned)(uintptr_t)lds; float* wsf = (float*)(lds + LDS_WS) + wid * 64;
    const bf16* ksrc = u.Kb + (long)lane * KP + wid * 8;
    const bf16* vsrc = u.Vb + (long)(16 * (wid & 3) + (lane >> 2)) * KP + (wid >> 2) * 32 + (lane & 3) * 8;
    const unsigned kdst = lds0 + LDS_K + wid * 1024, vdst = lds0 + LDS_V + wid * 1024;
#define KROW(t) ({ int r_ = u.q0 + key_rel(u, (t)); r_ < 0 ? 0 : r_; })
#define DMA_K(t, slot) glds16(ksrc + (long)KROW(t) * KP, (unsigned)__builtin_amdgcn_readfirstlane(kdst + (slot)))
#define DMA_V(t, slot) glds16(vsrc + (long)KROW(t) * KP, (unsigned)__builtin_amdgcn_readfirstlane(vdst + (slot)))
    const lds_cptr vp0 = (lds_cptr)lds + LDS_V + ((lane >> 4) & 1) * 32 + (lane & 3) * 8 + (4 * hi + ((lane & 15) >> 2)) * 64;
    const lds_cptr kp0 = (lds_cptr)lds + LDS_K + hi * 1024 + r32 * 16;
    DMA_K(0, 0); DMA_V(0, 0); DMA_K(1, SLOTB);
    bf16x8 qr[4];
#pragma unroll
    for (int d0 = 0; d0 < 4; ++d0) qr[d0] = *reinterpret_cast<const bf16x8*>(&u.Qw[(long)r32 * QP + d0 * 16 + hi * 8]);
    bf16x8 qaug, kaug0, kaug1;
    { const unsigned sh = bf16bits(u.slope2); const float rem = u.slope2 - __uint_as_float(sh << 16); const unsigned sl = bf16bits(rem);
      const unsigned Sh = bf16bits(64.f * __uint_as_float(sh << 16)), Sl = bf16bits(64.f * __uint_as_float(sl << 16));
      u32x4 w = {hi ? 0u : (sh | (sl << 16)), hi ? 0u : (Sh | (Sl << 16)), 0u, 0u}; qaug = __builtin_bit_cast(bf16x8, w);
      const unsigned k0b = bf16bits((float)r32), k1b = bf16bits((float)(r32 + 32));
      u32x4 a0 = {k0b | (k0b << 16), 0u, 0u, 0u}, a1 = {k1b | (k1b << 16), 0u, 0u, 0u}; kaug0 = __builtin_bit_cast(bf16x8, a0); kaug1 = __builtin_bit_cast(bf16x8, a1); }
#define SET_TILE(t) do { const unsigned tb_ = bf16bits((float)(key_rel(u, (t)) >> 6)); const unsigned tw_ = tb_ | (tb_ << 16); \
      u32x4 a0_ = __builtin_bit_cast(u32x4, kaug0), a1_ = __builtin_bit_cast(u32x4, kaug1); a0_[1] = tw_; a1_[1] = tw_; kaug0 = __builtin_bit_cast(bf16x8, a0_); kaug1 = __builtin_bit_cast(bf16x8, a1_); } while (0)
    float mhat = 0.f, l_reg = 0.f; f32x16 o[2]; o[0] = f32x16{}; o[1] = f32x16{};
    const int qrel = u.qrel0 + r32; bool resc = false; const unsigned okmask = u.okmask, wd = u.wd;
    f32x16 pA0, pA1, pB0, pB1; bf16x8 kf[8]; s16x4 vlo[8], vhi[8]; u32x4 pw0, pw1, pw2, pw3;
    int sl_prev = 0, sl_cur = 0, sl_next = SLOTB;
#define ROT() do { sl_prev = sl_cur; sl_cur = sl_next; sl_next = (sl_next == 2 * SLOTB) ? 0 : sl_next + SLOTB; } while (0)
#define EX(v) __builtin_amdgcn_exp2f((v) + nmh)
#define RESC() do { if (resc) { _Pragma("unroll") for (int d_ = 0; d_ < 2; ++d_) _Pragma("unroll") for (int r = 0; r < 16; ++r) o[d_][r] *= wsf[crow(r, hi)]; } } while (0)
    DMA_K(2, 2 * SLOTB);
    WAIT_BAR(3);
    _Pragma("unroll") for (int d0 = 0; d0 < 4; ++d0) kload2(kf, kp0, d0);
    SET_TILE(0);
    pA0 = MFMA(kaug0, qaug, f32x16{}); pA1 = MFMA(kaug1, qaug, f32x16{});
    pA0 = MFMA(kf[0], qr[0], pA0); pA1 = MFMA(kf[1], qr[0], pA1); pA0 = MFMA(kf[2], qr[1], pA0); pA1 = MFMA(kf[3], qr[1], pA1);
    pA0 = MFMA(kf[4], qr[2], pA0); pA1 = MFMA(kf[5], qr[2], pA1); pA0 = MFMA(kf[6], qr[3], pA0); pA1 = MFMA(kf[7], qr[3], pA1);
    emask(pA0, pA1, qrel - key_rel(u, 0) - 4 * hi, wd);
    { const float rm = rowmax(pA0, pA1); mhat = rm; const float nmh = -mhat;
#pragma unroll
      for (int r = 0; r < 16; ++r) { pA0[r] = EX(pA0[r]); pA1[r] = EX(pA1[r]); } }
    WAIT_BAR(0);
    DMA_K(3, 0); DMA_V(1, SLOTB); ROT();
    _Pragma("unroll") for (int d0 = 0; d0 < 4; ++d0) kload2(kf, kp0 + sl_cur, d0);
    WAIT_BAR(2);
#define PKW(P, i) cvtpk(P[i], P[i + 1])
#define PAF(k) __builtin_bit_cast(bf16x8, pw##k)
#define VFR(i) (bf16x8){vlo[i][0], vlo[i][1], vlo[i][2], vlo[i][3], vhi[i][0], vhi[i][1], vhi[i][2], vhi[i][3]}
#define VRD(i) do { vlo[i] = vtr(vp_ + (((i) >> 2) * 4096 + ((i) & 3) * 1024)); vhi[i] = vtr(vp_ + (((i) >> 2) * 4096 + ((i) & 3) * 1024 + 512)); } while (0)
#define KRD(G, d0) do { if (G) { kload2(kf, kp0 + sl_next, d0); SBAR(); } } while (0)
#define GAPA(MF, a0, a1, a2, a3, W0, W1, PW) do { MF; sacc += a0; sacc += a1; sacc += a2; sacc += a3; W0; W1; PIN(PW); PIN(sacc); SBAR(); } while (0)
#define GAPB(MF, X, i) do { MF; X[i] = EX(X[i]); X[i + 1] = EX(X[i + 1]); X[i + 2] = EX(X[i + 2]); X[i + 3] = EX(X[i + 3]); PIN(X); SBAR(); } while (0)
#define STEP(C0, C1, P0, P1, t, MASK, GK, GV, GL) do { SBAR(); \
    const lds_cptr vp_ = vp0 + sl_prev; SET_TILE(t); \
    C0 = MFMA(kaug0, qaug, f32x16{}); C1 = MFMA(kaug1, qaug, f32x16{}); SBAR(); \
    VRD(0); SBAR(); float sacc = P0[0] + P0[1]; \
                    GAPA(C0 = MFMA(kf[0], qr[0], C0), P0[2], P0[3], P0[4], P0[5],     pw0[0] = PKW(P0, 0),  pw0[1] = PKW(P0, 2),  pw0); \
    VRD(4); SBAR(); GAPA(C1 = MFMA(kf[1], qr[0], C1), P0[6], P0[7], P0[8], P0[9],     pw0[2] = PKW(P0, 4),  pw0[3] = PKW(P0, 6),  pw0); \
    VRD(1); SBAR(); GAPA(C0 = MFMA(kf[2], qr[1], C0),    P0[10], P0[11], P0[12], P0[13], pw1[0] = PKW(P0, 8),  pw1[1] = PKW(P0, 10), pw1); \
    VRD(5); SBAR(); GAPA(C1 = MFMA(kf[3], qr[1], C1),    P0[14], P0[15], P1[0], P1[1],   pw1[2] = PKW(P0, 12), pw1[3] = PKW(P0, 14), pw1); \
    VRD(2); SBAR(); GAPA(C0 = MFMA(kf[4], qr[2], C0),    P1[2], P1[3], P1[4], P1[5],     pw2[0] = PKW(P1, 0),  pw2[1] = PKW(P1, 2),  pw2); \
    VRD(6); SBAR(); GAPA(C1 = MFMA(kf[5], qr[2], C1),    P1[6], P1[7], P1[8], P1[9],     pw2[2] = PKW(P1, 4),  pw2[3] = PKW(P1, 6),  pw2); \
    VRD(3); SBAR(); GAPA(C0 = MFMA(kf[6], qr[3], C0),    P1[10], P1[11], P1[12], P1[13], pw3[0] = PKW(P1, 8),  pw3[1] = PKW(P1, 10), pw3); \
    VRD(7); SBAR(); GAPA(C1 = MFMA(kf[7], qr[3], C1),    P1[14], P1[15], 0.f, 0.f,       pw3[2] = PKW(P1, 12), pw3[3] = PKW(P1, 14), pw3); \
    l_reg += sacc; \
    if (GK) DMA_K((t) + 3, sl_cur); if (GV) DMA_V((t) + 1, sl_next); \
    if (MASK) emask(C0, C1, qrel - key_rel(u, (t)) - 4 * hi, wd); \
    const bool ok_ = (okmask >> (t)) & 1u; \
    { float rm = rowmax(C0, C1); rm = ok_ ? rm - mhat : -INFINITY; resc = false; \
      if (__builtin_expect(__any(rm > (float)FA_THR), 0)) { const float dl = __builtin_fmaxf(rm, 0.f); mhat += dl; \
          const float f = __builtin_amdgcn_exp2f(-dl); l_reg *= f; if (hi == 0) wsf[r32] = f; resc = true; } } \
    const float nmh = ok_ ? -mhat : -INFINITY; SBAR(); \
    GAPB(o[0] = MFMA(PAF(0), VFR(0), o[0]), C0, 0);              GAPB(o[1] = MFMA(PAF(0), VFR(4), o[1]), C0, 4); \
    KRD(GL, 0); GAPB(o[0] = MFMA(PAF(1), VFR(1), o[0]), C0, 8);  KRD(GL, 1); GAPB(o[1] = MFMA(PAF(1), VFR(5), o[1]), C0, 12); \
    KRD(GL, 2); GAPB(o[0] = MFMA(PAF(2), VFR(2), o[0]), C1, 0);  KRD(GL, 3); GAPB(o[1] = MFMA(PAF(2), VFR(6), o[1]), C1, 4); \
    GAPB(o[0] = MFMA(PAF(3), VFR(3), o[0]), C1, 8);              GAPB(o[1] = MFMA(PAF(3), VFR(7), o[1]), C1, 12); \
    } while (0)
    int t = 1;
    for (; t + 5 < NT; t += 2) {
        STEP(pB0, pB1, pA0, pA1, t, false, true, true, true);     WAIT_BAR(2); RESC(); ROT();
        STEP(pA0, pA1, pB0, pB1, t + 1, false, true, true, true); WAIT_BAR(2); RESC(); ROT();
    }
#define ENDW(tt) do { if ((tt) + 3 < NT) { WAIT_BAR(2); } else if ((tt) + 2 < NT) { WAIT_BAR(1); } else { WAIT_BAR(0); } } while (0)
    for (; t + 1 < NT; t += 2) {
        STEP(pB0, pB1, pA0, pA1, t, true, (t + 3 < NT), (t + 1 < NT), (t + 1 < NT));         ENDW(t);     RESC(); ROT();
        STEP(pA0, pA1, pB0, pB1, t + 1, true, (t + 4 < NT), (t + 2 < NT), (t + 2 < NT));     ENDW(t + 1); RESC(); ROT();
    }
    STEP(pB0, pB1, pA0, pA1, NT - 1, true, false, false, false); RESC();
    { float sacc = pB0[0] + pB0[1];
#pragma unroll
      for (int r = 2; r < 16; ++r) sacc += pB0[r];
#pragma unroll
      for (int r = 0; r < 16; ++r) sacc += pB1[r];
      l_reg += sacc;
      pw0 = (u32x4){PKW(pB0, 0), PKW(pB0, 2), PKW(pB0, 4), PKW(pB0, 6)}; pw1 = (u32x4){PKW(pB0, 8), PKW(pB0, 10), PKW(pB0, 12), PKW(pB0, 14)};
      pw2 = (u32x4){PKW(pB1, 0), PKW(pB1, 2), PKW(pB1, 4), PKW(pB1, 6)}; pw3 = (u32x4){PKW(pB1, 8), PKW(pB1, 10), PKW(pB1, 12), PKW(pB1, 14)};
      const lds_cptr vp_ = vp0 + sl_cur; _Pragma("unroll") for (int i = 0; i < 8; ++i) VRD(i);
      o[0] = MFMA(PAF(0), VFR(0), o[0]); o[1] = MFMA(PAF(0), VFR(4), o[1]); o[0] = MFMA(PAF(1), VFR(1), o[0]); o[1] = MFMA(PAF(1), VFR(5), o[1]);
      o[0] = MFMA(PAF(2), VFR(2), o[0]); o[1] = MFMA(PAF(2), VFR(6), o[1]); o[0] = MFMA(PAF(3), VFR(3), o[0]); o[1] = MFMA(PAF(3), VFR(7), o[1]); }
    { auto rr = __builtin_amdgcn_permlane32_swap(__float_as_uint(l_reg), __float_as_uint(l_reg), false, false); l_reg = __uint_as_float(rr[0]) + __uint_as_float(rr[1]); }
    {
      const float sk = u.sink2 + u.slope2 * (float)qrel, mf = __builtin_fmaxf(mhat, sk), c = __builtin_amdgcn_exp2f(mhat - mf);
      const float lt = l_reg * c + __builtin_amdgcn_exp2f(sk - mf);
      if (hi == 0) wsf[32 + r32] = c * __builtin_amdgcn_rcpf(lt); }
    asm volatile("s_waitcnt lgkmcnt(0)" ::: "memory");
    float rli[16];
#pragma unroll
    for (int r = 0; r < 16; ++r) rli[r] = wsf[32 + crow(r, hi)];
    bf16* stg = (bf16*)(lds + LDS_OST) + wid * 2048;
    { int l2 = lane; asm volatile("" : "+v"(l2)); const int r32b = l2 & 31, hib = l2 >> 5;
#pragma unroll
    for (int r = 0; r < 16; ++r) { const int orow = crow(r, hib);
#pragma unroll
        for (int d0 = 0; d0 < 2; ++d0) stg[orow * 64 + d0 * 32 + r32b] = (bf16)bf16bits(o[d0][r] * rli[r]); }
    asm volatile("s_waitcnt lgkmcnt(0)" ::: "memory");
    const int srow = l2 >> 3, ch = l2 & 7; const u32x4* sp = (const u32x4*)(stg + srow * 64 + ch * 8); bf16* gp = u.Ow + (long)srow * QP + ch * 8;
#pragma unroll
    for (int i = 0; i < 4; ++i) *(u32x4*)(gp + (long)i * 8 * QP) = sp[i * 64]; }
    asm volatile("s_waitcnt lgkmcnt(0)\n\ts_barrier" ::: "memory");
#undef KROW
#undef DMA_K
#undef DMA_V
#undef SET_TILE
#undef ROT
#undef EX
#undef RESC
#undef PKW
#undef PAF
#undef VFR
#undef VRD
#undef KRD
#undef ENDW
#undef GAPA
#undef GAPB
#undef STEP
}
#undef SBAR
#undef PIN
#undef MFMA
#undef WAIT_BAR
#undef MX3
}

__device__ __forceinline__ float bfbits2f(short s) { return __uint_as_float(((unsigned)(unsigned short)s) << 16); }
__device__ __forceinline__ void attn_fast_phase(Frame& F, char* lds, bf16* O) {
    const int wid = F.wave;
    for (int i = 0; i < 8; ++i) {
        int lane = F.lane; asm volatile("" : "+v"(lane)); const int r32 = lane & 31, hi = lane >> 5;
        fa::AU u; size_t qoff;
        if (i < 4) {
            const int p = F.vcu >> 1, b = p >> 3, h = p & 7, half = F.vcu & 1;
            const size_t rowbase = (size_t)b * SEQ;
            const int j = half ? (i == 0 ? 6 : i == 1 ? 5 : i == 2 ? 2 : 1) : (i == 0 ? 7 : i == 1 ? 4 : i == 2 ? 3 : 0);
            qoff = (rowbase + 256 * j + 32 * wid) * 1024 + h * 64;
            u.Kb = F.KA + rowbase * 512 + h * 64; u.Vb = F.VA + rowbase * 512 + h * 64; u.KP = 512;
            u.q0 = 256 * j; u.qrel0 = 32 * wid; u.NT = 4 * (j + 1); u.mode = 0; u.wd = 0x40000000u;
            u.slope2 = exp2f(-0.5f * (float)(h + 9)) * pg8::kLog2e; u.sink2 = -INFINITY;
            unsigned sel;
            if (j <= 3) sel = (1u << j) - 1u;
            else {
                fa::bf16x8 qv[4];
#pragma unroll
                for (int d0 = 0; d0 < 4; ++d0) qv[d0] = *reinterpret_cast<const fa::bf16x8*>(&F.Q[qoff + (size_t)r32 * 1024 + d0 * 16 + hi * 8]);
                float gs[7];
#pragma unroll
                for (int n = 0; n < 7; ++n) { gs[n] = -INFINITY;
                    if (n < j) { const float* km = F.kmean + ((size_t)(b * 8 + n) * 8 + h) * 64 + 8 * hi; float s = 0.f;
#pragma unroll
                        for (int d0 = 0; d0 < 4; ++d0) { const f32x4 k0 = *(const GAS f32x4*)(km + 16 * d0), k1 = *(const GAS f32x4*)(km + 16 * d0 + 4);
                            s = __builtin_fmaf(bfbits2f(qv[d0][0]), k0.x, s); s = __builtin_fmaf(bfbits2f(qv[d0][1]), k0.y, s); s = __builtin_fmaf(bfbits2f(qv[d0][2]), k0.z, s); s = __builtin_fmaf(bfbits2f(qv[d0][3]), k0.w, s);
                            s = __builtin_fmaf(bfbits2f(qv[d0][4]), k1.x, s); s = __builtin_fmaf(bfbits2f(qv[d0][5]), k1.y, s); s = __builtin_fmaf(bfbits2f(qv[d0][6]), k1.z, s); s = __builtin_fmaf(bfbits2f(qv[d0][7]), k1.w, s); }
                        s += __shfl_xor(s, 32); gs[n] = s; } }
                sel = 0u;
#pragma unroll
                for (int n = 0; n < 7; ++n) { int rank = 0;
#pragma unroll
                    for (int k = 0; k < 7; ++k) if (k != n) rank += (gs[k] > gs[n] || (gs[k] == gs[n] && k < n)) ? 1 : 0;
                    if (n < j && rank < 3) sel |= 1u << n; }
            }
            unsigned ok = 1u | (7u << (u.NT - 3));
#pragma unroll
            for (int n = 0; n < 7; ++n) if ((sel >> n) & 1u) ok |= 0xFu << (1 + 4 * n);
            u.okmask = ok;
        } else {
            const int us = F.vcu * 4 + (i - 4), b = us >> 6, kvh = (us >> 5) & 1, c = us & 31, hq = kvh * 4 + (wid >> 1);
            const size_t rowbase = (size_t)b * SEQ;
            qoff = (rowbase + 64 * c + 32 * (wid & 1)) * 1024 + 512 + hq * 64;
            u.Kb = F.KB + rowbase * 128 + kvh * 64; u.Vb = F.VB + rowbase * 128 + kvh * 64; u.KP = 128;
            u.q0 = 64 * c; u.qrel0 = 32 * (wid & 1); u.NT = 4; u.mode = 1; u.wd = 128u;
            u.slope2 = exp2f(-0.5f * (float)(hq + 1)) * pg8::kLog2e; u.sink2 = F.sinks[hq] * pg8::kLog2e;
            u.okmask = (c >= 3) ? 0xFu : ((1u << (c + 1)) - 1u);
        }
        u.Qw = F.Q + qoff; u.Ow = O + qoff;
        fa::attn_unit(u, lds);
    }
}
#if defined(DBG_ATTN)
__device__ __forceinline__ void dbg_compare(Frame& F, const bf16* Od) {
    const int gt = F.vcu * NWAVES * 64 + F.tid, NGT = F.G * NWAVES * 64; float num = 0.f, den = 0.f;
    for (size_t i = gt; i < (size_t)M * 64; i += NGT) { const size_t row = i >> 6, c8 = i & 63; const size_t off = row * 1024 + DBG_PART * 512 + c8 * 8;
        const v4u a = *(const GAS v4u*)(Od + off), r = *(const GAS v4u*)(F.Q + off);
#define DD(x) { const float a0 = __uint_as_float(a.x << 16), a1 = __uint_as_float(a.x & 0xffff0000u), r0 = __uint_as_float(r.x << 16), r1 = __uint_as_float(r.x & 0xffff0000u); num += (a0 - r0) * (a0 - r0) + (a1 - r1) * (a1 - r1); den += r0 * r0 + r1 * r1; }
        DD(x) DD(y) DD(z) DD(w)
#undef DD
    }
    num = wave_sum(num); den = wave_sum(den);
    if (F.lane == 0) { atomicAdd((float*)(F.ctl) + 8, num); atomicAdd((float*)(F.ctl) + 9, den); }
}
#endif

struct Args { const float* in[14]; float* out; unsigned char* ws; };
__global__ void __launch_bounds__(NWAVES * 64, 2) fwd_megakernel(Args args) {
    extern __shared__ __attribute__((aligned(16))) unsigned char lds[];
    Frame F;
    F.lds = (LAS unsigned char*)lds;
    F.MISC = (volatile LAS unsigned*)(F.lds + MISC_OFF);
    F.tid = threadIdx.x; F.lane = F.tid & 63; F.wave = __builtin_amdgcn_readfirstlane(F.tid >> 6);
    F.G = gridDim.x; { const int bx = blockIdx.x; F.vcu = (F.G % 8 == 0) ? (bx % 8) * (F.G / 8) + bx / 8 : bx; }
    unsigned char* ws = args.ws;
    F.ctl = (gu32*)(ws + WS_CTL);
    F.x = args.in[0]; F.norm_attn = args.in[1]; F.w_in = args.in[2]; F.qna = args.in[3]; F.kna = args.in[4]; F.qnb = args.in[5]; F.knb = args.in[6]; F.sinks = args.in[7];
    F.wba = args.in[8]; F.wbb = args.in[9]; F.w_out = args.in[10]; F.norm_mlp = args.in[11]; F.w_up = args.in[12]; F.w_down = args.in[13]; F.out = args.out;
    F.WinT = (bf16*)(ws + WS_WIN); F.WbrT = (bf16*)(ws + WS_WBR); F.WoT = (bf16*)(ws + WS_WO); F.WupT = (bf16*)(ws + WS_WUP); F.WdnT = (bf16*)(ws + WS_WDN);
    F.Q = (bf16*)(ws + WS_Q); F.KA = (bf16*)(ws + WS_KA); F.VA = (bf16*)(ws + WS_VA); F.KB = (bf16*)(ws + WS_KB); F.VB = (bf16*)(ws + WS_VB);
    F.GA = (bf16*)(ws + WS_GA); F.GB = (bf16*)(ws + WS_GB); F.HB = (bf16*)(ws + WS_H); F.A2 = (bf16*)(ws + WS_A2); F.XN = (bf16*)(ws + WS_XN);
    F.kmean = (float*)(ws + WS_CTL) + CW_KMEAN; F.rowsq = (float*)(ws + WS_CTL) + CW_ROWSQ;
    for (int u = F.tid; u < (LDS_BYTES - LDSCTL_OFF) / 4; u += NWAVES * 64) ((LAS unsigned*)(F.lds + LDSCTL_OFF))[u] = 0u;
    __syncthreads();
    XcdBarrier bar = xcd_barrier_post((unsigned*)(F.ctl + CW_BAR), F.MISC + 8);
#define GRID_BAR() xcd_barrier(bar)

#ifndef SKIP_P0
    p0_prologue(F);
#endif
    GRID_BAR();
#ifndef SKIP_P1
    {   pg8::Gemm g{F.XN, F.WinT, M, NIN, DM}; pg8::StaticOrder S; S.init(M, NIN, F.G, (int)blockIdx.x);
        pg8::EpiIn E{F.Q, F.KA, F.VA, F.KB, F.VB, F.GA, F.GB, F.qna, F.kna, F.qnb, F.knb, F.kmean};
        pg8::gemm_phase<pg8::EpiIn, pg8::StaticOrder, true, true>(F.lds + RING_OFF, g, S, E); }
#endif
    GRID_BAR();
#if defined(DBG_ATTN)
    attn_fast_phase(F, (char*)lds + RING_OFF, F.XN); GRID_BAR(); attn_simple_phase(F); GRID_BAR(); dbg_compare(F, F.XN);
#elif defined(SIMPLE_ATTN)
    attn_simple_phase(F);
#else
    attn_fast_phase(F, (char*)lds + RING_OFF, F.Q);
#endif
    GRID_BAR();
#ifndef SKIP_P3
    {   pg8::Gemm g{F.Q, F.WbrT, M, DM, DM}; pg8::StaticOrder S; S.init(M, DM, F.G, (int)blockIdx.x);
        pg8::EpiMix E{F.GA, F.GB, F.XN};
        pg8::gemm_phase<pg8::EpiMix, pg8::StaticOrder, true, true>(F.lds + RING_OFF, g, S, E); }
#endif
    GRID_BAR();
#ifndef SKIP_P4
    {   pg8::Gemm g{F.XN, F.WoT, M, DM, DM}; pg8::StaticOrder S; S.init(M, DM, F.G, (int)blockIdx.x);
        pg8::EpiX1 E{F.x, F.A2, F.rowsq};
        pg8::gemm_phase<pg8::EpiX1, pg8::StaticOrder, true, true>(F.lds + RING_OFF, g, S, E); }
#endif
    GRID_BAR();
#ifndef SKIP_P5
    {   pg8::Gemm g{F.A2, F.WupT, M, FF, DM}; pg8::StaticOrder S; S.init(M, FF, F.G, (int)blockIdx.x);
        pg8::EpiUp E{F.HB, F.rowsq};
        pg8::gemm_phase<pg8::EpiUp, pg8::StaticOrder, true, true>(F.lds + RING_OFF, g, S, E); }
#endif
    GRID_BAR();
#ifndef SKIP_P6
    {   pg8::Gemm g{F.HB, F.WdnT, M, DM, FF}; pg8::StaticOrder S; S.init(M, DM, F.G, (int)blockIdx.x);
#if defined(DBG_ATTN)
        const float dnum = ((const GAS float*)F.ctl)[8], dden = ((const GAS float*)F.ctl)[9];
        pg8::EpiDown E{F.A2, F.out, 1.0f + 100.0f * sqrtf(dnum / dden)};
#else
        pg8::EpiDown E{F.A2, F.out, 1.0f};
#endif
        pg8::gemm_phase<pg8::EpiDown, pg8::StaticOrder, true, true>(F.lds + RING_OFF, g, S, E); }
#endif
}

extern "C" void kernel_launch(void* const* d_in, const int* in_sizes, int n_in, void* d_out, int out_size, void* d_ws, size_t ws_size, hipStream_t stream) {
    static int grid = 0;
    if (grid == 0) {
        if (n_in != 14 || in_sizes[0] != M * DM || out_size != M * DM || ws_size < WS_END) { fprintf(stderr, "kernel_launch: unexpected shapes: n_in %d, in0 %d, out %d, ws %zu (need %zu); nothing launched\n", n_in, n_in > 0 ? in_sizes[0] : -1, out_size, ws_size, (size_t)WS_END); grid = -1; return; }
        int dev = 0, cus = 0, per_cu = 0;
        if (hipGetDevice(&dev) != hipSuccess || hipDeviceGetAttribute(&cus, hipDeviceAttributeMultiprocessorCount, dev) != hipSuccess) { fprintf(stderr, "kernel_launch: device query failed\n"); grid = -1; return; }
        if (hipFuncSetAttribute((const void*)fwd_megakernel, hipFuncAttributeMaxDynamicSharedMemorySize, LDS_BYTES) != hipSuccess) { fprintf(stderr, "kernel_launch: hipFuncSetAttribute failed\n"); grid = -1; return; }
        if (hipOccupancyMaxActiveBlocksPerMultiprocessor(&per_cu, (const void*)fwd_megakernel, NWAVES * 64, LDS_BYTES) != hipSuccess || per_cu < 1)
            fprintf(stderr, "kernel_launch: note: occupancy query reports %d workgroups per CU\n", per_cu);
        (void)hipGetLastError();
        grid = cus;
    }
    if (grid < 0) return;
    if (hipMemsetAsync((char*)d_ws + WS_CTL, 0, CTL_ZERO_BYTES, stream) != hipSuccess) { fprintf(stderr, "kernel_launch: hipMemsetAsync failed\n"); return; }
    Args a{};
    for (int i = 0; i < 14; ++i) a.in[i] = (const float*)d_in[i];
    a.out = (float*)d_out; a.ws = (unsigned char*)d_ws;
    hipLaunchKernelGGL(fwd_megakernel, dim3(grid), dim3(NWAVES * 64), LDS_BYTES, stream, a);
    const hipError_t le = hipPeekAtLastError();
    if (le != hipSuccess) fprintf(stderr, "kernel_launch: launch failed: %s\n", hipGetErrorName(le));
}
```

```cpp
#include <hip/hip_runtime.h>
#include <cstdio>
#include <cstdint>
namespace pg8 {
#define PG8_LAS __attribute__((address_space(3)))
typedef unsigned short bf16_t;
typedef short bf16x8 __attribute__((ext_vector_type(8)));
typedef float f32x4 __attribute__((ext_vector_type(4)));
typedef unsigned u32x4 __attribute__((ext_vector_type(4)));
constexpr int BM = 256, BK = 64, HALF = 128, HTB = HALF * BK * 2  , STAGE_BYTES = 8 * HTB, NXCD = 8, WGM = 8;

__host__ __device__ __forceinline__ int lds_byte(int r, int c) { const int st = (r >> 4) * 2 + (c >> 5), rr = r & 15, cc = c & 31, ob = rr * 64 + cc * 2; return st * 1024 + (ob ^ (((ob >> 9) & 1) << 5)); }
__host__ __device__ __forceinline__ void stage_rc(int b, int& R, int& C) { const int st = b / 1024, sb = b % 1024, swz = sb ^ (((sb >> 9) & 1) << 5); R = (st >> 1) * 16 + swz / 64; C = (st & 1) * 32 + (swz % 64) / 2; }
__host__ __device__ __forceinline__ int perm32(int rho) { const int n = rho >> 4, i = rho & 15; return 8 * (i >> 2) + 4 * n + (i & 3); }

struct Unit { int pm, pn; };
struct Gemm { const bf16_t* A; const bf16_t* Bt; int M, N, K; };

struct StaticOrder {
    int nM, nN, nwg, G, c;
    __host__ __device__ void init(int M, int N, int G_, int c_) { nM = M / BM; nN = N / BM; nwg = nM * nN; G = G_; c = c_; }
    __host__ __device__ bool next(int i, Unit& u) const {
        const long L = (long)i * G + c; if (L >= nwg) return false;
        int wgid = (int)L; { const int q = nwg / NXCD, r = nwg % NXCD, xcd = wgid % NXCD, off = wgid / NXCD; wgid = (xcd < r ? xcd * (q + 1) : r * (q + 1) + (xcd - r) * q) + off; }
        const int nig = WGM * nN, gid = wgid / nig, fm = gid * WGM, gsz = (nM - fm) < WGM ? (nM - fm) : WGM;
        u.pm = fm + ((wgid % nig) % gsz); u.pn = (wgid % nig) / gsz; return true;
    }
    __device__ __forceinline__ void a_ready(const Unit&) const {}
    __device__ __forceinline__ void done(const Unit&) const {}
};

__device__ __forceinline__ unsigned cvt_pk_bf16(float lo, float hi) { unsigned r; asm volatile("v_cvt_pk_bf16_f32 %0, %1, %2" : "=v"(r) : "v"(lo), "v"(hi)); return r; }
typedef unsigned u32x2 __attribute__((ext_vector_type(2)));
__device__ __forceinline__ float bf_lo(unsigned w) { return __uint_as_float(w << 16); }
__device__ __forceinline__ float bf_hi(unsigned w) { return __uint_as_float(w & 0xffff0000u); }
constexpr float kLog2e = 1.4426950408889634f;
constexpr float kC2 = 0.125f * 1.4426950408889634f;

struct EpiIn {
    static constexpr bool PERM = true, AFTER_DRAIN = false; static constexpr int MID_TILE = 0;
    bf16_t *Q, *KA, *VA, *KB, *VB, *GR, *GB; const float *qna, *kna, *qnb, *knb; float* kmean;
    __device__ __forceinline__ void mid(f32x4 (&)[2][2][4][2], const Unit&, int, int, int, int) const {}
    __device__ __forceinline__ void operator()(const f32x4 (&acc)[2][2][4][2], const Unit& u, int wr, int wc, int fr, int fq) const {
        const int pn = u.pn;
        const int rowb = u.pm * BM + wr * 64 + fr;
        if (pn >= 9) {
            const int col = 128 * (pn - 9) + 32 * wc + 8 * fq;
#pragma unroll
            for (int ai = 0; ai < 2; ++ai)
#pragma unroll
                for (int m = 0; m < 4; ++m) { const size_t off = (size_t)(rowb + ai * HALF + m * 16) * 1024 + col;
                    f32x4 rt[2], gb[2];
#pragma unroll
                    for (int n = 0; n < 2; ++n)
#pragma unroll
                        for (int e = 0; e < 4; ++e) { const float ea = __builtin_amdgcn_exp2f(-kLog2e * acc[ai][0][m][n][e]), eb = __builtin_amdgcn_exp2f(-kLog2e * acc[ai][1][m][n][e]);
                            gb[n][e] = __builtin_fmaxf(__builtin_amdgcn_rcpf(1.0f + eb), 1e-20f); rt[n][e] = __builtin_fminf((1.0f + eb) * __builtin_amdgcn_rcpf(1.0f + ea), 1e20f); }
                    u32x4 w; w.x = cvt_pk_bf16(rt[0][0], rt[0][1]); w.y = cvt_pk_bf16(rt[0][2], rt[0][3]); w.z = cvt_pk_bf16(rt[1][0], rt[1][1]); w.w = cvt_pk_bf16(rt[1][2], rt[1][3]);
                    *(u32x4*)(GR + off) = w;
                    w.x = cvt_pk_bf16(gb[0][0], gb[0][1]); w.y = cvt_pk_bf16(gb[0][2], gb[0][3]); w.z = cvt_pk_bf16(gb[1][0], gb[1][1]); w.w = cvt_pk_bf16(gb[1][2], gb[1][3]);
                    *(u32x4*)(GB + off) = w; }
            return;
        }
        bf16_t* dst; int pitch; bool norm = false, km = false; float scale = 1.f; const float* gain = qna;
        if (pn < 2)       { dst = Q + (4 * pn + wc) * 64; pitch = 1024; norm = true; gain = qna; scale = kC2; }
        else if (pn < 4)  { dst = KA + (4 * (pn - 2) + wc) * 64; pitch = 512; norm = true; gain = kna; km = true; }
        else if (pn < 6)  { dst = VA + (4 * (pn - 4) + wc) * 64; pitch = 512; }
        else if (pn < 8)  { dst = Q + 512 + (4 * (pn - 6) + wc) * 64; pitch = 1024; norm = true; gain = qnb; scale = kC2; }
        else              { pitch = 128; if (wc < 2) { dst = KB + wc * 64; norm = true; gain = knb; } else { dst = VB + (wc - 2) * 64; } }
        f32x4 g[2][2], cs[2][2];
#pragma unroll
        for (int bj = 0; bj < 2; ++bj)
#pragma unroll
            for (int n = 0; n < 2; ++n) { g[bj][n] = norm ? *(const f32x4*)(gain + 32 * bj + 8 * fq + 4 * n) : (f32x4){1.f, 1.f, 1.f, 1.f}; cs[bj][n] = (f32x4){0.f, 0.f, 0.f, 0.f}; }
#pragma unroll
        for (int ai = 0; ai < 2; ++ai)
#pragma unroll
            for (int m = 0; m < 4; ++m) {
                const int row = rowb + ai * HALF + m * 16;
                f32x4 v[2][2];
#pragma unroll
                for (int bj = 0; bj < 2; ++bj)
#pragma unroll
                    for (int n = 0; n < 2; ++n) v[bj][n] = acc[ai][bj][m][n];
                if (norm) {
                    float ss = 0.f;
#pragma unroll
                    for (int bj = 0; bj < 2; ++bj)
#pragma unroll
                        for (int n = 0; n < 2; ++n) { const f32x4 x = v[bj][n]; ss += (x[0] * x[0] + x[1] * x[1]) + (x[2] * x[2] + x[3] * x[3]); }
                    ss += __shfl_xor(ss, 16); ss += __shfl_xor(ss, 32);
                    const float rs = __builtin_amdgcn_rsqf(ss * (1.0f / 64.0f) + 1e-6f) * scale;
#pragma unroll
                    for (int bj = 0; bj < 2; ++bj)
#pragma unroll
                        for (int n = 0; n < 2; ++n) v[bj][n] = v[bj][n] * rs * g[bj][n];
                }
                if (km) {
#pragma unroll
                    for (int bj = 0; bj < 2; ++bj)
#pragma unroll
                        for (int n = 0; n < 2; ++n) cs[bj][n] += v[bj][n];
                }
#pragma unroll
                for (int bj = 0; bj < 2; ++bj) {
                    u32x4 w; w.x = cvt_pk_bf16(v[bj][0][0], v[bj][0][1]); w.y = cvt_pk_bf16(v[bj][0][2], v[bj][0][3]); w.z = cvt_pk_bf16(v[bj][1][0], v[bj][1][1]); w.w = cvt_pk_bf16(v[bj][1][2], v[bj][1][3]);
                    *(u32x4*)(dst + (size_t)row * pitch + 32 * bj + 8 * fq) = w;
                }
            }
        if (km) {
            float* kmp = kmean + ((size_t)u.pm * 8 + (4 * (pn - 2) + wc)) * 64;
#pragma unroll
            for (int bj = 0; bj < 2; ++bj)
#pragma unroll
                for (int n = 0; n < 2; ++n)
#pragma unroll
                    for (int e = 0; e < 4; ++e) {
                        float s = cs[bj][n][e];
                        s += __shfl_xor(s, 1); s += __shfl_xor(s, 2); s += __shfl_xor(s, 4); s += __shfl_xor(s, 8);
                        if (fr == 0) atomicAdd(kmp + 32 * bj + 8 * fq + 4 * n + e, s * (1.0f / 256.0f));
                    }
        }
    }
};

struct EpiMix {
    static constexpr bool PERM = true, AFTER_DRAIN = false; static constexpr int MID_TILE = 8;
    const bf16_t *GR, *GB; bf16_t* MIX;
    __device__ __forceinline__ void mid(f32x4 (&acc)[2][2][4][2], const Unit& u, int wr, int wc, int fr, int fq) const {
        int rowb = u.pm * BM + wr * 64 + fr, col0 = u.pn * BM + wc * 32 + 8 * fq;
        asm volatile("" : "+v"(rowb), "+v"(col0));
        const bf16_t* base = GR + (size_t)rowb * 1024 + col0;
        u32x4 rt[2][4][2];
#pragma unroll
        for (int ai = 0; ai < 2; ++ai)
#pragma unroll
            for (int m = 0; m < 4; ++m)
#pragma unroll
                for (int bj = 0; bj < 2; ++bj) rt[ai][m][bj] = *(const u32x4*)(base + (size_t)(ai * HALF + m * 16) * 1024 + bj * HALF);
#pragma unroll
        for (int ai = 0; ai < 2; ++ai)
#pragma unroll
            for (int m = 0; m < 4; ++m)
#pragma unroll
                for (int bj = 0; bj < 2; ++bj) { const u32x4 a = rt[ai][m][bj];
                    acc[ai][bj][m][0] *= (f32x4){bf_lo(a.x), bf_hi(a.x), bf_lo(a.y), bf_hi(a.y)}; acc[ai][bj][m][1] *= (f32x4){bf_lo(a.z), bf_hi(a.z), bf_lo(a.w), bf_hi(a.w)}; }
    }
    __device__ __forceinline__ void operator()(const f32x4 (&acc)[2][2][4][2], const Unit& u, int wr, int wc, int fr, int fq) const {
        const int rowb = u.pm * BM + wr * 64 + fr, col0 = u.pn * BM + wc * 32 + 8 * fq;
        const bf16_t* base = GB + (size_t)rowb * 1024 + col0; bf16_t* ob = MIX + (size_t)rowb * 1024 + col0;
        u32x4 gt[2][4][2];
#pragma unroll
        for (int ai = 0; ai < 2; ++ai)
#pragma unroll
            for (int m = 0; m < 4; ++m)
#pragma unroll
                for (int bj = 0; bj < 2; ++bj) gt[ai][m][bj] = *(const u32x4*)(base + (size_t)(ai * HALF + m * 16) * 1024 + bj * HALF);
#pragma unroll
        for (int ai = 0; ai < 2; ++ai)
#pragma unroll
            for (int m = 0; m < 4; ++m)
#pragma unroll
                for (int bj = 0; bj < 2; ++bj) { const u32x4 b = gt[ai][m][bj];
                    const f32x4 v0 = acc[ai][bj][m][0], v1 = acc[ai][bj][m][1];
                    u32x4 w; w.x = cvt_pk_bf16(v0[0] * bf_lo(b.x), v0[1] * bf_hi(b.x)); w.y = cvt_pk_bf16(v0[2] * bf_lo(b.y), v0[3] * bf_hi(b.y));
                    w.z = cvt_pk_bf16(v1[0] * bf_lo(b.z), v1[1] * bf_hi(b.z)); w.w = cvt_pk_bf16(v1[2] * bf_lo(b.w), v1[3] * bf_hi(b.w));
                    *(u32x4*)(ob + (size_t)(ai * HALF + m * 16) * 1024 + bj * HALF) = w; }
    }
};

struct EpiX1 {
    static constexpr bool PERM = false, AFTER_DRAIN = false; static constexpr int MID_TILE = 0;
    const float* x; bf16_t* X1; float* rowsq;
    __device__ __forceinline__ void mid(f32x4 (&)[2][2][4][2], const Unit&, int, int, int, int) const {}
    __device__ __forceinline__ void operator()(const f32x4 (&acc)[2][2][4][2], const Unit& u, int wr, int wc, int fr, int fq) const {
        const int rowb = u.pm * BM + wr * 64 + fr, col0 = u.pn * BM + wc * 32 + 4 * fq;
#pragma unroll
        for (int ai = 0; ai < 2; ++ai) {
            f32x4 xv[4][2][2];
#pragma unroll
            for (int m = 0; m < 4; ++m)
#pragma unroll
                for (int bj = 0; bj < 2; ++bj)
#pragma unroll
                    for (int n = 0; n < 2; ++n) xv[m][bj][n] = *(const f32x4*)(x + (size_t)(rowb + ai * HALF + m * 16) * 1024 + col0 + bj * HALF + n * 16);
#pragma unroll
            for (int m = 0; m < 4; ++m) { const int row = rowb + ai * HALF + m * 16; const size_t off = (size_t)row * 1024 + col0; float ss = 0.f;
#pragma unroll
                for (int bj = 0; bj < 2; ++bj)
#pragma unroll
                    for (int n = 0; n < 2; ++n) {
                        const f32x4 x1 = xv[m][bj][n] + acc[ai][bj][m][n];
                        ss += (x1[0] * x1[0] + x1[1] * x1[1]) + (x1[2] * x1[2] + x1[3] * x1[3]);
                        u32x2 w; w.x = cvt_pk_bf16(x1[0], x1[1]); w.y = cvt_pk_bf16(x1[2], x1[3]);
                        *(u32x2*)(X1 + off + bj * HALF + n * 16) = w;
                    }
                ss += __shfl_xor(ss, 16); ss += __shfl_xor(ss, 32);
                if (fq == 0) atomicAdd(rowsq + row, ss); }
            asm volatile("" ::: "memory"); }
    }
};

struct EpiUp {
    static constexpr bool PERM = true, AFTER_DRAIN = false; static constexpr int MID_TILE = 0;
    bf16_t* H; const float* rowsq;
    __device__ __forceinline__ void mid(f32x4 (&)[2][2][4][2], const Unit&, int, int, int, int) const {}
    __device__ __forceinline__ void operator()(const f32x4 (&acc)[2][2][4][2], const Unit& u, int wr, int wc, int fr, int fq) const {
        const int rowb = u.pm * BM + wr * 64 + fr, col0 = u.pn * BM + wc * 32 + 8 * fq;
#pragma unroll
        for (int ai = 0; ai < 2; ++ai)
#pragma unroll
            for (int m = 0; m < 4; ++m) { const int row = rowb + ai * HALF + m * 16;
                const float r = __builtin_amdgcn_rsqf(rowsq[row] * (1.0f / 1024.0f) + 1e-6f);
                bf16_t* rowp = H + (size_t)row * 4096 + col0;
#pragma unroll
                for (int bj = 0; bj < 2; ++bj) {
                    f32x4 v0 = acc[ai][bj][m][0] * r, v1 = acc[ai][bj][m][1] * r;
#pragma unroll
                    for (int e = 0; e < 4; ++e) { const float a = __builtin_fmaxf(v0[e], 0.f), b = __builtin_fmaxf(v1[e], 0.f); v0[e] = a * a; v1[e] = b * b; }
                    u32x4 w; w.x = cvt_pk_bf16(v0[0], v0[1]); w.y = cvt_pk_bf16(v0[2], v0[3]); w.z = cvt_pk_bf16(v1[0], v1[1]); w.w = cvt_pk_bf16(v1[2], v1[3]);
                    *(u32x4*)(rowp + bj * HALF) = w;
                } }
    }
};

struct EpiDown {
    static constexpr bool PERM = false, AFTER_DRAIN = false; static constexpr int MID_TILE = 0;
    const bf16_t* X1; float* out; float mul;
    __device__ __forceinline__ void mid(f32x4 (&)[2][2][4][2], const Unit&, int, int, int, int) const {}
    __device__ __forceinline__ void operator()(const f32x4 (&acc)[2][2][4][2], const Unit& u, int wr, int wc, int fr, int fq) const {
        const int rowb = u.pm * BM + wr * 64 + fr, col0 = u.pn * BM + wc * 32 + 4 * fq;
        u32x2 xv[2][4][2][2];
#pragma unroll
        for (int ai = 0; ai < 2; ++ai)
#pragma unroll
            for (int m = 0; m < 4; ++m)
#pragma unroll
                for (int bj = 0; bj < 2; ++bj)
#pragma unroll
                    for (int n = 0; n < 2; ++n) xv[ai][m][bj][n] = *(const u32x2*)(X1 + (size_t)(rowb + ai * HALF + m * 16) * 1024 + col0 + bj * HALF + n * 16);
#pragma unroll
        for (int ai = 0; ai < 2; ++ai)
#pragma unroll
            for (int m = 0; m < 4; ++m) { float* rowp = out + (size_t)(rowb + ai * HALF + m * 16) * 1024 + col0;
#pragma unroll
                for (int bj = 0; bj < 2; ++bj)
#pragma unroll
                    for (int n = 0; n < 2; ++n) { const u32x2 w = xv[ai][m][bj][n];
                        *(f32x4*)(rowp + bj * HALF + n * 16) = ((f32x4){bf_lo(w.x), bf_hi(w.x), bf_lo(w.y), bf_hi(w.y)} + acc[ai][bj][m][n]) * mul; } }
    }
};

template <class Epi, class Sched, bool ALIGN_EPI = false, bool SP2 = false>
__device__ __forceinline__ void gemm_phase(PG8_LAS unsigned char* lds, const Gemm g, const Sched& S, const Epi& E) {
    const int tid = threadIdx.x, wid = __builtin_amdgcn_readfirstlane(tid >> 6), lane = tid & 63, wr = wid >> 2, wc = wid & 3, fr = lane & 15, fq = lane >> 4;
    const int K = g.K, nt = K / BK;
    unsigned voffA[2], voffB[2];
#pragma unroll
    for (int i = 0; i < 2; ++i) { int R, C; stage_rc(tid * 16 + i * 8192, R, C); const int Rb = Epi::PERM ? ((R & ~31) + perm32(R & 31)) : R;
        voffA[i] = (unsigned)(R * K + C) * 2u; voffB[i] = (unsigned)(Rb * K + C) * 2u; }
    const size_t kstep = (size_t)(BK * 2);
    const size_t hstep = (size_t)HALF * K * 2;
    const size_t tstep = 2 * hstep;
    const unsigned ldsw = (unsigned)wid * 1024u;
    const int aoff = lds_byte(wr * 64 + fr, fq * 8), boff = lds_byte(wc * 32 + fr, fq * 8);
#define PG8_SA(b, h) (((b) * 2 + (h)) * HTB)
#define PG8_SB(b, h) ((4 + (b) * 2 + (h)) * HTB)
#define PG8_STAGE(bufoff, gbase, voff) do { _Pragma("unroll") for (int _i = 0; _i < 2; ++_i) \
        __builtin_amdgcn_global_load_lds((const unsigned*)((const char*)(gbase) + (voff)[_i]), (PG8_LAS unsigned*)(lds + (bufoff) + ldsw + _i * 8192), 16, 0, 0); } while (0)
#define PG8_LDA(dst, b, h) do { _Pragma("unroll") for (int m = 0; m < 4; ++m) _Pragma("unroll") for (int k = 0; k < 2; ++k) dst[m][k] = *(const PG8_LAS bf16x8*)(lds + PG8_SA(b, h) + aoff + m * 2048 + k * 1024); } while (0)
#define PG8_LDB(dst, b, h) do { _Pragma("unroll") for (int n = 0; n < 2; ++n) _Pragma("unroll") for (int k = 0; k < 2; ++k) dst[n][k] = *(const PG8_LAS bf16x8*)(lds + PG8_SB(b, h) + boff + n * 2048 + k * 1024); } while (0)
#define PG8_MMA(ai, bj, At, Bt) do { __builtin_amdgcn_s_setprio(1); _Pragma("unroll") for (int m = 0; m < 4; ++m) _Pragma("unroll") for (int n = 0; n < 2; ++n) _Pragma("unroll") for (int k = 0; k < 2; ++k) \
        acc[ai][bj][m][n] = __builtin_amdgcn_mfma_f32_16x16x32_bf16(Bt[n][k], At[m][k], acc[ai][bj][m][n], 0, 0, 0); __builtin_amdgcn_s_setprio(0); } while (0)
#define PG8_WAIT_V(n) asm volatile("s_waitcnt vmcnt(" #n ")" ::: "memory")
#define PG8_WAIT_L(n) asm volatile("s_waitcnt lgkmcnt(" #n ")" ::: "memory")
#define PG8_BAR __builtin_amdgcn_s_barrier()
#define PG8_SCHED __builtin_amdgcn_sched_barrier(0)
    Unit cur, nxt; int ui = 0;
    if (!S.next(0, cur)) return;
    f32x4 acc[2][2][4][2];
#pragma unroll
    for (int a = 0; a < 2; ++a)
#pragma unroll
        for (int b = 0; b < 2; ++b)
#pragma unroll
            for (int m = 0; m < 4; ++m)
#pragma unroll
                for (int n = 0; n < 2; ++n) acc[a][b][m][n] = (f32x4){0.f, 0.f, 0.f, 0.f};
    bf16x8 At[4][2], B0[2][2], B1[2][2];
    const char* cA = (const char*)g.A + (size_t)cur.pm * tstep; const char* cB = (const char*)g.Bt + (size_t)cur.pn * tstep;
    S.a_ready(cur);
    if constexpr (SP2) {
        PG8_STAGE(PG8_SB(0, 0), cB, voffB); PG8_STAGE(PG8_SB(0, 1), cB + hstep, voffB); PG8_STAGE(PG8_SA(0, 0), cA, voffA); PG8_STAGE(PG8_SA(0, 1), cA + hstep, voffA);
        if (wr == 1) PG8_BAR;
        PG8_WAIT_V(2); PG8_BAR;
        PG8_STAGE(PG8_SB(1, 0), cB + kstep, voffB); PG8_STAGE(PG8_SA(1, 0), cA + kstep, voffA); PG8_STAGE(PG8_SB(1, 1), cB + hstep + kstep, voffB);
        PG8_WAIT_V(6); PG8_BAR;
    } else {
        PG8_STAGE(PG8_SB(0, 0), cB, voffB); PG8_STAGE(PG8_SA(0, 0), cA, voffA); PG8_STAGE(PG8_SB(0, 1), cB + hstep, voffB); PG8_STAGE(PG8_SA(0, 1), cA + hstep, voffA);
        if (wr == 1) PG8_BAR;
        PG8_WAIT_V(4); PG8_BAR;
        PG8_STAGE(PG8_SB(1, 0), cB + kstep, voffB); PG8_STAGE(PG8_SA(1, 0), cA + kstep, voffA); PG8_STAGE(PG8_SB(1, 1), cB + hstep + kstep, voffB);
        PG8_WAIT_V(6); PG8_BAR;
    }
    for (;;) {
        const bool has_next = S.next(ui + 1, nxt);
        const char* nA = has_next ? (const char*)g.A + (size_t)nxt.pm * tstep : cA; const char* nB = has_next ? (const char*)g.Bt + (size_t)nxt.pn * tstep : cB;
        for (int t = 0; t < nt; t += 2) {
            if constexpr (Epi::MID_TILE > 0) { if (t == Epi::MID_TILE) { PG8_SCHED; E.mid(acc, cur, wr, wc, fr, fq); PG8_SCHED; } }
            const bool last = (t == nt - 2);
            const char* a1 = cA + (size_t)(t + 1) * kstep;
            const char* a2 = last ? nA : cA + (size_t)(t + 2) * kstep; const char* b2 = last ? nB : cB + (size_t)(t + 2) * kstep;
            const char* a3 = a2 + kstep; const char* b3 = b2 + kstep;
            if (last && has_next) S.a_ready(nxt);
            if constexpr (SP2) {
            PG8_LDB(B0, 0, 0); PG8_LDB(B1, 0, 1); PG8_SCHED; PG8_LDA(At, 0, 0); PG8_STAGE(PG8_SA(1, 1), a1 + hstep, voffA);
            PG8_WAIT_V(8); PG8_WAIT_L(0); PG8_BAR; PG8_MMA(0, 0, At, B0); PG8_MMA(0, 1, At, B1); PG8_BAR; PG8_SCHED;
            PG8_LDA(At, 0, 1); PG8_STAGE(PG8_SB(0, 0), b2, voffB); PG8_STAGE(PG8_SB(0, 1), b2 + hstep, voffB); PG8_STAGE(PG8_SA(0, 0), a2, voffA);
            PG8_WAIT_V(8); PG8_WAIT_L(0); PG8_BAR; PG8_MMA(1, 0, At, B0); PG8_MMA(1, 1, At, B1); PG8_BAR; PG8_SCHED;
            PG8_LDB(B0, 1, 0); PG8_LDB(B1, 1, 1); PG8_SCHED; PG8_LDA(At, 1, 0); PG8_STAGE(PG8_SA(0, 1), a2 + hstep, voffA);
            PG8_WAIT_V(8); PG8_WAIT_L(0); PG8_BAR; PG8_MMA(0, 0, At, B0); PG8_MMA(0, 1, At, B1); PG8_BAR; PG8_SCHED;
            PG8_LDA(At, 1, 1); PG8_STAGE(PG8_SB(1, 0), b3, voffB); PG8_STAGE(PG8_SB(1, 1), b3 + hstep, voffB); PG8_STAGE(PG8_SA(1, 0), a3, voffA);
            PG8_WAIT_V(8); PG8_WAIT_L(0); PG8_BAR; PG8_MMA(1, 0, At, B0); PG8_MMA(1, 1, At, B1); PG8_BAR; PG8_SCHED;
            } else {
            PG8_LDB(B0, 0, 0); PG8_SCHED; PG8_LDA(At, 0, 0); PG8_STAGE(PG8_SA(1, 1), a1 + hstep, voffA);
            PG8_WAIT_L(8); PG8_BAR; PG8_WAIT_L(0); PG8_MMA(0, 0, At, B0); PG8_BAR; PG8_SCHED;
            PG8_LDB(B1, 0, 1); PG8_STAGE(PG8_SB(0, 0), b2, voffB);
            PG8_BAR; PG8_WAIT_L(0); PG8_MMA(0, 1, At, B1); PG8_BAR;
            PG8_LDA(At, 0, 1); PG8_STAGE(PG8_SA(0, 0), a2, voffA);
            PG8_BAR; PG8_WAIT_L(0); PG8_MMA(1, 0, At, B0); PG8_BAR; PG8_SCHED;
            PG8_STAGE(PG8_SB(0, 1), b2 + hstep, voffB);
            PG8_WAIT_V(6); PG8_BAR; PG8_MMA(1, 1, At, B1); PG8_BAR;
            PG8_LDB(B0, 1, 0); PG8_SCHED; PG8_LDA(At, 1, 0); PG8_STAGE(PG8_SA(0, 1), a2 + hstep, voffA);
            PG8_WAIT_L(8); PG8_BAR; PG8_WAIT_L(0); PG8_MMA(0, 0, At, B0); PG8_BAR; PG8_SCHED;
            PG8_LDB(B1, 1, 1); PG8_STAGE(PG8_SB(1, 0), b3, voffB);
            PG8_BAR; PG8_WAIT_L(0); PG8_MMA(0, 1, At, B1); PG8_BAR;
            PG8_LDA(At, 1, 1); PG8_STAGE(PG8_SA(1, 0), a3, voffA);
            PG8_BAR; PG8_WAIT_L(0); PG8_MMA(1, 0, At, B0); PG8_BAR; PG8_SCHED;
            PG8_STAGE(PG8_SB(1, 1), b3 + hstep, voffB);
            PG8_WAIT_V(6); PG8_BAR; PG8_MMA(1, 1, At, B1); PG8_BAR;
            }
        }
        if constexpr (ALIGN_EPI) { if (wr == 0) PG8_BAR; }
        if constexpr (!Epi::AFTER_DRAIN) { E(acc, cur, wr, wc, fr, fq); S.done(cur); }
        if (!has_next) break;
#pragma unroll
        for (int a = 0; a < 2; ++a)
#pragma unroll
            for (int b = 0; b < 2; ++b)
#pragma unroll
                for (int m = 0; m < 4; ++m)
#pragma unroll
                    for (int n = 0; n < 2; ++n) acc[a][b][m][n] = (f32x4){0.f, 0.f, 0.f, 0.f};
        cur = nxt; cA = nA; cB = nB; ++ui;
        if constexpr (ALIGN_EPI) { if (wr == 1) PG8_BAR; }
    }
    PG8_WAIT_V(0);
    if constexpr (!ALIGN_EPI) { if (wr == 0) PG8_BAR; }
    PG8_BAR;
    if constexpr (Epi::AFTER_DRAIN) { E.fused(acc, cur, wr, wc, fr, fq, lds, wid, lane); S.done(cur); }
#undef PG8_SA
#undef PG8_SB
#undef PG8_STAGE
#undef PG8_LDA
#undef PG8_LDB
#undef PG8_MMA
#undef PG8_WAIT_V
#undef PG8_WAIT_L
#undef PG8_BAR
#undef PG8_SCHED
}
}
constexpr int NWAVES = 8;
constexpr int BATCH = 16, SEQ = 2048, DM = 1024, HD = 64, FF = 4096, NIN = 4352;
constexpr int M = BATCH * SEQ;
constexpr float EPS = 1e-6f;
constexpr size_t MiB = 1u << 20;
constexpr size_t WS_CTL = 0, CTL_ZERO_BYTES = 1 * MiB;
constexpr size_t WS_WIN = 2 * MiB, WS_WBR = 11 * MiB, WS_WO = 13 * MiB, WS_WUP = 15 * MiB, WS_WDN = 23 * MiB;
constexpr int NGRP = 8, GROWS = M / NGRP;
constexpr size_t WS_GRP0 = 32 * MiB, GRP_STRIDE = 50 * MiB;
constexpr size_t GO_Q = 0 * MiB;
constexpr size_t GO_KA = 8 * MiB, GO_VA = 12 * MiB;
constexpr size_t GO_KB = 16 * MiB, GO_VB = 17 * MiB;
constexpr size_t GO_GA = 18 * MiB, GO_GB = 26 * MiB;
constexpr size_t GO_H = 0 * MiB;
constexpr size_t GO_A2 = 34 * MiB;
constexpr size_t GO_XN = 42 * MiB;
constexpr size_t WS_END = WS_GRP0 + NGRP * GRP_STRIDE;
static_assert(WS_WIN + (size_t)NIN * DM * 2 <= WS_WBR && WS_WDN + (size_t)DM * FF * 2 <= WS_GRP0 && GO_GB + (size_t)GROWS * DM * 2 <= GO_A2 && GO_H + (size_t)GROWS * FF * 2 <= GO_A2 && GO_XN + (size_t)GROWS * DM * 2 <= GRP_STRIDE, "d_ws map");
__device__ __forceinline__ unsigned short* grp_ptr(unsigned char* ws, int g, size_t off, int pitch_elems) { return (unsigned short*)(ws + WS_GRP0 + (size_t)g * GRP_STRIDE + off) - (size_t)g * GROWS * pitch_elems; }
constexpr int CW_TMO = 0, CW_CODE = 1;
constexpr int CW_BAR = 4096;
constexpr int CW_CENSUS = 8192;
constexpr int CW_GSUB = 9216, CW_GGEN = 10240;
constexpr int CW_KMEAN = 16384;
constexpr int CW_ROWSQ = CW_KMEAN + BATCH * 8 * 8 * 64;
static_assert((CW_ROWSQ + M) * 4 <= (int)CTL_ZERO_BYTES, "CTL words inside the memset region");
constexpr int RING_OFF = 0, RING_BYTES = 131072;
constexpr int LDSCTL_OFF = RING_BYTES, MISC_OFF = LDSCTL_OFF + 320;
constexpr int LDS_BYTES = 147456;
static_assert(MISC_OFF + 128 <= LDS_BYTES, "LDS map");

#define GAS __attribute__((address_space(1)))
#define LAS __attribute__((address_space(3)))
typedef unsigned short bf16;
typedef unsigned v4u __attribute__((ext_vector_type(4)));
typedef float f32x4 __attribute__((ext_vector_type(4)));
typedef short bf16x8 __attribute__((ext_vector_type(8)));
typedef GAS unsigned gu32;
typedef GAS unsigned long long gu64;
#define RLX_AGENT __ATOMIC_RELAXED, __HIP_MEMORY_SCOPE_AGENT
#define LDS_WAIT() asm volatile("s_waitcnt lgkmcnt(0)" ::: "memory")
#define VM_WAIT() asm volatile("s_waitcnt vmcnt(0)" ::: "memory")
__device__ __forceinline__ unsigned long long rt() { return __builtin_amdgcn_s_memrealtime(); }
__device__ __forceinline__ unsigned f2bf(float f) { unsigned u = __builtin_bit_cast(unsigned, f); return (u + 0x7fffu + ((u >> 16) & 1u)) >> 16; }
__device__ __forceinline__ unsigned pk2(float lo, float hi) { return f2bf(lo) | (f2bf(hi) << 16); }

#define XB_TMO      128
#define XB_XCNT(j)  (256  + 64 * (j))
#define XB_XSUB(j)  (1280 + 64 * (j))
#define XB_XGEN(j)  (2304 + 64 * (j))
#define XB_TOP      3328
#define XB_TOPGEN   3392
#define XCD_BAR_WORDS 3456
#define XB_SPIN_CAP (1u << 18)

__device__ __forceinline__ unsigned xb_ld(unsigned* p)              { return __hip_atomic_load(p, __ATOMIC_RELAXED, __HIP_MEMORY_SCOPE_AGENT); }
__device__ __forceinline__ unsigned xb_add(unsigned* p, unsigned v) { return __hip_atomic_fetch_add(p, v, __ATOMIC_RELAXED, __HIP_MEMORY_SCOPE_AGENT); }
__device__ __forceinline__ unsigned xb_xcc_id() { return (unsigned)__builtin_amdgcn_s_getreg((3 << 11) | 20) & 0xFu; }
#define XB_SPIN(cond, bar) do { unsigned _sp = 0; while (cond) { __builtin_amdgcn_s_sleep(1); \
    if ((++_sp & 255u) == 0u) { if (xb_ld(&(bar)[XB_TMO])) break; if (_sp > XB_SPIN_CAP) { atomicAdd(&(bar)[XB_TMO], 1u); break; } } } } while (0)

struct XcdBarrier {
    unsigned* bar; unsigned x;
    volatile LAS unsigned* st;
};

__device__ __forceinline__ XcdBarrier xcd_barrier_post(unsigned* bar, volatile LAS unsigned* st) {
    XcdBarrier b; b.bar = bar; b.x = xb_xcc_id(); b.st = st;
    if (threadIdx.x == 0) (void)xb_add(&bar[XB_XCNT(b.x)], 1u);
    return b;
}
__device__ __forceinline__ void xcd_barrier_complete(unsigned* bar, unsigned x, unsigned& nloc, unsigned& nx) {
    const unsigned G = gridDim.x * gridDim.y * gridDim.z;
    unsigned sum, cnt, mine, sp = 0u;
    for (;;) {
        sum = 0u; cnt = 0u; mine = 0u;
#pragma unroll
        for (unsigned j = 0; j < 16; ++j) { const unsigned c = xb_ld(&bar[XB_XCNT(j)]); sum += c; cnt += (c > 0u) ? 1u : 0u; mine = (j == x) ? c : mine; }
        if (sum == G) break;
        __builtin_amdgcn_s_sleep(1);
        if ((++sp & 255u) == 0u) { if (xb_ld(&bar[XB_TMO])) break; if (sp > XB_SPIN_CAP) { atomicAdd(&bar[XB_TMO], 1u); break; } }
    }
    nloc = mine > 0u ? mine : 1u; nx = cnt > 0u ? cnt : 1u;
}

__device__ __forceinline__ void xcd_barrier(const XcdBarrier& b) {
    asm volatile("s_waitcnt vmcnt(0)" ::: "memory");
    __syncthreads();
    if (threadIdx.x == 0) {
        unsigned* bar = b.bar;
        __builtin_amdgcn_s_waitcnt(0);
        unsigned nloc = b.st[0], nx = b.st[1];
        if (nloc == 0u) { xcd_barrier_complete(bar, b.x, nloc, nx); b.st[0] = nloc; b.st[1] = nx; }
        const unsigned old = xb_add(&bar[XB_XSUB(b.x)], 1u);
        const unsigned gen = old / nloc;
        if (old + 1u == (gen + 1u) * nloc) {
            __builtin_amdgcn_fence(__ATOMIC_RELEASE, "agent");
            asm volatile("s_waitcnt vmcnt(0)" ::: "memory");
            const unsigned og = xb_add(&bar[XB_TOP], 1u);
            const unsigned tg = og / nx;
            if (og + 1u == (tg + 1u) * nx) xb_add(&bar[XB_TOPGEN], 1u);
            else XB_SPIN(xb_ld(&bar[XB_TOPGEN]) == tg, bar);
            __builtin_amdgcn_fence(__ATOMIC_ACQUIRE, "agent");
            xb_add(&bar[XB_XGEN(b.x)], 1u);
            asm volatile("s_waitcnt vmcnt(0)" ::: "memory");
        } else {
            XB_SPIN(xb_ld(&bar[XB_XGEN(b.x)]) == gen, bar);
            __builtin_amdgcn_fence(__ATOMIC_ACQUIRE, "agent");
            asm volatile("s_waitcnt vmcnt(0)" ::: "memory");
        }
    }
    __syncthreads();
}

struct GroupBar { unsigned* sub; unsigned* gen; unsigned* bar; };
__device__ __forceinline__ void group_barrier(const GroupBar& g) {
    asm volatile("s_waitcnt vmcnt(0)" ::: "memory");
    __syncthreads();
    if (threadIdx.x == 0) {
        __builtin_amdgcn_s_waitcnt(0);
        const unsigned old = xb_add(g.sub, 1u), gen = old / 32u;
        if (old + 1u == (gen + 1u) * 32u) {
            __builtin_amdgcn_fence(__ATOMIC_RELEASE, "agent");
            asm volatile("s_waitcnt vmcnt(0)" ::: "memory");
            __builtin_amdgcn_fence(__ATOMIC_ACQUIRE, "agent");
            xb_add(g.gen, 1u);
            asm volatile("s_waitcnt vmcnt(0)" ::: "memory");
        } else {
            XB_SPIN(xb_ld(g.gen) == gen, g.bar);
            __builtin_amdgcn_fence(__ATOMIC_ACQUIRE, "agent");
            asm volatile("s_waitcnt vmcnt(0)" ::: "memory");
        }
    }
    __syncthreads();
}

struct Frame {
    LAS unsigned char* lds;
    volatile LAS unsigned* MISC;
    gu32* ctl;
    int tid, lane, wave;
    int vcu, G;
    int grp, li, grouped;
    unsigned char* ws;
    const float *x, *norm_attn, *w_in, *qna, *kna, *qnb, *knb, *sinks, *wba, *wbb, *w_out, *norm_mlp, *w_up, *w_down; float* out;
    bf16 *WinT, *WbrT, *WoT, *WupT, *WdnT;
    bf16 *Q, *KA, *VA, *KB, *VB, *GA, *GB, *HB, *A2, *XN;
    float *kmean, *rowsq;
};

__device__ __forceinline__ float wave_sum(float v) {
#pragma unroll
    for (int o = 1; o < 64; o <<= 1) v += __shfl_xor(v, o);
    return v;
}
__device__ __forceinline__ void p0_transpose_item(const float* W, int N, bf16* WT, int ldt, int koff, int prow0, LAS float* scr, int k0, int n0, int lane, const float* kscale = nullptr) {
#pragma unroll 8
    for (int i = 0; i < 32; ++i) { const int kk = 2 * i + (lane >> 5); const float sc = kscale ? kscale[k0 + kk] : 1.0f; scr[kk * 33 + (lane & 31)] = W[(size_t)(k0 + kk) * N + n0 + (lane & 31)] * sc; }
    LDS_WAIT(); asm volatile("" ::: "memory");
    const int c = lane & 7;
#pragma unroll
    for (int j = 0; j < 4; ++j) { const int n = (lane >> 3) + 8 * j; const LAS float* s = scr + (8 * c) * 33 + n;
        v4u o; o.x = pk2(s[0 * 33], s[1 * 33]); o.y = pk2(s[2 * 33], s[3 * 33]); o.z = pk2(s[4 * 33], s[5 * 33]); o.w = pk2(s[6 * 33], s[7 * 33]);
        *(GAS v4u*)(WT + (size_t)(prow0 + n) * ldt + koff + k0 + 8 * c) = o; }
    LDS_WAIT(); asm volatile("" ::: "memory");
}
__device__ __forceinline__ void rms_row_to_bf16(const Frame& F, const float* xrow, const float* gain, bf16* orow) {
    const GAS f32x4* xr = (const GAS f32x4*)xrow + F.lane; const f32x4* gr = (const f32x4*)gain + F.lane;
    f32x4 v[4]; float s = 0.f;
#pragma unroll
    for (int j = 0; j < 4; ++j) { v[j] = xr[64 * j]; s += (v[j].x * v[j].x + v[j].y * v[j].y) + (v[j].z * v[j].z + v[j].w * v[j].w); }
    const float rs = 1.0f / sqrtf(wave_sum(s) * (1.f / DM) + EPS);
    GAS unsigned long long* o8 = (GAS unsigned long long*)orow + F.lane;
#pragma unroll
    for (int j = 0; j < 4; ++j) { const f32x4 g = gr[64 * j]; o8[64 * j] = (unsigned long long)pk2(v[j].x * rs * g.x, v[j].y * rs * g.y) | ((unsigned long long)pk2(v[j].z * rs * g.z, v[j].w * rs * g.w) << 32); }
}
__device__ __forceinline__ void p0_prologue(Frame& F) {
    LAS float* scr = (LAS float*)(F.lds + RING_OFF + F.wave * 16384);
    const int gw = (int)blockIdx.x * NWAVES + F.wave, NGW = F.G * NWAVES;
    constexpr int I_IN = (DM / 64) * (NIN / 32), I_BR = (512 / 64) * (DM / 32), I_O = (DM / 64) * (DM / 32), I_UP = (DM / 64) * (FF / 32), I_DN = (FF / 64) * (DM / 32);
    constexpr int NITEMS = I_IN + 2 * I_BR + I_O + I_UP + I_DN;
    for (int it = gw; it < NITEMS; it += NGW) {
        int r = it;
        if (r < I_IN) { const int nblk = NIN / 32, kb = r / nblk, nb = r % nblk, n0 = 32 * nb, nt = n0 & 255;
            int prow0 = (n0 & ~255) + 128 * ((nt >> 5) & 1) + 32 * (nt >> 6);
            if (n0 >= 2304) { const int isb = n0 >= 3328 ? 1 : 0, c0 = n0 - (isb ? 3328 : 2304); prow0 = 256 * (9 + (c0 >> 7)) + 128 * isb + 32 * ((c0 & 127) >> 5); }
            p0_transpose_item(F.w_in, NIN, F.WinT, DM, 0, prow0, scr, 64 * kb, n0, F.lane); continue; } r -= I_IN;
        if (r < I_BR) { const int nblk = DM / 32, kb = r / nblk, nb = r % nblk; p0_transpose_item(F.wba, DM, F.WbrT, DM, 0, 32 * nb, scr, 64 * kb, 32 * nb, F.lane); continue; } r -= I_BR;
        if (r < I_BR) { const int nblk = DM / 32, kb = r / nblk, nb = r % nblk; p0_transpose_item(F.wbb, DM, F.WbrT, DM, 512, 32 * nb, scr, 64 * kb, 32 * nb, F.lane); continue; } r -= I_BR;
        if (r < I_O)  { const int nblk = DM / 32, kb = r / nblk, nb = r % nblk; p0_transpose_item(F.w_out, DM, F.WoT, DM, 0, 32 * nb, scr, 64 * kb, 32 * nb, F.lane); continue; } r -= I_O;
        if (r < I_UP) { const int nblk = FF / 32, kb = r / nblk, nb = r % nblk; p0_transpose_item(F.w_up, FF, F.WupT, DM, 0, 32 * nb, scr, 64 * kb, 32 * nb, F.lane, F.norm_mlp); continue; } r -= I_UP;
        { const int nblk = DM / 32, kb = r / nblk, nb = r % nblk; p0_transpose_item(F.w_down, DM, F.WdnT, FF, 0, 32 * nb, scr, 64 * kb, 32 * nb, F.lane); }
    }
    for (int m = gw; m < M; m += NGW) rms_row_to_bf16(F, F.x + (size_t)m * DM, F.norm_attn, grp_ptr(F.ws, m / GROWS, GO_XN, DM) + (size_t)m * DM);
}
__device__ __forceinline__ void sa_load32(const bf16* p, float (&d)[32]) {
#pragma unroll
    for (int i = 0; i < 4; ++i) { const v4u w = *(const GAS v4u*)(p + 8 * i);
        d[8 * i + 0] = __uint_as_float(w.x << 16); d[8 * i + 1] = __uint_as_float(w.x & 0xffff0000u); d[8 * i + 2] = __uint_as_float(w.y << 16); d[8 * i + 3] = __uint_as_float(w.y & 0xffff0000u);
        d[8 * i + 4] = __uint_as_float(w.z << 16); d[8 * i + 5] = __uint_as_float(w.z & 0xffff0000u); d[8 * i + 6] = __uint_as_float(w.w << 16); d[8 * i + 7] = __uint_as_float(w.w & 0xffff0000u); }
}
__device__ __forceinline__ void sa_store32(bf16* p, const float (&o)[32], float sc) {
#pragma unroll
    for (int i = 0; i < 4; ++i) { v4u w; w.x = pk2(o[8 * i] * sc, o[8 * i + 1] * sc); w.y = pk2(o[8 * i + 2] * sc, o[8 * i + 3] * sc); w.z = pk2(o[8 * i + 4] * sc, o[8 * i + 5] * sc); w.w = pk2(o[8 * i + 6] * sc, o[8 * i + 7] * sc);
        *(GAS v4u*)(p + 8 * i) = w; }
}
#define SA_KEY(KPTR, VPTR, BIAS, VALID) do { \
    float s_ = 0.f; \
    { float kv_[32]; sa_load32((KPTR) + dof, kv_); \
        _Pragma("unroll") for (int d_ = 0; d_ < 32; ++d_) s_ = __builtin_fmaf(q[d_], kv_[d_], s_); asm volatile("" ::: "memory"); } \
    s_ += __shfl_xor(s_, 1); \
    s_ += (BIAS); const bool ok_ = (VALID); const float se_ = ok_ ? s_ : -1e30f; \
    if (__any(se_ > m)) { const float mn_ = __builtin_fmaxf(m, se_); const float c_ = __builtin_amdgcn_exp2f(m - mn_); l *= c_; _Pragma("unroll") for (int d_ = 0; d_ < 32; ++d_) o[d_] *= c_; m = mn_; } \
    const float p_ = ok_ ? __builtin_amdgcn_exp2f(s_ - m) : 0.f; l += p_; \
    { float kv_[32]; sa_load32((VPTR) + dof, kv_); \
        _Pragma("unroll") for (int d_ = 0; d_ < 32; ++d_) o[d_] = __builtin_fmaf(p_, kv_[d_], o[d_]); asm volatile("" ::: "memory"); } } while (0)

__device__ __forceinline__ void sa_moba(const bf16* Q, const bf16* KA, const bf16* VA, const float* kmean, bf16* O, int b, int h, int t0, int lane) {
    const int dof = 32 * (lane & 1);
    const int t = t0 + (lane >> 1), own = t0 >> 8;
    float q[32]; sa_load32(Q + ((size_t)(b * SEQ + t)) * 1024 + h * 64 + dof, q);
    unsigned sel;
    if (own <= 3) sel = (1u << own) - 1u;
    else {
        float gs[7];
#pragma unroll
        for (int n = 0; n < 7; ++n) { gs[n] = -INFINITY;
            if (n < own) { const float* km = kmean + ((size_t)(b * 8 + n) * 8 + h) * 64 + dof; float s = 0.f;
#pragma unroll
                for (int d = 0; d < 32; d += 4) { const f32x4 kv = *(const GAS f32x4*)(km + d); s = __builtin_fmaf(q[d], kv.x, s); s = __builtin_fmaf(q[d + 1], kv.y, s); s = __builtin_fmaf(q[d + 2], kv.z, s); s = __builtin_fmaf(q[d + 3], kv.w, s); }
                s += __shfl_xor(s, 1);
                gs[n] = s; asm volatile("" ::: "memory"); } }
        sel = 0u;
#pragma unroll
        for (int n = 0; n < 7; ++n) { int rank = 0;
#pragma unroll
            for (int j = 0; j < 7; ++j) if (j != n) rank += (gs[j] > gs[n] || (gs[j] == gs[n] && j < n)) ? 1 : 0;
            if (n < own && rank < 3) sel |= 1u << n; }
    }
    const float slope2 = exp2f(-0.5f * (float)(h + 9)) * pg8::kLog2e;
    float m = -1e30f, l = 0.f, o[32];
#pragma unroll
    for (int d = 0; d < 32; ++d) o[d] = 0.f;
    for (int n = 0; n <= own; ++n) {
        const bool isown = (n == own), mine = isown || ((sel >> n) & 1u);
        if (!__any(mine)) continue;
        const int nk = isown ? (t0 + 32 - n * 256) : 256;
        for (int kk = 0; kk < nk; ++kk) { const int tk = n * 256 + kk; const size_t r = (size_t)(b * SEQ + tk) * 512 + h * 64;
            SA_KEY(KA + r, VA + r, -slope2 * (float)(t - tk), mine && (tk <= t)); }
    }
    sa_store32(O + ((size_t)(b * SEQ + t)) * 1024 + h * 64 + dof, o, 1.0f / l);
}
__device__ __forceinline__ void sa_swa(const bf16* Q, const bf16* KB, const bf16* VB, const float* sinks, bf16* O, int b, int hq, int t0, int lane) {
    const int dof = 32 * (lane & 1);
    const int t = t0 + (lane >> 1), kvh = hq >> 2;
    float q[32]; sa_load32(Q + ((size_t)(b * SEQ + t)) * 1024 + 512 + hq * 64 + dof, q);
    const float slope2 = exp2f(-0.5f * (float)(hq + 1)) * pg8::kLog2e, sink2 = sinks[hq] * pg8::kLog2e;
    float m = -1e30f, l = 0.f, o[32];
#pragma unroll
    for (int d = 0; d < 32; ++d) o[d] = 0.f;
    const int k0 = t0 - 127 > 0 ? t0 - 127 : 0;
    for (int tk = k0; tk < t0 + 32; ++tk) { const size_t r = (size_t)(b * SEQ + tk) * 128 + kvh * 64;
        SA_KEY(KB + r, VB + r, -slope2 * (float)(t - tk), (tk <= t) && (t - tk < 128)); }
    const float mf = __builtin_fmaxf(m, sink2), c = __builtin_amdgcn_exp2f(m - mf);
    l = l * c + __builtin_amdgcn_exp2f(sink2 - mf);
    sa_store32(O + ((size_t)(b * SEQ + t)) * 1024 + 512 + hq * 64 + dof, o, c / l);
}
__device__ __forceinline__ void attn_simple_phase(Frame& F) {
    const int gw = F.li * NWAVES + F.wave, NGW = 32 * NWAVES;
    int i = 0;
    for (int u = gw; u < 1024; u += NGW, ++i) { const int b = 2 * F.grp + (u >> 9), h = (u >> 6) & 7; int ch = u & 63; if (i & 1) ch = 63 - ch;
        sa_moba(F.Q, F.KA, F.VA, F.kmean, F.Q, b, h, ch * 32, F.lane); }
    for (int u = gw; u < 1024; u += NGW) { const int b = 2 * F.grp + (u >> 9), hq = (u >> 6) & 7, ch = u & 63;
        sa_swa(F.Q, F.KB, F.VB, F.sinks, F.Q, b, hq, ch * 32, F.lane); }
}

namespace fa {
using bf16x8 = __attribute__((ext_vector_type(8))) short;
using s16x4 = __attribute__((ext_vector_type(4))) short;
using f32x16 = __attribute__((ext_vector_type(16))) float;
using u32x4 = __attribute__((ext_vector_type(4))) unsigned;
constexpr int NW = 8, QBLK = 32, KVBLK = 64;
constexpr int SLOTB = 8192, LDS_K = 0, LDS_V = 3 * SLOTB, LDS_WS = 6 * SLOTB, LDS_OST = LDS_WS + NW * 256, LDS_BYTES = LDS_OST + NW * 4096;
constexpr int QP = 1024;
#ifndef FA_THR
#define FA_THR 8
#endif
#define SBAR() __builtin_amdgcn_sched_barrier(0)
#define PIN(x) asm volatile("" : "+v"(x))
#define MFMA(a, b, c) __builtin_amdgcn_mfma_f32_32x32x16_bf16(a, b, c, 0, 0, 0)
#define WAIT_BAR(N) asm volatile("s_waitcnt vmcnt(" #N ") lgkmcnt(0)\n\ts_barrier" ::: "memory")
__device__ __forceinline__ int crow(int r, int hi) { return (r & 3) + 8 * (r >> 2) + 4 * hi; }
__device__ __forceinline__ unsigned cvtpk(float lo, float hi) { unsigned r; asm("v_cvt_pk_bf16_f32 %0, %1, %2" : "=v"(r) : "v"(lo), "v"(hi)); return r; }
__device__ __forceinline__ void glds16(const void* g, unsigned lds_base) {
    unsigned sv; asm volatile("s_mov_b32 %0, m0\n\ts_mov_b32 m0, %2\n\ts_nop 0\n\tglobal_load_lds_dwordx4 %1, off\n\ts_mov_b32 m0, %0" : "=&s"(sv) : "v"(g), "s"(lds_base) : "memory"); }
typedef __attribute__((address_space(3))) const char* lds_cptr;
typedef short v4i16_t __attribute__((ext_vector_type(4)));
__device__ __forceinline__ void kload2(bf16x8* kf, lds_cptr kp, int d0) { kf[2 * d0] = *(const __attribute__((address_space(3))) bf16x8*)(kp + d0 * 2048); kf[2 * d0 + 1] = *(const __attribute__((address_space(3))) bf16x8*)(kp + d0 * 2048 + 512); }
__device__ __forceinline__ s16x4 vtr(lds_cptr p) { return __builtin_bit_cast(s16x4, __builtin_amdgcn_ds_read_tr16_b64_v4i16((__attribute__((address_space(3))) v4i16_t*)p)); }
#define MX3(a, b, c) __builtin_fmaxf(__builtin_fmaxf((a), (b)), (c))
__device__ __forceinline__ float rowmax(const f32x16& p0, const f32x16& p1) {
    float a = MX3(p0[0], p0[1], p1[0]), b = MX3(p0[2], p0[3], p1[1]); a = MX3(a, p1[2], p1[3]);
#pragma unroll
    for (int r = 4; r < 16; r += 4) { a = MX3(a, p0[r], p0[r + 1]); b = MX3(b, p0[r + 2], p0[r + 3]); a = MX3(a, p1[r], p1[r + 1]); b = MX3(b, p1[r + 2], p1[r + 3]); }
    float m = __builtin_fmaxf(a, b); auto rr = __builtin_amdgcn_permlane32_swap(__float_as_uint(m), __float_as_uint(m), false, false);
    return __builtin_fmaxf(__uint_as_float(rr[0]), __uint_as_float(rr[1])); }
__device__ __forceinline__ void emask(f32x16& p0, f32x16& p1, int dq  , unsigned wd) {
#pragma unroll
    for (int r = 0; r < 16; ++r) { const int kv = (r & 3) + 8 * (r >> 2); if ((unsigned)(dq - kv) >= wd) p0[r] = -INFINITY; if ((unsigned)(dq - kv - 32) >= wd) p1[r] = -INFINITY; } }
__device__ __forceinline__ unsigned bf16bits(float f) { unsigned u = __float_as_uint(f); return (u + 0x7fffu + ((u >> 16) & 1u)) >> 16; }

struct AU {
    const bf16* Qw;
    bf16* Ow;
    const bf16* Kb;
    const bf16* Vb;
    int KP;
    int q0;
    int qrel0;
    int NT;
    int mode;
    unsigned wd;
    float slope2;
    float sink2;
    unsigned okmask;
};
__device__ __forceinline__ int key_rel(const AU& u, int t) {
    if (u.mode == 0) { const int np = u.NT - 4; return t == 0 ? 0 : (t <= np ? 64 * (t - 1) - 64 * np : 64 * (t - np)); }
    return -64 * t;
}
__device__ __forceinline__ void attn_unit(const AU& u, char* lds) {
    const int tid = threadIdx.x; int lane = tid & 63; asm volatile("" : "+v"(lane));
    const int r32 = lane & 31, hi = lane >> 5; const int wid = __builtin_amdgcn_readfirstlane(tid >> 6);
    const int NT = u.NT, KP = u.KP;
    const unsigned lds0 = (unsigned)(uintptr_t)lds; float* wsf = (float*)(lds + LDS_WS) + wid * 64;
    const bf16* ksrc = u.Kb + (long)lane * KP + wid * 8;
    const bf16* vsrc = u.Vb + (long)(16 * (wid & 3) + (lane >> 2)) * KP + (wid >> 2) * 32 + (lane & 3) * 8;
    const unsigned kdst = lds0 + LDS_K + wid * 1024, vdst = lds0 + LDS_V + wid * 1024;
#define KROW(t) ({ int r_ = u.q0 + key_rel(u, (t)); r_ < 0 ? 0 : r_; })
#define DMA_K(t, slot) glds16(ksrc + (long)KROW(t) * KP, (unsigned)__builtin_amdgcn_readfirstlane(kdst + (slot)))
#define DMA_V(t, slot) glds16(vsrc + (long)KROW(t) * KP, (unsigned)__builtin_amdgcn_readfirstlane(vdst + (slot)))
    const lds_cptr vp0 = (lds_cptr)lds + LDS_V + ((lane >> 4) & 1) * 32 + (lane & 3) * 8 + (4 * hi + ((lane & 15) >> 2)) * 64;
    const lds_cptr kp0 = (lds_cptr)lds + LDS_K + hi * 1024 + r32 * 16;
    DMA_K(0, 0); DMA_V(0, 0); DMA_K(1, SLOTB);
    bf16x8 qr[4];
#pragma unroll
    for (int d0 = 0; d0 < 4; ++d0) qr[d0] = *reinterpret_cast<const bf16x8*>(&u.Qw[(long)r32 * QP + d0 * 16 + hi * 8]);
    bf16x8 qaug, kaug0, kaug1;
    { const unsigned sh = bf16bits(u.slope2); const float rem = u.slope2 - __uint_as_float(sh << 16); const unsigned sl = bf16bits(rem);
      const unsigned Sh = bf16bits(64.f * __uint_as_float(sh << 16)), Sl = bf16bits(64.f * __uint_as_float(sl << 16));
      u32x4 w = {hi ? 0u : (sh | (sl << 16)), hi ? 0u : (Sh | (Sl << 16)), 0u, 0u}; qaug = __builtin_bit_cast(bf16x8, w);
      const unsigned k0b = bf16bits((float)r32), k1b = bf16bits((float)(r32 + 32));
      u32x4 a0 = {k0b | (k0b << 16), 0u, 0u, 0u}, a1 = {k1b | (k1b << 16), 0u, 0u, 0u}; kaug0 = __builtin_bit_cast(bf16x8, a0); kaug1 = __builtin_bit_cast(bf16x8, a1); }
#define SET_TILE(t) do { const unsigned tb_ = bf16bits((float)(key_rel(u, (t)) >> 6)); const unsigned tw_ = tb_ | (tb_ << 16); \
      u32x4 a0_ = __builtin_bit_cast(u32x4, kaug0), a1_ = __builtin_bit_cast(u32x4, kaug1); a0_[1] = tw_; a1_[1] = tw_; kaug0 = __builtin_bit_cast(bf16x8, a0_); kaug1 = __builtin_bit_cast(bf16x8, a1_); } while (0)
    float mhat = 0.f, l_reg = 0.f; f32x16 o[2]; o[0] = f32x16{}; o[1] = f32x16{};
    const int qrel = u.qrel0 + r32; bool resc = false; const unsigned okmask = u.okmask, wd = u.wd;
    f32x16 pA0, pA1, pB0, pB1; bf16x8 kf[8]; s16x4 vlo[8], vhi[8]; u32x4 pw0, pw1, pw2, pw3;
    int sl_prev = 0, sl_cur = 0, sl_next = SLOTB;
#define ROT() do { sl_prev = sl_cur; sl_cur = sl_next; sl_next = (sl_next == 2 * SLOTB) ? 0 : sl_next + SLOTB; } while (0)
#define EX(v) __builtin_amdgcn_exp2f((v) + nmh)
#define RESC() do { if (resc) { _Pragma("unroll") for (int d_ = 0; d_ < 2; ++d_) _Pragma("unroll") for (int r = 0; r < 16; ++r) o[d_][r] *= wsf[crow(r, hi)]; } } while (0)
    DMA_K(2, 2 * SLOTB);
    WAIT_BAR(3);
    _Pragma("unroll") for (int d0 = 0; d0 < 4; ++d0) kload2(kf, kp0, d0);
    SET_TILE(0);
    pA0 = MFMA(kaug0, qaug, f32x16{}); pA1 = MFMA(kaug1, qaug, f32x16{});
    pA0 = MFMA(kf[0], qr[0], pA0); pA1 = MFMA(kf[1], qr[0], pA1); pA0 = MFMA(kf[2], qr[1], pA0); pA1 = MFMA(kf[3], qr[1], pA1);
    pA0 = MFMA(kf[4], qr[2], pA0); pA1 = MFMA(kf[5], qr[2], pA1); pA0 = MFMA(kf[6], qr[3], pA0); pA1 = MFMA(kf[7], qr[3], pA1);
    emask(pA0, pA1, qrel - key_rel(u, 0) - 4 * hi, wd);
    { const float rm = rowmax(pA0, pA1); mhat = rm; const float nmh = -mhat;
#pragma unroll
      for (int r = 0; r < 16; ++r) { pA0[r] = EX(pA0[r]); pA1[r] = EX(pA1[r]); } }
    WAIT_BAR(0);
    DMA_K(3, 0); DMA_V(1, SLOTB); ROT();
    _Pragma("unroll") for (int d0 = 0; d0 < 4; ++d0) kload2(kf, kp0 + sl_cur, d0);
    WAIT_BAR(2);
#define PKW(P, i) cvtpk(P[i], P[i + 1])
#define PAF(k) __builtin_bit_cast(bf16x8, pw##k)
#define VFR(i) (bf16x8){vlo[i][0], vlo[i][1], vlo[i][2], vlo[i][3], vhi[i][0], vhi[i][1], vhi[i][2], vhi[i][3]}
#define VRD(i) do { vlo[i] = vtr(vp_ + (((i) >> 2) * 4096 + ((i) & 3) * 1024)); vhi[i] = vtr(vp_ + (((i) >> 2) * 4096 + ((i) & 3) * 1024 + 512)); } while (0)
#define KRD(G, d0) do { if (G) { kload2(kf, kp0 + sl_next, d0); SBAR(); } } while (0)
#define GAPA(MF, a0, a1, a2, a3, W0, W1, PW) do { MF; sacc += a0; sacc += a1; sacc += a2; sacc += a3; W0; W1; PIN(PW); PIN(sacc); SBAR(); } while (0)
#define GAPB(MF, X, i) do { MF; X[i] = EX(X[i]); X[i + 1] = EX(X[i + 1]); X[i + 2] = EX(X[i + 2]); X[i + 3] = EX(X[i + 3]); PIN(X); SBAR(); } while (0)
#define STEP(C0, C1, P0, P1, t, MASK, GK, GV, GL) do { SBAR(); \
    const lds_cptr vp_ = vp0 + sl_prev; SET_TILE(t); \
    C0 = MFMA(kaug0, qaug, f32x16{}); C1 = MFMA(kaug1, qaug, f32x16{}); SBAR(); \
    VRD(0); SBAR(); float sacc = P0[0] + P0[1]; \
                    GAPA(C0 = MFMA(kf[0], qr[0], C0), P0[2], P0[3], P0[4], P0[5],     pw0[0] = PKW(P0, 0),  pw0[1] = PKW(P0, 2),  pw0); \
    VRD(4); SBAR(); GAPA(C1 = MFMA(kf[1], qr[0], C1), P0[6], P0[7], P0[8], P0[9],     pw0[2] = PKW(P0, 4),  pw0[3] = PKW(P0, 6),  pw0); \
    VRD(1); SBAR(); GAPA(C0 = MFMA(kf[2], qr[1], C0),    P0[10], P0[11], P0[12], P0[13], pw1[0] = PKW(P0, 8),  pw1[1] = PKW(P0, 10), pw1); \
    VRD(5); SBAR(); GAPA(C1 = MFMA(kf[3], qr[1], C1),    P0[14], P0[15], P1[0], P1[1],   pw1[2] = PKW(P0, 12), pw1[3] = PKW(P0, 14), pw1); \
    VRD(2); SBAR(); GAPA(C0 = MFMA(kf[4], qr[2], C0),    P1[2], P1[3], P1[4], P1[5],     pw2[0] = PKW(P1, 0),  pw2[1] = PKW(P1, 2),  pw2); \
    VRD(6); SBAR(); GAPA(C1 = MFMA(kf[5], qr[2], C1),    P1[6], P1[7], P1[8], P1[9],     pw2[2] = PKW(P1, 4),  pw2[3] = PKW(P1, 6),  pw2); \
    VRD(3); SBAR(); GAPA(C0 = MFMA(kf[6], qr[3], C0),    P1[10], P1[11], P1[12], P1[13], pw3[0] = PKW(P1, 8),  pw3[1] = PKW(P1, 10), pw3); \
    VRD(7); SBAR(); GAPA(C1 = MFMA(kf[7], qr[3], C1),    P1[14], P1[15], 0.f, 0.f,       pw3[2] = PKW(P1, 12), pw3[3] = PKW(P1, 14), pw3); \
    l_reg += sacc; \
    if (GK) DMA_K((t) + 3, sl_cur); if (GV) DMA_V((t) + 1, sl_next); \
    if (MASK) emask(C0, C1, qrel - key_rel(u, (t)) - 4 * hi, wd); \
    const bool ok_ = (okmask >> (t)) & 1u; \
    { float rm = rowmax(C0, C1); rm = ok_ ? rm - mhat : -INFINITY; resc = false; \
      if (__builtin_expect(__any(rm > (float)FA_THR), 0)) { const float dl = __builtin_fmaxf(rm, 0.f); mhat += dl; \
          const float f = __builtin_amdgcn_exp2f(-dl); l_reg *= f; if (hi == 0) wsf[r32] = f; resc = true; } } \
    const float nmh = ok_ ? -mhat : -INFINITY; SBAR(); \
    GAPB(o[0] = MFMA(PAF(0), VFR(0), o[0]), C0, 0);              GAPB(o[1] = MFMA(PAF(0), VFR(4), o[1]), C0, 4); \
    KRD(GL, 0); GAPB(o[0] = MFMA(PAF(1), VFR(1), o[0]), C0, 8);  KRD(GL, 1); GAPB(o[1] = MFMA(PAF(1), VFR(5), o[1]), C0, 12); \
    KRD(GL, 2); GAPB(o[0] = MFMA(PAF(2), VFR(2), o[0]), C1, 0);  KRD(GL, 3); GAPB(o[1] = MFMA(PAF(2), VFR(6), o[1]), C1, 4); \
    GAPB(o[0] = MFMA(PAF(3), VFR(3), o[0]), C1, 8);              GAPB(o[1] = MFMA(PAF(3), VFR(7), o[1]), C1, 12); \
    } while (0)
    int t = 1;
    for (; t + 5 < NT; t += 2) {
        STEP(pB0, pB1, pA0, pA1, t, false, true, true, true);     WAIT_BAR(2); RESC(); ROT();
        STEP(pA0, pA1, pB0, pB1, t + 1, false, true, true, true); WAIT_BAR(2); RESC(); ROT();
    }
#define ENDW(tt) do { if ((tt) + 3 < NT) { WAIT_BAR(2); } else if ((tt) + 2 < NT) { WAIT_BAR(1); } else { WAIT_BAR(0); } } while (0)
    for (; t + 1 < NT; t += 2) {
        STEP(pB0, pB1, pA0, pA1, t, true, (t + 3 < NT), (t + 1 < NT), (t + 1 < NT));         ENDW(t);     RESC(); ROT();
        STEP(pA0, pA1, pB0, pB1, t + 1, true, (t + 4 < NT), (t + 2 < NT), (t + 2 < NT));     ENDW(t + 1); RESC(); ROT();
    }
    STEP(pB0, pB1, pA0, pA1, NT - 1, true, false, false, false); RESC();
    { float sacc = pB0[0] + pB0[1];
#pragma unroll
      for (int r = 2; r < 16; ++r) sacc += pB0[r];
#pragma unroll
      for (int r = 0; r < 16; ++r) sacc += pB1[r];
      l_reg += sacc;
      pw0 = (u32x4){PKW(pB0, 0), PKW(pB0, 2), PKW(pB0, 4), PKW(pB0, 6)}; pw1 = (u32x4){PKW(pB0, 8), PKW(pB0, 10), PKW(pB0, 12), PKW(pB0, 14)};
      pw2 = (u32x4){PKW(pB1, 0), PKW(pB1, 2), PKW(pB1, 4), PKW(pB1, 6)}; pw3 = (u32x4){PKW(pB1, 8), PKW(pB1, 10), PKW(pB1, 12), PKW(pB1, 14)};
      const lds_cptr vp_ = vp0 + sl_cur; _Pragma("unroll") for (int i = 0; i < 8; ++i) VRD(i);
      o[0] = MFMA(PAF(0), VFR(0), o[0]); o[1] = MFMA(PAF(0), VFR(4), o[1]); o[0] = MFMA(PAF(1), VFR(1), o[0]); o[1] = MFMA(PAF(1), VFR(5), o[1]);
      o[0] = MFMA(PAF(2), VFR(2), o[0]); o[1] = MFMA(PAF(2), VFR(6), o[1]); o[0] = MFMA(PAF(3), VFR(3), o[0]); o[1] = MFMA(PAF(3), VFR(7), o[1]); }
    { auto rr = __builtin_amdgcn_permlane32_swap(__float_as_uint(l_reg), __float_as_uint(l_reg), false, false); l_reg = __uint_as_float(rr[0]) + __uint_as_float(rr[1]); }
    {
      const float sk = u.sink2 + u.slope2 * (float)qrel, mf = __builtin_fmaxf(mhat, sk), c = __builtin_amdgcn_exp2f(mhat - mf);
      const float lt = l_reg * c + __builtin_amdgcn_exp2f(sk - mf);
      if (hi == 0) wsf[32 + r32] = c * __builtin_amdgcn_rcpf(lt); }
    asm volatile("s_waitcnt lgkmcnt(0)" ::: "memory");
    float rli[16];
#pragma unroll
    for (int r = 0; r < 16; ++r) rli[r] = wsf[32 + crow(r, hi)];
    bf16* stg = (bf16*)(lds + LDS_OST) + wid * 2048;
    { int l2 = lane; asm volatile("" : "+v"(l2)); const int r32b = l2 & 31, hib = l2 >> 5;
#pragma unroll
    for (int r = 0; r < 16; ++r) { const int orow = crow(r, hib);
#pragma unroll
        for (int d0 = 0; d0 < 2; ++d0) stg[orow * 64 + d0 * 32 + r32b] = (bf16)bf16bits(o[d0][r] * rli[r]); }
    asm volatile("s_waitcnt lgkmcnt(0)" ::: "memory");
    const int srow = l2 >> 3, ch = l2 & 7; const u32x4* sp = (const u32x4*)(stg + srow * 64 + ch * 8); bf16* gp = u.Ow + (long)srow * QP + ch * 8;
#pragma unroll
    for (int i = 0; i < 4; ++i) *(u32x4*)(gp + (long)i * 8 * QP) = sp[i * 64]; }
    asm volatile("s_waitcnt lgkmcnt(0)\n\ts_barrier" ::: "memory");
#undef KROW
#undef DMA_K
#undef DMA_V
#undef SET_TILE
#undef ROT
#undef EX
#undef RESC
#undef PKW
#undef PAF
#undef VFR
#undef VRD
#undef KRD
#undef ENDW
#undef GAPA
#undef GAPB
#undef STEP
}
#undef SBAR
#undef PIN
#undef MFMA
#undef WAIT_BAR
#undef MX3
}

__device__ __forceinline__ float bfbits2f(short s) { return __uint_as_float(((unsigned)(unsigned short)s) << 16); }
__device__ __forceinline__ void attn_fast_phase(Frame& F, char* lds, bf16* O) {
    const int wid = F.wave;
    for (int i = 0; i < 8; ++i) {
        int lane = F.lane; asm volatile("" : "+v"(lane)); const int r32 = lane & 31, hi = lane >> 5;
        fa::AU u; size_t qoff;
        if (i < 4) {
            const int p = F.vcu >> 1, b = p >> 3, h = p & 7, half = F.vcu & 1;
            const size_t rowbase = (size_t)b * SEQ;
            const int j = half ? (i == 0 ? 6 : i == 1 ? 5 : i == 2 ? 2 : 1) : (i == 0 ? 7 : i == 1 ? 4 : i == 2 ? 3 : 0);
            qoff = (rowbase + 256 * j + 32 * wid) * 1024 + h * 64;
            u.Kb = F.KA + rowbase * 512 + h * 64; u.Vb = F.VA + rowbase * 512 + h * 64; u.KP = 512;
            u.q0 = 256 * j; u.qrel0 = 32 * wid; u.NT = 4 * (j + 1); u.mode = 0; u.wd = 0x40000000u;
            u.slope2 = exp2f(-0.5f * (float)(h + 9)) * pg8::kLog2e; u.sink2 = -INFINITY;
            unsigned sel;
            if (j <= 3) sel = (1u << j) - 1u;
            else {
                fa::bf16x8 qv[4];
#pragma unroll
                for (int d0 = 0; d0 < 4; ++d0) qv[d0] = *reinterpret_cast<const fa::bf16x8*>(&F.Q[qoff + (size_t)r32 * 1024 + d0 * 16 + hi * 8]);
                float gs[7];
#pragma unroll
                for (int n = 0; n < 7; ++n) { gs[n] = -INFINITY;
                    if (n < j) { const float* km = F.kmean + ((size_t)(b * 8 + n) * 8 + h) * 64 + 8 * hi; float s = 0.f;
#pragma unroll
                        for (int d0 = 0; d0 < 4; ++d0) { const f32x4 k0 = *(const GAS f32x4*)(km + 16 * d0), k1 = *(const GAS f32x4*)(km + 16 * d0 + 4);
                            s = __builtin_fmaf(bfbits2f(qv[d0][0]), k0.x, s); s = __builtin_fmaf(bfbits2f(qv[d0][1]), k0.y, s); s = __builtin_fmaf(bfbits2f(qv[d0][2]), k0.z, s); s = __builtin_fmaf(bfbits2f(qv[d0][3]), k0.w, s);
                            s = __builtin_fmaf(bfbits2f(qv[d0][4]), k1.x, s); s = __builtin_fmaf(bfbits2f(qv[d0][5]), k1.y, s); s = __builtin_fmaf(bfbits2f(qv[d0][6]), k1.z, s); s = __builtin_fmaf(bfbits2f(qv[d0][7]), k1.w, s); }
                        s += __shfl_xor(s, 32); gs[n] = s; } }
                sel = 0u;
#pragma unroll
                for (int n = 0; n < 7; ++n) { int rank = 0;
#pragma unroll
                    for (int k = 0; k < 7; ++k) if (k != n) rank += (gs[k] > gs[n] || (gs[k] == gs[n] && k < n)) ? 1 : 0;
                    if (n < j && rank < 3) sel |= 1u << n; }
            }
            unsigned ok = 1u | (7u << (u.NT - 3));
#pragma unroll
            for (int n = 0; n < 7; ++n) if ((sel >> n) & 1u) ok |= 0xFu << (1 + 4 * n);
            u.okmask = ok;
        } else {
            const int us = F.vcu * 4 + (i - 4), b = us >> 6, kvh = (us >> 5) & 1, c = us & 31, hq = kvh * 4 + (wid >> 1);
            const size_t rowbase = (size_t)b * SEQ;
            qoff = (rowbase + 64 * c + 32 * (wid & 1)) * 1024 + 512 + hq * 64;
            u.Kb = F.KB + rowbase * 128 + kvh * 64; u.Vb = F.VB + rowbase * 128 + kvh * 64; u.KP = 128;
            u.q0 = 64 * c; u.qrel0 = 32 * (wid & 1); u.NT = 4; u.mode = 1; u.wd = 128u;
            u.slope2 = exp2f(-0.5f * (float)(hq + 1)) * pg8::kLog2e; u.sink2 = F.sinks[hq] * pg8::kLog2e;
            u.okmask = (c >= 3) ? 0xFu : ((1u << (c + 1)) - 1u);
        }
        u.Qw = F.Q + qoff; u.Ow = O + qoff;
        fa::attn_unit(u, lds);
    }
}
#if defined(DBG_ATTN)
__device__ __forceinline__ void dbg_compare(Frame& F, const bf16* Od) {
    const int gt = F.li * NWAVES * 64 + F.tid, NGT = 32 * NWAVES * 64; float num = 0.f, den = 0.f;
    for (size_t i = gt; i < (size_t)GROWS * 64; i += NGT) { const size_t row = (size_t)F.grp * GROWS + (i >> 6), c8 = i & 63; const size_t off = row * 1024 + DBG_PART * 512 + c8 * 8;
        const v4u a = *(const GAS v4u*)(Od + off), r = *(const GAS v4u*)(F.Q + off);
#define DD(x) { const float a0 = __uint_as_float(a.x << 16), a1 = __uint_as_float(a.x & 0xffff0000u), r0 = __uint_as_float(r.x << 16), r1 = __uint_as_float(r.x & 0xffff0000u); num += (a0 - r0) * (a0 - r0) + (a1 - r1) * (a1 - r1); den += r0 * r0 + r1 * r1; }
        DD(x) DD(y) DD(z) DD(w)
#undef DD
    }
    num = wave_sum(num); den = wave_sum(den);
    if (F.lane == 0) { atomicAdd((float*)(F.ctl) + 8, num); atomicAdd((float*)(F.ctl) + 9, den); }
}
#endif

struct Args { const float* in[14]; float* out; unsigned char* ws; };
__global__ void __launch_bounds__(NWAVES * 64, 2) fwd_megakernel(Args args) {
    extern __shared__ __attribute__((aligned(16))) unsigned char lds[];
    Frame F;
    F.lds = (LAS unsigned char*)lds;
    F.MISC = (volatile LAS unsigned*)(F.lds + MISC_OFF);
    F.tid = threadIdx.x; F.lane = F.tid & 63; F.wave = __builtin_amdgcn_readfirstlane(F.tid >> 6);
    F.G = gridDim.x;
    unsigned char* ws = args.ws; F.ws = ws;
    F.ctl = (gu32*)(ws + WS_CTL);
    F.x = args.in[0]; F.norm_attn = args.in[1]; F.w_in = args.in[2]; F.qna = args.in[3]; F.kna = args.in[4]; F.qnb = args.in[5]; F.knb = args.in[6]; F.sinks = args.in[7];
    F.wba = args.in[8]; F.wbb = args.in[9]; F.w_out = args.in[10]; F.norm_mlp = args.in[11]; F.w_up = args.in[12]; F.w_down = args.in[13]; F.out = args.out;
    F.WinT = (bf16*)(ws + WS_WIN); F.WbrT = (bf16*)(ws + WS_WBR); F.WoT = (bf16*)(ws + WS_WO); F.WupT = (bf16*)(ws + WS_WUP); F.WdnT = (bf16*)(ws + WS_WDN);
    F.kmean = (float*)(ws + WS_CTL) + CW_KMEAN; F.rowsq = (float*)(ws + WS_CTL) + CW_ROWSQ;
    for (int u = F.tid; u < (LDS_BYTES - LDSCTL_OFF) / 4; u += NWAVES * 64) ((LAS unsigned*)(F.lds + LDSCTL_OFF))[u] = 0u;
    __syncthreads();
    XcdBarrier bar = xcd_barrier_post((unsigned*)(F.ctl + CW_BAR), F.MISC + 8);
    if (F.tid == 0) F.MISC[12] = xb_add((unsigned*)(F.ctl + CW_CENSUS) + 64 * bar.x, 1u);
    __syncthreads();
    const unsigned my_arrival = F.MISC[12];
#define GRID_BAR() xcd_barrier(bar)

#ifndef SKIP_P0
    p0_prologue(F);
#endif
    GRID_BAR();
    {   bool ok = (F.G == 256);
        for (int j = 0; j < 16; ++j) { const unsigned c = __hip_atomic_load((unsigned*)(F.ctl + CW_CENSUS) + 64 * j, RLX_AGENT); ok = ok && (c == (j < NGRP ? 32u : 0u)); }
        F.grouped = ok ? 1 : 0;
        if (ok) { F.grp = (int)bar.x; F.li = (int)my_arrival; }
        else    { F.grp = (int)blockIdx.x % NGRP; F.li = (int)blockIdx.x / NGRP; }
        F.grp = __builtin_amdgcn_readfirstlane(F.grp); F.li = __builtin_amdgcn_readfirstlane(F.li);
        F.vcu = F.grp * 32 + F.li; }
    const int vbid = F.li * NGRP + F.grp;
    F.Q = grp_ptr(ws, F.grp, GO_Q, 1024); F.KA = grp_ptr(ws, F.grp, GO_KA, 512); F.VA = grp_ptr(ws, F.grp, GO_VA, 512); F.KB = grp_ptr(ws, F.grp, GO_KB, 128); F.VB = grp_ptr(ws, F.grp, GO_VB, 128);
    F.GA = grp_ptr(ws, F.grp, GO_GA, 1024); F.GB = grp_ptr(ws, F.grp, GO_GB, 1024); F.HB = grp_ptr(ws, F.grp, GO_H, 4096); F.A2 = grp_ptr(ws, F.grp, GO_A2, 1024); F.XN = grp_ptr(ws, F.grp, GO_XN, 1024);
    GroupBar gbar{(unsigned*)(F.ctl + CW_GSUB) + 64 * F.grp, (unsigned*)(F.ctl + CW_GGEN) + 64 * F.grp, (unsigned*)(F.ctl + CW_BAR)};
#define GROUP_BAR() do { if (F.grouped) group_barrier(gbar); else xcd_barrier(bar); } while (0)
#ifndef SKIP_P1
    {   pg8::Gemm g{F.XN, F.WinT, M, NIN, DM}; pg8::StaticOrder S; S.init(M, NIN, F.G, vbid);
        pg8::EpiIn E{F.Q, F.KA, F.VA, F.KB, F.VB, F.GA, F.GB, F.qna, F.kna, F.qnb, F.knb, F.kmean};
        pg8::gemm_phase<pg8::EpiIn, pg8::StaticOrder, true, true>(F.lds + RING_OFF, g, S, E); }
#endif
    GROUP_BAR();
#if defined(DBG_ATTN)
    attn_fast_phase(F, (char*)lds + RING_OFF, F.XN); GROUP_BAR(); attn_simple_phase(F); GROUP_BAR(); dbg_compare(F, F.XN);
#elif defined(SIMPLE_ATTN)
    attn_simple_phase(F);
#else
    attn_fast_phase(F, (char*)lds + RING_OFF, F.Q);
#endif
    GROUP_BAR();
#ifndef SKIP_P3
    {   pg8::Gemm g{F.Q, F.WbrT, M, DM, DM}; pg8::StaticOrder S; S.init(M, DM, F.G, vbid);
        pg8::EpiMix E{F.GA, F.GB, F.XN};
        pg8::gemm_phase<pg8::EpiMix, pg8::StaticOrder, true, true>(F.lds + RING_OFF, g, S, E); }
#endif
    GROUP_BAR();
#ifndef SKIP_P4
    {   pg8::Gemm g{F.XN, F.WoT, M, DM, DM}; pg8::StaticOrder S; S.init(M, DM, F.G, vbid);
        pg8::EpiX1 E{F.x, F.A2, F.rowsq};
        pg8::gemm_phase<pg8::EpiX1, pg8::StaticOrder, true, true>(F.lds + RING_OFF, g, S, E); }
#endif
    GROUP_BAR();
#ifndef SKIP_P5
    {   pg8::Gemm g{F.A2, F.WupT, M, FF, DM}; pg8::StaticOrder S; S.init(M, FF, F.G, vbid);
        pg8::EpiUp E{F.HB, F.rowsq};
        pg8::gemm_phase<pg8::EpiUp, pg8::StaticOrder, true, true>(F.lds + RING_OFF, g, S, E); }
#endif
    GROUP_BAR();
#ifndef SKIP_P6
    {   pg8::Gemm g{F.HB, F.WdnT, M, DM, FF}; pg8::StaticOrder S; S.init(M, DM, F.G, vbid);
#if defined(DBG_ATTN)
        const float dnum = ((const GAS float*)F.ctl)[8], dden = ((const GAS float*)F.ctl)[9];
        pg8::EpiDown E{F.A2, F.out, 1.0f + 100.0f * sqrtf(dnum / dden)};
#else
        pg8::EpiDown E{F.A2, F.out, 1.0f};
#endif
        pg8::gemm_phase<pg8::EpiDown, pg8::StaticOrder, true, true>(F.lds + RING_OFF, g, S, E); }
#endif
}

extern "C" void kernel_launch(void* const* d_in, const int* in_sizes, int n_in, void* d_out, int out_size, void* d_ws, size_t ws_size, hipStream_t stream) {
    static int grid = 0;
    if (grid == 0) {
        if (n_in != 14 || in_sizes[0] != M * DM || out_size != M * DM || ws_size < WS_END) { fprintf(stderr, "kernel_launch: unexpected shapes: n_in %d, in0 %d, out %d, ws %zu (need %zu); nothing launched\n", n_in, n_in > 0 ? in_sizes[0] : -1, out_size, ws_size, (size_t)WS_END); grid = -1; return; }
        int dev = 0, cus = 0, per_cu = 0;
        if (hipGetDevice(&dev) != hipSuccess || hipDeviceGetAttribute(&cus, hipDeviceAttributeMultiprocessorCount, dev) != hipSuccess) { fprintf(stderr, "kernel_launch: device query failed\n"); grid = -1; return; }
        if (hipFuncSetAttribute((const void*)fwd_megakernel, hipFuncAttributeMaxDynamicSharedMemorySize, LDS_BYTES) != hipSuccess) { fprintf(stderr, "kernel_launch: hipFuncSetAttribute failed\n"); grid = -1; return; }
        if (hipOccupancyMaxActiveBlocksPerMultiprocessor(&per_cu, (const void*)fwd_megakernel, NWAVES * 64, LDS_BYTES) != hipSuccess || per_cu < 1)
            fprintf(stderr, "kernel_launch: note: occupancy query reports %d workgroups per CU\n", per_cu);
        (void)hipGetLastError();
        grid = cus;
    }
    if (grid < 0) return;
    if (hipMemsetAsync((char*)d_ws + WS_CTL, 0, CTL_ZERO_BYTES, stream) != hipSuccess) { fprintf(stderr, "kernel_launch: hipMemsetAsync failed\n"); return; }
    Args a{};
    for (int i = 0; i < 14; ++i) a.in[i] = (const float*)d_in[i];
    a.out = (float*)d_out; a.ws = (unsigned char*)d_ws;
    hipLaunchKernelGGL(fwd_megakernel, dim3(grid), dim3(NWAVES * 64), LDS_BYTES, stream, a);
    const hipError_t le = hipPeekAtLastError();
    if (le != hipSuccess) fprintf(stderr, "kernel_launch: launch failed: %s\n", hipGetErrorName(le));
}
```

```cpp
#include <hip/hip_runtime.h>
#include <cstdio>
#include <cstdint>
namespace pg8 {
#define PG8_LAS __attribute__((address_space(3)))
typedef unsigned short bf16_t;
typedef short bf16x8 __attribute__((ext_vector_type(8)));
typedef float f32x4 __attribute__((ext_vector_type(4)));
typedef unsigned u32x4 __attribute__((ext_vector_type(4)));
constexpr int BM = 256, BK = 64, HALF = 128, HTB = HALF * BK * 2  , STAGE_BYTES = 8 * HTB, NXCD = 8, WGM = 8;

__host__ __device__ __forceinline__ int lds_byte(int r, int c) { const int st = (r >> 4) * 2 + (c >> 5), rr = r & 15, cc = c & 31, ob = rr * 64 + cc * 2; return st * 1024 + (ob ^ (((ob >> 9) & 1) << 5)); }
__host__ __device__ __forceinline__ void stage_rc(int b, int& R, int& C) { const int st = b / 1024, sb = b % 1024, swz = sb ^ (((sb >> 9) & 1) << 5); R = (st >> 1) * 16 + swz / 64; C = (st & 1) * 32 + (swz % 64) / 2; }
__host__ __device__ __forceinline__ int perm32(int rho) { const int n = rho >> 4, i = rho & 15; return 8 * (i >> 2) + 4 * n + (i & 3); }

struct Unit { int pm, pn; };
struct Gemm { const bf16_t* A; const bf16_t* Bt; int M, N, K; };

struct StaticOrder {
    int nM, nN, nwg, G, c;
    __host__ __device__ void init(int M, int N, int G_, int c_) { nM = M / BM; nN = N / BM; nwg = nM * nN; G = G_; c = c_; }
    __host__ __device__ bool next(int i, Unit& u) const {
        const long L = (long)i * G + c; if (L >= nwg) return false;
        int wgid = (int)L; { const int q = nwg / NXCD, r = nwg % NXCD, xcd = wgid % NXCD, off = wgid / NXCD; wgid = (xcd < r ? xcd * (q + 1) : r * (q + 1) + (xcd - r) * q) + off; }
        const int nig = WGM * nN, gid = wgid / nig, fm = gid * WGM, gsz = (nM - fm) < WGM ? (nM - fm) : WGM;
        u.pm = fm + ((wgid % nig) % gsz); u.pn = (wgid % nig) / gsz; return true;
    }
    __device__ __forceinline__ void a_ready(const Unit&) const {}
    __device__ __forceinline__ void done(const Unit&) const {}
};

__device__ __forceinline__ unsigned cvt_pk_bf16(float lo, float hi) { unsigned r; asm volatile("v_cvt_pk_bf16_f32 %0, %1, %2" : "=v"(r) : "v"(lo), "v"(hi)); return r; }
typedef unsigned u32x2 __attribute__((ext_vector_type(2)));
__device__ __forceinline__ float bf_lo(unsigned w) { return __uint_as_float(w << 16); }
__device__ __forceinline__ float bf_hi(unsigned w) { return __uint_as_float(w & 0xffff0000u); }
constexpr float kLog2e = 1.4426950408889634f;
constexpr float kC2 = 0.125f * 1.4426950408889634f;

struct EpiIn {
    static constexpr bool PERM = true, AFTER_DRAIN = false; static constexpr int MID_TILE = 0;
    bf16_t *Q, *KA, *VA, *KB, *VB, *GR, *GB; const float *qna, *kna, *qnb, *knb; float* kmean;
    __device__ __forceinline__ void mid(f32x4 (&)[2][2][4][2], const Unit&, int, int, int, int) const {}
    __device__ __forceinline__ void operator()(const f32x4 (&acc)[2][2][4][2], const Unit& u, int wr, int wc, int fr, int fq) const {
        const int pn = u.pn;
        const int rowb = u.pm * BM + wr * 64 + fr;
        if (pn >= 9) {
            const int col = 128 * (pn - 9) + 32 * wc + 8 * fq;
#pragma unroll
            for (int ai = 0; ai < 2; ++ai)
#pragma unroll
                for (int m = 0; m < 4; ++m) { const size_t off = (size_t)(rowb + ai * HALF + m * 16) * 1024 + col;
                    f32x4 rt[2], gb[2];
#pragma unroll
                    for (int n = 0; n < 2; ++n)
#pragma unroll
                        for (int e = 0; e < 4; ++e) { const float ea = __builtin_amdgcn_exp2f(-kLog2e * acc[ai][0][m][n][e]), eb = __builtin_amdgcn_exp2f(-kLog2e * acc[ai][1][m][n][e]);
                            gb[n][e] = __builtin_fmaxf(__builtin_amdgcn_rcpf(1.0f + eb), 1e-20f); rt[n][e] = __builtin_fminf((1.0f + eb) * __builtin_amdgcn_rcpf(1.0f + ea), 1e20f); }
                    u32x4 w; w.x = cvt_pk_bf16(rt[0][0], rt[0][1]); w.y = cvt_pk_bf16(rt[0][2], rt[0][3]); w.z = cvt_pk_bf16(rt[1][0], rt[1][1]); w.w = cvt_pk_bf16(rt[1][2], rt[1][3]);
                    *(u32x4*)(GR + off) = w;
                    w.x = cvt_pk_bf16(gb[0][0], gb[0][1]); w.y = cvt_pk_bf16(gb[0][2], gb[0][3]); w.z = cvt_pk_bf16(gb[1][0], gb[1][1]); w.w = cvt_pk_bf16(gb[1][2], gb[1][3]);
                    *(u32x4*)(GB + off) = w; }
            return;
        }
        bf16_t* dst; int pitch; bool norm = false, km = false; float scale = 1.f; const float* gain = qna;
        if (pn < 2)       { dst = Q + (4 * pn + wc) * 64; pitch = 1024; norm = true; gain = qna; scale = kC2; }
        else if (pn < 4)  { dst = KA + (4 * (pn - 2) + wc) * 64; pitch = 512; norm = true; gain = kna; km = true; }
        else if (pn < 6)  { dst = VA + (4 * (pn - 4) + wc) * 64; pitch = 512; }
        else if (pn < 8)  { dst = Q + 512 + (4 * (pn - 6) + wc) * 64; pitch = 1024; norm = true; gain = qnb; scale = kC2; }
        else              { pitch = 128; if (wc < 2) { dst = KB + wc * 64; norm = true; gain = knb; } else { dst = VB + (wc - 2) * 64; } }
        f32x4 g[2][2], cs[2][2];
#pragma unroll
        for (int bj = 0; bj < 2; ++bj)
#pragma unroll
            for (int n = 0; n < 2; ++n) { g[bj][n] = norm ? *(const f32x4*)(gain + 32 * bj + 8 * fq + 4 * n) : (f32x4){1.f, 1.f, 1.f, 1.f}; cs[bj][n] = (f32x4){0.f, 0.f, 0.f, 0.f}; }
#pragma unroll
        for (int ai = 0; ai < 2; ++ai)
#pragma unroll
            for (int m = 0; m < 4; ++m) {
                const int row = rowb + ai * HALF + m * 16;
                f32x4 v[2][2];
#pragma unroll
                for (int bj = 0; bj < 2; ++bj)
#pragma unroll
                    for (int n = 0; n < 2; ++n) v[bj][n] = acc[ai][bj][m][n];
                if (norm) {
                    float ss = 0.f;
#pragma unroll
                    for (int bj = 0; bj < 2; ++bj)
#pragma unroll
                        for (int n = 0; n < 2; ++n) { const f32x4 x = v[bj][n]; ss += (x[0] * x[0] + x[1] * x[1]) + (x[2] * x[2] + x[3] * x[3]); }
                    ss += __shfl_xor(ss, 16); ss += __shfl_xor(ss, 32);
                    const float rs = __builtin_amdgcn_rsqf(ss * (1.0f / 64.0f) + 1e-6f) * scale;
#pragma unroll
                    for (int bj = 0; bj < 2; ++bj)
#pragma unroll
                        for (int n = 0; n < 2; ++n) v[bj][n] = v[bj][n] * rs * g[bj][n];
                }
                if (km) {
#pragma unroll
                    for (int bj = 0; bj < 2; ++bj)
#pragma unroll
                        for (int n = 0; n < 2; ++n) cs[bj][n] += v[bj][n];
                }
#pragma unroll
                for (int bj = 0; bj < 2; ++bj) {
                    u32x4 w; w.x = cvt_pk_bf16(v[bj][0][0], v[bj][0][1]); w.y = cvt_pk_bf16(v[bj][0][2], v[bj][0][3]); w.z = cvt_pk_bf16(v[bj][1][0], v[bj][1][1]); w.w = cvt_pk_bf16(v[bj][1][2], v[bj][1][3]);
                    *(u32x4*)(dst + (size_t)row * pitch + 32 * bj + 8 * fq) = w;
                }
            }
        if (km) {
            float* kmp = kmean + ((size_t)u.pm * 8 + (4 * (pn - 2) + wc)) * 64;
#pragma unroll
            for (int bj = 0; bj < 2; ++bj)
#pragma unroll
                for (int n = 0; n < 2; ++n)
#pragma unroll
                    for (int e = 0; e < 4; ++e) {
                        float s = cs[bj][n][e];
                        s += __shfl_xor(s, 1); s += __shfl_xor(s, 2); s += __shfl_xor(s, 4); s += __shfl_xor(s, 8);
                        if (fr == 0) atomicAdd(kmp + 32 * bj + 8 * fq + 4 * n + e, s * (1.0f / 256.0f));
                    }
        }
    }
};

struct EpiMix {
    static constexpr bool PERM = true, AFTER_DRAIN = false; static constexpr int MID_TILE = 8;
    const bf16_t *GR, *GB; bf16_t* MIX;
    __device__ __forceinline__ void mid(f32x4 (&acc)[2][2][4][2], const Unit& u, int wr, int wc, int fr, int fq) const {
        int rowb = u.pm * BM + wr * 64 + fr, col0 = u.pn * BM + wc * 32 + 8 * fq;
        asm volatile("" : "+v"(rowb), "+v"(col0));
        const bf16_t* base = GR + (size_t)rowb * 1024 + col0;
        u32x4 rt[2][4][2];
#pragma unroll
        for (int ai = 0; ai < 2; ++ai)
#pragma unroll
            for (int m = 0; m < 4; ++m)
#pragma unroll
                for (int bj = 0; bj < 2; ++bj) rt[ai][m][bj] = *(const u32x4*)(base + (size_t)(ai * HALF + m * 16) * 1024 + bj * HALF);
#pragma unroll
        for (int ai = 0; ai < 2; ++ai)
#pragma unroll
            for (int m = 0; m < 4; ++m)
#pragma unroll
                for (int bj = 0; bj < 2; ++bj) { const u32x4 a = rt[ai][m][bj];
                    acc[ai][bj][m][0] *= (f32x4){bf_lo(a.x), bf_hi(a.x), bf_lo(a.y), bf_hi(a.y)}; acc[ai][bj][m][1] *= (f32x4){bf_lo(a.z), bf_hi(a.z), bf_lo(a.w), bf_hi(a.w)}; }
    }
    __device__ __forceinline__ void operator()(const f32x4 (&acc)[2][2][4][2], const Unit& u, int wr, int wc, int fr, int fq) const {
        const int rowb = u.pm * BM + wr * 64 + fr, col0 = u.pn * BM + wc * 32 + 8 * fq;
        const bf16_t* base = GB + (size_t)rowb * 1024 + col0; bf16_t* ob = MIX + (size_t)rowb * 1024 + col0;
        u32x4 gt[2][4][2];
#pragma unroll
        for (int ai = 0; ai < 2; ++ai)
#pragma unroll
            for (int m = 0; m < 4; ++m)
#pragma unroll
                for (int bj = 0; bj < 2; ++bj) gt[ai][m][bj] = *(const u32x4*)(base + (size_t)(ai * HALF + m * 16) * 1024 + bj * HALF);
#pragma unroll
        for (int ai = 0; ai < 2; ++ai)
#pragma unroll
            for (int m = 0; m < 4; ++m)
#pragma unroll
                for (int bj = 0; bj < 2; ++bj) { const u32x4 b = gt[ai][m][bj];
                    const f32x4 v0 = acc[ai][bj][m][0], v1 = acc[ai][bj][m][1];
                    u32x4 w; w.x = cvt_pk_bf16(v0[0] * bf_lo(b.x), v0[1] * bf_hi(b.x)); w.y = cvt_pk_bf16(v0[2] * bf_lo(b.y), v0[3] * bf_hi(b.y));
                    w.z = cvt_pk_bf16(v1[0] * bf_lo(b.z), v1[1] * bf_hi(b.z)); w.w = cvt_pk_bf16(v1[2] * bf_lo(b.w), v1[3] * bf_hi(b.w));
                    *(u32x4*)(ob + (size_t)(ai * HALF + m * 16) * 1024 + bj * HALF) = w; }
    }
};

struct EpiX1 {
    static constexpr bool PERM = false, AFTER_DRAIN = false; static constexpr int MID_TILE = 0;
    const float* x; bf16_t* X1; float* rowsq;
    __device__ __forceinline__ void mid(f32x4 (&)[2][2][4][2], const Unit&, int, int, int, int) const {}
    __device__ __forceinline__ void operator()(const f32x4 (&acc)[2][2][4][2], const Unit& u, int wr, int wc, int fr, int fq) const {
        const int rowb = u.pm * BM + wr * 64 + fr, col0 = u.pn * BM + wc * 32 + 4 * fq;
#pragma unroll
        for (int ai = 0; ai < 2; ++ai) {
            f32x4 xv[4][2][2];
#pragma unroll
            for (int m = 0; m < 4; ++m)
#pragma unroll
                for (int bj = 0; bj < 2; ++bj)
#pragma unroll
                    for (int n = 0; n < 2; ++n) xv[m][bj][n] = *(const f32x4*)(x + (size_t)(rowb + ai * HALF + m * 16) * 1024 + col0 + bj * HALF + n * 16);
#pragma unroll
            for (int m = 0; m < 4; ++m) { const int row = rowb + ai * HALF + m * 16; const size_t off = (size_t)row * 1024 + col0; float ss = 0.f;
#pragma unroll
                for (int bj = 0; bj < 2; ++bj)
#pragma unroll
                    for (int n = 0; n < 2; ++n) {
                        const f32x4 x1 = xv[m][bj][n] + acc[ai][bj][m][n];
                        ss += (x1[0] * x1[0] + x1[1] * x1[1]) + (x1[2] * x1[2] + x1[3] * x1[3]);
                        u32x2 w; w.x = cvt_pk_bf16(x1[0], x1[1]); w.y = cvt_pk_bf16(x1[2], x1[3]);
                        *(u32x2*)(X1 + off + bj * HALF + n * 16) = w;
                    }
                ss += __shfl_xor(ss, 16); ss += __shfl_xor(ss, 32);
                if (fq == 0) atomicAdd(rowsq + row, ss); }
            asm volatile("" ::: "memory"); }
    }
};

struct EpiUp {
    static constexpr bool PERM = true, AFTER_DRAIN = false; static constexpr int MID_TILE = 0;
    bf16_t* H; const float* rowsq;
    __device__ __forceinline__ void mid(f32x4 (&)[2][2][4][2], const Unit&, int, int, int, int) const {}
    __device__ __forceinline__ void operator()(const f32x4 (&acc)[2][2][4][2], const Unit& u, int wr, int wc, int fr, int fq) const {
        const int rowb = u.pm * BM + wr * 64 + fr, col0 = u.pn * BM + wc * 32 + 8 * fq;
#pragma unroll
        for (int ai = 0; ai < 2; ++ai)
#pragma unroll
            for (int m = 0; m < 4; ++m) { const int row = rowb + ai * HALF + m * 16;
                const float r = __builtin_amdgcn_rsqf(rowsq[row] * (1.0f / 1024.0f) + 1e-6f);
                bf16_t* rowp = H + (size_t)row * 4096 + col0;
#pragma unroll
                for (int bj = 0; bj < 2; ++bj) {
                    f32x4 v0 = acc[ai][bj][m][0] * r, v1 = acc[ai][bj][m][1] * r;
#pragma unroll
                    for (int e = 0; e < 4; ++e) { const float a = __builtin_fmaxf(v0[e], 0.f), b = __builtin_fmaxf(v1[e], 0.f); v0[e] = a * a; v1[e] = b * b; }
                    u32x4 w; w.x = cvt_pk_bf16(v0[0], v0[1]); w.y = cvt_pk_bf16(v0[2], v0[3]); w.z = cvt_pk_bf16(v1[0], v1[1]); w.w = cvt_pk_bf16(v1[2], v1[3]);
                    *(u32x4*)(rowp + bj * HALF) = w;
                } }
    }
};

struct EpiDown {
    static constexpr bool PERM = false, AFTER_DRAIN = false; static constexpr int MID_TILE = 0;
    const bf16_t* X1; float* out; float mul;
    __device__ __forceinline__ void mid(f32x4 (&)[2][2][4][2], const Unit&, int, int, int, int) const {}
    __device__ __forceinline__ void operator()(const f32x4 (&acc)[2][2][4][2], const Unit& u, int wr, int wc, int fr, int fq) const {
        const int rowb = u.pm * BM + wr * 64 + fr, col0 = u.pn * BM + wc * 32 + 4 * fq;
        u32x2 xv[2][4][2][2];
#pragma unroll
        for (int ai = 0; ai < 2; ++ai)
#pragma unroll
            for (int m = 0; m < 4; ++m)
#pragma unroll
                for (int bj = 0; bj < 2; ++bj)
#pragma unroll
                    for (int n = 0; n < 2; ++n) xv[ai][m][bj][n] = *(const u32x2*)(X1 + (size_t)(rowb + ai * HALF + m * 16) * 1024 + col0 + bj * HALF + n * 16);
#pragma unroll
        for (int ai = 0; ai < 2; ++ai)
#pragma unroll
            for (int m = 0; m < 4; ++m) { float* rowp = out + (size_t)(rowb + ai * HALF + m * 16) * 1024 + col0;
#pragma unroll
                for (int bj = 0; bj < 2; ++bj)
#pragma unroll
                    for (int n = 0; n < 2; ++n) { const u32x2 w = xv[ai][m][bj][n];
                        *(f32x4*)(rowp + bj * HALF + n * 16) = ((f32x4){bf_lo(w.x), bf_hi(w.x), bf_lo(w.y), bf_hi(w.y)} + acc[ai][bj][m][n]) * mul; } }
    }
};

template <class Epi, class Sched, bool ALIGN_EPI = false, bool SP2 = false>
__device__ __forceinline__ void gemm_phase(PG8_LAS unsigned char* lds, const Gemm g, const Sched& S, const Epi& E) {
    int tid = threadIdx.x; asm volatile("" : "+v"(tid));
    const int wid = __builtin_amdgcn_readfirstlane(tid >> 6), lane = tid & 63, wr = wid >> 2, wc = wid & 3, fr = lane & 15, fq = lane >> 4;
    const int K = g.K, nt = K / BK;
    unsigned voffA[2], voffB[2];
#pragma unroll
    for (int i = 0; i < 2; ++i) { int R, C; stage_rc(tid * 16 + i * 8192, R, C); const int Rb = Epi::PERM ? ((R & ~31) + perm32(R & 31)) : R;
        voffA[i] = (unsigned)(R * K + C) * 2u; voffB[i] = (unsigned)(Rb * K + C) * 2u; }
    const size_t kstep = (size_t)(BK * 2);
    const size_t hstep = (size_t)HALF * K * 2;
    const size_t tstep = 2 * hstep;
    const unsigned ldsw = (unsigned)wid * 1024u;
    const int aoff = lds_byte(wr * 64 + fr, fq * 8), boff = lds_byte(wc * 32 + fr, fq * 8);
#define PG8_SA(b, h) (((b) * 2 + (h)) * HTB)
#define PG8_SB(b, h) ((4 + (b) * 2 + (h)) * HTB)
#define PG8_STAGE(bufoff, gbase, voff) do { _Pragma("unroll") for (int _i = 0; _i < 2; ++_i) \
        __builtin_amdgcn_global_load_lds((const unsigned*)((const char*)(gbase) + (voff)[_i]), (PG8_LAS unsigned*)(lds + (bufoff) + ldsw + _i * 8192), 16, 0, 0); } while (0)
#define PG8_LDA(dst, b, h) do { _Pragma("unroll") for (int m = 0; m < 4; ++m) _Pragma("unroll") for (int k = 0; k < 2; ++k) dst[m][k] = *(const PG8_LAS bf16x8*)(lds + PG8_SA(b, h) + aoff + m * 2048 + k * 1024); } while (0)
#define PG8_LDB(dst, b, h) do { _Pragma("unroll") for (int n = 0; n < 2; ++n) _Pragma("unroll") for (int k = 0; k < 2; ++k) dst[n][k] = *(const PG8_LAS bf16x8*)(lds + PG8_SB(b, h) + boff + n * 2048 + k * 1024); } while (0)
#define PG8_MMA(ai, bj, At, Bt) do { __builtin_amdgcn_s_setprio(1); _Pragma("unroll") for (int m = 0; m < 4; ++m) _Pragma("unroll") for (int n = 0; n < 2; ++n) _Pragma("unroll") for (int k = 0; k < 2; ++k) \
        acc[ai][bj][m][n] = __builtin_amdgcn_mfma_f32_16x16x32_bf16(Bt[n][k], At[m][k], acc[ai][bj][m][n], 0, 0, 0); __builtin_amdgcn_s_setprio(0); } while (0)
#define PG8_WAIT_V(n) asm volatile("s_waitcnt vmcnt(" #n ")" ::: "memory")
#define PG8_WAIT_L(n) asm volatile("s_waitcnt lgkmcnt(" #n ")" ::: "memory")
#define PG8_BAR __builtin_amdgcn_s_barrier()
#define PG8_SCHED __builtin_amdgcn_sched_barrier(0)
    Unit cur, nxt; int ui = 0;
    if (!S.next(0, cur)) return;
    f32x4 acc[2][2][4][2];
#pragma unroll
    for (int a = 0; a < 2; ++a)
#pragma unroll
        for (int b = 0; b < 2; ++b)
#pragma unroll
            for (int m = 0; m < 4; ++m)
#pragma unroll
                for (int n = 0; n < 2; ++n) acc[a][b][m][n] = (f32x4){0.f, 0.f, 0.f, 0.f};
    bf16x8 At[4][2], B0[2][2], B1[2][2];
    const char* cA = (const char*)g.A + (size_t)cur.pm * tstep; const char* cB = (const char*)g.Bt + (size_t)cur.pn * tstep;
    S.a_ready(cur);
    if constexpr (SP2) {
        PG8_STAGE(PG8_SB(0, 0), cB, voffB); PG8_STAGE(PG8_SB(0, 1), cB + hstep, voffB); PG8_STAGE(PG8_SA(0, 0), cA, voffA); PG8_STAGE(PG8_SA(0, 1), cA + hstep, voffA);
        if (wr == 1) PG8_BAR;
        PG8_WAIT_V(2); PG8_BAR;
        PG8_STAGE(PG8_SB(1, 0), cB + kstep, voffB); PG8_STAGE(PG8_SA(1, 0), cA + kstep, voffA); PG8_STAGE(PG8_SB(1, 1), cB + hstep + kstep, voffB);
        PG8_WAIT_V(6); PG8_BAR;
    } else {
        PG8_STAGE(PG8_SB(0, 0), cB, voffB); PG8_STAGE(PG8_SA(0, 0), cA, voffA); PG8_STAGE(PG8_SB(0, 1), cB + hstep, voffB); PG8_STAGE(PG8_SA(0, 1), cA + hstep, voffA);
        if (wr == 1) PG8_BAR;
        PG8_WAIT_V(4); PG8_BAR;
        PG8_STAGE(PG8_SB(1, 0), cB + kstep, voffB); PG8_STAGE(PG8_SA(1, 0), cA + kstep, voffA); PG8_STAGE(PG8_SB(1, 1), cB + hstep + kstep, voffB);
        PG8_WAIT_V(6); PG8_BAR;
    }
    for (;;) {
        const bool has_next = S.next(ui + 1, nxt);
        const char* nA = has_next ? (const char*)g.A + (size_t)nxt.pm * tstep : cA; const char* nB = has_next ? (const char*)g.Bt + (size_t)nxt.pn * tstep : cB;
        for (int t = 0; t < nt; t += 2) {
            if constexpr (Epi::MID_TILE > 0) { if (t == Epi::MID_TILE) { PG8_SCHED; E.mid(acc, cur, wr, wc, fr, fq); PG8_SCHED; } }
            const bool last = (t == nt - 2);
            const char* a1 = cA + (size_t)(t + 1) * kstep;
            const char* a2 = last ? nA : cA + (size_t)(t + 2) * kstep; const char* b2 = last ? nB : cB + (size_t)(t + 2) * kstep;
            const char* a3 = a2 + kstep; const char* b3 = b2 + kstep;
            if (last && has_next) S.a_ready(nxt);
            if constexpr (SP2) {
            PG8_LDB(B0, 0, 0); PG8_LDB(B1, 0, 1); PG8_SCHED; PG8_LDA(At, 0, 0); PG8_STAGE(PG8_SA(1, 1), a1 + hstep, voffA);
            PG8_WAIT_V(8); PG8_WAIT_L(0); PG8_BAR; PG8_MMA(0, 0, At, B0); PG8_MMA(0, 1, At, B1); PG8_BAR; PG8_SCHED;
            PG8_LDA(At, 0, 1); PG8_STAGE(PG8_SB(0, 0), b2, voffB); PG8_STAGE(PG8_SB(0, 1), b2 + hstep, voffB); PG8_STAGE(PG8_SA(0, 0), a2, voffA);
            PG8_WAIT_V(8); PG8_WAIT_L(0); PG8_BAR; PG8_MMA(1, 0, At, B0); PG8_MMA(1, 1, At, B1); PG8_BAR; PG8_SCHED;
            PG8_LDB(B0, 1, 0); PG8_LDB(B1, 1, 1); PG8_SCHED; PG8_LDA(At, 1, 0); PG8_STAGE(PG8_SA(0, 1), a2 + hstep, voffA);
            PG8_WAIT_V(8); PG8_WAIT_L(0); PG8_BAR; PG8_MMA(0, 0, At, B0); PG8_MMA(0, 1, At, B1); PG8_BAR; PG8_SCHED;
            PG8_LDA(At, 1, 1); PG8_STAGE(PG8_SB(1, 0), b3, voffB); PG8_STAGE(PG8_SB(1, 1), b3 + hstep, voffB); PG8_STAGE(PG8_SA(1, 0), a3, voffA);
            PG8_WAIT_V(8); PG8_WAIT_L(0); PG8_BAR; PG8_MMA(1, 0, At, B0); PG8_MMA(1, 1, At, B1); PG8_BAR; PG8_SCHED;
            } else {
            PG8_LDB(B0, 0, 0); PG8_SCHED; PG8_LDA(At, 0, 0); PG8_STAGE(PG8_SA(1, 1), a1 + hstep, voffA);
            PG8_WAIT_L(8); PG8_BAR; PG8_WAIT_L(0); PG8_MMA(0, 0, At, B0); PG8_BAR; PG8_SCHED;
            PG8_LDB(B1, 0, 1); PG8_STAGE(PG8_SB(0, 0), b2, voffB);
            PG8_BAR; PG8_WAIT_L(0); PG8_MMA(0, 1, At, B1); PG8_BAR;
            PG8_LDA(At, 0, 1); PG8_STAGE(PG8_SA(0, 0), a2, voffA);
            PG8_BAR; PG8_WAIT_L(0); PG8_MMA(1, 0, At, B0); PG8_BAR; PG8_SCHED;
            PG8_STAGE(PG8_SB(0, 1), b2 + hstep, voffB);
            PG8_WAIT_V(6); PG8_BAR; PG8_MMA(1, 1, At, B1); PG8_BAR;
            PG8_LDB(B0, 1, 0); PG8_SCHED; PG8_LDA(At, 1, 0); PG8_STAGE(PG8_SA(0, 1), a2 + hstep, voffA);
            PG8_WAIT_L(8); PG8_BAR; PG8_WAIT_L(0); PG8_MMA(0, 0, At, B0); PG8_BAR; PG8_SCHED;
            PG8_LDB(B1, 1, 1); PG8_STAGE(PG8_SB(1, 0), b3, voffB);
            PG8_BAR; PG8_WAIT_L(0); PG8_MMA(0, 1, At, B1); PG8_BAR;
            PG8_LDA(At, 1, 1); PG8_STAGE(PG8_SA(1, 0), a3, voffA);
            PG8_BAR; PG8_WAIT_L(0); PG8_MMA(1, 0, At, B0); PG8_BAR; PG8_SCHED;
            PG8_STAGE(PG8_SB(1, 1), b3 + hstep, voffB);
            PG8_WAIT_V(6); PG8_BAR; PG8_MMA(1, 1, At, B1); PG8_BAR;
            }
        }
        if constexpr (ALIGN_EPI) { if (wr == 0) PG8_BAR; }
        if constexpr (!Epi::AFTER_DRAIN) { E(acc, cur, wr, wc, fr, fq); S.done(cur); }
        if (!has_next) break;
#pragma unroll
        for (int a = 0; a < 2; ++a)
#pragma unroll
            for (int b = 0; b < 2; ++b)
#pragma unroll
                for (int m = 0; m < 4; ++m)
#pragma unroll
                    for (int n = 0; n < 2; ++n) acc[a][b][m][n] = (f32x4){0.f, 0.f, 0.f, 0.f};
        cur = nxt; cA = nA; cB = nB; ++ui;
        if constexpr (ALIGN_EPI) { if (wr == 1) PG8_BAR; }
    }
    PG8_WAIT_V(0);
    if constexpr (!ALIGN_EPI) { if (wr == 0) PG8_BAR; }
    PG8_BAR;
    if constexpr (Epi::AFTER_DRAIN) { E.fused(acc, cur, wr, wc, fr, fq, lds, wid, lane); S.done(cur); }
#undef PG8_SA
#undef PG8_SB
#undef PG8_STAGE
#undef PG8_LDA
#undef PG8_LDB
#undef PG8_MMA
#undef PG8_WAIT_V
#undef PG8_WAIT_L
#undef PG8_BAR
#undef PG8_SCHED
}
}
constexpr int NWAVES = 8;
constexpr int BATCH = 16, SEQ = 2048, DM = 1024, HD = 64, FF = 4096, NIN = 4352;
constexpr int M = BATCH * SEQ;
constexpr float EPS = 1e-6f;
constexpr size_t MiB = 1u << 20;
constexpr size_t WS_CTL = 0, CTL_ZERO_BYTES = 1 * MiB;
constexpr size_t WS_WIN = 2 * MiB, WS_WBR = 11 * MiB, WS_WO = 13 * MiB, WS_WUP = 15 * MiB, WS_WDN = 23 * MiB;
constexpr int NGRP = 8, GROWS = M / NGRP;
constexpr size_t WS_GRP0 = 32 * MiB, GRP_STRIDE = 50 * MiB;
constexpr size_t GO_Q = 0 * MiB;
constexpr size_t GO_KA = 8 * MiB, GO_VA = 12 * MiB;
constexpr size_t GO_KB = 16 * MiB, GO_VB = 17 * MiB;
constexpr size_t GO_GA = 18 * MiB, GO_GB = 26 * MiB;
constexpr size_t GO_H = 0 * MiB;
constexpr size_t GO_A2 = 34 * MiB;
constexpr size_t GO_XN = 42 * MiB;
constexpr size_t WS_END = WS_GRP0 + NGRP * GRP_STRIDE;
static_assert(WS_WIN + (size_t)NIN * DM * 2 <= WS_WBR && WS_WDN + (size_t)DM * FF * 2 <= WS_GRP0 && GO_GB + (size_t)GROWS * DM * 2 <= GO_A2 && GO_H + (size_t)GROWS * FF * 2 <= GO_A2 && GO_XN + (size_t)GROWS * DM * 2 <= GRP_STRIDE, "d_ws map");
__device__ __forceinline__ unsigned short* grp_ptr(unsigned char* ws, int g, size_t off, int pitch_elems) { return (unsigned short*)(ws + WS_GRP0 + (size_t)g * GRP_STRIDE + off) - (size_t)g * GROWS * pitch_elems; }
constexpr int CW_TMO = 0, CW_CODE = 1;
constexpr int CW_BAR = 4096;
constexpr int CW_CENSUS = 8192;
constexpr int CW_GSUB = 9216, CW_GGEN = 10240;
constexpr int CW_KMEAN = 16384;
constexpr int CW_ROWSQ = CW_KMEAN + BATCH * 8 * 8 * 64;
static_assert((CW_ROWSQ + M) * 4 <= (int)CTL_ZERO_BYTES, "CTL words inside the memset region");
constexpr int RING_OFF = 0, RING_BYTES = 131072;
constexpr int LDSCTL_OFF = RING_BYTES, MISC_OFF = LDSCTL_OFF + 320;
constexpr int LDS_BYTES = 147456;
static_assert(MISC_OFF + 128 <= LDS_BYTES, "LDS map");

#define GAS __attribute__((address_space(1)))
#define LAS __attribute__((address_space(3)))
typedef unsigned short bf16;
typedef unsigned v4u __attribute__((ext_vector_type(4)));
typedef float f32x4 __attribute__((ext_vector_type(4)));
typedef short bf16x8 __attribute__((ext_vector_type(8)));
typedef GAS unsigned gu32;
typedef GAS unsigned long long gu64;
#define RLX_AGENT __ATOMIC_RELAXED, __HIP_MEMORY_SCOPE_AGENT
#define LDS_WAIT() asm volatile("s_waitcnt lgkmcnt(0)" ::: "memory")
#define VM_WAIT() asm volatile("s_waitcnt vmcnt(0)" ::: "memory")
__device__ __forceinline__ unsigned long long rt() { return __builtin_amdgcn_s_memrealtime(); }
__device__ __forceinline__ unsigned f2bf(float f) { unsigned u = __builtin_bit_cast(unsigned, f); return (u + 0x7fffu + ((u >> 16) & 1u)) >> 16; }
__device__ __forceinline__ unsigned pk2(float lo, float hi) { return f2bf(lo) | (f2bf(hi) << 16); }

#define XB_TMO      128
#define XB_XCNT(j)  (256  + 64 * (j))
#define XB_XSUB(j)  (1280 + 64 * (j))
#define XB_XGEN(j)  (2304 + 64 * (j))
#define XB_TOP      3328
#define XB_TOPGEN   3392
#define XCD_BAR_WORDS 3456
#define XB_SPIN_CAP (1u << 18)

__device__ __forceinline__ unsigned xb_ld(unsigned* p)              { return __hip_atomic_load(p, __ATOMIC_RELAXED, __HIP_MEMORY_SCOPE_AGENT); }
__device__ __forceinline__ unsigned xb_add(unsigned* p, unsigned v) { return __hip_atomic_fetch_add(p, v, __ATOMIC_RELAXED, __HIP_MEMORY_SCOPE_AGENT); }
__device__ __forceinline__ unsigned xb_xcc_id() { return (unsigned)__builtin_amdgcn_s_getreg((3 << 11) | 20) & 0xFu; }
#define XB_SPIN(cond, bar) do { unsigned _sp = 0; while (cond) { __builtin_amdgcn_s_sleep(1); \
    if ((++_sp & 255u) == 0u) { if (xb_ld(&(bar)[XB_TMO])) break; if (_sp > XB_SPIN_CAP) { atomicAdd(&(bar)[XB_TMO], 1u); break; } } } } while (0)

struct XcdBarrier {
    unsigned* bar; unsigned x;
    volatile LAS unsigned* st;
};

__device__ __forceinline__ XcdBarrier xcd_barrier_post(unsigned* bar, volatile LAS unsigned* st) {
    XcdBarrier b; b.bar = bar; b.x = xb_xcc_id(); b.st = st;
    if (threadIdx.x == 0) (void)xb_add(&bar[XB_XCNT(b.x)], 1u);
    return b;
}
__device__ __forceinline__ void xcd_barrier_complete(unsigned* bar, unsigned x, unsigned& nloc, unsigned& nx) {
    const unsigned G = gridDim.x * gridDim.y * gridDim.z;
    unsigned sum, cnt, mine, sp = 0u;
    for (;;) {
        sum = 0u; cnt = 0u; mine = 0u;
#pragma unroll
        for (unsigned j = 0; j < 16; ++j) { const unsigned c = xb_ld(&bar[XB_XCNT(j)]); sum += c; cnt += (c > 0u) ? 1u : 0u; mine = (j == x) ? c : mine; }
        if (sum == G) break;
        __builtin_amdgcn_s_sleep(1);
        if ((++sp & 255u) == 0u) { if (xb_ld(&bar[XB_TMO])) break; if (sp > XB_SPIN_CAP) { atomicAdd(&bar[XB_TMO], 1u); break; } }
    }
    nloc = mine > 0u ? mine : 1u; nx = cnt > 0u ? cnt : 1u;
}

__device__ __forceinline__ void xcd_barrier(const XcdBarrier& b) {
    asm volatile("s_waitcnt vmcnt(0)" ::: "memory");
    __syncthreads();
    if (threadIdx.x == 0) {
        unsigned* bar = b.bar;
        __builtin_amdgcn_s_waitcnt(0);
        unsigned nloc = b.st[0], nx = b.st[1];
        if (nloc == 0u) { xcd_barrier_complete(bar, b.x, nloc, nx); b.st[0] = nloc; b.st[1] = nx; }
        const unsigned old = xb_add(&bar[XB_XSUB(b.x)], 1u);
        const unsigned gen = old / nloc;
        if (old + 1u == (gen + 1u) * nloc) {
            __builtin_amdgcn_fence(__ATOMIC_RELEASE, "agent");
            asm volatile("s_waitcnt vmcnt(0)" ::: "memory");
            const unsigned og = xb_add(&bar[XB_TOP], 1u);
            const unsigned tg = og / nx;
            if (og + 1u == (tg + 1u) * nx) xb_add(&bar[XB_TOPGEN], 1u);
            else XB_SPIN(xb_ld(&bar[XB_TOPGEN]) == tg, bar);
            __builtin_amdgcn_fence(__ATOMIC_ACQUIRE, "agent");
            xb_add(&bar[XB_XGEN(b.x)], 1u);
            asm volatile("s_waitcnt vmcnt(0)" ::: "memory");
        } else {
            XB_SPIN(xb_ld(&bar[XB_XGEN(b.x)]) == gen, bar);
            __builtin_amdgcn_fence(__ATOMIC_ACQUIRE, "agent");
            asm volatile("s_waitcnt vmcnt(0)" ::: "memory");
        }
    }
    __syncthreads();
}

struct GroupBar { unsigned* sub; unsigned* gen; unsigned* bar; };
__device__ __forceinline__ void group_barrier(const GroupBar& g) {
    asm volatile("s_waitcnt vmcnt(0)" ::: "memory");
    __syncthreads();
    if (threadIdx.x == 0) {
        __builtin_amdgcn_s_waitcnt(0);
        const unsigned old = xb_add(g.sub, 1u), gen = old / 32u;
        if (old + 1u == (gen + 1u) * 32u) {
            __builtin_amdgcn_fence(__ATOMIC_RELEASE, "agent");
            asm volatile("s_waitcnt vmcnt(0)" ::: "memory");
            __builtin_amdgcn_fence(__ATOMIC_ACQUIRE, "agent");
            xb_add(g.gen, 1u);
            asm volatile("s_waitcnt vmcnt(0)" ::: "memory");
        } else {
            XB_SPIN(xb_ld(g.gen) == gen, g.bar);
            __builtin_amdgcn_fence(__ATOMIC_ACQUIRE, "agent");
            asm volatile("s_waitcnt vmcnt(0)" ::: "memory");
        }
    }
    __syncthreads();
}

struct Frame {
    LAS unsigned char* lds;
    volatile LAS unsigned* MISC;
    gu32* ctl;
    int tid, lane, wave;
    int vcu, G;
    int grp, li, grouped;
    unsigned char* ws;
    const float *x, *norm_attn, *w_in, *qna, *kna, *qnb, *knb, *sinks, *wba, *wbb, *w_out, *norm_mlp, *w_up, *w_down; float* out;
    bf16 *WinT, *WbrT, *WoT, *WupT, *WdnT;
    bf16 *Q, *KA, *VA, *KB, *VB, *GA, *GB, *HB, *A2, *XN;
    float *kmean, *rowsq;
};

__device__ __forceinline__ float wave_sum(float v) {
#pragma unroll
    for (int o = 1; o < 64; o <<= 1) v += __shfl_xor(v, o);
    return v;
}
__device__ __forceinline__ void p0_transpose_item(const float* W, int N, bf16* WT, int ldt, int koff, int prow0, LAS float* scr, int k0, int n0, int lane, const float* kscale = nullptr) {
    float wv[32];
#pragma unroll
    for (int i = 0; i < 32; ++i) wv[i] = W[(size_t)(k0 + 2 * i + (lane >> 5)) * N + n0 + (lane & 31)];
    if (kscale) {
#pragma unroll
        for (int i = 0; i < 32; ++i) wv[i] *= kscale[k0 + 2 * i + (lane >> 5)];
    }
#pragma unroll
    for (int i = 0; i < 32; ++i) scr[(2 * i + (lane >> 5)) * 33 + (lane & 31)] = wv[i];
    LDS_WAIT(); asm volatile("" ::: "memory");
    const int c = lane & 7;
#pragma unroll
    for (int j = 0; j < 4; ++j) { const int n = (lane >> 3) + 8 * j; const LAS float* s = scr + (8 * c) * 33 + n;
        v4u o; o.x = pk2(s[0 * 33], s[1 * 33]); o.y = pk2(s[2 * 33], s[3 * 33]); o.z = pk2(s[4 * 33], s[5 * 33]); o.w = pk2(s[6 * 33], s[7 * 33]);
        *(GAS v4u*)(WT + (size_t)(prow0 + n) * ldt + koff + k0 + 8 * c) = o; }
    LDS_WAIT(); asm volatile("" ::: "memory");
}
__device__ __forceinline__ void rms_row_to_bf16(const Frame& F, const float* xrow, const float* gain, bf16* orow) {
    const GAS f32x4* xr = (const GAS f32x4*)xrow + F.lane; const f32x4* gr = (const f32x4*)gain + F.lane;
    f32x4 v[4]; float s = 0.f;
#pragma unroll
    for (int j = 0; j < 4; ++j) { v[j] = xr[64 * j]; s += (v[j].x * v[j].x + v[j].y * v[j].y) + (v[j].z * v[j].z + v[j].w * v[j].w); }
    const float rs = 1.0f / sqrtf(wave_sum(s) * (1.f / DM) + EPS);
    GAS unsigned long long* o8 = (GAS unsigned long long*)orow + F.lane;
#pragma unroll
    for (int j = 0; j < 4; ++j) { const f32x4 g = gr[64 * j]; o8[64 * j] = (unsigned long long)pk2(v[j].x * rs * g.x, v[j].y * rs * g.y) | ((unsigned long long)pk2(v[j].z * rs * g.z, v[j].w * rs * g.w) << 32); }
}
__device__ __forceinline__ void p0_prologue(Frame& F) {
    LAS float* scr = (LAS float*)(F.lds + RING_OFF + F.wave * 16384);
    const int gw = (int)blockIdx.x * NWAVES + F.wave, NGW = F.G * NWAVES;
    constexpr int I_IN = (DM / 64) * (NIN / 32), I_BR = (512 / 64) * (DM / 32), I_O = (DM / 64) * (DM / 32), I_UP = (DM / 64) * (FF / 32), I_DN = (FF / 64) * (DM / 32);
    constexpr int NITEMS = I_IN + 2 * I_BR + I_O + I_UP + I_DN;
    for (int it = gw; it < NITEMS; it += NGW) {
        int r = it;
        if (r < I_IN) { const int nblk = NIN / 32, kb = r / nblk, nb = r % nblk, n0 = 32 * nb, nt = n0 & 255;
            int prow0 = (n0 & ~255) + 128 * ((nt >> 5) & 1) + 32 * (nt >> 6);
            if (n0 >= 2304) { const int isb = n0 >= 3328 ? 1 : 0, c0 = n0 - (isb ? 3328 : 2304); prow0 = 256 * (9 + (c0 >> 7)) + 128 * isb + 32 * ((c0 & 127) >> 5); }
            p0_transpose_item(F.w_in, NIN, F.WinT, DM, 0, prow0, scr, 64 * kb, n0, F.lane); continue; } r -= I_IN;
        if (r < I_BR) { const int nblk = DM / 32, kb = r / nblk, nb = r % nblk; p0_transpose_item(F.wba, DM, F.WbrT, DM, 0, 32 * nb, scr, 64 * kb, 32 * nb, F.lane); continue; } r -= I_BR;
        if (r < I_BR) { const int nblk = DM / 32, kb = r / nblk, nb = r % nblk; p0_transpose_item(F.wbb, DM, F.WbrT, DM, 512, 32 * nb, scr, 64 * kb, 32 * nb, F.lane); continue; } r -= I_BR;
        if (r < I_O)  { const int nblk = DM / 32, kb = r / nblk, nb = r % nblk; p0_transpose_item(F.w_out, DM, F.WoT, DM, 0, 32 * nb, scr, 64 * kb, 32 * nb, F.lane); continue; } r -= I_O;
        if (r < I_UP) { const int nblk = FF / 32, kb = r / nblk, nb = r % nblk; p0_transpose_item(F.w_up, FF, F.WupT, DM, 0, 32 * nb, scr, 64 * kb, 32 * nb, F.lane, F.norm_mlp); continue; } r -= I_UP;
        { const int nblk = DM / 32, kb = r / nblk, nb = r % nblk; p0_transpose_item(F.w_down, DM, F.WdnT, FF, 0, 32 * nb, scr, 64 * kb, 32 * nb, F.lane); }
    }
    {
        const f32x4* gr = (const f32x4*)F.norm_attn + F.lane; f32x4 g[4];
#pragma unroll
        for (int j = 0; j < 4; ++j) g[j] = gr[64 * j];
        for (int m = gw; m < M; m += 2 * NGW) { const int m2 = m + NGW;
            const GAS f32x4* xa = (const GAS f32x4*)(F.x + (size_t)m * DM) + F.lane; const GAS f32x4* xb = (const GAS f32x4*)(F.x + (size_t)m2 * DM) + F.lane;
            f32x4 va[4], vb[4]; float sa = 0.f, sb = 0.f;
#pragma unroll
            for (int j = 0; j < 4; ++j) { va[j] = xa[64 * j]; vb[j] = xb[64 * j]; }
#pragma unroll
            for (int j = 0; j < 4; ++j) { sa += (va[j].x * va[j].x + va[j].y * va[j].y) + (va[j].z * va[j].z + va[j].w * va[j].w); sb += (vb[j].x * vb[j].x + vb[j].y * vb[j].y) + (vb[j].z * vb[j].z + vb[j].w * vb[j].w); }
#pragma unroll
            for (int o = 1; o < 64; o <<= 1) { sa += __shfl_xor(sa, o); sb += __shfl_xor(sb, o); }
            const float ra = 1.0f / sqrtf(sa * (1.f / DM) + EPS), rb = 1.0f / sqrtf(sb * (1.f / DM) + EPS);
            GAS unsigned long long* oa = (GAS unsigned long long*)(grp_ptr(F.ws, m / GROWS, GO_XN, DM) + (size_t)m * DM) + F.lane;
            GAS unsigned long long* ob = (GAS unsigned long long*)(grp_ptr(F.ws, m2 / GROWS, GO_XN, DM) + (size_t)m2 * DM) + F.lane;
#pragma unroll
            for (int j = 0; j < 4; ++j) {
                oa[64 * j] = (unsigned long long)pk2(va[j].x * ra * g[j].x, va[j].y * ra * g[j].y) | ((unsigned long long)pk2(va[j].z * ra * g[j].z, va[j].w * ra * g[j].w) << 32);
                ob[64 * j] = (unsigned long long)pk2(vb[j].x * rb * g[j].x, vb[j].y * rb * g[j].y) | ((unsigned long long)pk2(vb[j].z * rb * g[j].z, vb[j].w * rb * g[j].w) << 32); }
        }
    }
}
__device__ __forceinline__ void sa_load32(const bf16* p, float (&d)[32]) {
#pragma unroll
    for (int i = 0; i < 4; ++i) { const v4u w = *(const GAS v4u*)(p + 8 * i);
        d[8 * i + 0] = __uint_as_float(w.x << 16); d[8 * i + 1] = __uint_as_float(w.x & 0xffff0000u); d[8 * i + 2] = __uint_as_float(w.y << 16); d[8 * i + 3] = __uint_as_float(w.y & 0xffff0000u);
        d[8 * i + 4] = __uint_as_float(w.z << 16); d[8 * i + 5] = __uint_as_float(w.z & 0xffff0000u); d[8 * i + 6] = __uint_as_float(w.w << 16); d[8 * i + 7] = __uint_as_float(w.w & 0xffff0000u); }
}
__device__ __forceinline__ void sa_store32(bf16* p, const float (&o)[32], float sc) {
#pragma unroll
    for (int i = 0; i < 4; ++i) { v4u w; w.x = pk2(o[8 * i] * sc, o[8 * i + 1] * sc); w.y = pk2(o[8 * i + 2] * sc, o[8 * i + 3] * sc); w.z = pk2(o[8 * i + 4] * sc, o[8 * i + 5] * sc); w.w = pk2(o[8 * i + 6] * sc, o[8 * i + 7] * sc);
        *(GAS v4u*)(p + 8 * i) = w; }
}
#define SA_KEY(KPTR, VPTR, BIAS, VALID) do { \
    float s_ = 0.f; \
    { float kv_[32]; sa_load32((KPTR) + dof, kv_); \
        _Pragma("unroll") for (int d_ = 0; d_ < 32; ++d_) s_ = __builtin_fmaf(q[d_], kv_[d_], s_); asm volatile("" ::: "memory"); } \
    s_ += __shfl_xor(s_, 1); \
    s_ += (BIAS); const bool ok_ = (VALID); const float se_ = ok_ ? s_ : -1e30f; \
    if (__any(se_ > m)) { const float mn_ = __builtin_fmaxf(m, se_); const float c_ = __builtin_amdgcn_exp2f(m - mn_); l *= c_; _Pragma("unroll") for (int d_ = 0; d_ < 32; ++d_) o[d_] *= c_; m = mn_; } \
    const float p_ = ok_ ? __builtin_amdgcn_exp2f(s_ - m) : 0.f; l += p_; \
    { float kv_[32]; sa_load32((VPTR) + dof, kv_); \
        _Pragma("unroll") for (int d_ = 0; d_ < 32; ++d_) o[d_] = __builtin_fmaf(p_, kv_[d_], o[d_]); asm volatile("" ::: "memory"); } } while (0)

__device__ __forceinline__ void sa_moba(const bf16* Q, const bf16* KA, const bf16* VA, const float* kmean, bf16* O, int b, int h, int t0, int lane) {
    const int dof = 32 * (lane & 1);
    const int t = t0 + (lane >> 1), own = t0 >> 8;
    float q[32]; sa_load32(Q + ((size_t)(b * SEQ + t)) * 1024 + h * 64 + dof, q);
    unsigned sel;
    if (own <= 3) sel = (1u << own) - 1u;
    else {
        float gs[7];
#pragma unroll
        for (int n = 0; n < 7; ++n) { gs[n] = -INFINITY;
            if (n < own) { const float* km = kmean + ((size_t)(b * 8 + n) * 8 + h) * 64 + dof; float s = 0.f;
#pragma unroll
                for (int d = 0; d < 32; d += 4) { const f32x4 kv = *(const GAS f32x4*)(km + d); s = __builtin_fmaf(q[d], kv.x, s); s = __builtin_fmaf(q[d + 1], kv.y, s); s = __builtin_fmaf(q[d + 2], kv.z, s); s = __builtin_fmaf(q[d + 3], kv.w, s); }
                s += __shfl_xor(s, 1);
                gs[n] = s; asm volatile("" ::: "memory"); } }
        sel = 0u;
#pragma unroll
        for (int n = 0; n < 7; ++n) { int rank = 0;
#pragma unroll
            for (int j = 0; j < 7; ++j) if (j != n) rank += (gs[j] > gs[n] || (gs[j] == gs[n] && j < n)) ? 1 : 0;
            if (n < own && rank < 3) sel |= 1u << n; }
    }
    const float slope2 = exp2f(-0.5f * (float)(h + 9)) * pg8::kLog2e;
    float m = -1e30f, l = 0.f, o[32];
#pragma unroll
    for (int d = 0; d < 32; ++d) o[d] = 0.f;
    for (int n = 0; n <= own; ++n) {
        const bool isown = (n == own), mine = isown || ((sel >> n) & 1u);
        if (!__any(mine)) continue;
        const int nk = isown ? (t0 + 32 - n * 256) : 256;
        for (int kk = 0; kk < nk; ++kk) { const int tk = n * 256 + kk; const size_t r = (size_t)(b * SEQ + tk) * 512 + h * 64;
            SA_KEY(KA + r, VA + r, -slope2 * (float)(t - tk), mine && (tk <= t)); }
    }
    sa_store32(O + ((size_t)(b * SEQ + t)) * 1024 + h * 64 + dof, o, 1.0f / l);
}
__device__ __forceinline__ void sa_swa(const bf16* Q, const bf16* KB, const bf16* VB, const float* sinks, bf16* O, int b, int hq, int t0, int lane) {
    const int dof = 32 * (lane & 1);
    const int t = t0 + (lane >> 1), kvh = hq >> 2;
    float q[32]; sa_load32(Q + ((size_t)(b * SEQ + t)) * 1024 + 512 + hq * 64 + dof, q);
    const float slope2 = exp2f(-0.5f * (float)(hq + 1)) * pg8::kLog2e, sink2 = sinks[hq] * pg8::kLog2e;
    float m = -1e30f, l = 0.f, o[32];
#pragma unroll
    for (int d = 0; d < 32; ++d) o[d] = 0.f;
    const int k0 = t0 - 127 > 0 ? t0 - 127 : 0;
    for (int tk = k0; tk < t0 + 32; ++tk) { const size_t r = (size_t)(b * SEQ + tk) * 128 + kvh * 64;
        SA_KEY(KB + r, VB + r, -slope2 * (float)(t - tk), (tk <= t) && (t - tk < 128)); }
    const float mf = __builtin_fmaxf(m, sink2), c = __builtin_amdgcn_exp2f(m - mf);
    l = l * c + __builtin_amdgcn_exp2f(sink2 - mf);
    sa_store32(O + ((size_t)(b * SEQ + t)) * 1024 + 512 + hq * 64 + dof, o, c / l);
}
__device__ __forceinline__ void attn_simple_phase(Frame& F) {
    const int gw = F.li * NWAVES + F.wave, NGW = 32 * NWAVES;
    int i = 0;
    for (int u = gw; u < 1024; u += NGW, ++i) { const int b = 2 * F.grp + (u >> 9), h = (u >> 6) & 7; int ch = u & 63; if (i & 1) ch = 63 - ch;
        sa_moba(F.Q, F.KA, F.VA, F.kmean, F.Q, b, h, ch * 32, F.lane); }
    for (int u = gw; u < 1024; u += NGW) { const int b = 2 * F.grp + (u >> 9), hq = (u >> 6) & 7, ch = u & 63;
        sa_swa(F.Q, F.KB, F.VB, F.sinks, F.Q, b, hq, ch * 32, F.lane); }
}

namespace fa {
using bf16x8 = __attribute__((ext_vector_type(8))) short;
using s16x4 = __attribute__((ext_vector_type(4))) short;
using f32x16 = __attribute__((ext_vector_type(16))) float;
using u32x4 = __attribute__((ext_vector_type(4))) unsigned;
using f32x4 = __attribute__((ext_vector_type(4))) float;
constexpr int NW = 8, QBLK = 32, KVBLK = 64;
constexpr int SLOTB = 8192, LDS_K = 0, LDS_V = 3 * SLOTB, LDS_WS = 6 * SLOTB, LDS_OST = LDS_WS + NW * 256, LDS_BYTES = LDS_OST + NW * 4096;
constexpr int QP = 1024;
#ifndef FA_THR
#define FA_THR 8
#endif
#define SBAR() __builtin_amdgcn_sched_barrier(0)
#define PIN(x) asm volatile("" : "+v"(x))
#define MFMA(a, b, c) __builtin_amdgcn_mfma_f32_32x32x16_bf16(a, b, c, 0, 0, 0)
#define WAIT_BAR(N) asm volatile("s_waitcnt vmcnt(" #N ") lgkmcnt(0)\n\ts_barrier" ::: "memory")
__device__ __forceinline__ int crow(int r, int hi) { return (r & 3) + 8 * (r >> 2) + 4 * hi; }
__device__ __forceinline__ unsigned cvtpk(float lo, float hi) { unsigned r; asm("v_cvt_pk_bf16_f32 %0, %1, %2" : "=v"(r) : "v"(lo), "v"(hi)); return r; }
__device__ __forceinline__ void glds16(const void* g, unsigned lds_base) {
    unsigned sv; asm volatile("s_mov_b32 %0, m0\n\ts_mov_b32 m0, %2\n\ts_nop 0\n\tglobal_load_lds_dwordx4 %1, off\n\ts_mov_b32 m0, %0" : "=&s"(sv) : "v"(g), "s"(lds_base) : "memory"); }
typedef __attribute__((address_space(3))) const char* lds_cptr;
typedef short v4i16_t __attribute__((ext_vector_type(4)));
__device__ __forceinline__ void kload2(bf16x8* kf, lds_cptr kp, int d0) { kf[2 * d0] = *(const __attribute__((address_space(3))) bf16x8*)(kp + d0 * 2048); kf[2 * d0 + 1] = *(const __attribute__((address_space(3))) bf16x8*)(kp + d0 * 2048 + 512); }
__device__ __forceinline__ s16x4 vtr(lds_cptr p) { return __builtin_bit_cast(s16x4, __builtin_amdgcn_ds_read_tr16_b64_v4i16((__attribute__((address_space(3))) v4i16_t*)p)); }
#define MX3(a, b, c) __builtin_fmaxf(__builtin_fmaxf((a), (b)), (c))
__device__ __forceinline__ float rowmax(const f32x16& p0, const f32x16& p1) {
    float a = MX3(p0[0], p0[1], p1[0]), b = MX3(p0[2], p0[3], p1[1]); a = MX3(a, p1[2], p1[3]);
#pragma unroll
    for (int r = 4; r < 16; r += 4) { a = MX3(a, p0[r], p0[r + 1]); b = MX3(b, p0[r + 2], p0[r + 3]); a = MX3(a, p1[r], p1[r + 1]); b = MX3(b, p1[r + 2], p1[r + 3]); }
    float m = __builtin_fmaxf(a, b); auto rr = __builtin_amdgcn_permlane32_swap(__float_as_uint(m), __float_as_uint(m), false, false);
    return __builtin_fmaxf(__uint_as_float(rr[0]), __uint_as_float(rr[1])); }
__device__ __forceinline__ void emask(f32x16& p0, f32x16& p1, int dq  , unsigned wd) {
#pragma unroll
    for (int r = 0; r < 16; ++r) { const int kv = (r & 3) + 8 * (r >> 2); if ((unsigned)(dq - kv) >= wd) p0[r] = -INFINITY; if ((unsigned)(dq - kv - 32) >= wd) p1[r] = -INFINITY; } }
__device__ __forceinline__ unsigned bf16bits(float f) { unsigned u = __float_as_uint(f); return (u + 0x7fffu + ((u >> 16) & 1u)) >> 16; }

struct AU {
    const bf16* Qw;
    bf16* Ow;
    const bf16* Kb;
    const bf16* Vb;
    int KP;
    int q0;
    int qrel0;
    int NT;
    int mode;
    unsigned wd;
    float slope2;
    float sink2;
    unsigned okmask;
    const float* km;
    int gj;
};
__device__ __forceinline__ int key_rel(const AU& u, int t) {
    if (u.mode == 0) { const int np = u.NT - 4; return t == 0 ? 0 : (t <= np ? 64 * (t - 1) - 64 * np : 64 * (t - np)); }
    return -64 * t;
}
__device__ __forceinline__ void attn_unit(const AU& u, char* lds) {
    const int tid = threadIdx.x; int lane = tid & 63; asm volatile("" : "+v"(lane));
    const int r32 = lane & 31, hi = lane >> 5; const int wid = __builtin_amdgcn_readfirstlane(tid >> 6);
    const int NT = u.NT, KP = u.KP;
    const unsigned lds0 = (unsigned)(uintptr_t)lds; float* wsf = (float*)(lds + LDS_WS) + wid * 64;
    const bf16* ksrc = u.Kb + (long)lane * KP + wid * 8;
    const bf16* vsrc = u.Vb + (long)(16 * (wid & 3) + (lane >> 2)) * KP + (wid >> 2) * 32 + (lane & 3) * 8;
    const unsigned kdst = lds0 + LDS_K + wid * 1024, vdst = lds0 + LDS_V + wid * 1024;
#define KROW(t) ({ int r_ = u.q0 + key_rel(u, (t)); r_ < 0 ? 0 : r_; })
#define DMA_K(t, slot) glds16(ksrc + (long)KROW(t) * KP, (unsigned)__builtin_amdgcn_readfirstlane(kdst + (slot)))
#define DMA_V(t, slot) glds16(vsrc + (long)KROW(t) * KP, (unsigned)__builtin_amdgcn_readfirstlane(vdst + (slot)))
    const lds_cptr vp0 = (lds_cptr)lds + LDS_V + ((lane >> 4) & 1) * 32 + (lane & 3) * 8 + (4 * hi + ((lane & 15) >> 2)) * 64;
    const lds_cptr kp0 = (lds_cptr)lds + LDS_K + hi * 1024 + r32 * 16;
    DMA_K(0, 0); DMA_V(0, 0); DMA_K(1, SLOTB);
    bf16x8 qr[4];
#pragma unroll
    for (int d0 = 0; d0 < 4; ++d0) qr[d0] = *reinterpret_cast<const bf16x8*>(&u.Qw[(long)r32 * QP + d0 * 16 + hi * 8]);
    bf16x8 qaug, kaug0, kaug1;
    { const unsigned sh = bf16bits(u.slope2); const float rem = u.slope2 - __uint_as_float(sh << 16); const unsigned sl = bf16bits(rem);
      const unsigned Sh = bf16bits(64.f * __uint_as_float(sh << 16)), Sl = bf16bits(64.f * __uint_as_float(sl << 16));
      u32x4 w = {hi ? 0u : (sh | (sl << 16)), hi ? 0u : (Sh | (Sl << 16)), 0u, 0u}; qaug = __builtin_bit_cast(bf16x8, w);
      const unsigned k0b = bf16bits((float)r32), k1b = bf16bits((float)(r32 + 32));
      u32x4 a0 = {k0b | (k0b << 16), 0u, 0u, 0u}, a1 = {k1b | (k1b << 16), 0u, 0u, 0u}; kaug0 = __builtin_bit_cast(bf16x8, a0); kaug1 = __builtin_bit_cast(bf16x8, a1); }
#define SET_TILE(t) do { const unsigned tb_ = bf16bits((float)(key_rel(u, (t)) >> 6)); const unsigned tw_ = tb_ | (tb_ << 16); \
      u32x4 a0_ = __builtin_bit_cast(u32x4, kaug0), a1_ = __builtin_bit_cast(u32x4, kaug1); a0_[1] = tw_; a1_[1] = tw_; kaug0 = __builtin_bit_cast(bf16x8, a0_); kaug1 = __builtin_bit_cast(bf16x8, a1_); } while (0)
    unsigned okmask = u.okmask;
    if (u.gj >= 4) {
        float gs[7];
#pragma unroll
        for (int n = 0; n < 7; ++n) { gs[n] = -INFINITY;
            if (n < u.gj) { const float* km = u.km + 512 * n + 8 * hi; float sg = 0.f;
#pragma unroll
                for (int d0 = 0; d0 < 4; ++d0) { const f32x4 k0 = *(const f32x4*)(km + 16 * d0), k1 = *(const f32x4*)(km + 16 * d0 + 4);
#define QF(e) __uint_as_float(((unsigned)(unsigned short)qr[d0][e]) << 16)
                    sg = __builtin_fmaf(QF(0), k0.x, sg); sg = __builtin_fmaf(QF(1), k0.y, sg); sg = __builtin_fmaf(QF(2), k0.z, sg); sg = __builtin_fmaf(QF(3), k0.w, sg);
                    sg = __builtin_fmaf(QF(4), k1.x, sg); sg = __builtin_fmaf(QF(5), k1.y, sg); sg = __builtin_fmaf(QF(6), k1.z, sg); sg = __builtin_fmaf(QF(7), k1.w, sg);
#undef QF
                }
                sg += __shfl_xor(sg, 32); gs[n] = sg; } }
        unsigned ok = 1u | (7u << (NT - 3));
#pragma unroll
        for (int n = 0; n < 7; ++n) { int rank = 0;
#pragma unroll
            for (int k = 0; k < 7; ++k) if (k != n) rank += (gs[k] > gs[n] || (gs[k] == gs[n] && k < n)) ? 1 : 0;
            if (n < u.gj && rank < 3) ok |= 0xFu << (1 + 4 * n); }
        okmask = ok;
    }
    float mhat = 0.f, l_reg = 0.f; f32x16 o[2]; o[0] = f32x16{}; o[1] = f32x16{};
    const int qrel = u.qrel0 + r32; bool resc = false; const unsigned wd = u.wd;
    f32x16 cin; bool okp = true;
#define SETCIN(okv) do { const float cv_ = (okv) ? -mhat : -INFINITY; _Pragma("unroll") for (int r_ = 0; r_ < 16; ++r_) cin[r_] = cv_; PIN(cin); } while (0)
    f32x16 pA0, pA1, pB0, pB1; bf16x8 kf[8]; s16x4 vlo[8], vhi[8]; u32x4 pw0, pw1, pw2, pw3;
    int sl_prev = 0, sl_cur = 0, sl_next = SLOTB;
#define ROT() do { sl_prev = sl_cur; sl_cur = sl_next; sl_next = (sl_next == 2 * SLOTB) ? 0 : sl_next + SLOTB; } while (0)
#define EX(v) __builtin_amdgcn_exp2f(v)
#define RESC() do { if (resc) { _Pragma("unroll") for (int d_ = 0; d_ < 2; ++d_) _Pragma("unroll") for (int r = 0; r < 16; ++r) o[d_][r] *= wsf[crow(r, hi)]; } } while (0)
    DMA_K(2, 2 * SLOTB);
    WAIT_BAR(3);
    _Pragma("unroll") for (int d0 = 0; d0 < 4; ++d0) kload2(kf, kp0, d0);
    SET_TILE(0);
    pA0 = MFMA(kaug0, qaug, f32x16{}); pA1 = MFMA(kaug1, qaug, f32x16{});
    pA0 = MFMA(kf[0], qr[0], pA0); pA1 = MFMA(kf[1], qr[0], pA1); pA0 = MFMA(kf[2], qr[1], pA0); pA1 = MFMA(kf[3], qr[1], pA1);
    pA0 = MFMA(kf[4], qr[2], pA0); pA1 = MFMA(kf[5], qr[2], pA1); pA0 = MFMA(kf[6], qr[3], pA0); pA1 = MFMA(kf[7], qr[3], pA1);
    emask(pA0, pA1, qrel - key_rel(u, 0) - 4 * hi, wd);
    { const float rm = rowmax(pA0, pA1); mhat = rm;
#pragma unroll
      for (int r = 0; r < 16; ++r) { pA0[r] = EX(pA0[r] - rm); pA1[r] = EX(pA1[r] - rm); }
      SETCIN(true); }
    WAIT_BAR(0);
    DMA_K(3, 0); DMA_V(1, SLOTB); ROT();
    _Pragma("unroll") for (int d0 = 0; d0 < 4; ++d0) kload2(kf, kp0 + sl_cur, d0);
    WAIT_BAR(2);
#define PKW(P, i) cvtpk(P[i], P[i + 1])
#define PAF(k) __builtin_bit_cast(bf16x8, pw##k)
#define VFR(i) (bf16x8){vlo[i][0], vlo[i][1], vlo[i][2], vlo[i][3], vhi[i][0], vhi[i][1], vhi[i][2], vhi[i][3]}
#define VRD(i) do { vlo[i] = vtr(vp_ + (((i) >> 2) * 4096 + ((i) & 3) * 1024)); vhi[i] = vtr(vp_ + (((i) >> 2) * 4096 + ((i) & 3) * 1024 + 512)); } while (0)
#define KRD(G, d0) do { if (G) { kload2(kf, kp0 + sl_next, d0); SBAR(); } } while (0)
#define GAPA(MF, a0, a1, a2, a3, W0, W1, PW) do { MF; sacc += a0; sacc += a1; sacc += a2; sacc += a3; W0; W1; PIN(PW); PIN(sacc); SBAR(); } while (0)
#define GAPB(MF, X, i) do { MF; X[i] = EX(X[i]); X[i + 1] = EX(X[i + 1]); X[i + 2] = EX(X[i + 2]); X[i + 3] = EX(X[i + 3]); PIN(X); SBAR(); } while (0)
#define STEP(C0, C1, P0, P1, t, MASK, GK, GV, GL) do { SBAR(); \
    const lds_cptr vp_ = vp0 + sl_prev; SET_TILE(t); \
    const bool ok_ = (okmask >> (t)) & 1u; \
    if (__any(ok_ != okp)) { SETCIN(ok_); okp = ok_; } \
    C0 = MFMA(kaug0, qaug, cin); C1 = MFMA(kaug1, qaug, cin); SBAR(); \
    VRD(0); SBAR(); float sacc = P0[0] + P0[1]; \
                    GAPA(C0 = MFMA(kf[0], qr[0], C0), P0[2], P0[3], P0[4], P0[5],     pw0[0] = PKW(P0, 0),  pw0[1] = PKW(P0, 2),  pw0); \
    VRD(4); SBAR(); GAPA(C1 = MFMA(kf[1], qr[0], C1), P0[6], P0[7], P0[8], P0[9],     pw0[2] = PKW(P0, 4),  pw0[3] = PKW(P0, 6),  pw0); \
    VRD(1); SBAR(); GAPA(C0 = MFMA(kf[2], qr[1], C0),    P0[10], P0[11], P0[12], P0[13], pw1[0] = PKW(P0, 8),  pw1[1] = PKW(P0, 10), pw1); \
    VRD(5); SBAR(); GAPA(C1 = MFMA(kf[3], qr[1], C1),    P0[14], P0[15], P1[0], P1[1],   pw1[2] = PKW(P0, 12), pw1[3] = PKW(P0, 14), pw1); \
    VRD(2); SBAR(); GAPA(C0 = MFMA(kf[4], qr[2], C0),    P1[2], P1[3], P1[4], P1[5],     pw2[0] = PKW(P1, 0),  pw2[1] = PKW(P1, 2),  pw2); \
    VRD(6); SBAR(); GAPA(C1 = MFMA(kf[5], qr[2], C1),    P1[6], P1[7], P1[8], P1[9],     pw2[2] = PKW(P1, 4),  pw2[3] = PKW(P1, 6),  pw2); \
    VRD(3); SBAR(); GAPA(C0 = MFMA(kf[6], qr[3], C0),    P1[10], P1[11], P1[12], P1[13], pw3[0] = PKW(P1, 8),  pw3[1] = PKW(P1, 10), pw3); \
    VRD(7); SBAR(); GAPA(C1 = MFMA(kf[7], qr[3], C1),    P1[14], P1[15], 0.f, 0.f,       pw3[2] = PKW(P1, 12), pw3[3] = PKW(P1, 14), pw3); \
    l_reg += sacc; \
    if (GK) DMA_K((t) + 3, sl_cur); if (GV) DMA_V((t) + 1, sl_next); \
    if (MASK) { if (u.mode == 1 || (t) > NT - 4) emask(C0, C1, qrel - key_rel(u, (t)) - 4 * hi, wd); }            \
    { const float rm = rowmax(C0, C1); resc = false;                                                    \
      if (__builtin_expect(__any(rm > (float)FA_THR), 0)) { const float dl = __builtin_fmaxf(rm, 0.f); mhat += dl; \
          _Pragma("unroll") for (int r = 0; r < 16; ++r) { C0[r] -= dl; C1[r] -= dl; } SETCIN(ok_); \
          const float f = __builtin_amdgcn_exp2f(-dl); l_reg *= f; if (hi == 0) wsf[r32] = f; resc = true; } } \
    SBAR(); \
    GAPB(o[0] = MFMA(PAF(0), VFR(0), o[0]), C0, 0);              GAPB(o[1] = MFMA(PAF(0), VFR(4), o[1]), C0, 4); \
    KRD(GL, 0); GAPB(o[0] = MFMA(PAF(1), VFR(1), o[0]), C0, 8);  KRD(GL, 1); GAPB(o[1] = MFMA(PAF(1), VFR(5), o[1]), C0, 12); \
    KRD(GL, 2); GAPB(o[0] = MFMA(PAF(2), VFR(2), o[0]), C1, 0);  KRD(GL, 3); GAPB(o[1] = MFMA(PAF(2), VFR(6), o[1]), C1, 4); \
    GAPB(o[0] = MFMA(PAF(3), VFR(3), o[0]), C1, 8);              GAPB(o[1] = MFMA(PAF(3), VFR(7), o[1]), C1, 12); \
    } while (0)
    int t = 1;
    for (; t + 5 < NT; t += 2) {
        STEP(pB0, pB1, pA0, pA1, t, false, true, true, true);     WAIT_BAR(2); RESC(); ROT();
        STEP(pA0, pA1, pB0, pB1, t + 1, false, true, true, true); WAIT_BAR(2); RESC(); ROT();
    }
#define ENDW(tt) do { if ((tt) + 3 < NT) { WAIT_BAR(2); } else if ((tt) + 2 < NT) { WAIT_BAR(1); } else { WAIT_BAR(0); } } while (0)
    for (; t + 1 < NT; t += 2) {
        STEP(pB0, pB1, pA0, pA1, t, true, (t + 3 < NT), (t + 1 < NT), (t + 1 < NT));         ENDW(t);     RESC(); ROT();
        STEP(pA0, pA1, pB0, pB1, t + 1, true, (t + 4 < NT), (t + 2 < NT), (t + 2 < NT));     ENDW(t + 1); RESC(); ROT();
    }
    STEP(pB0, pB1, pA0, pA1, NT - 1, true, false, false, false); RESC();
    { float sacc = pB0[0] + pB0[1];
#pragma unroll
      for (int r = 2; r < 16; ++r) sacc += pB0[r];
#pragma unroll
      for (int r = 0; r < 16; ++r) sacc += pB1[r];
      l_reg += sacc;
      pw0 = (u32x4){PKW(pB0, 0), PKW(pB0, 2), PKW(pB0, 4), PKW(pB0, 6)}; pw1 = (u32x4){PKW(pB0, 8), PKW(pB0, 10), PKW(pB0, 12), PKW(pB0, 14)};
      pw2 = (u32x4){PKW(pB1, 0), PKW(pB1, 2), PKW(pB1, 4), PKW(pB1, 6)}; pw3 = (u32x4){PKW(pB1, 8), PKW(pB1, 10), PKW(pB1, 12), PKW(pB1, 14)};
      const lds_cptr vp_ = vp0 + sl_cur; _Pragma("unroll") for (int i = 0; i < 8; ++i) VRD(i);
      o[0] = MFMA(PAF(0), VFR(0), o[0]); o[1] = MFMA(PAF(0), VFR(4), o[1]); o[0] = MFMA(PAF(1), VFR(1), o[0]); o[1] = MFMA(PAF(1), VFR(5), o[1]);
      o[0] = MFMA(PAF(2), VFR(2), o[0]); o[1] = MFMA(PAF(2), VFR(6), o[1]); o[0] = MFMA(PAF(3), VFR(3), o[0]); o[1] = MFMA(PAF(3), VFR(7), o[1]); }
    { auto rr = __builtin_amdgcn_permlane32_swap(__float_as_uint(l_reg), __float_as_uint(l_reg), false, false); l_reg = __uint_as_float(rr[0]) + __uint_as_float(rr[1]); }
    {
      const float sk = u.sink2 + u.slope2 * (float)qrel, mf = __builtin_fmaxf(mhat, sk), c = __builtin_amdgcn_exp2f(mhat - mf);
      const float lt = l_reg * c + __builtin_amdgcn_exp2f(sk - mf);
      if (hi == 0) wsf[32 + r32] = c * __builtin_amdgcn_rcpf(lt); }
    asm volatile("s_waitcnt lgkmcnt(0)" ::: "memory");
    float rli[16];
#pragma unroll
    for (int r = 0; r < 16; ++r) rli[r] = wsf[32 + crow(r, hi)];
    bf16* stg = (bf16*)(lds + LDS_OST) + wid * 2048;
    { int l2 = lane; asm volatile("" : "+v"(l2)); const int r32b = l2 & 31, hib = l2 >> 5;
#pragma unroll
    for (int r = 0; r < 16; ++r) { const int orow = crow(r, hib);
#pragma unroll
        for (int d0 = 0; d0 < 2; ++d0) stg[orow * 64 + d0 * 32 + r32b] = (bf16)bf16bits(o[d0][r] * rli[r]); }
    asm volatile("s_waitcnt lgkmcnt(0)" ::: "memory");
    const int srow = l2 >> 3, ch = l2 & 7; const u32x4* sp = (const u32x4*)(stg + srow * 64 + ch * 8); bf16* gp = u.Ow + (long)srow * QP + ch * 8;
#pragma unroll
    for (int i = 0; i < 4; ++i) *(u32x4*)(gp + (long)i * 8 * QP) = sp[i * 64]; }
    asm volatile("s_waitcnt lgkmcnt(0)\n\ts_barrier" ::: "memory");
#undef KROW
#undef DMA_K
#undef DMA_V
#undef SET_TILE
#undef SETCIN
#undef ROT
#undef EX
#undef RESC
#undef PKW
#undef PAF
#undef VFR
#undef VRD
#undef KRD
#undef ENDW
#undef GAPA
#undef GAPB
#undef STEP
}
#undef SBAR
#undef PIN
#undef MFMA
#undef WAIT_BAR
#undef MX3
}

__device__ __forceinline__ float bfbits2f(short s) { return __uint_as_float(((unsigned)(unsigned short)s) << 16); }
__device__ __forceinline__ void attn_fast_phase(Frame& F, char* lds, bf16* O) {
    const int wid = F.wave;
    for (int i = 0; i < 8; ++i) {
        int lane = F.lane; asm volatile("" : "+v"(lane)); const int r32 = lane & 31, hi = lane >> 5;
        fa::AU u; size_t qoff;
        if (i < 4) {
            const int p = F.vcu >> 1, b = p >> 3, h = p & 7, half = F.vcu & 1;
            const size_t rowbase = (size_t)b * SEQ;
            const int j = half ? (i == 0 ? 6 : i == 1 ? 5 : i == 2 ? 2 : 1) : (i == 0 ? 7 : i == 1 ? 4 : i == 2 ? 3 : 0);
            qoff = (rowbase + 256 * j + 32 * wid) * 1024 + h * 64;
            u.Kb = F.KA + rowbase * 512 + h * 64; u.Vb = F.VA + rowbase * 512 + h * 64; u.KP = 512;
            u.q0 = 256 * j; u.qrel0 = 32 * wid; u.NT = 4 * (j + 1); u.mode = 0; u.wd = 0x40000000u;
            u.slope2 = exp2f(-0.5f * (float)(h + 9)) * pg8::kLog2e; u.sink2 = -INFINITY;
            unsigned ok = 1u | (7u << (u.NT - 3));
            if (j <= 3) { for (int n = 0; n < j; ++n) ok |= 0xFu << (1 + 4 * n); }
            u.km = F.kmean + ((size_t)(b * 8) * 8 + h) * 64; u.gj = j;
            u.okmask = ok;
        } else {
            const int us = F.vcu * 4 + (i - 4), b = us >> 6, kvh = (us >> 5) & 1, c = us & 31, hq = kvh * 4 + (wid >> 1);
            const size_t rowbase = (size_t)b * SEQ;
            qoff = (rowbase + 64 * c + 32 * (wid & 1)) * 1024 + 512 + hq * 64;
            u.Kb = F.KB + rowbase * 128 + kvh * 64; u.Vb = F.VB + rowbase * 128 + kvh * 64; u.KP = 128;
            u.q0 = 64 * c; u.qrel0 = 32 * (wid & 1); u.NT = 4; u.mode = 1; u.wd = 128u;
            u.slope2 = exp2f(-0.5f * (float)(hq + 1)) * pg8::kLog2e; u.sink2 = F.sinks[hq] * pg8::kLog2e;
            u.okmask = (c >= 3) ? 0xFu : ((1u << (c + 1)) - 1u);
            u.km = F.kmean; u.gj = 0;
        }
        u.Qw = F.Q + qoff; u.Ow = O + qoff;
        fa::attn_unit(u, lds);
    }
}
#if defined(DBG_ATTN)
__device__ __forceinline__ void dbg_compare(Frame& F, const bf16* Od) {
    const int gt = F.li * NWAVES * 64 + F.tid, NGT = 32 * NWAVES * 64; float num = 0.f, den = 0.f;
    for (size_t i = gt; i < (size_t)GROWS * 64; i += NGT) { const size_t row = (size_t)F.grp * GROWS + (i >> 6), c8 = i & 63; const size_t off = row * 1024 + DBG_PART * 512 + c8 * 8;
        const v4u a = *(const GAS v4u*)(Od + off), r = *(const GAS v4u*)(F.Q + off);
#define DD(x) { const float a0 = __uint_as_float(a.x << 16), a1 = __uint_as_float(a.x & 0xffff0000u), r0 = __uint_as_float(r.x << 16), r1 = __uint_as_float(r.x & 0xffff0000u); num += (a0 - r0) * (a0 - r0) + (a1 - r1) * (a1 - r1); den += r0 * r0 + r1 * r1; }
        DD(x) DD(y) DD(z) DD(w)
#undef DD
    }
    num = wave_sum(num); den = wave_sum(den);
    if (F.lane == 0) { atomicAdd((float*)(F.ctl) + 8, num); atomicAdd((float*)(F.ctl) + 9, den); }
}
#endif

struct Args { const float* in[14]; float* out; unsigned char* ws; };
__global__ void __launch_bounds__(NWAVES * 64, 2) fwd_megakernel(Args args) {
    extern __shared__ __attribute__((aligned(16))) unsigned char lds[];
    Frame F;
    F.lds = (LAS unsigned char*)lds;
    F.MISC = (volatile LAS unsigned*)(F.lds + MISC_OFF);
    F.tid = threadIdx.x; F.lane = F.tid & 63; F.wave = __builtin_amdgcn_readfirstlane(F.tid >> 6);
    F.G = gridDim.x;
    unsigned char* ws = args.ws; F.ws = ws;
    F.ctl = (gu32*)(ws + WS_CTL);
    F.x = args.in[0]; F.norm_attn = args.in[1]; F.w_in = args.in[2]; F.qna = args.in[3]; F.kna = args.in[4]; F.qnb = args.in[5]; F.knb = args.in[6]; F.sinks = args.in[7];
    F.wba = args.in[8]; F.wbb = args.in[9]; F.w_out = args.in[10]; F.norm_mlp = args.in[11]; F.w_up = args.in[12]; F.w_down = args.in[13]; F.out = args.out;
    F.WinT = (bf16*)(ws + WS_WIN); F.WbrT = (bf16*)(ws + WS_WBR); F.WoT = (bf16*)(ws + WS_WO); F.WupT = (bf16*)(ws + WS_WUP); F.WdnT = (bf16*)(ws + WS_WDN);
    F.kmean = (float*)(ws + WS_CTL) + CW_KMEAN; F.rowsq = (float*)(ws + WS_CTL) + CW_ROWSQ;
    for (int u = F.tid; u < (LDS_BYTES - LDSCTL_OFF) / 4; u += NWAVES * 64) ((LAS unsigned*)(F.lds + LDSCTL_OFF))[u] = 0u;
    __syncthreads();
    XcdBarrier bar = xcd_barrier_post((unsigned*)(F.ctl + CW_BAR), F.MISC + 8);
    if (F.tid == 0) F.MISC[12] = xb_add((unsigned*)(F.ctl + CW_CENSUS) + 64 * bar.x, 1u);
    __syncthreads();
    const unsigned my_arrival = F.MISC[12];
#define GRID_BAR() xcd_barrier(bar)

#ifndef SKIP_P0
    p0_prologue(F);
#endif
    GRID_BAR();
    {   bool ok = (F.G == 256);
        for (int j = 0; j < 16; ++j) { const unsigned c = __hip_atomic_load((unsigned*)(F.ctl + CW_CENSUS) + 64 * j, RLX_AGENT); ok = ok && (c == (j < NGRP ? 32u : 0u)); }
        F.grouped = ok ? 1 : 0;
        if (ok) { F.grp = (int)bar.x; F.li = (int)my_arrival; }
        else    { F.grp = (int)blockIdx.x % NGRP; F.li = (int)blockIdx.x / NGRP; }
        F.grp = __builtin_amdgcn_readfirstlane(F.grp); F.li = __builtin_amdgcn_readfirstlane(F.li);
        F.vcu = F.grp * 32 + F.li; }
    const int vbid = F.li * NGRP + F.grp;
    F.Q = grp_ptr(ws, F.grp, GO_Q, 1024); F.KA = grp_ptr(ws, F.grp, GO_KA, 512); F.VA = grp_ptr(ws, F.grp, GO_VA, 512); F.KB = grp_ptr(ws, F.grp, GO_KB, 128); F.VB = grp_ptr(ws, F.grp, GO_VB, 128);
    F.GA = grp_ptr(ws, F.grp, GO_GA, 1024); F.GB = grp_ptr(ws, F.grp, GO_GB, 1024); F.HB = grp_ptr(ws, F.grp, GO_H, 4096); F.A2 = grp_ptr(ws, F.grp, GO_A2, 1024); F.XN = grp_ptr(ws, F.grp, GO_XN, 1024);
    GroupBar gbar{(unsigned*)(F.ctl + CW_GSUB) + 64 * F.grp, (unsigned*)(F.ctl + CW_GGEN) + 64 * F.grp, (unsigned*)(F.ctl + CW_BAR)};
#define GROUP_BAR() do { if (F.grouped) group_barrier(gbar); else xcd_barrier(bar); } while (0)
#ifndef SKIP_P1
    {   pg8::Gemm g{F.XN, F.WinT, M, NIN, DM}; pg8::StaticOrder S; S.init(M, NIN, F.G, vbid);
        pg8::EpiIn E{F.Q, F.KA, F.VA, F.KB, F.VB, F.GA, F.GB, F.qna, F.kna, F.qnb, F.knb, F.kmean};
        pg8::gemm_phase<pg8::EpiIn, pg8::StaticOrder, true, true>(F.lds + RING_OFF, g, S, E); }
#endif
    GROUP_BAR();
#if defined(DBG_ATTN)
    attn_fast_phase(F, (char*)lds + RING_OFF, F.XN); GROUP_BAR(); attn_simple_phase(F); GROUP_BAR(); dbg_compare(F, F.XN);
#elif defined(SIMPLE_ATTN)
    attn_simple_phase(F);
#else
    attn_fast_phase(F, (char*)lds + RING_OFF, F.Q);
#endif
    GROUP_BAR();
#ifndef SKIP_P3
    {   pg8::Gemm g{F.Q, F.WbrT, M, DM, DM}; pg8::StaticOrder S; S.init(M, DM, F.G, vbid);
        pg8::EpiMix E{F.GA, F.GB, F.XN};
        pg8::gemm_phase<pg8::EpiMix, pg8::StaticOrder, true, true>(F.lds + RING_OFF, g, S, E); }
#endif
    GROUP_BAR();
#ifndef SKIP_P4
    {   pg8::Gemm g{F.XN, F.WoT, M, DM, DM}; pg8::StaticOrder S; S.init(M, DM, F.G, vbid);
        pg8::EpiX1 E{F.x, F.A2, F.rowsq};
        pg8::gemm_phase<pg8::EpiX1, pg8::StaticOrder, true, true>(F.lds + RING_OFF, g, S, E); }
#endif
    GROUP_BAR();
#ifndef SKIP_P5
    {   pg8::Gemm g{F.A2, F.WupT, M, FF, DM}; pg8::StaticOrder S; S.init(M, FF, F.G, vbid);
        pg8::EpiUp E{F.HB, F.rowsq};
        pg8::gemm_phase<pg8::EpiUp, pg8::StaticOrder, true, true>(F.lds + RING_OFF, g, S, E); }
#endif
    GROUP_BAR();
#ifndef SKIP_P6
    {   pg8::Gemm g{F.HB, F.WdnT, M, DM, FF}; pg8::StaticOrder S; S.init(M, DM, F.G, vbid);
#if defined(DBG_ATTN)
        const float dnum = ((const GAS float*)F.ctl)[8], dden = ((const GAS float*)F.ctl)[9];
        pg8::EpiDown E{F.A2, F.out, 1.0f + 100.0f * sqrtf(dnum / dden)};
#else
        pg8::EpiDown E{F.A2, F.out, 1.0f};
#endif
        pg8::gemm_phase<pg8::EpiDown, pg8::StaticOrder, true, true>(F.lds + RING_OFF, g, S, E); }
#endif
}

extern "C" void kernel_launch(void* const* d_in, const int* in_sizes, int n_in, void* d_out, int out_size, void* d_ws, size_t ws_size, hipStream_t stream) {
    static int grid = 0;
    if (grid == 0) {
        if (n_in != 14 || in_sizes[0] != M * DM || out_size != M * DM || ws_size < WS_END) { fprintf(stderr, "kernel_launch: unexpected shapes: n_in %d, in0 %d, out %d, ws %zu (need %zu); nothing launched\n", n_in, n_in > 0 ? in_sizes[0] : -1, out_size, ws_size, (size_t)WS_END); grid = -1; return; }
        int dev = 0, cus = 0, per_cu = 0;
        if (hipGetDevice(&dev) != hipSuccess || hipDeviceGetAttribute(&cus, hipDeviceAttributeMultiprocessorCount, dev) != hipSuccess) { fprintf(stderr, "kernel_launch: device query failed\n"); grid = -1; return; }
        if (hipFuncSetAttribute((const void*)fwd_megakernel, hipFuncAttributeMaxDynamicSharedMemorySize, LDS_BYTES) != hipSuccess) { fprintf(stderr, "kernel_launch: hipFuncSetAttribute failed\n"); grid = -1; return; }
        if (hipOccupancyMaxActiveBlocksPerMultiprocessor(&per_cu, (const void*)fwd_megakernel, NWAVES * 64, LDS_BYTES) != hipSuccess || per_cu < 1)
            fprintf(stderr, "kernel_launch: note: occupancy query reports %d workgroups per CU\n", per_cu);
        (void)hipGetLastError();
        grid = cus;
    }
    if (grid < 0) return;
    if (hipMemsetAsync((char*)d_ws + WS_CTL, 0, CTL_ZERO_BYTES, stream) != hipSuccess) { fprintf(stderr, "kernel_launch: hipMemsetAsync failed\n"); return; }
    Args a{};
    for (int i = 0; i < 14; ++i) a.in[i] = (const float*)d_in[i];
    a.out = (float*)d_out; a.ws = (unsigned char*)d_ws;
    hipLaunchKernelGGL(fwd_megakernel, dim3(grid), dim3(NWAVES * 64), LDS_BYTES, stream, a);
    const hipError_t le = hipPeekAtLastError();
    if (le != hipSuccess) fprintf(stderr, "kernel_launch: launch failed: %s\n", hipGetErrorName(le));
}
```

```cpp
#include <hip/hip_runtime.h>
#include <cstdio>
#include <cstdint>
namespace pg8 {
#define PG8_LAS __attribute__((address_space(3)))
typedef unsigned short bf16_t;
typedef short bf16x8 __attribute__((ext_vector_type(8)));
typedef float f32x4 __attribute__((ext_vector_type(4)));
typedef unsigned u32x4 __attribute__((ext_vector_type(4)));
constexpr int BM = 256, BK = 64, HALF = 128, HTB = HALF * BK * 2  , STAGE_BYTES = 8 * HTB, NXCD = 8, WGM = 8;

__host__ __device__ __forceinline__ int lds_byte(int r, int c) { const int st = (r >> 4) * 2 + (c >> 5), rr = r & 15, cc = c & 31, ob = rr * 64 + cc * 2; return st * 1024 + (ob ^ (((ob >> 9) & 1) << 5)); }
__host__ __device__ __forceinline__ void stage_rc(int b, int& R, int& C) { const int st = b / 1024, sb = b % 1024, swz = sb ^ (((sb >> 9) & 1) << 5); R = (st >> 1) * 16 + swz / 64; C = (st & 1) * 32 + (swz % 64) / 2; }
__host__ __device__ __forceinline__ int perm32(int rho) { const int n = rho >> 4, i = rho & 15; return 8 * (i >> 2) + 4 * n + (i & 3); }

struct Unit { int pm, pn; };
struct Gemm { const bf16_t* A; const bf16_t* Bt; int M, N, K; };

struct StaticOrder {
    int nM, nN, nwg, G, c, ioff = 0, ilim = 1 << 30;
    __host__ __device__ void init(int M, int N, int G_, int c_) { nM = M / BM; nN = N / BM; nwg = nM * nN; G = G_; c = c_; }
    __host__ __device__ bool next(int i, Unit& u) const {
        if (i >= ilim) return false;
        const long L = (long)(i + ioff) * G + c; if (L >= nwg) return false;
        int wgid = (int)L; { const int q = nwg / NXCD, r = nwg % NXCD, xcd = wgid % NXCD, off = wgid / NXCD; wgid = (xcd < r ? xcd * (q + 1) : r * (q + 1) + (xcd - r) * q) + off; }
        const int nig = WGM * nN, gid = wgid / nig, fm = gid * WGM, gsz = (nM - fm) < WGM ? (nM - fm) : WGM;
        u.pm = fm + ((wgid % nig) % gsz); u.pn = (wgid % nig) / gsz; return true;
    }
    __device__ __forceinline__ void a_ready(const Unit&) const {}
    __device__ __forceinline__ void done(const Unit&) const {}
};

__device__ __forceinline__ unsigned cvt_pk_bf16(float lo, float hi) { unsigned r; asm volatile("v_cvt_pk_bf16_f32 %0, %1, %2" : "=v"(r) : "v"(lo), "v"(hi)); return r; }
typedef unsigned u32x2 __attribute__((ext_vector_type(2)));
__device__ __forceinline__ float bf_lo(unsigned w) { return __uint_as_float(w << 16); }
__device__ __forceinline__ float bf_hi(unsigned w) { return __uint_as_float(w & 0xffff0000u); }
constexpr float kLog2e = 1.4426950408889634f;
constexpr float kC2 = 0.125f * 1.4426950408889634f;

struct EpiIn {
    static constexpr bool PERM = true, AFTER_DRAIN = false; static constexpr int MID_TILE = 0;
    bf16_t *Q, *KA, *VA, *KB, *VB, *GR, *GB; const float *qna, *kna, *qnb, *knb; float* kmean;
    __device__ __forceinline__ void mid(f32x4 (&)[2][2][4][2], const Unit&, int, int, int, int) const {}
    __device__ __forceinline__ void operator()(const f32x4 (&acc)[2][2][4][2], const Unit& u, int wr, int wc, int fr, int fq) const {
        const int pn = u.pn;
        const int rowb = u.pm * BM + wr * 64 + fr;
        if (pn >= 9) {
            const int col = 128 * (pn - 9) + 32 * wc + 8 * fq;
#pragma unroll
            for (int ai = 0; ai < 2; ++ai)
#pragma unroll
                for (int m = 0; m < 4; ++m) { const size_t off = (size_t)(rowb + ai * HALF + m * 16) * 1024 + col;
                    f32x4 rt[2], gb[2];
#pragma unroll
                    for (int n = 0; n < 2; ++n)
#pragma unroll
                        for (int e = 0; e < 4; ++e) { const float ea = __builtin_amdgcn_exp2f(-kLog2e * acc[ai][0][m][n][e]), eb = __builtin_amdgcn_exp2f(-kLog2e * acc[ai][1][m][n][e]);
                            gb[n][e] = __builtin_fmaxf(__builtin_amdgcn_rcpf(1.0f + eb), 1e-20f); rt[n][e] = __builtin_fminf((1.0f + eb) * __builtin_amdgcn_rcpf(1.0f + ea), 1e20f); }
                    u32x4 w; w.x = cvt_pk_bf16(rt[0][0], rt[0][1]); w.y = cvt_pk_bf16(rt[0][2], rt[0][3]); w.z = cvt_pk_bf16(rt[1][0], rt[1][1]); w.w = cvt_pk_bf16(rt[1][2], rt[1][3]);
                    *(u32x4*)(GR + off) = w;
                    w.x = cvt_pk_bf16(gb[0][0], gb[0][1]); w.y = cvt_pk_bf16(gb[0][2], gb[0][3]); w.z = cvt_pk_bf16(gb[1][0], gb[1][1]); w.w = cvt_pk_bf16(gb[1][2], gb[1][3]);
                    *(u32x4*)(GB + off) = w; }
            return;
        }
        bf16_t* dst; int pitch; bool norm = false, km = false; float scale = 1.f; const float* gain = qna;
        if (pn < 2)       { dst = Q + (4 * pn + wc) * 64; pitch = 1024; norm = true; gain = qna; scale = kC2; }
        else if (pn < 4)  { dst = KA + (4 * (pn - 2) + wc) * 64; pitch = 512; norm = true; gain = kna; km = true; }
        else if (pn < 6)  { dst = VA + (4 * (pn - 4) + wc) * 64; pitch = 512; }
        else if (pn < 8)  { dst = Q + 512 + (4 * (pn - 6) + wc) * 64; pitch = 1024; norm = true; gain = qnb; scale = kC2; }
        else              { pitch = 128; if (wc < 2) { dst = KB + wc * 64; norm = true; gain = knb; } else { dst = VB + (wc - 2) * 64; } }
        f32x4 g[2][2], cs[2][2];
#pragma unroll
        for (int bj = 0; bj < 2; ++bj)
#pragma unroll
            for (int n = 0; n < 2; ++n) { g[bj][n] = norm ? *(const f32x4*)(gain + 32 * bj + 8 * fq + 4 * n) : (f32x4){1.f, 1.f, 1.f, 1.f}; cs[bj][n] = (f32x4){0.f, 0.f, 0.f, 0.f}; }
#pragma unroll
        for (int ai = 0; ai < 2; ++ai)
#pragma unroll
            for (int m = 0; m < 4; ++m) {
                const int row = rowb + ai * HALF + m * 16;
                f32x4 v[2][2];
#pragma unroll
                for (int bj = 0; bj < 2; ++bj)
#pragma unroll
                    for (int n = 0; n < 2; ++n) v[bj][n] = acc[ai][bj][m][n];
                if (norm) {
                    float ss = 0.f;
#pragma unroll
                    for (int bj = 0; bj < 2; ++bj)
#pragma unroll
                        for (int n = 0; n < 2; ++n) { const f32x4 x = v[bj][n]; ss += (x[0] * x[0] + x[1] * x[1]) + (x[2] * x[2] + x[3] * x[3]); }
                    ss += __shfl_xor(ss, 16); ss += __shfl_xor(ss, 32);
                    const float rs = __builtin_amdgcn_rsqf(ss * (1.0f / 64.0f) + 1e-6f) * scale;
#pragma unroll
                    for (int bj = 0; bj < 2; ++bj)
#pragma unroll
                        for (int n = 0; n < 2; ++n) v[bj][n] = v[bj][n] * rs * g[bj][n];
                }
                if (km) {
#pragma unroll
                    for (int bj = 0; bj < 2; ++bj)
#pragma unroll
                        for (int n = 0; n < 2; ++n) cs[bj][n] += v[bj][n];
                }
#pragma unroll
                for (int bj = 0; bj < 2; ++bj) {
                    u32x4 w; w.x = cvt_pk_bf16(v[bj][0][0], v[bj][0][1]); w.y = cvt_pk_bf16(v[bj][0][2], v[bj][0][3]); w.z = cvt_pk_bf16(v[bj][1][0], v[bj][1][1]); w.w = cvt_pk_bf16(v[bj][1][2], v[bj][1][3]);
                    *(u32x4*)(dst + (size_t)row * pitch + 32 * bj + 8 * fq) = w;
                }
            }
        if (km) {
            float* kmp = kmean + ((size_t)u.pm * 8 + (4 * (pn - 2) + wc)) * 64;
#pragma unroll
            for (int bj = 0; bj < 2; ++bj)
#pragma unroll
                for (int n = 0; n < 2; ++n)
#pragma unroll
                    for (int e = 0; e < 4; ++e) {
                        float s = cs[bj][n][e];
                        s += __shfl_xor(s, 1); s += __shfl_xor(s, 2); s += __shfl_xor(s, 4); s += __shfl_xor(s, 8);
                        if (fr == 0) atomicAdd(kmp + 32 * bj + 8 * fq + 4 * n + e, s * (1.0f / 256.0f));
                    }
        }
    }
};

struct EpiMix {
    static constexpr bool PERM = true, AFTER_DRAIN = false; static constexpr int MID_TILE = 8;
    const bf16_t *GR, *GB; bf16_t* MIX;
    __device__ __forceinline__ void mid(f32x4 (&acc)[2][2][4][2], const Unit& u, int wr, int wc, int fr, int fq) const {
        int rowb = u.pm * BM + wr * 64 + fr, col0 = u.pn * BM + wc * 32 + 8 * fq;
        asm volatile("" : "+v"(rowb), "+v"(col0));
        const bf16_t* base = GR + (size_t)rowb * 1024 + col0;
        u32x4 rt[2][4][2];
#pragma unroll
        for (int ai = 0; ai < 2; ++ai)
#pragma unroll
            for (int m = 0; m < 4; ++m)
#pragma unroll
                for (int bj = 0; bj < 2; ++bj) rt[ai][m][bj] = *(const u32x4*)(base + (size_t)(ai * HALF + m * 16) * 1024 + bj * HALF);
#pragma unroll
        for (int ai = 0; ai < 2; ++ai)
#pragma unroll
            for (int m = 0; m < 4; ++m)
#pragma unroll
                for (int bj = 0; bj < 2; ++bj) { const u32x4 a = rt[ai][m][bj];
                    acc[ai][bj][m][0] *= (f32x4){bf_lo(a.x), bf_hi(a.x), bf_lo(a.y), bf_hi(a.y)}; acc[ai][bj][m][1] *= (f32x4){bf_lo(a.z), bf_hi(a.z), bf_lo(a.w), bf_hi(a.w)}; }
    }
    __device__ __forceinline__ void operator()(const f32x4 (&acc)[2][2][4][2], const Unit& u, int wr, int wc, int fr, int fq) const {
        const int rowb = u.pm * BM + wr * 64 + fr, col0 = u.pn * BM + wc * 32 + 8 * fq;
        const bf16_t* base = GB + (size_t)rowb * 1024 + col0; bf16_t* ob = MIX + (size_t)rowb * 1024 + col0;
        u32x4 gt[2][4][2];
#pragma unroll
        for (int ai = 0; ai < 2; ++ai)
#pragma unroll
            for (int m = 0; m < 4; ++m)
#pragma unroll
                for (int bj = 0; bj < 2; ++bj) gt[ai][m][bj] = *(const u32x4*)(base + (size_t)(ai * HALF + m * 16) * 1024 + bj * HALF);
#pragma unroll
        for (int ai = 0; ai < 2; ++ai)
#pragma unroll
            for (int m = 0; m < 4; ++m)
#pragma unroll
                for (int bj = 0; bj < 2; ++bj) { const u32x4 b = gt[ai][m][bj];
                    const f32x4 v0 = acc[ai][bj][m][0], v1 = acc[ai][bj][m][1];
                    u32x4 w; w.x = cvt_pk_bf16(v0[0] * bf_lo(b.x), v0[1] * bf_hi(b.x)); w.y = cvt_pk_bf16(v0[2] * bf_lo(b.y), v0[3] * bf_hi(b.y));
                    w.z = cvt_pk_bf16(v1[0] * bf_lo(b.z), v1[1] * bf_hi(b.z)); w.w = cvt_pk_bf16(v1[2] * bf_lo(b.w), v1[3] * bf_hi(b.w));
                    *(u32x4*)(ob + (size_t)(ai * HALF + m * 16) * 1024 + bj * HALF) = w; }
    }
};

struct EpiX1 {
    static constexpr bool PERM = false, AFTER_DRAIN = false; static constexpr int MID_TILE = 0;
    const float* x; bf16_t* X1; float* rowsq;
    __device__ __forceinline__ void mid(f32x4 (&)[2][2][4][2], const Unit&, int, int, int, int) const {}
    __device__ __forceinline__ void operator()(const f32x4 (&acc)[2][2][4][2], const Unit& u, int wr, int wc, int fr, int fq) const {
        const int rowb = u.pm * BM + wr * 64 + fr, col0 = u.pn * BM + wc * 32 + 4 * fq;
#pragma unroll
        for (int ai = 0; ai < 2; ++ai) {
            f32x4 xv[4][2][2];
#pragma unroll
            for (int m = 0; m < 4; ++m)
#pragma unroll
                for (int bj = 0; bj < 2; ++bj)
#pragma unroll
                    for (int n = 0; n < 2; ++n) xv[m][bj][n] = *(const f32x4*)(x + (size_t)(rowb + ai * HALF + m * 16) * 1024 + col0 + bj * HALF + n * 16);
#pragma unroll
            for (int m = 0; m < 4; ++m) { const int row = rowb + ai * HALF + m * 16; const size_t off = (size_t)row * 1024 + col0; float ss = 0.f;
#pragma unroll
                for (int bj = 0; bj < 2; ++bj)
#pragma unroll
                    for (int n = 0; n < 2; ++n) {
                        const f32x4 x1 = xv[m][bj][n] + acc[ai][bj][m][n];
                        ss += (x1[0] * x1[0] + x1[1] * x1[1]) + (x1[2] * x1[2] + x1[3] * x1[3]);
                        u32x2 w; w.x = cvt_pk_bf16(x1[0], x1[1]); w.y = cvt_pk_bf16(x1[2], x1[3]);
                        *(u32x2*)(X1 + off + bj * HALF + n * 16) = w;
                    }
                ss += __shfl_xor(ss, 16); ss += __shfl_xor(ss, 32);
                if (fq == 0) atomicAdd(rowsq + row, ss); }
            asm volatile("" ::: "memory"); }
    }
};

struct EpiUp {
    static constexpr bool PERM = true, AFTER_DRAIN = false; static constexpr int MID_TILE = 0;
    bf16_t* H; const float* rowsq;
    __device__ __forceinline__ void mid(f32x4 (&)[2][2][4][2], const Unit&, int, int, int, int) const {}
    __device__ __forceinline__ void operator()(const f32x4 (&acc)[2][2][4][2], const Unit& u, int wr, int wc, int fr, int fq) const {
        const int rowb = u.pm * BM + wr * 64 + fr, col0 = u.pn * BM + wc * 32 + 8 * fq;
#pragma unroll
        for (int ai = 0; ai < 2; ++ai)
#pragma unroll
            for (int m = 0; m < 4; ++m) { const int row = rowb + ai * HALF + m * 16;
                const float r = __builtin_amdgcn_rsqf(rowsq[row] * (1.0f / 1024.0f) + 1e-6f);
                bf16_t* rowp = H + (size_t)row * 4096 + col0;
#pragma unroll
                for (int bj = 0; bj < 2; ++bj) {
                    f32x4 v0 = acc[ai][bj][m][0] * r, v1 = acc[ai][bj][m][1] * r;
#pragma unroll
                    for (int e = 0; e < 4; ++e) { const float a = __builtin_fmaxf(v0[e], 0.f), b = __builtin_fmaxf(v1[e], 0.f); v0[e] = a * a; v1[e] = b * b; }
                    u32x4 w; w.x = cvt_pk_bf16(v0[0], v0[1]); w.y = cvt_pk_bf16(v0[2], v0[3]); w.z = cvt_pk_bf16(v1[0], v1[1]); w.w = cvt_pk_bf16(v1[2], v1[3]);
                    *(u32x4*)(rowp + bj * HALF) = w;
                } }
    }
};

struct EpiDown {
    static constexpr bool PERM = false, AFTER_DRAIN = false; static constexpr int MID_TILE = 0;
    const bf16_t* X1; float* out; float mul;
    __device__ __forceinline__ void mid(f32x4 (&)[2][2][4][2], const Unit&, int, int, int, int) const {}
    __device__ __forceinline__ void operator()(const f32x4 (&acc)[2][2][4][2], const Unit& u, int wr, int wc, int fr, int fq) const {
        const int rowb = u.pm * BM + wr * 64 + fr, col0 = u.pn * BM + wc * 32 + 4 * fq;
        u32x2 xv[2][4][2][2];
#pragma unroll
        for (int ai = 0; ai < 2; ++ai)
#pragma unroll
            for (int m = 0; m < 4; ++m)
#pragma unroll
                for (int bj = 0; bj < 2; ++bj)
#pragma unroll
                    for (int n = 0; n < 2; ++n) xv[ai][m][bj][n] = *(const u32x2*)(X1 + (size_t)(rowb + ai * HALF + m * 16) * 1024 + col0 + bj * HALF + n * 16);
#pragma unroll
        for (int ai = 0; ai < 2; ++ai)
#pragma unroll
            for (int m = 0; m < 4; ++m) { float* rowp = out + (size_t)(rowb + ai * HALF + m * 16) * 1024 + col0;
#pragma unroll
                for (int bj = 0; bj < 2; ++bj)
#pragma unroll
                    for (int n = 0; n < 2; ++n) { const u32x2 w = xv[ai][m][bj][n];
                        *(f32x4*)(rowp + bj * HALF + n * 16) = ((f32x4){bf_lo(w.x), bf_hi(w.x), bf_lo(w.y), bf_hi(w.y)} + acc[ai][bj][m][n]) * mul; } }
    }
};

template <class Epi, class Sched, bool ALIGN_EPI = false, bool SP2 = false>
__device__ __forceinline__ void gemm_phase(PG8_LAS unsigned char* lds, const Gemm g, const Sched& S, const Epi& E) {
    int tid = threadIdx.x; asm volatile("" : "+v"(tid));
    const int wid = __builtin_amdgcn_readfirstlane(tid >> 6), lane = tid & 63, wr = wid >> 2, wc = wid & 3, fr = lane & 15, fq = lane >> 4;
    const int K = g.K, nt = K / BK;
    unsigned voffA[2], voffB[2];
#pragma unroll
    for (int i = 0; i < 2; ++i) { int R, C; stage_rc(tid * 16 + i * 8192, R, C); const int Rb = Epi::PERM ? ((R & ~31) + perm32(R & 31)) : R;
        voffA[i] = (unsigned)(R * K + C) * 2u; voffB[i] = (unsigned)(Rb * K + C) * 2u; }
    const size_t kstep = (size_t)(BK * 2);
    const size_t hstep = (size_t)HALF * K * 2;
    const size_t tstep = 2 * hstep;
    const unsigned ldsw = (unsigned)wid * 1024u;
    const int aoff = lds_byte(wr * 64 + fr, fq * 8), boff = lds_byte(wc * 32 + fr, fq * 8);
#define PG8_SA(b, h) (((b) * 2 + (h)) * HTB)
#define PG8_SB(b, h) ((4 + (b) * 2 + (h)) * HTB)
#define PG8_STAGE(bufoff, gbase, voff) do { _Pragma("unroll") for (int _i = 0; _i < 2; ++_i) \
        __builtin_amdgcn_global_load_lds((const unsigned*)((const char*)(gbase) + (voff)[_i]), (PG8_LAS unsigned*)(lds + (bufoff) + ldsw + _i * 8192), 16, 0, 0); } while (0)
#define PG8_LDA(dst, b, h) do { _Pragma("unroll") for (int m = 0; m < 4; ++m) _Pragma("unroll") for (int k = 0; k < 2; ++k) dst[m][k] = *(const PG8_LAS bf16x8*)(lds + PG8_SA(b, h) + aoff + m * 2048 + k * 1024); } while (0)
#define PG8_LDB(dst, b, h) do { _Pragma("unroll") for (int n = 0; n < 2; ++n) _Pragma("unroll") for (int k = 0; k < 2; ++k) dst[n][k] = *(const PG8_LAS bf16x8*)(lds + PG8_SB(b, h) + boff + n * 2048 + k * 1024); } while (0)
#define PG8_MMA(ai, bj, At, Bt) do { __builtin_amdgcn_s_setprio(1); _Pragma("unroll") for (int m = 0; m < 4; ++m) _Pragma("unroll") for (int n = 0; n < 2; ++n) _Pragma("unroll") for (int k = 0; k < 2; ++k) \
        acc[ai][bj][m][n] = __builtin_amdgcn_mfma_f32_16x16x32_bf16(Bt[n][k], At[m][k], acc[ai][bj][m][n], 0, 0, 0); __builtin_amdgcn_s_setprio(0); } while (0)
#define PG8_WAIT_V(n) asm volatile("s_waitcnt vmcnt(" #n ")" ::: "memory")
#define PG8_WAIT_L(n) asm volatile("s_waitcnt lgkmcnt(" #n ")" ::: "memory")
#define PG8_BAR __builtin_amdgcn_s_barrier()
#define PG8_SCHED __builtin_amdgcn_sched_barrier(0)
    Unit cur, nxt; int ui = 0;
    if (!S.next(0, cur)) return;
    f32x4 acc[2][2][4][2];
#pragma unroll
    for (int a = 0; a < 2; ++a)
#pragma unroll
        for (int b = 0; b < 2; ++b)
#pragma unroll
            for (int m = 0; m < 4; ++m)
#pragma unroll
                for (int n = 0; n < 2; ++n) acc[a][b][m][n] = (f32x4){0.f, 0.f, 0.f, 0.f};
    bf16x8 At[4][2], B0[2][2], B1[2][2];
    const char* cA = (const char*)g.A + (size_t)cur.pm * tstep; const char* cB = (const char*)g.Bt + (size_t)cur.pn * tstep;
    S.a_ready(cur);
    if constexpr (SP2) {
        PG8_STAGE(PG8_SB(0, 0), cB, voffB); PG8_STAGE(PG8_SB(0, 1), cB + hstep, voffB); PG8_STAGE(PG8_SA(0, 0), cA, voffA); PG8_STAGE(PG8_SA(0, 1), cA + hstep, voffA);
        if (wr == 1) PG8_BAR;
        PG8_WAIT_V(2); PG8_BAR;
        PG8_STAGE(PG8_SB(1, 0), cB + kstep, voffB); PG8_STAGE(PG8_SA(1, 0), cA + kstep, voffA); PG8_STAGE(PG8_SB(1, 1), cB + hstep + kstep, voffB);
        PG8_WAIT_V(6); PG8_BAR;
    } else {
        PG8_STAGE(PG8_SB(0, 0), cB, voffB); PG8_STAGE(PG8_SA(0, 0), cA, voffA); PG8_STAGE(PG8_SB(0, 1), cB + hstep, voffB); PG8_STAGE(PG8_SA(0, 1), cA + hstep, voffA);
        if (wr == 1) PG8_BAR;
        PG8_WAIT_V(4); PG8_BAR;
        PG8_STAGE(PG8_SB(1, 0), cB + kstep, voffB); PG8_STAGE(PG8_SA(1, 0), cA + kstep, voffA); PG8_STAGE(PG8_SB(1, 1), cB + hstep + kstep, voffB);
        PG8_WAIT_V(6); PG8_BAR;
    }
    for (;;) {
        const bool has_next = S.next(ui + 1, nxt);
        const char* nA = has_next ? (const char*)g.A + (size_t)nxt.pm * tstep : cA; const char* nB = has_next ? (const char*)g.Bt + (size_t)nxt.pn * tstep : cB;
        for (int t = 0; t < nt; t += 2) {
            if constexpr (Epi::MID_TILE > 0) { if (t == Epi::MID_TILE) { PG8_SCHED; E.mid(acc, cur, wr, wc, fr, fq); PG8_SCHED; } }
            const bool last = (t == nt - 2);
            const char* a1 = cA + (size_t)(t + 1) * kstep;
            const char* a2 = last ? nA : cA + (size_t)(t + 2) * kstep; const char* b2 = last ? nB : cB + (size_t)(t + 2) * kstep;
            const char* a3 = a2 + kstep; const char* b3 = b2 + kstep;
            if (last && has_next) S.a_ready(nxt);
            if constexpr (SP2) {
            PG8_LDB(B0, 0, 0); PG8_LDB(B1, 0, 1); PG8_SCHED; PG8_LDA(At, 0, 0); PG8_STAGE(PG8_SA(1, 1), a1 + hstep, voffA);
            PG8_WAIT_V(8); PG8_WAIT_L(0); PG8_BAR; PG8_MMA(0, 0, At, B0); PG8_MMA(0, 1, At, B1); PG8_BAR; PG8_SCHED;
            PG8_LDA(At, 0, 1); PG8_STAGE(PG8_SB(0, 0), b2, voffB); PG8_STAGE(PG8_SB(0, 1), b2 + hstep, voffB); PG8_STAGE(PG8_SA(0, 0), a2, voffA);
            PG8_WAIT_V(8); PG8_WAIT_L(0); PG8_BAR; PG8_MMA(1, 0, At, B0); PG8_MMA(1, 1, At, B1); PG8_BAR; PG8_SCHED;
            PG8_LDB(B0, 1, 0); PG8_LDB(B1, 1, 1); PG8_SCHED; PG8_LDA(At, 1, 0); PG8_STAGE(PG8_SA(0, 1), a2 + hstep, voffA);
            PG8_WAIT_V(8); PG8_WAIT_L(0); PG8_BAR; PG8_MMA(0, 0, At, B0); PG8_MMA(0, 1, At, B1); PG8_BAR; PG8_SCHED;
            PG8_LDA(At, 1, 1); PG8_STAGE(PG8_SB(1, 0), b3, voffB); PG8_STAGE(PG8_SB(1, 1), b3 + hstep, voffB); PG8_STAGE(PG8_SA(1, 0), a3, voffA);
            PG8_WAIT_V(8); PG8_WAIT_L(0); PG8_BAR; PG8_MMA(1, 0, At, B0); PG8_MMA(1, 1, At, B1); PG8_BAR; PG8_SCHED;
            } else {
            PG8_LDB(B0, 0, 0); PG8_SCHED; PG8_LDA(At, 0, 0); PG8_STAGE(PG8_SA(1, 1), a1 + hstep, voffA);
            PG8_WAIT_L(8); PG8_BAR; PG8_WAIT_L(0); PG8_MMA(0, 0, At, B0); PG8_BAR; PG8_SCHED;
            PG8_LDB(B1, 0, 1); PG8_STAGE(PG8_SB(0, 0), b2, voffB);
            PG8_BAR; PG8_WAIT_L(0); PG8_MMA(0, 1, At, B1); PG8_BAR;
            PG8_LDA(At, 0, 1); PG8_STAGE(PG8_SA(0, 0), a2, voffA);
            PG8_BAR; PG8_WAIT_L(0); PG8_MMA(1, 0, At, B0); PG8_BAR; PG8_SCHED;
            PG8_STAGE(PG8_SB(0, 1), b2 + hstep, voffB);
            PG8_WAIT_V(6); PG8_BAR; PG8_MMA(1, 1, At, B1); PG8_BAR;
            PG8_LDB(B0, 1, 0); PG8_SCHED; PG8_LDA(At, 1, 0); PG8_STAGE(PG8_SA(0, 1), a2 + hstep, voffA);
            PG8_WAIT_L(8); PG8_BAR; PG8_WAIT_L(0); PG8_MMA(0, 0, At, B0); PG8_BAR; PG8_SCHED;
            PG8_LDB(B1, 1, 1); PG8_STAGE(PG8_SB(1, 0), b3, voffB);
            PG8_BAR; PG8_WAIT_L(0); PG8_MMA(0, 1, At, B1); PG8_BAR;
            PG8_LDA(At, 1, 1); PG8_STAGE(PG8_SA(1, 0), a3, voffA);
            PG8_BAR; PG8_WAIT_L(0); PG8_MMA(1, 0, At, B0); PG8_BAR; PG8_SCHED;
            PG8_STAGE(PG8_SB(1, 1), b3 + hstep, voffB);
            PG8_WAIT_V(6); PG8_BAR; PG8_MMA(1, 1, At, B1); PG8_BAR;
            }
        }
        if constexpr (ALIGN_EPI) { if (wr == 0) PG8_BAR; }
        if constexpr (!Epi::AFTER_DRAIN) { E(acc, cur, wr, wc, fr, fq); S.done(cur); }
        if (!has_next) break;
#pragma unroll
        for (int a = 0; a < 2; ++a)
#pragma unroll
            for (int b = 0; b < 2; ++b)
#pragma unroll
                for (int m = 0; m < 4; ++m)
#pragma unroll
                    for (int n = 0; n < 2; ++n) acc[a][b][m][n] = (f32x4){0.f, 0.f, 0.f, 0.f};
        cur = nxt; cA = nA; cB = nB; ++ui;
        if constexpr (ALIGN_EPI) { if (wr == 1) PG8_BAR; }
    }
    PG8_WAIT_V(0);
    if constexpr (!ALIGN_EPI) { if (wr == 0) PG8_BAR; }
    PG8_BAR;
    if constexpr (Epi::AFTER_DRAIN) { E.fused(acc, cur, wr, wc, fr, fq, lds, wid, lane); S.done(cur); }
#undef PG8_SA
#undef PG8_SB
#undef PG8_STAGE
#undef PG8_LDA
#undef PG8_LDB
#undef PG8_MMA
#undef PG8_WAIT_V
#undef PG8_WAIT_L
#undef PG8_BAR
#undef PG8_SCHED
}
}
constexpr int NWAVES = 8;
constexpr int BATCH = 16, SEQ = 2048, DM = 1024, HD = 64, FF = 4096, NIN = 4352;
constexpr int M = BATCH * SEQ;
constexpr float EPS = 1e-6f;
constexpr size_t MiB = 1u << 20;
constexpr size_t WS_CTL = 0, CTL_ZERO_BYTES = 1 * MiB;
constexpr size_t WS_WIN = 2 * MiB, WS_WBR = 11 * MiB, WS_WO = 13 * MiB, WS_WUP = 15 * MiB, WS_WDN = 23 * MiB;
constexpr int NGRP = 8, GROWS = M / NGRP;
constexpr size_t WS_GRP0 = 32 * MiB, GRP_STRIDE = 50 * MiB;
constexpr size_t GO_Q = 0 * MiB;
constexpr size_t GO_KA = 8 * MiB, GO_VA = 12 * MiB;
constexpr size_t GO_KB = 16 * MiB, GO_VB = 17 * MiB;
constexpr size_t GO_GA = 18 * MiB, GO_GB = 26 * MiB;
constexpr size_t GO_H = 0 * MiB;
constexpr size_t GO_A2 = 34 * MiB;
constexpr size_t GO_XN = 42 * MiB;
constexpr size_t WS_END = WS_GRP0 + NGRP * GRP_STRIDE;
static_assert(WS_WIN + (size_t)NIN * DM * 2 <= WS_WBR && WS_WDN + (size_t)DM * FF * 2 <= WS_GRP0 && GO_GB + (size_t)GROWS * DM * 2 <= GO_A2 && GO_H + (size_t)GROWS * FF * 2 <= GO_A2 && GO_XN + (size_t)GROWS * DM * 2 <= GRP_STRIDE, "d_ws map");
__device__ __forceinline__ unsigned short* grp_ptr(unsigned char* ws, int g, size_t off, int pitch_elems) { return (unsigned short*)(ws + WS_GRP0 + (size_t)g * GRP_STRIDE + off) - (size_t)g * GROWS * pitch_elems; }
constexpr int CW_TMO = 0, CW_CODE = 1;
constexpr int CW_BAR = 4096;
constexpr int CW_CENSUS = 8192;
constexpr int CW_GSUB = 9216, CW_GGEN = 10240;
constexpr int CW_KMEAN = 16384;
constexpr int CW_ROWSQ = CW_KMEAN + BATCH * 8 * 8 * 64;
static_assert((CW_ROWSQ + M) * 4 <= (int)CTL_ZERO_BYTES, "CTL words inside the memset region");
constexpr int RING_OFF = 0, RING_BYTES = 131072;
constexpr int LDSCTL_OFF = RING_BYTES, MISC_OFF = LDSCTL_OFF + 320;
constexpr int LDS_BYTES = 147456;
static_assert(MISC_OFF + 128 <= LDS_BYTES, "LDS map");

#define GAS __attribute__((address_space(1)))
#define LAS __attribute__((address_space(3)))
typedef unsigned short bf16;
typedef unsigned v4u __attribute__((ext_vector_type(4)));
typedef float f32x4 __attribute__((ext_vector_type(4)));
typedef short bf16x8 __attribute__((ext_vector_type(8)));
typedef GAS unsigned gu32;
typedef GAS unsigned long long gu64;
#define RLX_AGENT __ATOMIC_RELAXED, __HIP_MEMORY_SCOPE_AGENT
#define LDS_WAIT() asm volatile("s_waitcnt lgkmcnt(0)" ::: "memory")
#define VM_WAIT() asm volatile("s_waitcnt vmcnt(0)" ::: "memory")
__device__ __forceinline__ unsigned long long rt() { return __builtin_amdgcn_s_memrealtime(); }
__device__ __forceinline__ unsigned f2bf(float f) { unsigned u = __builtin_bit_cast(unsigned, f); return (u + 0x7fffu + ((u >> 16) & 1u)) >> 16; }
__device__ __forceinline__ unsigned pk2(float lo, float hi) { return f2bf(lo) | (f2bf(hi) << 16); }

#define XB_TMO      128
#define XB_XCNT(j)  (256  + 64 * (j))
#define XB_XSUB(j)  (1280 + 64 * (j))
#define XB_XGEN(j)  (2304 + 64 * (j))
#define XB_TOP      3328
#define XB_TOPGEN   3392
#define XCD_BAR_WORDS 3456
#define XB_SPIN_CAP (1u << 18)

__device__ __forceinline__ unsigned xb_ld(unsigned* p)              { return __hip_atomic_load(p, __ATOMIC_RELAXED, __HIP_MEMORY_SCOPE_AGENT); }
__device__ __forceinline__ unsigned xb_add(unsigned* p, unsigned v) { return __hip_atomic_fetch_add(p, v, __ATOMIC_RELAXED, __HIP_MEMORY_SCOPE_AGENT); }
__device__ __forceinline__ unsigned xb_xcc_id() { return (unsigned)__builtin_amdgcn_s_getreg((3 << 11) | 20) & 0xFu; }
#define XB_SPIN(cond, bar) do { unsigned _sp = 0; while (cond) { __builtin_amdgcn_s_sleep(1); \
    if ((++_sp & 255u) == 0u) { if (xb_ld(&(bar)[XB_TMO])) break; if (_sp > XB_SPIN_CAP) { atomicAdd(&(bar)[XB_TMO], 1u); break; } } } } while (0)

struct XcdBarrier {
    unsigned* bar; unsigned x;
    volatile LAS unsigned* st;
};

__device__ __forceinline__ XcdBarrier xcd_barrier_post(unsigned* bar, volatile LAS unsigned* st) {
    XcdBarrier b; b.bar = bar; b.x = xb_xcc_id(); b.st = st;
    if (threadIdx.x == 0) (void)xb_add(&bar[XB_XCNT(b.x)], 1u);
    return b;
}
__device__ __forceinline__ void xcd_barrier_complete(unsigned* bar, unsigned x, unsigned& nloc, unsigned& nx) {
    const unsigned G = gridDim.x * gridDim.y * gridDim.z;
    unsigned sum, cnt, mine, sp = 0u;
    for (;;) {
        sum = 0u; cnt = 0u; mine = 0u;
#pragma unroll
        for (unsigned j = 0; j < 16; ++j) { const unsigned c = xb_ld(&bar[XB_XCNT(j)]); sum += c; cnt += (c > 0u) ? 1u : 0u; mine = (j == x) ? c : mine; }
        if (sum == G) break;
        __builtin_amdgcn_s_sleep(1);
        if ((++sp & 255u) == 0u) { if (xb_ld(&bar[XB_TMO])) break; if (sp > XB_SPIN_CAP) { atomicAdd(&bar[XB_TMO], 1u); break; } }
    }
    nloc = mine > 0u ? mine : 1u; nx = cnt > 0u ? cnt : 1u;
}

__device__ __forceinline__ void xcd_barrier(const XcdBarrier& b) {
    asm volatile("s_waitcnt vmcnt(0)" ::: "memory");
    __syncthreads();
    if (threadIdx.x == 0) {
        unsigned* bar = b.bar;
        __builtin_amdgcn_s_waitcnt(0);
        unsigned nloc = b.st[0], nx = b.st[1];
        if (nloc == 0u) { xcd_barrier_complete(bar, b.x, nloc, nx); b.st[0] = nloc; b.st[1] = nx; }
        const unsigned old = xb_add(&bar[XB_XSUB(b.x)], 1u);
        const unsigned gen = old / nloc;
        if (old + 1u == (gen + 1u) * nloc) {
            __builtin_amdgcn_fence(__ATOMIC_RELEASE, "agent");
            asm volatile("s_waitcnt vmcnt(0)" ::: "memory");
            const unsigned og = xb_add(&bar[XB_TOP], 1u);
            const unsigned tg = og / nx;
            if (og + 1u == (tg + 1u) * nx) xb_add(&bar[XB_TOPGEN], 1u);
            else XB_SPIN(xb_ld(&bar[XB_TOPGEN]) == tg, bar);
            __builtin_amdgcn_fence(__ATOMIC_ACQUIRE, "agent");
            xb_add(&bar[XB_XGEN(b.x)], 1u);
            asm volatile("s_waitcnt vmcnt(0)" ::: "memory");
        } else {
            XB_SPIN(xb_ld(&bar[XB_XGEN(b.x)]) == gen, bar);
            __builtin_amdgcn_fence(__ATOMIC_ACQUIRE, "agent");
            asm volatile("s_waitcnt vmcnt(0)" ::: "memory");
        }
    }
    __syncthreads();
}

struct GroupBar { unsigned* sub; unsigned* gen; unsigned* bar; };
__device__ __forceinline__ void group_barrier(const GroupBar& g) {
    asm volatile("s_waitcnt vmcnt(0)" ::: "memory");
    __syncthreads();
    if (threadIdx.x == 0) {
        __builtin_amdgcn_s_waitcnt(0);
        const unsigned old = xb_add(g.sub, 1u), gen = old / 32u;
        if (old + 1u == (gen + 1u) * 32u) {
            __builtin_amdgcn_fence(__ATOMIC_RELEASE, "agent");
            asm volatile("s_waitcnt vmcnt(0)" ::: "memory");
            __builtin_amdgcn_fence(__ATOMIC_ACQUIRE, "agent");
            xb_add(g.gen, 1u);
            asm volatile("s_waitcnt vmcnt(0)" ::: "memory");
        } else {
            XB_SPIN(xb_ld(g.gen) == gen, g.bar);
            __builtin_amdgcn_fence(__ATOMIC_ACQUIRE, "agent");
            asm volatile("s_waitcnt vmcnt(0)" ::: "memory");
        }
    }
    __syncthreads();
}

struct Frame {
    LAS unsigned char* lds;
    volatile LAS unsigned* MISC;
    gu32* ctl;
    int tid, lane, wave;
    int vcu, G;
    int grp, li, grouped;
    unsigned char* ws;
    const float *x, *norm_attn, *w_in, *qna, *kna, *qnb, *knb, *sinks, *wba, *wbb, *w_out, *norm_mlp, *w_up, *w_down; float* out;
    bf16 *WinT, *WbrT, *WoT, *WupT, *WdnT;
    bf16 *Q, *KA, *VA, *KB, *VB, *GA, *GB, *HB, *A2, *XN;
    float *kmean, *rowsq;
};

__device__ __forceinline__ float wave_sum(float v) {
#pragma unroll
    for (int o = 1; o < 64; o <<= 1) v += __shfl_xor(v, o);
    return v;
}
__device__ __forceinline__ void p0_transpose_item(const float* W, int N, bf16* WT, int ldt, int koff, int prow0, LAS float* scr, int k0, int n0, int lane, const float* kscale = nullptr) {
    float wv[32];
#pragma unroll
    for (int i = 0; i < 32; ++i) wv[i] = W[(size_t)(k0 + 2 * i + (lane >> 5)) * N + n0 + (lane & 31)];
    if (kscale) {
#pragma unroll
        for (int i = 0; i < 32; ++i) wv[i] *= kscale[k0 + 2 * i + (lane >> 5)];
    }
#pragma unroll
    for (int i = 0; i < 32; ++i) scr[(2 * i + (lane >> 5)) * 33 + (lane & 31)] = wv[i];
    LDS_WAIT(); asm volatile("" ::: "memory");
    const int c = lane & 7;
#pragma unroll
    for (int j = 0; j < 4; ++j) { const int n = (lane >> 3) + 8 * j; const LAS float* s = scr + (8 * c) * 33 + n;
        v4u o; o.x = pk2(s[0 * 33], s[1 * 33]); o.y = pk2(s[2 * 33], s[3 * 33]); o.z = pk2(s[4 * 33], s[5 * 33]); o.w = pk2(s[6 * 33], s[7 * 33]);
        *(GAS v4u*)(WT + (size_t)(prow0 + n) * ldt + koff + k0 + 8 * c) = o; }
    LDS_WAIT(); asm volatile("" ::: "memory");
}
__device__ __forceinline__ void rms_row_to_bf16(const Frame& F, const float* xrow, const float* gain, bf16* orow) {
    const GAS f32x4* xr = (const GAS f32x4*)xrow + F.lane; const f32x4* gr = (const f32x4*)gain + F.lane;
    f32x4 v[4]; float s = 0.f;
#pragma unroll
    for (int j = 0; j < 4; ++j) { v[j] = xr[64 * j]; s += (v[j].x * v[j].x + v[j].y * v[j].y) + (v[j].z * v[j].z + v[j].w * v[j].w); }
    const float rs = 1.0f / sqrtf(wave_sum(s) * (1.f / DM) + EPS);
    GAS unsigned long long* o8 = (GAS unsigned long long*)orow + F.lane;
#pragma unroll
    for (int j = 0; j < 4; ++j) { const f32x4 g = gr[64 * j]; o8[64 * j] = (unsigned long long)pk2(v[j].x * rs * g.x, v[j].y * rs * g.y) | ((unsigned long long)pk2(v[j].z * rs * g.z, v[j].w * rs * g.w) << 32); }
}
__device__ __forceinline__ void p0_prologue(Frame& F) {
    LAS float* scr = (LAS float*)(F.lds + RING_OFF + F.wave * 16384);
    const int gw = (int)blockIdx.x * NWAVES + F.wave, NGW = F.G * NWAVES;
    constexpr int I_IN = (DM / 64) * (NIN / 32), I_BR = (512 / 64) * (DM / 32), I_O = (DM / 64) * (DM / 32), I_UP = (DM / 64) * (FF / 32), I_DN = (FF / 64) * (DM / 32);
    constexpr int NITEMS = I_IN + 2 * I_BR + I_O + I_UP + I_DN;
    for (int it = gw; it < NITEMS; it += NGW) {
        int r = it;
        if (r < I_IN) { const int nblk = NIN / 32, kb = r / nblk, nb = r % nblk, n0 = 32 * nb, nt = n0 & 255;
            int prow0 = (n0 & ~255) + 128 * ((nt >> 5) & 1) + 32 * (nt >> 6);
            if (n0 >= 2304) { const int isb = n0 >= 3328 ? 1 : 0, c0 = n0 - (isb ? 3328 : 2304); prow0 = 256 * (9 + (c0 >> 7)) + 128 * isb + 32 * ((c0 & 127) >> 5); }
            p0_transpose_item(F.w_in, NIN, F.WinT, DM, 0, prow0, scr, 64 * kb, n0, F.lane); continue; } r -= I_IN;
        if (r < I_BR) { const int nblk = DM / 32, kb = r / nblk, nb = r % nblk; p0_transpose_item(F.wba, DM, F.WbrT, DM, 0, 32 * nb, scr, 64 * kb, 32 * nb, F.lane); continue; } r -= I_BR;
        if (r < I_BR) { const int nblk = DM / 32, kb = r / nblk, nb = r % nblk; p0_transpose_item(F.wbb, DM, F.WbrT, DM, 512, 32 * nb, scr, 64 * kb, 32 * nb, F.lane); continue; } r -= I_BR;
        if (r < I_O)  { const int nblk = DM / 32, kb = r / nblk, nb = r % nblk; p0_transpose_item(F.w_out, DM, F.WoT, DM, 0, 32 * nb, scr, 64 * kb, 32 * nb, F.lane); continue; } r -= I_O;
        if (r < I_UP) { const int nblk = FF / 32, kb = r / nblk, nb = r % nblk; p0_transpose_item(F.w_up, FF, F.WupT, DM, 0, 32 * nb, scr, 64 * kb, 32 * nb, F.lane, F.norm_mlp); continue; } r -= I_UP;
        { const int nblk = DM / 32, kb = r / nblk, nb = r % nblk; p0_transpose_item(F.w_down, DM, F.WdnT, FF, 0, 32 * nb, scr, 64 * kb, 32 * nb, F.lane); }
    }
    {
        const f32x4* gr = (const f32x4*)F.norm_attn + F.lane; f32x4 g[4];
#pragma unroll
        for (int j = 0; j < 4; ++j) g[j] = gr[64 * j];
        for (int m = gw; m < M; m += 2 * NGW) { const int m2 = m + NGW;
            const GAS f32x4* xa = (const GAS f32x4*)(F.x + (size_t)m * DM) + F.lane; const GAS f32x4* xb = (const GAS f32x4*)(F.x + (size_t)m2 * DM) + F.lane;
            f32x4 va[4], vb[4]; float sa = 0.f, sb = 0.f;
#pragma unroll
            for (int j = 0; j < 4; ++j) { va[j] = xa[64 * j]; vb[j] = xb[64 * j]; }
#pragma unroll
            for (int j = 0; j < 4; ++j) { sa += (va[j].x * va[j].x + va[j].y * va[j].y) + (va[j].z * va[j].z + va[j].w * va[j].w); sb += (vb[j].x * vb[j].x + vb[j].y * vb[j].y) + (vb[j].z * vb[j].z + vb[j].w * vb[j].w); }
#pragma unroll
            for (int o = 1; o < 64; o <<= 1) { sa += __shfl_xor(sa, o); sb += __shfl_xor(sb, o); }
            const float ra = 1.0f / sqrtf(sa * (1.f / DM) + EPS), rb = 1.0f / sqrtf(sb * (1.f / DM) + EPS);
            GAS unsigned long long* oa = (GAS unsigned long long*)(grp_ptr(F.ws, m / GROWS, GO_XN, DM) + (size_t)m * DM) + F.lane;
            GAS unsigned long long* ob = (GAS unsigned long long*)(grp_ptr(F.ws, m2 / GROWS, GO_XN, DM) + (size_t)m2 * DM) + F.lane;
#pragma unroll
            for (int j = 0; j < 4; ++j) {
                oa[64 * j] = (unsigned long long)pk2(va[j].x * ra * g[j].x, va[j].y * ra * g[j].y) | ((unsigned long long)pk2(va[j].z * ra * g[j].z, va[j].w * ra * g[j].w) << 32);
                ob[64 * j] = (unsigned long long)pk2(vb[j].x * rb * g[j].x, vb[j].y * rb * g[j].y) | ((unsigned long long)pk2(vb[j].z * rb * g[j].z, vb[j].w * rb * g[j].w) << 32); }
        }
    }
}
__device__ __forceinline__ void sa_load32(const bf16* p, float (&d)[32]) {
#pragma unroll
    for (int i = 0; i < 4; ++i) { const v4u w = *(const GAS v4u*)(p + 8 * i);
        d[8 * i + 0] = __uint_as_float(w.x << 16); d[8 * i + 1] = __uint_as_float(w.x & 0xffff0000u); d[8 * i + 2] = __uint_as_float(w.y << 16); d[8 * i + 3] = __uint_as_float(w.y & 0xffff0000u);
        d[8 * i + 4] = __uint_as_float(w.z << 16); d[8 * i + 5] = __uint_as_float(w.z & 0xffff0000u); d[8 * i + 6] = __uint_as_float(w.w << 16); d[8 * i + 7] = __uint_as_float(w.w & 0xffff0000u); }
}
__device__ __forceinline__ void sa_store32(bf16* p, const float (&o)[32], float sc) {
#pragma unroll
    for (int i = 0; i < 4; ++i) { v4u w; w.x = pk2(o[8 * i] * sc, o[8 * i + 1] * sc); w.y = pk2(o[8 * i + 2] * sc, o[8 * i + 3] * sc); w.z = pk2(o[8 * i + 4] * sc, o[8 * i + 5] * sc); w.w = pk2(o[8 * i + 6] * sc, o[8 * i + 7] * sc);
        *(GAS v4u*)(p + 8 * i) = w; }
}
#define SA_KEY(KPTR, VPTR, BIAS, VALID) do { \
    float s_ = 0.f; \
    { float kv_[32]; sa_load32((KPTR) + dof, kv_); \
        _Pragma("unroll") for (int d_ = 0; d_ < 32; ++d_) s_ = __builtin_fmaf(q[d_], kv_[d_], s_); asm volatile("" ::: "memory"); } \
    s_ += __shfl_xor(s_, 1); \
    s_ += (BIAS); const bool ok_ = (VALID); const float se_ = ok_ ? s_ : -1e30f; \
    if (__any(se_ > m)) { const float mn_ = __builtin_fmaxf(m, se_); const float c_ = __builtin_amdgcn_exp2f(m - mn_); l *= c_; _Pragma("unroll") for (int d_ = 0; d_ < 32; ++d_) o[d_] *= c_; m = mn_; } \
    const float p_ = ok_ ? __builtin_amdgcn_exp2f(s_ - m) : 0.f; l += p_; \
    { float kv_[32]; sa_load32((VPTR) + dof, kv_); \
        _Pragma("unroll") for (int d_ = 0; d_ < 32; ++d_) o[d_] = __builtin_fmaf(p_, kv_[d_], o[d_]); asm volatile("" ::: "memory"); } } while (0)

__device__ __forceinline__ void sa_moba(const bf16* Q, const bf16* KA, const bf16* VA, const float* kmean, bf16* O, int b, int h, int t0, int lane) {
    const int dof = 32 * (lane & 1);
    const int t = t0 + (lane >> 1), own = t0 >> 8;
    float q[32]; sa_load32(Q + ((size_t)(b * SEQ + t)) * 1024 + h * 64 + dof, q);
    unsigned sel;
    if (own <= 3) sel = (1u << own) - 1u;
    else {
        float gs[7];
#pragma unroll
        for (int n = 0; n < 7; ++n) { gs[n] = -INFINITY;
            if (n < own) { const float* km = kmean + ((size_t)(b * 8 + n) * 8 + h) * 64 + dof; float s = 0.f;
#pragma unroll
                for (int d = 0; d < 32; d += 4) { const f32x4 kv = *(const GAS f32x4*)(km + d); s = __builtin_fmaf(q[d], kv.x, s); s = __builtin_fmaf(q[d + 1], kv.y, s); s = __builtin_fmaf(q[d + 2], kv.z, s); s = __builtin_fmaf(q[d + 3], kv.w, s); }
                s += __shfl_xor(s, 1);
                gs[n] = s; asm volatile("" ::: "memory"); } }
        sel = 0u;
#pragma unroll
        for (int n = 0; n < 7; ++n) { int rank = 0;
#pragma unroll
            for (int j = 0; j < 7; ++j) if (j != n) rank += (gs[j] > gs[n] || (gs[j] == gs[n] && j < n)) ? 1 : 0;
            if (n < own && rank < 3) sel |= 1u << n; }
    }
    const float slope2 = exp2f(-0.5f * (float)(h + 9)) * pg8::kLog2e;
    float m = -1e30f, l = 0.f, o[32];
#pragma unroll
    for (int d = 0; d < 32; ++d) o[d] = 0.f;
    for (int n = 0; n <= own; ++n) {
        const bool isown = (n == own), mine = isown || ((sel >> n) & 1u);
        if (!__any(mine)) continue;
        const int nk = isown ? (t0 + 32 - n * 256) : 256;
        for (int kk = 0; kk < nk; ++kk) { const int tk = n * 256 + kk; const size_t r = (size_t)(b * SEQ + tk) * 512 + h * 64;
            SA_KEY(KA + r, VA + r, -slope2 * (float)(t - tk), mine && (tk <= t)); }
    }
    sa_store32(O + ((size_t)(b * SEQ + t)) * 1024 + h * 64 + dof, o, 1.0f / l);
}
__device__ __forceinline__ void sa_swa(const bf16* Q, const bf16* KB, const bf16* VB, const float* sinks, bf16* O, int b, int hq, int t0, int lane) {
    const int dof = 32 * (lane & 1);
    const int t = t0 + (lane >> 1), kvh = hq >> 2;
    float q[32]; sa_load32(Q + ((size_t)(b * SEQ + t)) * 1024 + 512 + hq * 64 + dof, q);
    const float slope2 = exp2f(-0.5f * (float)(hq + 1)) * pg8::kLog2e, sink2 = sinks[hq] * pg8::kLog2e;
    float m = -1e30f, l = 0.f, o[32];
#pragma unroll
    for (int d = 0; d < 32; ++d) o[d] = 0.f;
    const int k0 = t0 - 127 > 0 ? t0 - 127 : 0;
    for (int tk = k0; tk < t0 + 32; ++tk) { const size_t r = (size_t)(b * SEQ + tk) * 128 + kvh * 64;
        SA_KEY(KB + r, VB + r, -slope2 * (float)(t - tk), (tk <= t) && (t - tk < 128)); }
    const float mf = __builtin_fmaxf(m, sink2), c = __builtin_amdgcn_exp2f(m - mf);
    l = l * c + __builtin_amdgcn_exp2f(sink2 - mf);
    sa_store32(O + ((size_t)(b * SEQ + t)) * 1024 + 512 + hq * 64 + dof, o, c / l);
}
__device__ __forceinline__ void attn_simple_phase(Frame& F) {
    const int gw = F.li * NWAVES + F.wave, NGW = 32 * NWAVES;
    int i = 0;
    for (int u = gw; u < 1024; u += NGW, ++i) { const int b = 2 * F.grp + (u >> 9), h = (u >> 6) & 7; int ch = u & 63; if (i & 1) ch = 63 - ch;
        sa_moba(F.Q, F.KA, F.VA, F.kmean, F.Q, b, h, ch * 32, F.lane); }
    for (int u = gw; u < 1024; u += NGW) { const int b = 2 * F.grp + (u >> 9), hq = (u >> 6) & 7, ch = u & 63;
        sa_swa(F.Q, F.KB, F.VB, F.sinks, F.Q, b, hq, ch * 32, F.lane); }
}

namespace fa {
using bf16x8 = __attribute__((ext_vector_type(8))) short;
using s16x4 = __attribute__((ext_vector_type(4))) short;
using f32x16 = __attribute__((ext_vector_type(16))) float;
using u32x4 = __attribute__((ext_vector_type(4))) unsigned;
using f32x4 = __attribute__((ext_vector_type(4))) float;
constexpr int NW = 8, QBLK = 32, KVBLK = 64;
constexpr int SLOTB = 8192, LDS_K = 0, LDS_V = 3 * SLOTB, LDS_WS = 6 * SLOTB, LDS_OST = LDS_WS + NW * 256, LDS_QN = LDS_OST + NW * 4096, LDS_BYTES = LDS_QN + NW * 4096;
constexpr int QP = 1024;
#ifndef FA_THR
#define FA_THR 8
#endif
#define SBAR() __builtin_amdgcn_sched_barrier(0)
#define PIN(x) asm volatile("" : "+v"(x))
#define MFMA(a, b, c) __builtin_amdgcn_mfma_f32_32x32x16_bf16(a, b, c, 0, 0, 0)
#define WAIT_BAR(N) asm volatile("s_waitcnt vmcnt(" #N ") lgkmcnt(0)\n\ts_barrier" ::: "memory")
__device__ __forceinline__ int crow(int r, int hi) { return (r & 3) + 8 * (r >> 2) + 4 * hi; }
__device__ __forceinline__ unsigned cvtpk(float lo, float hi) { unsigned r; asm("v_cvt_pk_bf16_f32 %0, %1, %2" : "=v"(r) : "v"(lo), "v"(hi)); return r; }
__device__ __forceinline__ void glds16(const void* g, unsigned lds_base) {
    unsigned sv; asm volatile("s_mov_b32 %0, m0\n\ts_mov_b32 m0, %2\n\ts_nop 0\n\tglobal_load_lds_dwordx4 %1, off\n\ts_mov_b32 m0, %0" : "=&s"(sv) : "v"(g), "s"(lds_base) : "memory"); }
typedef __attribute__((address_space(3))) const char* lds_cptr;
typedef short v4i16_t __attribute__((ext_vector_type(4)));
__device__ __forceinline__ void kload2(bf16x8* kf, lds_cptr kp, int d0) { kf[2 * d0] = *(const __attribute__((address_space(3))) bf16x8*)(kp + d0 * 2048); kf[2 * d0 + 1] = *(const __attribute__((address_space(3))) bf16x8*)(kp + d0 * 2048 + 512); }
__device__ __forceinline__ s16x4 vtr(lds_cptr p) { return __builtin_bit_cast(s16x4, __builtin_amdgcn_ds_read_tr16_b64_v4i16((__attribute__((address_space(3))) v4i16_t*)p)); }
#define MX3(a, b, c) __builtin_fmaxf(__builtin_fmaxf((a), (b)), (c))
__device__ __forceinline__ float rowmax(const f32x16& p0, const f32x16& p1) {
    float a = MX3(p0[0], p0[1], p1[0]), b = MX3(p0[2], p0[3], p1[1]); a = MX3(a, p1[2], p1[3]);
#pragma unroll
    for (int r = 4; r < 16; r += 4) { a = MX3(a, p0[r], p0[r + 1]); b = MX3(b, p0[r + 2], p0[r + 3]); a = MX3(a, p1[r], p1[r + 1]); b = MX3(b, p1[r + 2], p1[r + 3]); }
    float m = __builtin_fmaxf(a, b); auto rr = __builtin_amdgcn_permlane32_swap(__float_as_uint(m), __float_as_uint(m), false, false);
    return __builtin_fmaxf(__uint_as_float(rr[0]), __uint_as_float(rr[1])); }
__device__ __forceinline__ void emask(f32x16& p0, f32x16& p1, int dq  , unsigned wd) {
#pragma unroll
    for (int r = 0; r < 16; ++r) { const int kv = (r & 3) + 8 * (r >> 2); if ((unsigned)(dq - kv) >= wd) p0[r] = -INFINITY; if ((unsigned)(dq - kv - 32) >= wd) p1[r] = -INFINITY; } }
__device__ __forceinline__ unsigned bf16bits(float f) { unsigned u = __float_as_uint(f); return (u + 0x7fffu + ((u >> 16) & 1u)) >> 16; }

struct AU {
    const bf16* Qw;
    bf16* Ow;
    const bf16* Kb;
    const bf16* Vb;
    int KP;
    int q0;
    int qrel0;
    int NT;
    int mode;
    unsigned wd;
    float slope2;
    float sink2;
    unsigned okmask;
    const float* km;
    int gj;
};
__device__ __forceinline__ int key_rel(const AU& u, int t) {
    if (u.mode == 0) { const int np = u.NT - 4; return t == 0 ? 0 : (t <= np ? 64 * (t - 1) - 64 * np : 64 * (t - np)); }
    return -64 * t;
}
__device__ __forceinline__ int attn_unit(const AU& u, const AU& n, bool has_next, bool pre, int s0, char* lds) {
    const int tid = threadIdx.x; int lane = tid & 63; asm volatile("" : "+v"(lane));
    const int r32 = lane & 31, hi = lane >> 5; const int wid = __builtin_amdgcn_readfirstlane(tid >> 6);
    const int NT = u.NT, KP = u.KP;
    const unsigned lds0 = (unsigned)(uintptr_t)lds; float* wsf = (float*)(lds + LDS_WS) + wid * 64;
    const bf16* ksrc = u.Kb + (long)lane * KP + wid * 8;
    const bf16* vsrc = u.Vb + (long)(16 * (wid & 3) + (lane >> 2)) * KP + (wid >> 2) * 32 + (lane & 3) * 8;
    const unsigned kdst = lds0 + LDS_K + wid * 1024, vdst = lds0 + LDS_V + wid * 1024;
#define KROW(t) ({ int r_ = u.q0 + key_rel(u, (t)); r_ < 0 ? 0 : r_; })
#define DMA_K(t, slot) glds16(ksrc + (long)KROW(t) * KP, (unsigned)__builtin_amdgcn_readfirstlane(kdst + (slot)))
#define DMA_V(t, slot) glds16(vsrc + (long)KROW(t) * KP, (unsigned)__builtin_amdgcn_readfirstlane(vdst + (slot)))
    const lds_cptr vp0 = (lds_cptr)lds + LDS_V + ((lane >> 4) & 1) * 32 + (lane & 3) * 8 + (4 * hi + ((lane & 15) >> 2)) * 64;
    const lds_cptr kp0 = (lds_cptr)lds + LDS_K + hi * 1024 + r32 * 16;
    const int sA = s0, sB = (sA == 2 * SLOTB) ? 0 : sA + SLOTB, sC = (sB == 2 * SLOTB) ? 0 : sB + SLOTB;
    const lds_cptr qn0 = (lds_cptr)lds + LDS_QN + wid * 4096;
    bf16x8 qr[4];
    if (!pre) {
        DMA_K(0, sA); DMA_V(0, sA); DMA_K(1, sB);
#pragma unroll
        for (int d0 = 0; d0 < 4; ++d0) qr[d0] = *reinterpret_cast<const bf16x8*>(&u.Qw[(long)r32 * QP + d0 * 16 + hi * 8]);
    } else {
        asm volatile("s_waitcnt vmcnt(7)" ::: "memory");
#pragma unroll
        for (int d0 = 0; d0 < 4; ++d0) qr[d0] = *(const __attribute__((address_space(3))) bf16x8*)(qn0 + r32 * 128 + d0 * 32 + hi * 16);
    }
    bf16x8 qaug, kaug0, kaug1;
    { const unsigned sh = bf16bits(u.slope2); const float rem = u.slope2 - __uint_as_float(sh << 16); const unsigned sl = bf16bits(rem);
      const unsigned Sh = bf16bits(64.f * __uint_as_float(sh << 16)), Sl = bf16bits(64.f * __uint_as_float(sl << 16));
      u32x4 w = {hi ? 0u : (sh | (sl << 16)), hi ? 0u : (Sh | (Sl << 16)), 0u, 0u}; qaug = __builtin_bit_cast(bf16x8, w);
      const unsigned k0b = bf16bits((float)r32), k1b = bf16bits((float)(r32 + 32));
      u32x4 a0 = {k0b | (k0b << 16), 0u, 0u, 0u}, a1 = {k1b | (k1b << 16), 0u, 0u, 0u}; kaug0 = __builtin_bit_cast(bf16x8, a0); kaug1 = __builtin_bit_cast(bf16x8, a1); }
#define SET_TILE(t) do { const unsigned tb_ = bf16bits((float)(key_rel(u, (t)) >> 6)); const unsigned tw_ = tb_ | (tb_ << 16); \
      u32x4 a0_ = __builtin_bit_cast(u32x4, kaug0), a1_ = __builtin_bit_cast(u32x4, kaug1); a0_[1] = tw_; a1_[1] = tw_; kaug0 = __builtin_bit_cast(bf16x8, a0_); kaug1 = __builtin_bit_cast(bf16x8, a1_); } while (0)
    unsigned okmask = u.okmask;
    if (u.gj >= 4) {
        float gs[7];
#pragma unroll
        for (int n = 0; n < 7; ++n) { gs[n] = -INFINITY;
            if (n < u.gj) { const float* km = u.km + 512 * n + 8 * hi; float sg = 0.f;
#pragma unroll
                for (int d0 = 0; d0 < 4; ++d0) { const f32x4 k0 = *(const f32x4*)(km + 16 * d0), k1 = *(const f32x4*)(km + 16 * d0 + 4);
#define QF(e) __uint_as_float(((unsigned)(unsigned short)qr[d0][e]) << 16)
                    sg = __builtin_fmaf(QF(0), k0.x, sg); sg = __builtin_fmaf(QF(1), k0.y, sg); sg = __builtin_fmaf(QF(2), k0.z, sg); sg = __builtin_fmaf(QF(3), k0.w, sg);
                    sg = __builtin_fmaf(QF(4), k1.x, sg); sg = __builtin_fmaf(QF(5), k1.y, sg); sg = __builtin_fmaf(QF(6), k1.z, sg); sg = __builtin_fmaf(QF(7), k1.w, sg);
#undef QF
                }
                sg += __shfl_xor(sg, 32); gs[n] = sg; } }
        unsigned ok = 1u | (7u << (NT - 3));
#pragma unroll
        for (int n = 0; n < 7; ++n) { int rank = 0;
#pragma unroll
            for (int k = 0; k < 7; ++k) if (k != n) rank += (gs[k] > gs[n] || (gs[k] == gs[n] && k < n)) ? 1 : 0;
            if (n < u.gj && rank < 3) ok |= 0xFu << (1 + 4 * n); }
        okmask = ok;
    }
    float mhat = 0.f, l_reg = 0.f; f32x16 o[2]; o[0] = f32x16{}; o[1] = f32x16{};
    const int qrel = u.qrel0 + r32; bool resc = false; const unsigned wd = u.wd;
    f32x16 cin; bool okp = true;
#define SETCIN(okv) do { const float cv_ = (okv) ? -mhat : -INFINITY; _Pragma("unroll") for (int r_ = 0; r_ < 16; ++r_) cin[r_] = cv_; PIN(cin); } while (0)
    f32x16 pA0, pA1, pB0, pB1; bf16x8 kf[8]; s16x4 vlo[8], vhi[8]; u32x4 pw0, pw1, pw2, pw3;
    int sl_prev = sA, sl_cur = sA, sl_next = sB;
#define ROT() do { sl_prev = sl_cur; sl_cur = sl_next; sl_next = (sl_next == 2 * SLOTB) ? 0 : sl_next + SLOTB; } while (0)
#define EX(v) __builtin_amdgcn_exp2f(v)
#define RESC() do { if (resc) { _Pragma("unroll") for (int d_ = 0; d_ < 2; ++d_) _Pragma("unroll") for (int r = 0; r < 16; ++r) o[d_][r] *= wsf[crow(r, hi)]; } } while (0)
    if (!pre) { DMA_K(2, sC); WAIT_BAR(3); } else { WAIT_BAR(7); }
    _Pragma("unroll") for (int d0 = 0; d0 < 4; ++d0) kload2(kf, kp0 + sA, d0);
    SET_TILE(0);
    pA0 = MFMA(kaug0, qaug, f32x16{}); pA1 = MFMA(kaug1, qaug, f32x16{});
    pA0 = MFMA(kf[0], qr[0], pA0); pA1 = MFMA(kf[1], qr[0], pA1); pA0 = MFMA(kf[2], qr[1], pA0); pA1 = MFMA(kf[3], qr[1], pA1);
    pA0 = MFMA(kf[4], qr[2], pA0); pA1 = MFMA(kf[5], qr[2], pA1); pA0 = MFMA(kf[6], qr[3], pA0); pA1 = MFMA(kf[7], qr[3], pA1);
    emask(pA0, pA1, qrel - key_rel(u, 0) - 4 * hi, wd);
    { const float rm = rowmax(pA0, pA1); mhat = rm;
#pragma unroll
      for (int r = 0; r < 16; ++r) { pA0[r] = EX(pA0[r] - rm); pA1[r] = EX(pA1[r] - rm); }
      SETCIN(true); }
    WAIT_BAR(0);
    DMA_K(3, sA); DMA_V(1, sB); ROT();
    _Pragma("unroll") for (int d0 = 0; d0 < 4; ++d0) kload2(kf, kp0 + sl_cur, d0);
    WAIT_BAR(2);
#define PKW(P, i) cvtpk(P[i], P[i + 1])
#define PAF(k) __builtin_bit_cast(bf16x8, pw##k)
#define VFR(i) (bf16x8){vlo[i][0], vlo[i][1], vlo[i][2], vlo[i][3], vhi[i][0], vhi[i][1], vhi[i][2], vhi[i][3]}
#define VRD(i) do { vlo[i] = vtr(vp_ + (((i) >> 2) * 4096 + ((i) & 3) * 1024)); vhi[i] = vtr(vp_ + (((i) >> 2) * 4096 + ((i) & 3) * 1024 + 512)); } while (0)
#define KRD(G, d0) do { if (G) { kload2(kf, kp0 + sl_next, d0); SBAR(); } } while (0)
#define GAPA(MF, a0, a1, a2, a3, W0, W1, PW) do { MF; sacc += a0; sacc += a1; sacc += a2; sacc += a3; W0; W1; PIN(PW); PIN(sacc); SBAR(); } while (0)
#define GAPB(MF, X, i) do { MF; X[i] = EX(X[i]); X[i + 1] = EX(X[i + 1]); X[i + 2] = EX(X[i + 2]); X[i + 3] = EX(X[i + 3]); PIN(X); SBAR(); } while (0)
#define STEP(C0, C1, P0, P1, t, MASK, GK, GV, GL) do { SBAR(); \
    const lds_cptr vp_ = vp0 + sl_prev; SET_TILE(t); \
    const bool ok_ = (okmask >> (t)) & 1u; \
    if (__any(ok_ != okp)) { SETCIN(ok_); okp = ok_; } \
    C0 = MFMA(kaug0, qaug, cin); C1 = MFMA(kaug1, qaug, cin); SBAR(); \
    VRD(0); SBAR(); float sacc = P0[0] + P0[1]; \
                    GAPA(C0 = MFMA(kf[0], qr[0], C0), P0[2], P0[3], P0[4], P0[5],     pw0[0] = PKW(P0, 0),  pw0[1] = PKW(P0, 2),  pw0); \
    VRD(4); SBAR(); GAPA(C1 = MFMA(kf[1], qr[0], C1), P0[6], P0[7], P0[8], P0[9],     pw0[2] = PKW(P0, 4),  pw0[3] = PKW(P0, 6),  pw0); \
    VRD(1); SBAR(); GAPA(C0 = MFMA(kf[2], qr[1], C0),    P0[10], P0[11], P0[12], P0[13], pw1[0] = PKW(P0, 8),  pw1[1] = PKW(P0, 10), pw1); \
    VRD(5); SBAR(); GAPA(C1 = MFMA(kf[3], qr[1], C1),    P0[14], P0[15], P1[0], P1[1],   pw1[2] = PKW(P0, 12), pw1[3] = PKW(P0, 14), pw1); \
    VRD(2); SBAR(); GAPA(C0 = MFMA(kf[4], qr[2], C0),    P1[2], P1[3], P1[4], P1[5],     pw2[0] = PKW(P1, 0),  pw2[1] = PKW(P1, 2),  pw2); \
    VRD(6); SBAR(); GAPA(C1 = MFMA(kf[5], qr[2], C1),    P1[6], P1[7], P1[8], P1[9],     pw2[2] = PKW(P1, 4),  pw2[3] = PKW(P1, 6),  pw2); \
    VRD(3); SBAR(); GAPA(C0 = MFMA(kf[6], qr[3], C0),    P1[10], P1[11], P1[12], P1[13], pw3[0] = PKW(P1, 8),  pw3[1] = PKW(P1, 10), pw3); \
    VRD(7); SBAR(); GAPA(C1 = MFMA(kf[7], qr[3], C1),    P1[14], P1[15], 0.f, 0.f,       pw3[2] = PKW(P1, 12), pw3[3] = PKW(P1, 14), pw3); \
    l_reg += sacc; \
    if (GK) DMA_K((t) + 3, sl_cur); if (GV) DMA_V((t) + 1, sl_next); \
    if (MASK) { if (u.mode == 1 || (t) > NT - 4) emask(C0, C1, qrel - key_rel(u, (t)) - 4 * hi, wd); }            \
    { const float rm = rowmax(C0, C1); resc = false;                                                    \
      if (__builtin_expect(__any(rm > (float)FA_THR), 0)) { const float dl = __builtin_fmaxf(rm, 0.f); mhat += dl; \
          _Pragma("unroll") for (int r = 0; r < 16; ++r) { C0[r] -= dl; C1[r] -= dl; } SETCIN(ok_); \
          const float f = __builtin_amdgcn_exp2f(-dl); l_reg *= f; if (hi == 0) wsf[r32] = f; resc = true; } } \
    SBAR(); \
    GAPB(o[0] = MFMA(PAF(0), VFR(0), o[0]), C0, 0);              GAPB(o[1] = MFMA(PAF(0), VFR(4), o[1]), C0, 4); \
    KRD(GL, 0); GAPB(o[0] = MFMA(PAF(1), VFR(1), o[0]), C0, 8);  KRD(GL, 1); GAPB(o[1] = MFMA(PAF(1), VFR(5), o[1]), C0, 12); \
    KRD(GL, 2); GAPB(o[0] = MFMA(PAF(2), VFR(2), o[0]), C1, 0);  KRD(GL, 3); GAPB(o[1] = MFMA(PAF(2), VFR(6), o[1]), C1, 4); \
    GAPB(o[0] = MFMA(PAF(3), VFR(3), o[0]), C1, 8);              GAPB(o[1] = MFMA(PAF(3), VFR(7), o[1]), C1, 12); \
    } while (0)
    int t = 1;
    for (; t + 5 < NT; t += 2) {
        STEP(pB0, pB1, pA0, pA1, t, false, true, true, true);     WAIT_BAR(2); RESC(); ROT();
        STEP(pA0, pA1, pB0, pB1, t + 1, false, true, true, true); WAIT_BAR(2); RESC(); ROT();
    }
#define ENDW(tt) do { if ((tt) + 3 < NT) { WAIT_BAR(2); } else if ((tt) + 2 < NT) { WAIT_BAR(1); } else { WAIT_BAR(0); } } while (0)
    for (; t + 1 < NT; t += 2) {
        STEP(pB0, pB1, pA0, pA1, t, true, (t + 3 < NT), (t + 1 < NT), (t + 1 < NT));         ENDW(t);     RESC(); ROT();
        STEP(pA0, pA1, pB0, pB1, t + 1, true, (t + 4 < NT), (t + 2 < NT), (t + 2 < NT));     ENDW(t + 1); RESC(); ROT();
    }
    int s_ret = 0;
    if (has_next) {
        const int n0 = sl_next, n1 = (n0 == 2 * SLOTB) ? 0 : n0 + SLOTB, n2 = (n1 == 2 * SLOTB) ? 0 : n1 + SLOTB; s_ret = n0;
        const bf16* ks2 = n.Kb + (long)lane * n.KP + wid * 8;
        const bf16* vs2 = n.Vb + (long)(16 * (wid & 3) + (lane >> 2)) * n.KP + (wid >> 2) * 32 + (lane & 3) * 8;
#define NROW(t) ({ int r_ = n.q0 + key_rel(n, (t)); r_ < 0 ? 0 : r_; })
        glds16(ks2 + (long)NROW(0) * n.KP, (unsigned)__builtin_amdgcn_readfirstlane(kdst + n0));
        const bf16* qs2 = n.Qw + (long)(lane >> 3) * QP + (lane & 7) * 8; const unsigned qdst = lds0 + LDS_QN + wid * 4096;
#pragma unroll
        for (int k = 0; k < 4; ++k) glds16(qs2 + (long)(8 * k) * QP, (unsigned)__builtin_amdgcn_readfirstlane(qdst + k * 1024));
        glds16(vs2 + (long)NROW(0) * n.KP, (unsigned)__builtin_amdgcn_readfirstlane(vdst + n0));
        glds16(ks2 + (long)NROW(1) * n.KP, (unsigned)__builtin_amdgcn_readfirstlane(kdst + n1));
        glds16(ks2 + (long)NROW(2) * n.KP, (unsigned)__builtin_amdgcn_readfirstlane(kdst + n2));
#undef NROW
    }
    STEP(pB0, pB1, pA0, pA1, NT - 1, true, false, false, false); RESC();
    { float sacc = pB0[0] + pB0[1];
#pragma unroll
      for (int r = 2; r < 16; ++r) sacc += pB0[r];
#pragma unroll
      for (int r = 0; r < 16; ++r) sacc += pB1[r];
      l_reg += sacc;
      pw0 = (u32x4){PKW(pB0, 0), PKW(pB0, 2), PKW(pB0, 4), PKW(pB0, 6)}; pw1 = (u32x4){PKW(pB0, 8), PKW(pB0, 10), PKW(pB0, 12), PKW(pB0, 14)};
      pw2 = (u32x4){PKW(pB1, 0), PKW(pB1, 2), PKW(pB1, 4), PKW(pB1, 6)}; pw3 = (u32x4){PKW(pB1, 8), PKW(pB1, 10), PKW(pB1, 12), PKW(pB1, 14)};
      const lds_cptr vp_ = vp0 + sl_cur; _Pragma("unroll") for (int i = 0; i < 8; ++i) VRD(i);
      o[0] = MFMA(PAF(0), VFR(0), o[0]); o[1] = MFMA(PAF(0), VFR(4), o[1]); o[0] = MFMA(PAF(1), VFR(1), o[0]); o[1] = MFMA(PAF(1), VFR(5), o[1]);
      o[0] = MFMA(PAF(2), VFR(2), o[0]); o[1] = MFMA(PAF(2), VFR(6), o[1]); o[0] = MFMA(PAF(3), VFR(3), o[0]); o[1] = MFMA(PAF(3), VFR(7), o[1]); }
    { auto rr = __builtin_amdgcn_permlane32_swap(__float_as_uint(l_reg), __float_as_uint(l_reg), false, false); l_reg = __uint_as_float(rr[0]) + __uint_as_float(rr[1]); }
    {
      const float sk = u.sink2 + u.slope2 * (float)qrel, mf = __builtin_fmaxf(mhat, sk), c = __builtin_amdgcn_exp2f(mhat - mf);
      const float lt = l_reg * c + __builtin_amdgcn_exp2f(sk - mf);
      if (hi == 0) wsf[32 + r32] = c * __builtin_amdgcn_rcpf(lt); }
    asm volatile("s_waitcnt lgkmcnt(0)" ::: "memory");
    float rli[16];
#pragma unroll
    for (int r = 0; r < 16; ++r) rli[r] = wsf[32 + crow(r, hi)];
    bf16* stg = (bf16*)(lds + LDS_OST) + wid * 2048;
    { int l2 = lane; asm volatile("" : "+v"(l2)); const int r32b = l2 & 31, hib = l2 >> 5;
#pragma unroll
    for (int r = 0; r < 16; ++r) { const int orow = crow(r, hib);
#pragma unroll
        for (int d0 = 0; d0 < 2; ++d0) stg[orow * 64 + d0 * 32 + r32b] = (bf16)bf16bits(o[d0][r] * rli[r]); }
    asm volatile("s_waitcnt lgkmcnt(0)" ::: "memory");
    const int srow = l2 >> 3, ch = l2 & 7; const u32x4* sp = (const u32x4*)(stg + srow * 64 + ch * 8); bf16* gp = u.Ow + (long)srow * QP + ch * 8;
#pragma unroll
    for (int i = 0; i < 4; ++i) *(u32x4*)(gp + (long)i * 8 * QP) = sp[i * 64]; }
    asm volatile("s_waitcnt lgkmcnt(0)\n\ts_barrier" ::: "memory");
    return s_ret;
#undef KROW
#undef DMA_K
#undef DMA_V
#undef SET_TILE
#undef SETCIN
#undef ROT
#undef EX
#undef RESC
#undef PKW
#undef PAF
#undef VFR
#undef VRD
#undef KRD
#undef ENDW
#undef GAPA
#undef GAPB
#undef STEP
}
#undef SBAR
#undef PIN
#undef MFMA
#undef WAIT_BAR
#undef MX3
}

__device__ __forceinline__ float bfbits2f(short s) { return __uint_as_float(((unsigned)(unsigned short)s) << 16); }
__device__ __forceinline__ fa::AU attn_make_unit(const Frame& F, bf16* O, int i, float sink2w) {
    const int wid = F.wave; fa::AU u;
    const bool moba = i < 4;
    const int p = F.vcu >> 1, bm = p >> 3, h = p & 7, half = F.vcu & 1, im = i & 3;
    const int j = half ? (im == 0 ? 6 : im == 1 ? 5 : im == 2 ? 2 : 1) : (im == 0 ? 7 : im == 1 ? 4 : im == 2 ? 3 : 0);
    const int k = i - 4, us = (k < 4) ? F.vcu * 4 + k : (F.vcu - 16) * 4 + (k - 2), bs = us >> 6, kvh = (us >> 5) & 1, c = us & 31, hq = kvh * 4 + (wid >> 1);
    const int b = moba ? bm : bs;
    const size_t rowbase = (size_t)b * SEQ;
    const size_t qoff = moba ? (rowbase + 256 * j + 32 * wid) * 1024 + h * 64 : (rowbase + 64 * c + 32 * (wid & 1)) * 1024 + 512 + hq * 64;
    u.Kb = moba ? F.KA + rowbase * 512 + h * 64 : F.KB + rowbase * 128 + kvh * 64;
    u.Vb = moba ? F.VA + rowbase * 512 + h * 64 : F.VB + rowbase * 128 + kvh * 64;
    u.KP = moba ? 512 : 128;
    u.q0 = moba ? 256 * j : 64 * c; u.qrel0 = moba ? 32 * wid : 32 * (wid & 1); u.NT = moba ? 4 * (j + 1) : 4; u.mode = moba ? 0 : 1; u.wd = moba ? 0x40000000u : 128u;
    u.slope2 = exp2f(-0.5f * (float)(moba ? h + 9 : hq + 1)) * pg8::kLog2e; u.sink2 = moba ? -INFINITY : sink2w;
    const unsigned okm = 1u | (7u << (4 * (j + 1) - 3)) | (j <= 3 ? ((1u << (4 * j)) - 1u) << 1 : 0u);
    const unsigned oks = (c >= 3) ? 0xFu : ((1u << (c + 1)) - 1u);
    u.okmask = moba ? okm : oks;
    u.km = F.kmean + ((size_t)(bm * 8) * 8 + h) * 64; u.gj = moba ? j : 0;
    u.Qw = F.Q + qoff; u.Ow = O + qoff;
    return u;
}
__device__ __forceinline__ void attn_fast_phase(Frame& F, char* lds, bf16* O) {
    const float sink2w = F.sinks[(((F.vcu * 4) >> 5) & 1) * 4 + (F.wave >> 1)] * pg8::kLog2e;
    const int nun = (F.li < 16) ? 6 : 10;
    fa::AU cur = attn_make_unit(F, O, 0, sink2w); int s0 = 0; bool pre = false;
    for (int i = 0; i < nun; ++i) {
        const bool has_next = i + 1 < nun;
        const fa::AU nxt = attn_make_unit(F, O, has_next ? i + 1 : i, sink2w);
        s0 = fa::attn_unit(cur, nxt, has_next, pre, s0, lds);
        pre = has_next; cur = nxt;
    }
}
#if defined(DBG_ATTN)
__device__ __forceinline__ void dbg_compare(Frame& F, const bf16* Od) {
    const int gt = F.li * NWAVES * 64 + F.tid, NGT = 32 * NWAVES * 64; float num = 0.f, den = 0.f;
    for (size_t i = gt; i < (size_t)GROWS * 64; i += NGT) { const size_t row = (size_t)F.grp * GROWS + (i >> 6), c8 = i & 63; const size_t off = row * 1024 + DBG_PART * 512 + c8 * 8;
        const v4u a = *(const GAS v4u*)(Od + off), r = *(const GAS v4u*)(F.Q + off);
#define DD(x) { const float a0 = __uint_as_float(a.x << 16), a1 = __uint_as_float(a.x & 0xffff0000u), r0 = __uint_as_float(r.x << 16), r1 = __uint_as_float(r.x & 0xffff0000u); num += (a0 - r0) * (a0 - r0) + (a1 - r1) * (a1 - r1); den += r0 * r0 + r1 * r1; }
        DD(x) DD(y) DD(z) DD(w)
#undef DD
    }
    num = wave_sum(num); den = wave_sum(den);
    if (F.lane == 0) { atomicAdd((float*)(F.ctl) + 8, num); atomicAdd((float*)(F.ctl) + 9, den); }
}
#endif

struct Args { const float* in[14]; float* out; unsigned char* ws; };
__global__ void __launch_bounds__(NWAVES * 64, 2) fwd_megakernel(Args args) {
    extern __shared__ __attribute__((aligned(16))) unsigned char lds[];
    Frame F;
    F.lds = (LAS unsigned char*)lds;
    F.MISC = (volatile LAS unsigned*)(F.lds + MISC_OFF);
    F.tid = threadIdx.x; F.lane = F.tid & 63; F.wave = __builtin_amdgcn_readfirstlane(F.tid >> 6);
    F.G = gridDim.x;
    unsigned char* ws = args.ws; F.ws = ws;
    F.ctl = (gu32*)(ws + WS_CTL);
    F.x = args.in[0]; F.norm_attn = args.in[1]; F.w_in = args.in[2]; F.qna = args.in[3]; F.kna = args.in[4]; F.qnb = args.in[5]; F.knb = args.in[6]; F.sinks = args.in[7];
    F.wba = args.in[8]; F.wbb = args.in[9]; F.w_out = args.in[10]; F.norm_mlp = args.in[11]; F.w_up = args.in[12]; F.w_down = args.in[13]; F.out = args.out;
    F.WinT = (bf16*)(ws + WS_WIN); F.WbrT = (bf16*)(ws + WS_WBR); F.WoT = (bf16*)(ws + WS_WO); F.WupT = (bf16*)(ws + WS_WUP); F.WdnT = (bf16*)(ws + WS_WDN);
    F.kmean = (float*)(ws + WS_CTL) + CW_KMEAN; F.rowsq = (float*)(ws + WS_CTL) + CW_ROWSQ;
    for (int u = F.tid; u < (LDS_BYTES - LDSCTL_OFF) / 4; u += NWAVES * 64) ((LAS unsigned*)(F.lds + LDSCTL_OFF))[u] = 0u;
    __syncthreads();
    XcdBarrier bar = xcd_barrier_post((unsigned*)(F.ctl + CW_BAR), F.MISC + 8);
    if (F.tid == 0) F.MISC[12] = xb_add((unsigned*)(F.ctl + CW_CENSUS) + 64 * bar.x, 1u);
    __syncthreads();
    const unsigned my_arrival = F.MISC[12];
#define GRID_BAR() xcd_barrier(bar)

#ifndef SKIP_P0
    p0_prologue(F);
#endif
    GRID_BAR();
    {   bool ok = (F.G == 256);
        for (int j = 0; j < 16; ++j) { const unsigned c = __hip_atomic_load((unsigned*)(F.ctl + CW_CENSUS) + 64 * j, RLX_AGENT); ok = ok && (c == (j < NGRP ? 32u : 0u)); }
        F.grouped = ok ? 1 : 0;
        if (ok) { F.grp = (int)bar.x; F.li = (int)my_arrival; }
        else    { F.grp = (int)blockIdx.x % NGRP; F.li = (int)blockIdx.x / NGRP; }
        F.grp = __builtin_amdgcn_readfirstlane(F.grp); F.li = __builtin_amdgcn_readfirstlane(F.li);
        F.vcu = F.grp * 32 + F.li; }
    const int vbid = F.li * NGRP + F.grp;
    F.Q = grp_ptr(ws, F.grp, GO_Q, 1024); F.KA = grp_ptr(ws, F.grp, GO_KA, 512); F.VA = grp_ptr(ws, F.grp, GO_VA, 512); F.KB = grp_ptr(ws, F.grp, GO_KB, 128); F.VB = grp_ptr(ws, F.grp, GO_VB, 128);
    F.GA = grp_ptr(ws, F.grp, GO_GA, 1024); F.GB = grp_ptr(ws, F.grp, GO_GB, 1024); F.HB = grp_ptr(ws, F.grp, GO_H, 4096); F.A2 = grp_ptr(ws, F.grp, GO_A2, 1024); F.XN = grp_ptr(ws, F.grp, GO_XN, 1024);
    GroupBar gbar{(unsigned*)(F.ctl + CW_GSUB) + 64 * F.grp, (unsigned*)(F.ctl + CW_GGEN) + 64 * F.grp, (unsigned*)(F.ctl + CW_BAR)};
#define GROUP_BAR() do { if (F.grouped) group_barrier(gbar); else xcd_barrier(bar); } while (0)
#ifndef SKIP_P1
    {   pg8::Gemm g{F.XN, F.WinT, M, NIN, DM}; pg8::StaticOrder S; S.init(M, NIN, F.G, vbid);
        pg8::EpiIn E{F.Q, F.KA, F.VA, F.KB, F.VB, F.GA, F.GB, F.qna, F.kna, F.qnb, F.knb, F.kmean};
        S.ilim = 8;
        pg8::gemm_phase<pg8::EpiIn, pg8::StaticOrder, true, true>(F.lds + RING_OFF, g, S, E);
        GROUP_BAR();
        if (F.li < 16) { S.ioff = 8; S.ilim = 1; pg8::gemm_phase<pg8::EpiIn, pg8::StaticOrder, true, true>(F.lds + RING_OFF, g, S, E); } }
#endif
#if defined(DBG_ATTN)
    attn_fast_phase(F, (char*)lds + RING_OFF, F.XN); GROUP_BAR(); attn_simple_phase(F); GROUP_BAR(); dbg_compare(F, F.XN);
#elif defined(SIMPLE_ATTN)
    attn_simple_phase(F);
#else
    attn_fast_phase(F, (char*)lds + RING_OFF, F.Q);
#endif
    GROUP_BAR();
#ifndef SKIP_P3
    {   pg8::Gemm g{F.Q, F.WbrT, M, DM, DM}; pg8::StaticOrder S; S.init(M, DM, F.G, vbid);
        pg8::EpiMix E{F.GA, F.GB, F.XN};
        pg8::gemm_phase<pg8::EpiMix, pg8::StaticOrder, true, true>(F.lds + RING_OFF, g, S, E); }
#endif
    GROUP_BAR();
#ifndef SKIP_P4
    {   pg8::Gemm g{F.XN, F.WoT, M, DM, DM}; pg8::StaticOrder S; S.init(M, DM, F.G, vbid);
        pg8::EpiX1 E{F.x, F.A2, F.rowsq};
        pg8::gemm_phase<pg8::EpiX1, pg8::StaticOrder, true, true>(F.lds + RING_OFF, g, S, E); }
#endif
    GROUP_BAR();
#ifndef SKIP_P5
    {   pg8::Gemm g{F.A2, F.WupT, M, FF, DM}; pg8::StaticOrder S; S.init(M, FF, F.G, vbid);
        pg8::EpiUp E{F.HB, F.rowsq};
        pg8::gemm_phase<pg8::EpiUp, pg8::StaticOrder, true, true>(F.lds + RING_OFF, g, S, E); }
#endif
    GROUP_BAR();
#ifndef SKIP_P6
    {   pg8::Gemm g{F.HB, F.WdnT, M, DM, FF}; pg8::StaticOrder S; S.init(M, DM, F.G, vbid);
#if defined(DBG_ATTN)
        const float dnum = ((const GAS float*)F.ctl)[8], dden = ((const GAS float*)F.ctl)[9];
        pg8::EpiDown E{F.A2, F.out, 1.0f + 100.0f * sqrtf(dnum / dden)};
#else
        pg8::EpiDown E{F.A2, F.out, 1.0f};
#endif
        pg8::gemm_phase<pg8::EpiDown, pg8::StaticOrder, true, true>(F.lds + RING_OFF, g, S, E); }
#endif
}

extern "C" void kernel_launch(void* const* d_in, const int* in_sizes, int n_in, void* d_out, int out_size, void* d_ws, size_t ws_size, hipStream_t stream) {
    static int grid = 0;
    if (grid == 0) {
        if (n_in != 14 || in_sizes[0] != M * DM || out_size != M * DM || ws_size < WS_END) { fprintf(stderr, "kernel_launch: unexpected shapes: n_in %d, in0 %d, out %d, ws %zu (need %zu); nothing launched\n", n_in, n_in > 0 ? in_sizes[0] : -1, out_size, ws_size, (size_t)WS_END); grid = -1; return; }
        int dev = 0, cus = 0, per_cu = 0;
        if (hipGetDevice(&dev) != hipSuccess || hipDeviceGetAttribute(&cus, hipDeviceAttributeMultiprocessorCount, dev) != hipSuccess) { fprintf(stderr, "kernel_launch: device query failed\n"); grid = -1; return; }
        if (hipFuncSetAttribute((const void*)fwd_megakernel, hipFuncAttributeMaxDynamicSharedMemorySize, LDS_BYTES) != hipSuccess) { fprintf(stderr, "kernel_launch: hipFuncSetAttribute failed\n"); grid = -1; return; }
        if (hipOccupancyMaxActiveBlocksPerMultiprocessor(&per_cu, (const void*)fwd_megakernel, NWAVES * 64, LDS_BYTES) != hipSuccess || per_cu < 1)
            fprintf(stderr, "kernel_launch: note: occupancy query reports %d workgroups per CU\n", per_cu);
        (void)hipGetLastError();
        grid = cus;
    }
    if (grid < 0) return;
    if (hipMemsetAsync((char*)d_ws + WS_CTL, 0, CTL_ZERO_BYTES, stream) != hipSuccess) { fprintf(stderr, "kernel_launch: hipMemsetAsync failed\n"); return; }
    Args a{};
    for (int i = 0; i < 14; ++i) a.in[i] = (const float*)d_in[i];
    a.out = (float*)d_out; a.ws = (unsigned char*)d_ws;
    hipLaunchKernelGGL(fwd_megakernel, dim3(grid), dim3(NWAVES * 64), LDS_BYTES, stream, a);
    const hipError_t le = hipPeekAtLastError();
    if (le != hipSuccess) fprintf(stderr, "kernel_launch: launch failed: %s\n", hipGetErrorName(le));
}
```

```cpp
#include <hip/hip_runtime.h>
#include <cstdio>
#include <cstdint>
namespace pg8 {
#define PG8_LAS __attribute__((address_space(3)))
typedef unsigned short bf16_t;
typedef short bf16x8 __attribute__((ext_vector_type(8)));
typedef float f32x4 __attribute__((ext_vector_type(4)));
typedef unsigned u32x4 __attribute__((ext_vector_type(4)));
constexpr int BM = 256, BK = 64, HALF = 128, HTB = HALF * BK * 2  , STAGE_BYTES = 8 * HTB, NXCD = 8, WGM = 8;

__host__ __device__ __forceinline__ int lds_byte(int r, int c) { const int st = (r >> 4) * 2 + (c >> 5), rr = r & 15, cc = c & 31, ob = rr * 64 + cc * 2; return st * 1024 + (ob ^ (((ob >> 9) & 1) << 5)); }
__host__ __device__ __forceinline__ void stage_rc(int b, int& R, int& C) { const int st = b / 1024, sb = b % 1024, swz = sb ^ (((sb >> 9) & 1) << 5); R = (st >> 1) * 16 + swz / 64; C = (st & 1) * 32 + (swz % 64) / 2; }
__host__ __device__ __forceinline__ int perm32(int rho) { const int n = rho >> 4, i = rho & 15; return 8 * (i >> 2) + 4 * n + (i & 3); }

struct Unit { int pm, pn; };
struct Gemm { const bf16_t* A; const bf16_t* Bt; int M, N, K; };

struct StaticOrder {
    int nM, nN, nwg, G, c, ioff = 0, ilim = 1 << 30;
    __host__ __device__ void init(int M, int N, int G_, int c_) { nM = M / BM; nN = N / BM; nwg = nM * nN; G = G_; c = c_; }
    __host__ __device__ bool next(int i, Unit& u) const {
        if (i >= ilim) return false;
        const long L = (long)(i + ioff) * G + c; if (L >= nwg) return false;
        int wgid = (int)L; { const int q = nwg / NXCD, r = nwg % NXCD, xcd = wgid % NXCD, off = wgid / NXCD; wgid = (xcd < r ? xcd * (q + 1) : r * (q + 1) + (xcd - r) * q) + off; }
        const int nig = WGM * nN, gid = wgid / nig, fm = gid * WGM, gsz = (nM - fm) < WGM ? (nM - fm) : WGM;
        u.pm = fm + ((wgid % nig) % gsz); u.pn = (wgid % nig) / gsz; return true;
    }
    __device__ __forceinline__ void a_ready(const Unit&) const {}
    __device__ __forceinline__ void done(const Unit&) const {}
};

__device__ __forceinline__ unsigned cvt_pk_bf16(float lo, float hi) { unsigned r; asm volatile("v_cvt_pk_bf16_f32 %0, %1, %2" : "=v"(r) : "v"(lo), "v"(hi)); return r; }
typedef unsigned u32x2 __attribute__((ext_vector_type(2)));
__device__ __forceinline__ float bf_lo(unsigned w) { return __uint_as_float(w << 16); }
__device__ __forceinline__ float bf_hi(unsigned w) { return __uint_as_float(w & 0xffff0000u); }
constexpr float kLog2e = 1.4426950408889634f;
constexpr float kC2 = 0.125f * 1.4426950408889634f;

struct EpiIn {
    static constexpr bool PERM = true, AFTER_DRAIN = false; static constexpr int MID_TILE = 0;
    bf16_t *Q, *KA, *VA, *KB, *VB, *GR, *GB; const float *qna, *kna, *qnb, *knb; float* kmean;
    __device__ __forceinline__ void mid(f32x4 (&)[2][2][4][2], const Unit&, int, int, int, int) const {}
    __device__ __forceinline__ void operator()(const f32x4 (&acc)[2][2][4][2], const Unit& u, int wr, int wc, int fr, int fq) const {
        const int pn = u.pn;
        const int rowb = u.pm * BM + wr * 64 + fr;
        if (pn >= 9) {
            const int col = 128 * (pn - 9) + 32 * wc + 8 * fq;
#pragma unroll
            for (int ai = 0; ai < 2; ++ai)
#pragma unroll
                for (int m = 0; m < 4; ++m) { const size_t off = (size_t)(rowb + ai * HALF + m * 16) * 1024 + col;
                    f32x4 rt[2], gb[2];
#pragma unroll
                    for (int n = 0; n < 2; ++n)
#pragma unroll
                        for (int e = 0; e < 4; ++e) { const float ea = __builtin_amdgcn_exp2f(-kLog2e * acc[ai][0][m][n][e]), eb = __builtin_amdgcn_exp2f(-kLog2e * acc[ai][1][m][n][e]);
                            gb[n][e] = __builtin_fmaxf(__builtin_amdgcn_rcpf(1.0f + eb), 1e-20f); rt[n][e] = __builtin_fminf((1.0f + eb) * __builtin_amdgcn_rcpf(1.0f + ea), 1e20f); }
                    u32x4 w; w.x = cvt_pk_bf16(rt[0][0], rt[0][1]); w.y = cvt_pk_bf16(rt[0][2], rt[0][3]); w.z = cvt_pk_bf16(rt[1][0], rt[1][1]); w.w = cvt_pk_bf16(rt[1][2], rt[1][3]);
                    *(u32x4*)(GR + off) = w;
                    w.x = cvt_pk_bf16(gb[0][0], gb[0][1]); w.y = cvt_pk_bf16(gb[0][2], gb[0][3]); w.z = cvt_pk_bf16(gb[1][0], gb[1][1]); w.w = cvt_pk_bf16(gb[1][2], gb[1][3]);
                    *(u32x4*)(GB + off) = w; }
            return;
        }
        bf16_t* dst; int pitch; bool norm = false, km = false; float scale = 1.f; const float* gain = qna;
        if (pn < 2)       { dst = Q + (4 * pn + wc) * 64; pitch = 1024; norm = true; gain = qna; scale = kC2; }
        else if (pn < 4)  { dst = KA + (4 * (pn - 2) + wc) * 64; pitch = 512; norm = true; gain = kna; km = true; }
        else if (pn < 6)  { dst = VA + (4 * (pn - 4) + wc) * 64; pitch = 512; }
        else if (pn < 8)  { dst = Q + 512 + (4 * (pn - 6) + wc) * 64; pitch = 1024; norm = true; gain = qnb; scale = kC2; }
        else              { pitch = 128; if (wc < 2) { dst = KB + wc * 64; norm = true; gain = knb; } else { dst = VB + (wc - 2) * 64; } }
        f32x4 g[2][2], cs[2][2];
#pragma unroll
        for (int bj = 0; bj < 2; ++bj)
#pragma unroll
            for (int n = 0; n < 2; ++n) { g[bj][n] = norm ? *(const f32x4*)(gain + 32 * bj + 8 * fq + 4 * n) : (f32x4){1.f, 1.f, 1.f, 1.f}; cs[bj][n] = (f32x4){0.f, 0.f, 0.f, 0.f}; }
#pragma unroll
        for (int ai = 0; ai < 2; ++ai)
#pragma unroll
            for (int m = 0; m < 4; ++m) {
                const int row = rowb + ai * HALF + m * 16;
                f32x4 v[2][2];
#pragma unroll
                for (int bj = 0; bj < 2; ++bj)
#pragma unroll
                    for (int n = 0; n < 2; ++n) v[bj][n] = acc[ai][bj][m][n];
                if (norm) {
                    float ss = 0.f;
#pragma unroll
                    for (int bj = 0; bj < 2; ++bj)
#pragma unroll
                        for (int n = 0; n < 2; ++n) { const f32x4 x = v[bj][n]; ss += (x[0] * x[0] + x[1] * x[1]) + (x[2] * x[2] + x[3] * x[3]); }
                    ss += __shfl_xor(ss, 16); ss += __shfl_xor(ss, 32);
                    const float rs = __builtin_amdgcn_rsqf(ss * (1.0f / 64.0f) + 1e-6f) * scale;
#pragma unroll
                    for (int bj = 0; bj < 2; ++bj)
#pragma unroll
                        for (int n = 0; n < 2; ++n) v[bj][n] = v[bj][n] * rs * g[bj][n];
                }
                if (km) {
#pragma unroll
                    for (int bj = 0; bj < 2; ++bj)
#pragma unroll
                        for (int n = 0; n < 2; ++n) cs[bj][n] += v[bj][n];
                }
#pragma unroll
                for (int bj = 0; bj < 2; ++bj) {
                    u32x4 w; w.x = cvt_pk_bf16(v[bj][0][0], v[bj][0][1]); w.y = cvt_pk_bf16(v[bj][0][2], v[bj][0][3]); w.z = cvt_pk_bf16(v[bj][1][0], v[bj][1][1]); w.w = cvt_pk_bf16(v[bj][1][2], v[bj][1][3]);
                    *(u32x4*)(dst + (size_t)row * pitch + 32 * bj + 8 * fq) = w;
                }
            }
        if (km) {
            float* kmp = kmean + ((size_t)u.pm * 8 + (4 * (pn - 2) + wc)) * 64;
#pragma unroll
            for (int bj = 0; bj < 2; ++bj)
#pragma unroll
                for (int n = 0; n < 2; ++n)
#pragma unroll
                    for (int e = 0; e < 4; ++e) {
                        float s = cs[bj][n][e];
                        s += __shfl_xor(s, 1); s += __shfl_xor(s, 2); s += __shfl_xor(s, 4); s += __shfl_xor(s, 8);
                        if (fr == 0) atomicAdd(kmp + 32 * bj + 8 * fq + 4 * n + e, s * (1.0f / 256.0f));
                    }
        }
    }
};

struct EpiMix {
    static constexpr bool PERM = true, AFTER_DRAIN = false; static constexpr int MID_TILE = 8;
    const bf16_t *GR, *GB; bf16_t* MIX;
    __device__ __forceinline__ void mid(f32x4 (&acc)[2][2][4][2], const Unit& u, int wr, int wc, int fr, int fq) const {
        int rowb = u.pm * BM + wr * 64 + fr, col0 = u.pn * BM + wc * 32 + 8 * fq;
        asm volatile("" : "+v"(rowb), "+v"(col0));
        const bf16_t* base = GR + (size_t)rowb * 1024 + col0;
        u32x4 rt[2][4][2];
#pragma unroll
        for (int ai = 0; ai < 2; ++ai)
#pragma unroll
            for (int m = 0; m < 4; ++m)
#pragma unroll
                for (int bj = 0; bj < 2; ++bj) rt[ai][m][bj] = *(const u32x4*)(base + (size_t)(ai * HALF + m * 16) * 1024 + bj * HALF);
#pragma unroll
        for (int ai = 0; ai < 2; ++ai)
#pragma unroll
            for (int m = 0; m < 4; ++m)
#pragma unroll
                for (int bj = 0; bj < 2; ++bj) { const u32x4 a = rt[ai][m][bj];
                    acc[ai][bj][m][0] *= (f32x4){bf_lo(a.x), bf_hi(a.x), bf_lo(a.y), bf_hi(a.y)}; acc[ai][bj][m][1] *= (f32x4){bf_lo(a.z), bf_hi(a.z), bf_lo(a.w), bf_hi(a.w)}; }
    }
    __device__ __forceinline__ void operator()(const f32x4 (&acc)[2][2][4][2], const Unit& u, int wr, int wc, int fr, int fq) const {
        const int rowb = u.pm * BM + wr * 64 + fr, col0 = u.pn * BM + wc * 32 + 8 * fq;
        const bf16_t* base = GB + (size_t)rowb * 1024 + col0; bf16_t* ob = MIX + (size_t)rowb * 1024 + col0;
        u32x4 gt[2][4][2];
#pragma unroll
        for (int ai = 0; ai < 2; ++ai)
#pragma unroll
            for (int m = 0; m < 4; ++m)
#pragma unroll
                for (int bj = 0; bj < 2; ++bj) gt[ai][m][bj] = *(const u32x4*)(base + (size_t)(ai * HALF + m * 16) * 1024 + bj * HALF);
#pragma unroll
        for (int ai = 0; ai < 2; ++ai)
#pragma unroll
            for (int m = 0; m < 4; ++m)
#pragma unroll
                for (int bj = 0; bj < 2; ++bj) { const u32x4 b = gt[ai][m][bj];
                    const f32x4 v0 = acc[ai][bj][m][0], v1 = acc[ai][bj][m][1];
                    u32x4 w; w.x = cvt_pk_bf16(v0[0] * bf_lo(b.x), v0[1] * bf_hi(b.x)); w.y = cvt_pk_bf16(v0[2] * bf_lo(b.y), v0[3] * bf_hi(b.y));
                    w.z = cvt_pk_bf16(v1[0] * bf_lo(b.z), v1[1] * bf_hi(b.z)); w.w = cvt_pk_bf16(v1[2] * bf_lo(b.w), v1[3] * bf_hi(b.w));
                    *(u32x4*)(ob + (size_t)(ai * HALF + m * 16) * 1024 + bj * HALF) = w; }
    }
};

struct EpiX1 {
    static constexpr bool PERM = false, AFTER_DRAIN = false; static constexpr int MID_TILE = 0;
    const float* x; bf16_t* X1; float* rowsq;
    __device__ __forceinline__ void mid(f32x4 (&)[2][2][4][2], const Unit&, int, int, int, int) const {}
    __device__ __forceinline__ void operator()(const f32x4 (&acc)[2][2][4][2], const Unit& u, int wr, int wc, int fr, int fq) const {
        const int rowb = u.pm * BM + wr * 64 + fr, col0 = u.pn * BM + wc * 32 + 4 * fq;
#pragma unroll
        for (int ai = 0; ai < 2; ++ai) {
            f32x4 xv[4][2][2];
#pragma unroll
            for (int m = 0; m < 4; ++m)
#pragma unroll
                for (int bj = 0; bj < 2; ++bj)
#pragma unroll
                    for (int n = 0; n < 2; ++n) xv[m][bj][n] = *(const f32x4*)(x + (size_t)(rowb + ai * HALF + m * 16) * 1024 + col0 + bj * HALF + n * 16);
#pragma unroll
            for (int m = 0; m < 4; ++m) { const int row = rowb + ai * HALF + m * 16; const size_t off = (size_t)row * 1024 + col0; float ss = 0.f;
#pragma unroll
                for (int bj = 0; bj < 2; ++bj)
#pragma unroll
                    for (int n = 0; n < 2; ++n) {
                        const f32x4 x1 = xv[m][bj][n] + acc[ai][bj][m][n];
                        ss += (x1[0] * x1[0] + x1[1] * x1[1]) + (x1[2] * x1[2] + x1[3] * x1[3]);
                        u32x2 w; w.x = cvt_pk_bf16(x1[0], x1[1]); w.y = cvt_pk_bf16(x1[2], x1[3]);
                        *(u32x2*)(X1 + off + bj * HALF + n * 16) = w;
                    }
                ss += __shfl_xor(ss, 16); ss += __shfl_xor(ss, 32);
                if (fq == 0) atomicAdd(rowsq + row, ss); }
            asm volatile("" ::: "memory"); }
    }
};

struct EpiUp {
    static constexpr bool PERM = true, AFTER_DRAIN = false; static constexpr int MID_TILE = 0;
    bf16_t* H; const float* rowsq; PG8_LAS unsigned char* stg;
    __device__ __forceinline__ void mid(f32x4 (&)[2][2][4][2], const Unit&, int, int, int, int) const {}
    __device__ __forceinline__ void operator()(const f32x4 (&acc)[2][2][4][2], const Unit& u, int wr, int wc, int fr, int fq) const {
        const int rowb = u.pm * BM + wr * 64, colw = u.pn * BM + wc * 64;
        PG8_LAS unsigned char* sw = stg + (wr * 4 + wc) * 2048;
        const int lane = fq * 16 + fr, rr = lane >> 3, ch = lane & 7;
#pragma unroll
        for (int ai = 0; ai < 2; ++ai)
#pragma unroll
            for (int m = 0; m < 4; ++m) { const int row0 = rowb + ai * HALF + m * 16;
                const float r = __builtin_amdgcn_rsqf(rowsq[row0 + fr] * (1.0f / 1024.0f) + 1e-6f);
#pragma unroll
                for (int bj = 0; bj < 2; ++bj) {
                    f32x4 v0 = acc[ai][bj][m][0] * r, v1 = acc[ai][bj][m][1] * r;
#pragma unroll
                    for (int e = 0; e < 4; ++e) { const float a = __builtin_fmaxf(v0[e], 0.f), b = __builtin_fmaxf(v1[e], 0.f); v0[e] = a * a; v1[e] = b * b; }
                    u32x4 w; w.x = cvt_pk_bf16(v0[0], v0[1]); w.y = cvt_pk_bf16(v0[2], v0[3]); w.z = cvt_pk_bf16(v1[0], v1[1]); w.w = cvt_pk_bf16(v1[2], v1[3]);
                    *(PG8_LAS u32x4*)(sw + fr * 128 + (((bj * 4 + fq) ^ (fr & 7)) << 4)) = w;
                }
                asm volatile("s_waitcnt lgkmcnt(0)" ::: "memory");
#pragma unroll
                for (int hh = 0; hh < 2; ++hh) { const int r2 = rr + 8 * hh;
                    const u32x4 w = *(const PG8_LAS u32x4*)(sw + r2 * 128 + ((ch ^ (r2 & 7)) << 4));
                    *(u32x4*)(H + (size_t)(row0 + r2) * 4096 + colw + ch * 8) = w; }
                asm volatile("s_waitcnt lgkmcnt(0)" ::: "memory");
            }
    }
};

struct EpiDown {
    static constexpr bool PERM = false, AFTER_DRAIN = false; static constexpr int MID_TILE = 0;
    const bf16_t* X1; float* out; float mul; PG8_LAS unsigned char* stg;
    __device__ __forceinline__ void mid(f32x4 (&)[2][2][4][2], const Unit&, int, int, int, int) const {}
    __device__ __forceinline__ void operator()(const f32x4 (&acc)[2][2][4][2], const Unit& u, int wr, int wc, int fr, int fq) const {
        const int rowb = u.pm * BM + wr * 64, col0 = u.pn * BM + wc * 32;
        PG8_LAS unsigned char* sw = stg + (wr * 4 + wc) * 2048;
        const int lane = fq * 16 + fr, rr = lane >> 3, ch = lane & 7;
        u32x2 xv[2][4][2][2];
#pragma unroll
        for (int ai = 0; ai < 2; ++ai)
#pragma unroll
            for (int m = 0; m < 4; ++m)
#pragma unroll
                for (int bj = 0; bj < 2; ++bj)
#pragma unroll
                    for (int n = 0; n < 2; ++n) xv[ai][m][bj][n] = *(const u32x2*)(X1 + (size_t)(rowb + fr + ai * HALF + m * 16) * 1024 + col0 + 4 * fq + bj * HALF + n * 16);
#pragma unroll
        for (int ai = 0; ai < 2; ++ai)
#pragma unroll
            for (int m = 0; m < 4; ++m)
#pragma unroll
                for (int bj = 0; bj < 2; ++bj) { const int row0 = rowb + ai * HALF + m * 16;
#pragma unroll
                    for (int n = 0; n < 2; ++n) { const u32x2 w = xv[ai][m][bj][n];
                        const f32x4 o = ((f32x4){bf_lo(w.x), bf_hi(w.x), bf_lo(w.y), bf_hi(w.y)} + acc[ai][bj][m][n]) * mul;
                        *(PG8_LAS f32x4*)(sw + fr * 128 + (((n * 4 + fq) ^ (fr & 7)) << 4)) = o; }
                    asm volatile("s_waitcnt lgkmcnt(0)" ::: "memory");
#pragma unroll
                    for (int hh = 0; hh < 2; ++hh) { const int r2 = rr + 8 * hh;
                        const f32x4 o = *(const PG8_LAS f32x4*)(sw + r2 * 128 + ((ch ^ (r2 & 7)) << 4));
                        *(f32x4*)(out + (size_t)(row0 + r2) * 1024 + col0 + bj * HALF + ch * 4) = o; }
                    asm volatile("s_waitcnt lgkmcnt(0)" ::: "memory"); }
    }
};

template <class Epi, class Sched, bool ALIGN_EPI = false, bool SP2 = false>
__device__ __forceinline__ void gemm_phase(PG8_LAS unsigned char* lds, const Gemm g, const Sched& S, const Epi& E) {
    int tid = threadIdx.x; asm volatile("" : "+v"(tid));
    const int wid = __builtin_amdgcn_readfirstlane(tid >> 6), lane = tid & 63, wr = wid >> 2, wc = wid & 3, fr = lane & 15, fq = lane >> 4;
    const int K = g.K, nt = K / BK;
    unsigned voffA[2], voffB[2];
#pragma unroll
    for (int i = 0; i < 2; ++i) { int R, C; stage_rc(tid * 16 + i * 8192, R, C); const int Rb = Epi::PERM ? ((R & ~31) + perm32(R & 31)) : R;
        voffA[i] = (unsigned)(R * K + C) * 2u; voffB[i] = (unsigned)(Rb * K + C) * 2u; }
    const size_t kstep = (size_t)(BK * 2);
    const size_t hstep = (size_t)HALF * K * 2;
    const size_t tstep = 2 * hstep;
    const unsigned ldsw = (unsigned)wid * 1024u;
    const int aoff = lds_byte(wr * 64 + fr, fq * 8), boff = lds_byte(wc * 32 + fr, fq * 8);
#define PG8_SA(b, h) (((b) * 2 + (h)) * HTB)
#define PG8_SB(b, h) ((4 + (b) * 2 + (h)) * HTB)
#define PG8_STAGE(bufoff, gbase, voff) do { _Pragma("unroll") for (int _i = 0; _i < 2; ++_i) \
        __builtin_amdgcn_global_load_lds((const unsigned*)((const char*)(gbase) + (voff)[_i]), (PG8_LAS unsigned*)(lds + (bufoff) + ldsw + _i * 8192), 16, 0, 0); } while (0)
#define PG8_LDA(dst, b, h) do { _Pragma("unroll") for (int m = 0; m < 4; ++m) _Pragma("unroll") for (int k = 0; k < 2; ++k) dst[m][k] = *(const PG8_LAS bf16x8*)(lds + PG8_SA(b, h) + aoff + m * 2048 + k * 1024); } while (0)
#define PG8_LDB(dst, b, h) do { _Pragma("unroll") for (int n = 0; n < 2; ++n) _Pragma("unroll") for (int k = 0; k < 2; ++k) dst[n][k] = *(const PG8_LAS bf16x8*)(lds + PG8_SB(b, h) + boff + n * 2048 + k * 1024); } while (0)
#define PG8_MMA(ai, bj, At, Bt) do { __builtin_amdgcn_s_setprio(1); _Pragma("unroll") for (int m = 0; m < 4; ++m) _Pragma("unroll") for (int n = 0; n < 2; ++n) _Pragma("unroll") for (int k = 0; k < 2; ++k) \
        acc[ai][bj][m][n] = __builtin_amdgcn_mfma_f32_16x16x32_bf16(Bt[n][k], At[m][k], acc[ai][bj][m][n], 0, 0, 0); __builtin_amdgcn_s_setprio(0); } while (0)
#define PG8_WAIT_V(n) asm volatile("s_waitcnt vmcnt(" #n ")" ::: "memory")
#define PG8_WAIT_L(n) asm volatile("s_waitcnt lgkmcnt(" #n ")" ::: "memory")
#define PG8_BAR __builtin_amdgcn_s_barrier()
#define PG8_SCHED __builtin_amdgcn_sched_barrier(0)
    Unit cur, nxt; int ui = 0;
    if (!S.next(0, cur)) return;
    f32x4 acc[2][2][4][2];
#pragma unroll
    for (int a = 0; a < 2; ++a)
#pragma unroll
        for (int b = 0; b < 2; ++b)
#pragma unroll
            for (int m = 0; m < 4; ++m)
#pragma unroll
                for (int n = 0; n < 2; ++n) acc[a][b][m][n] = (f32x4){0.f, 0.f, 0.f, 0.f};
    bf16x8 At[4][2], B0[2][2], B1[2][2];
    const char* cA = (const char*)g.A + (size_t)cur.pm * tstep; const char* cB = (const char*)g.Bt + (size_t)cur.pn * tstep;
    S.a_ready(cur);
    if constexpr (SP2) {
        PG8_STAGE(PG8_SB(0, 0), cB, voffB); PG8_STAGE(PG8_SB(0, 1), cB + hstep, voffB); PG8_STAGE(PG8_SA(0, 0), cA, voffA); PG8_STAGE(PG8_SA(0, 1), cA + hstep, voffA);
        if (wr == 1) PG8_BAR;
        PG8_WAIT_V(2); PG8_BAR;
        PG8_STAGE(PG8_SB(1, 0), cB + kstep, voffB); PG8_STAGE(PG8_SA(1, 0), cA + kstep, voffA); PG8_STAGE(PG8_SB(1, 1), cB + hstep + kstep, voffB);
        PG8_WAIT_V(6); PG8_BAR;
    } else {
        PG8_STAGE(PG8_SB(0, 0), cB, voffB); PG8_STAGE(PG8_SA(0, 0), cA, voffA); PG8_STAGE(PG8_SB(0, 1), cB + hstep, voffB); PG8_STAGE(PG8_SA(0, 1), cA + hstep, voffA);
        if (wr == 1) PG8_BAR;
        PG8_WAIT_V(4); PG8_BAR;
        PG8_STAGE(PG8_SB(1, 0), cB + kstep, voffB); PG8_STAGE(PG8_SA(1, 0), cA + kstep, voffA); PG8_STAGE(PG8_SB(1, 1), cB + hstep + kstep, voffB);
        PG8_WAIT_V(6); PG8_BAR;
    }
    for (;;) {
        const bool has_next = S.next(ui + 1, nxt);
        const char* nA = has_next ? (const char*)g.A + (size_t)nxt.pm * tstep : cA; const char* nB = has_next ? (const char*)g.Bt + (size_t)nxt.pn * tstep : cB;
        for (int t = 0; t < nt; t += 2) {
            if constexpr (Epi::MID_TILE > 0) { if (t == Epi::MID_TILE) { PG8_SCHED; E.mid(acc, cur, wr, wc, fr, fq); PG8_SCHED; } }
            const bool last = (t == nt - 2);
            const char* a1 = cA + (size_t)(t + 1) * kstep;
            const char* a2 = last ? nA : cA + (size_t)(t + 2) * kstep; const char* b2 = last ? nB : cB + (size_t)(t + 2) * kstep;
            const char* a3 = a2 + kstep; const char* b3 = b2 + kstep;
            if (last && has_next) S.a_ready(nxt);
            if constexpr (SP2) {
            PG8_LDB(B0, 0, 0); PG8_LDB(B1, 0, 1); PG8_SCHED; PG8_LDA(At, 0, 0); PG8_STAGE(PG8_SA(1, 1), a1 + hstep, voffA);
            PG8_WAIT_V(8); PG8_WAIT_L(0); PG8_BAR; PG8_MMA(0, 0, At, B0); PG8_MMA(0, 1, At, B1); PG8_BAR; PG8_SCHED;
            PG8_LDA(At, 0, 1); PG8_STAGE(PG8_SB(0, 0), b2, voffB); PG8_STAGE(PG8_SB(0, 1), b2 + hstep, voffB); PG8_STAGE(PG8_SA(0, 0), a2, voffA);
            PG8_WAIT_V(8); PG8_WAIT_L(0); PG8_BAR; PG8_MMA(1, 0, At, B0); PG8_MMA(1, 1, At, B1); PG8_BAR; PG8_SCHED;
            PG8_LDB(B0, 1, 0); PG8_LDB(B1, 1, 1); PG8_SCHED; PG8_LDA(At, 1, 0); PG8_STAGE(PG8_SA(0, 1), a2 + hstep, voffA);
            PG8_WAIT_V(8); PG8_WAIT_L(0); PG8_BAR; PG8_MMA(0, 0, At, B0); PG8_MMA(0, 1, At, B1); PG8_BAR; PG8_SCHED;
            PG8_LDA(At, 1, 1); PG8_STAGE(PG8_SB(1, 0), b3, voffB); PG8_STAGE(PG8_SB(1, 1), b3 + hstep, voffB); PG8_STAGE(PG8_SA(1, 0), a3, voffA);
            PG8_WAIT_V(8); PG8_WAIT_L(0); PG8_BAR; PG8_MMA(1, 0, At, B0); PG8_MMA(1, 1, At, B1); PG8_BAR; PG8_SCHED;
            } else {
            PG8_LDB(B0, 0, 0); PG8_SCHED; PG8_LDA(At, 0, 0); PG8_STAGE(PG8_SA(1, 1), a1 + hstep, voffA);
            PG8_WAIT_L(8); PG8_BAR; PG8_WAIT_L(0); PG8_MMA(0, 0, At, B0); PG8_BAR; PG8_SCHED;
            PG8_LDB(B1, 0, 1); PG8_STAGE(PG8_SB(0, 0), b2, voffB);
            PG8_BAR; PG8_WAIT_L(0); PG8_MMA(0, 1, At, B1); PG8_BAR;
            PG8_LDA(At, 0, 1); PG8_STAGE(PG8_SA(0, 0), a2, voffA);
            PG8_BAR; PG8_WAIT_L(0); PG8_MMA(1, 0, At, B0); PG8_BAR; PG8_SCHED;
            PG8_STAGE(PG8_SB(0, 1), b2 + hstep, voffB);
            PG8_WAIT_V(6); PG8_BAR; PG8_MMA(1, 1, At, B1); PG8_BAR;
            PG8_LDB(B0, 1, 0); PG8_SCHED; PG8_LDA(At, 1, 0); PG8_STAGE(PG8_SA(0, 1), a2 + hstep, voffA);
            PG8_WAIT_L(8); PG8_BAR; PG8_WAIT_L(0); PG8_MMA(0, 0, At, B0); PG8_BAR; PG8_SCHED;
            PG8_LDB(B1, 1, 1); PG8_STAGE(PG8_SB(1, 0), b3, voffB);
            PG8_BAR; PG8_WAIT_L(0); PG8_MMA(0, 1, At, B1); PG8_BAR;
            PG8_LDA(At, 1, 1); PG8_STAGE(PG8_SA(1, 0), a3, voffA);
            PG8_BAR; PG8_WAIT_L(0); PG8_MMA(1, 0, At, B0); PG8_BAR; PG8_SCHED;
            PG8_STAGE(PG8_SB(1, 1), b3 + hstep, voffB);
            PG8_WAIT_V(6); PG8_BAR; PG8_MMA(1, 1, At, B1); PG8_BAR;
            }
        }
        if constexpr (ALIGN_EPI) { if (wr == 0) PG8_BAR; }
        if constexpr (!Epi::AFTER_DRAIN) { E(acc, cur, wr, wc, fr, fq); S.done(cur); }
        if (!has_next) break;
#pragma unroll
        for (int a = 0; a < 2; ++a)
#pragma unroll
            for (int b = 0; b < 2; ++b)
#pragma unroll
                for (int m = 0; m < 4; ++m)
#pragma unroll
                    for (int n = 0; n < 2; ++n) acc[a][b][m][n] = (f32x4){0.f, 0.f, 0.f, 0.f};
        cur = nxt; cA = nA; cB = nB; ++ui;
        if constexpr (ALIGN_EPI) { if (wr == 1) PG8_BAR; }
    }
    PG8_WAIT_V(0);
    if constexpr (!ALIGN_EPI) { if (wr == 0) PG8_BAR; }
    PG8_BAR;
    if constexpr (Epi::AFTER_DRAIN) { E.fused(acc, cur, wr, wc, fr, fq, lds, wid, lane); S.done(cur); }
#undef PG8_SA
#undef PG8_SB
#undef PG8_STAGE
#undef PG8_LDA
#undef PG8_LDB
#undef PG8_MMA
#undef PG8_WAIT_V
#undef PG8_WAIT_L
#undef PG8_BAR
#undef PG8_SCHED
}
}
constexpr int NWAVES = 8;
constexpr int BATCH = 16, SEQ = 2048, DM = 1024, HD = 64, FF = 4096, NIN = 4352;
constexpr int M = BATCH * SEQ;
constexpr float EPS = 1e-6f;
constexpr size_t MiB = 1u << 20;
constexpr size_t WS_CTL = 0, CTL_ZERO_BYTES = 1 * MiB;
constexpr size_t WS_WIN = 2 * MiB, WS_WBR = 11 * MiB, WS_WO = 13 * MiB, WS_WUP = 15 * MiB, WS_WDN = 23 * MiB;
constexpr int NGRP = 8, GROWS = M / NGRP;
constexpr size_t WS_GRP0 = 32 * MiB, GRP_STRIDE = 50 * MiB;
constexpr size_t GO_Q = 0 * MiB;
constexpr size_t GO_KA = 8 * MiB, GO_VA = 12 * MiB;
constexpr size_t GO_KB = 16 * MiB, GO_VB = 17 * MiB;
constexpr size_t GO_GA = 18 * MiB, GO_GB = 26 * MiB;
constexpr size_t GO_H = 0 * MiB;
constexpr size_t GO_A2 = 34 * MiB;
constexpr size_t GO_XN = 42 * MiB;
constexpr size_t WS_END = WS_GRP0 + NGRP * GRP_STRIDE;
static_assert(WS_WIN + (size_t)NIN * DM * 2 <= WS_WBR && WS_WDN + (size_t)DM * FF * 2 <= WS_GRP0 && GO_GB + (size_t)GROWS * DM * 2 <= GO_A2 && GO_H + (size_t)GROWS * FF * 2 <= GO_A2 && GO_XN + (size_t)GROWS * DM * 2 <= GRP_STRIDE, "d_ws map");
__device__ __forceinline__ unsigned short* grp_ptr(unsigned char* ws, int g, size_t off, int pitch_elems) { return (unsigned short*)(ws + WS_GRP0 + (size_t)g * GRP_STRIDE + off) - (size_t)g * GROWS * pitch_elems; }
constexpr int CW_TMO = 0, CW_CODE = 1;
constexpr int CW_BAR = 4096;
constexpr int CW_CENSUS = 8192;
constexpr int CW_GSUB = 9216, CW_GGEN = 10240;
constexpr int CW_KMEAN = 16384;
constexpr int CW_ROWSQ = CW_KMEAN + BATCH * 8 * 8 * 64;
static_assert((CW_ROWSQ + M) * 4 <= (int)CTL_ZERO_BYTES, "CTL words inside the memset region");
constexpr int RING_OFF = 0, RING_BYTES = 131072;
constexpr int LDSCTL_OFF = RING_BYTES, MISC_OFF = LDSCTL_OFF + 320;
constexpr int STG_OFF = RING_BYTES + 1024, STG_BYTES = 8 * 2048;
constexpr int LDS_BYTES = STG_OFF + STG_BYTES;
static_assert(MISC_OFF + 128 <= LDS_BYTES, "LDS map");

#define GAS __attribute__((address_space(1)))
#define LAS __attribute__((address_space(3)))
typedef unsigned short bf16;
typedef unsigned v4u __attribute__((ext_vector_type(4)));
typedef float f32x4 __attribute__((ext_vector_type(4)));
typedef short bf16x8 __attribute__((ext_vector_type(8)));
typedef GAS unsigned gu32;
typedef GAS unsigned long long gu64;
#define RLX_AGENT __ATOMIC_RELAXED, __HIP_MEMORY_SCOPE_AGENT
#define LDS_WAIT() asm volatile("s_waitcnt lgkmcnt(0)" ::: "memory")
#define VM_WAIT() asm volatile("s_waitcnt vmcnt(0)" ::: "memory")
__device__ __forceinline__ unsigned long long rt() { return __builtin_amdgcn_s_memrealtime(); }
__device__ __forceinline__ unsigned f2bf(float f) { unsigned u = __builtin_bit_cast(unsigned, f); return (u + 0x7fffu + ((u >> 16) & 1u)) >> 16; }
__device__ __forceinline__ unsigned pk2(float lo, float hi) { return f2bf(lo) | (f2bf(hi) << 16); }

#define XB_TMO      128
#define XB_XCNT(j)  (256  + 64 * (j))
#define XB_XSUB(j)  (1280 + 64 * (j))
#define XB_XGEN(j)  (2304 + 64 * (j))
#define XB_TOP      3328
#define XB_TOPGEN   3392
#define XCD_BAR_WORDS 3456
#define XB_SPIN_CAP (1u << 18)

__device__ __forceinline__ unsigned xb_ld(unsigned* p)              { return __hip_atomic_load(p, __ATOMIC_RELAXED, __HIP_MEMORY_SCOPE_AGENT); }
__device__ __forceinline__ unsigned xb_add(unsigned* p, unsigned v) { return __hip_atomic_fetch_add(p, v, __ATOMIC_RELAXED, __HIP_MEMORY_SCOPE_AGENT); }
__device__ __forceinline__ unsigned xb_xcc_id() { return (unsigned)__builtin_amdgcn_s_getreg((3 << 11) | 20) & 0xFu; }
#define XB_SPIN(cond, bar) do { unsigned _sp = 0; while (cond) { __builtin_amdgcn_s_sleep(1); \
    if ((++_sp & 255u) == 0u) { if (xb_ld(&(bar)[XB_TMO])) break; if (_sp > XB_SPIN_CAP) { atomicAdd(&(bar)[XB_TMO], 1u); break; } } } } while (0)

struct XcdBarrier {
    unsigned* bar; unsigned x;
    volatile LAS unsigned* st;
};

__device__ __forceinline__ XcdBarrier xcd_barrier_post(unsigned* bar, volatile LAS unsigned* st) {
    XcdBarrier b; b.bar = bar; b.x = xb_xcc_id(); b.st = st;
    if (threadIdx.x == 0) (void)xb_add(&bar[XB_XCNT(b.x)], 1u);
    return b;
}
__device__ __forceinline__ void xcd_barrier_complete(unsigned* bar, unsigned x, unsigned& nloc, unsigned& nx) {
    const unsigned G = gridDim.x * gridDim.y * gridDim.z;
    unsigned sum, cnt, mine, sp = 0u;
    for (;;) {
        sum = 0u; cnt = 0u; mine = 0u;
#pragma unroll
        for (unsigned j = 0; j < 16; ++j) { const unsigned c = xb_ld(&bar[XB_XCNT(j)]); sum += c; cnt += (c > 0u) ? 1u : 0u; mine = (j == x) ? c : mine; }
        if (sum == G) break;
        __builtin_amdgcn_s_sleep(1);
        if ((++sp & 255u) == 0u) { if (xb_ld(&bar[XB_TMO])) break; if (sp > XB_SPIN_CAP) { atomicAdd(&bar[XB_TMO], 1u); break; } }
    }
    nloc = mine > 0u ? mine : 1u; nx = cnt > 0u ? cnt : 1u;
}

__device__ __forceinline__ void xcd_barrier(const XcdBarrier& b) {
    asm volatile("s_waitcnt vmcnt(0)" ::: "memory");
    __syncthreads();
    if (threadIdx.x == 0) {
        unsigned* bar = b.bar;
        __builtin_amdgcn_s_waitcnt(0);
        unsigned nloc = b.st[0], nx = b.st[1];
        if (nloc == 0u) { xcd_barrier_complete(bar, b.x, nloc, nx); b.st[0] = nloc; b.st[1] = nx; }
        const unsigned old = xb_add(&bar[XB_XSUB(b.x)], 1u);
        const unsigned gen = old / nloc;
        if (old + 1u == (gen + 1u) * nloc) {
            __builtin_amdgcn_fence(__ATOMIC_RELEASE, "agent");
            asm volatile("s_waitcnt vmcnt(0)" ::: "memory");
            const unsigned og = xb_add(&bar[XB_TOP], 1u);
            const unsigned tg = og / nx;
            if (og + 1u == (tg + 1u) * nx) xb_add(&bar[XB_TOPGEN], 1u);
            else XB_SPIN(xb_ld(&bar[XB_TOPGEN]) == tg, bar);
            __builtin_amdgcn_fence(__ATOMIC_ACQUIRE, "agent");
            xb_add(&bar[XB_XGEN(b.x)], 1u);
            asm volatile("s_waitcnt vmcnt(0)" ::: "memory");
        } else {
            XB_SPIN(xb_ld(&bar[XB_XGEN(b.x)]) == gen, bar);
            __builtin_amdgcn_fence(__ATOMIC_ACQUIRE, "agent");
            asm volatile("s_waitcnt vmcnt(0)" ::: "memory");
        }
    }
    __syncthreads();
}

struct GroupBar { unsigned* sub; unsigned* gen; unsigned* bar; };
__device__ __forceinline__ void group_barrier(const GroupBar& g) {
    asm volatile("s_waitcnt vmcnt(0)" ::: "memory");
    __syncthreads();
    if (threadIdx.x == 0) {
        __builtin_amdgcn_s_waitcnt(0);
        const unsigned old = xb_add(g.sub, 1u), gen = old / 32u;
        if (old + 1u == (gen + 1u) * 32u) {
            __builtin_amdgcn_fence(__ATOMIC_RELEASE, "agent");
            asm volatile("s_waitcnt vmcnt(0)" ::: "memory");
            __builtin_amdgcn_fence(__ATOMIC_ACQUIRE, "agent");
            xb_add(g.gen, 1u);
            asm volatile("s_waitcnt vmcnt(0)" ::: "memory");
        } else {
            XB_SPIN(xb_ld(g.gen) == gen, g.bar);
            __builtin_amdgcn_fence(__ATOMIC_ACQUIRE, "agent");
            asm volatile("s_waitcnt vmcnt(0)" ::: "memory");
        }
    }
    __syncthreads();
}

struct Frame {
    LAS unsigned char* lds;
    volatile LAS unsigned* MISC;
    gu32* ctl;
    int tid, lane, wave;
    int vcu, G;
    int grp, li, grouped;
    unsigned char* ws;
    const float *x, *norm_attn, *w_in, *qna, *kna, *qnb, *knb, *sinks, *wba, *wbb, *w_out, *norm_mlp, *w_up, *w_down; float* out;
    bf16 *WinT, *WbrT, *WoT, *WupT, *WdnT;
    bf16 *Q, *KA, *VA, *KB, *VB, *GA, *GB, *HB, *A2, *XN;
    float *kmean, *rowsq;
};

__device__ __forceinline__ float wave_sum(float v) {
#pragma unroll
    for (int o = 1; o < 64; o <<= 1) v += __shfl_xor(v, o);
    return v;
}
__device__ __forceinline__ void p0_transpose_item(const float* W, int N, bf16* WT, int ldt, int koff, int prow0, LAS float* scr, int k0, int n0, int lane, const float* kscale = nullptr) {
    float wv[32];
#pragma unroll
    for (int i = 0; i < 32; ++i) wv[i] = W[(size_t)(k0 + 2 * i + (lane >> 5)) * N + n0 + (lane & 31)];
    if (kscale) {
#pragma unroll
        for (int i = 0; i < 32; ++i) wv[i] *= kscale[k0 + 2 * i + (lane >> 5)];
    }
#pragma unroll
    for (int i = 0; i < 32; ++i) scr[(2 * i + (lane >> 5)) * 33 + (lane & 31)] = wv[i];
    LDS_WAIT(); asm volatile("" ::: "memory");
    const int c = lane & 7;
#pragma unroll
    for (int j = 0; j < 4; ++j) { const int n = (lane >> 3) + 8 * j; const LAS float* s = scr + (8 * c) * 33 + n;
        v4u o; o.x = pk2(s[0 * 33], s[1 * 33]); o.y = pk2(s[2 * 33], s[3 * 33]); o.z = pk2(s[4 * 33], s[5 * 33]); o.w = pk2(s[6 * 33], s[7 * 33]);
        *(GAS v4u*)(WT + (size_t)(prow0 + n) * ldt + koff + k0 + 8 * c) = o; }
    LDS_WAIT(); asm volatile("" ::: "memory");
}
__device__ __forceinline__ void rms_row_to_bf16(const Frame& F, const float* xrow, const float* gain, bf16* orow) {
    const GAS f32x4* xr = (const GAS f32x4*)xrow + F.lane; const f32x4* gr = (const f32x4*)gain + F.lane;
    f32x4 v[4]; float s = 0.f;
#pragma unroll
    for (int j = 0; j < 4; ++j) { v[j] = xr[64 * j]; s += (v[j].x * v[j].x + v[j].y * v[j].y) + (v[j].z * v[j].z + v[j].w * v[j].w); }
    const float rs = 1.0f / sqrtf(wave_sum(s) * (1.f / DM) + EPS);
    GAS unsigned long long* o8 = (GAS unsigned long long*)orow + F.lane;
#pragma unroll
    for (int j = 0; j < 4; ++j) { const f32x4 g = gr[64 * j]; o8[64 * j] = (unsigned long long)pk2(v[j].x * rs * g.x, v[j].y * rs * g.y) | ((unsigned long long)pk2(v[j].z * rs * g.z, v[j].w * rs * g.w) << 32); }
}
__device__ __forceinline__ void p0_prologue(Frame& F) {
    LAS float* scr = (LAS float*)(F.lds + RING_OFF + F.wave * 16384);
    const int gw = (int)blockIdx.x * NWAVES + F.wave, NGW = F.G * NWAVES;
    constexpr int I_IN = (DM / 64) * (NIN / 32), I_BR = (512 / 64) * (DM / 32), I_O = (DM / 64) * (DM / 32), I_UP = (DM / 64) * (FF / 32), I_DN = (FF / 64) * (DM / 32);
    constexpr int NITEMS = I_IN + 2 * I_BR + I_O + I_UP + I_DN;
    for (int it = gw; it < NITEMS; it += NGW) {
        int r = it;
        if (r < I_IN) { const int nblk = NIN / 32, kb = r / nblk, nb = r % nblk, n0 = 32 * nb, nt = n0 & 255;
            int prow0 = (n0 & ~255) + 128 * ((nt >> 5) & 1) + 32 * (nt >> 6);
            if (n0 >= 2304) { const int isb = n0 >= 3328 ? 1 : 0, c0 = n0 - (isb ? 3328 : 2304); prow0 = 256 * (9 + (c0 >> 7)) + 128 * isb + 32 * ((c0 & 127) >> 5); }
            p0_transpose_item(F.w_in, NIN, F.WinT, DM, 0, prow0, scr, 64 * kb, n0, F.lane); continue; } r -= I_IN;
        if (r < I_BR) { const int nblk = DM / 32, kb = r / nblk, nb = r % nblk; p0_transpose_item(F.wba, DM, F.WbrT, DM, 0, 32 * nb, scr, 64 * kb, 32 * nb, F.lane); continue; } r -= I_BR;
        if (r < I_BR) { const int nblk = DM / 32, kb = r / nblk, nb = r % nblk; p0_transpose_item(F.wbb, DM, F.WbrT, DM, 512, 32 * nb, scr, 64 * kb, 32 * nb, F.lane); continue; } r -= I_BR;
        if (r < I_O)  { const int nblk = DM / 32, kb = r / nblk, nb = r % nblk; p0_transpose_item(F.w_out, DM, F.WoT, DM, 0, 32 * nb, scr, 64 * kb, 32 * nb, F.lane); continue; } r -= I_O;
        if (r < I_UP) { const int nblk = FF / 32, kb = r / nblk, nb = r % nblk; const int n0 = 32 * nb, nt = n0 & 255; p0_transpose_item(F.w_up, FF, F.WupT, DM, 0, (n0 & ~255) + 128 * ((nt >> 5) & 1) + 32 * (nt >> 6), scr, 64 * kb, n0, F.lane, F.norm_mlp); continue; } r -= I_UP;
        { const int nblk = DM / 32, kb = r / nblk, nb = r % nblk; p0_transpose_item(F.w_down, DM, F.WdnT, FF, 0, 32 * nb, scr, 64 * kb, 32 * nb, F.lane); }
    }
    {
        const f32x4* gr = (const f32x4*)F.norm_attn + F.lane; f32x4 g[4];
#pragma unroll
        for (int j = 0; j < 4; ++j) g[j] = gr[64 * j];
        for (int m = gw; m < M; m += 2 * NGW) { const int m2 = m + NGW;
            const GAS f32x4* xa = (const GAS f32x4*)(F.x + (size_t)m * DM) + F.lane; const GAS f32x4* xb = (const GAS f32x4*)(F.x + (size_t)m2 * DM) + F.lane;
            f32x4 va[4], vb[4]; float sa = 0.f, sb = 0.f;
#pragma unroll
            for (int j = 0; j < 4; ++j) { va[j] = xa[64 * j]; vb[j] = xb[64 * j]; }
#pragma unroll
            for (int j = 0; j < 4; ++j) { sa += (va[j].x * va[j].x + va[j].y * va[j].y) + (va[j].z * va[j].z + va[j].w * va[j].w); sb += (vb[j].x * vb[j].x + vb[j].y * vb[j].y) + (vb[j].z * vb[j].z + vb[j].w * vb[j].w); }
#pragma unroll
            for (int o = 1; o < 64; o <<= 1) { sa += __shfl_xor(sa, o); sb += __shfl_xor(sb, o); }
            const float ra = 1.0f / sqrtf(sa * (1.f / DM) + EPS), rb = 1.0f / sqrtf(sb * (1.f / DM) + EPS);
            GAS unsigned long long* oa = (GAS unsigned long long*)(grp_ptr(F.ws, m / GROWS, GO_XN, DM) + (size_t)m * DM) + F.lane;
            GAS unsigned long long* ob = (GAS unsigned long long*)(grp_ptr(F.ws, m2 / GROWS, GO_XN, DM) + (size_t)m2 * DM) + F.lane;
#pragma unroll
            for (int j = 0; j < 4; ++j) {
                oa[64 * j] = (unsigned long long)pk2(va[j].x * ra * g[j].x, va[j].y * ra * g[j].y) | ((unsigned long long)pk2(va[j].z * ra * g[j].z, va[j].w * ra * g[j].w) << 32);
                ob[64 * j] = (unsigned long long)pk2(vb[j].x * rb * g[j].x, vb[j].y * rb * g[j].y) | ((unsigned long long)pk2(vb[j].z * rb * g[j].z, vb[j].w * rb * g[j].w) << 32); }
        }
    }
}
__device__ __forceinline__ void sa_load32(const bf16* p, float (&d)[32]) {
#pragma unroll
    for (int i = 0; i < 4; ++i) { const v4u w = *(const GAS v4u*)(p + 8 * i);
        d[8 * i + 0] = __uint_as_float(w.x << 16); d[8 * i + 1] = __uint_as_float(w.x & 0xffff0000u); d[8 * i + 2] = __uint_as_float(w.y << 16); d[8 * i + 3] = __uint_as_float(w.y & 0xffff0000u);
        d[8 * i + 4] = __uint_as_float(w.z << 16); d[8 * i + 5] = __uint_as_float(w.z & 0xffff0000u); d[8 * i + 6] = __uint_as_float(w.w << 16); d[8 * i + 7] = __uint_as_float(w.w & 0xffff0000u); }
}
__device__ __forceinline__ void sa_store32(bf16* p, const float (&o)[32], float sc) {
#pragma unroll
    for (int i = 0; i < 4; ++i) { v4u w; w.x = pk2(o[8 * i] * sc, o[8 * i + 1] * sc); w.y = pk2(o[8 * i + 2] * sc, o[8 * i + 3] * sc); w.z = pk2(o[8 * i + 4] * sc, o[8 * i + 5] * sc); w.w = pk2(o[8 * i + 6] * sc, o[8 * i + 7] * sc);
        *(GAS v4u*)(p + 8 * i) = w; }
}
#define SA_KEY(KPTR, VPTR, BIAS, VALID) do { \
    float s_ = 0.f; \
    { float kv_[32]; sa_load32((KPTR) + dof, kv_); \
        _Pragma("unroll") for (int d_ = 0; d_ < 32; ++d_) s_ = __builtin_fmaf(q[d_], kv_[d_], s_); asm volatile("" ::: "memory"); } \
    s_ += __shfl_xor(s_, 1); \
    s_ += (BIAS); const bool ok_ = (VALID); const float se_ = ok_ ? s_ : -1e30f; \
    if (__any(se_ > m)) { const float mn_ = __builtin_fmaxf(m, se_); const float c_ = __builtin_amdgcn_exp2f(m - mn_); l *= c_; _Pragma("unroll") for (int d_ = 0; d_ < 32; ++d_) o[d_] *= c_; m = mn_; } \
    const float p_ = ok_ ? __builtin_amdgcn_exp2f(s_ - m) : 0.f; l += p_; \
    { float kv_[32]; sa_load32((VPTR) + dof, kv_); \
        _Pragma("unroll") for (int d_ = 0; d_ < 32; ++d_) o[d_] = __builtin_fmaf(p_, kv_[d_], o[d_]); asm volatile("" ::: "memory"); } } while (0)

__device__ __forceinline__ void sa_moba(const bf16* Q, const bf16* KA, const bf16* VA, const float* kmean, bf16* O, int b, int h, int t0, int lane) {
    const int dof = 32 * (lane & 1);
    const int t = t0 + (lane >> 1), own = t0 >> 8;
    float q[32]; sa_load32(Q + ((size_t)(b * SEQ + t)) * 1024 + h * 64 + dof, q);
    unsigned sel;
    if (own <= 3) sel = (1u << own) - 1u;
    else {
        float gs[7];
#pragma unroll
        for (int n = 0; n < 7; ++n) { gs[n] = -INFINITY;
            if (n < own) { const float* km = kmean + ((size_t)(b * 8 + n) * 8 + h) * 64 + dof; float s = 0.f;
#pragma unroll
                for (int d = 0; d < 32; d += 4) { const f32x4 kv = *(const GAS f32x4*)(km + d); s = __builtin_fmaf(q[d], kv.x, s); s = __builtin_fmaf(q[d + 1], kv.y, s); s = __builtin_fmaf(q[d + 2], kv.z, s); s = __builtin_fmaf(q[d + 3], kv.w, s); }
                s += __shfl_xor(s, 1);
                gs[n] = s; asm volatile("" ::: "memory"); } }
        sel = 0u;
#pragma unroll
        for (int n = 0; n < 7; ++n) { int rank = 0;
#pragma unroll
            for (int j = 0; j < 7; ++j) if (j != n) rank += (gs[j] > gs[n] || (gs[j] == gs[n] && j < n)) ? 1 : 0;
            if (n < own && rank < 3) sel |= 1u << n; }
    }
    const float slope2 = exp2f(-0.5f * (float)(h + 9)) * pg8::kLog2e;
    float m = -1e30f, l = 0.f, o[32];
#pragma unroll
    for (int d = 0; d < 32; ++d) o[d] = 0.f;
    for (int n = 0; n <= own; ++n) {
        const bool isown = (n == own), mine = isown || ((sel >> n) & 1u);
        if (!__any(mine)) continue;
        const int nk = isown ? (t0 + 32 - n * 256) : 256;
        for (int kk = 0; kk < nk; ++kk) { const int tk = n * 256 + kk; const size_t r = (size_t)(b * SEQ + tk) * 512 + h * 64;
            SA_KEY(KA + r, VA + r, -slope2 * (float)(t - tk), mine && (tk <= t)); }
    }
    sa_store32(O + ((size_t)(b * SEQ + t)) * 1024 + h * 64 + dof, o, 1.0f / l);
}
__device__ __forceinline__ void sa_swa(const bf16* Q, const bf16* KB, const bf16* VB, const float* sinks, bf16* O, int b, int hq, int t0, int lane) {
    const int dof = 32 * (lane & 1);
    const int t = t0 + (lane >> 1), kvh = hq >> 2;
    float q[32]; sa_load32(Q + ((size_t)(b * SEQ + t)) * 1024 + 512 + hq * 64 + dof, q);
    const float slope2 = exp2f(-0.5f * (float)(hq + 1)) * pg8::kLog2e, sink2 = sinks[hq] * pg8::kLog2e;
    float m = -1e30f, l = 0.f, o[32];
#pragma unroll
    for (int d = 0; d < 32; ++d) o[d] = 0.f;
    const int k0 = t0 - 127 > 0 ? t0 - 127 : 0;
    for (int tk = k0; tk < t0 + 32; ++tk) { const size_t r = (size_t)(b * SEQ + tk) * 128 + kvh * 64;
        SA_KEY(KB + r, VB + r, -slope2 * (float)(t - tk), (tk <= t) && (t - tk < 128)); }
    const float mf = __builtin_fmaxf(m, sink2), c = __builtin_amdgcn_exp2f(m - mf);
    l = l * c + __builtin_amdgcn_exp2f(sink2 - mf);
    sa_store32(O + ((size_t)(b * SEQ + t)) * 1024 + 512 + hq * 64 + dof, o, c / l);
}
__device__ __forceinline__ void attn_simple_phase(Frame& F) {
    const int gw = F.li * NWAVES + F.wave, NGW = 32 * NWAVES;
    int i = 0;
    for (int u = gw; u < 1024; u += NGW, ++i) { const int b = 2 * F.grp + (u >> 9), h = (u >> 6) & 7; int ch = u & 63; if (i & 1) ch = 63 - ch;
        sa_moba(F.Q, F.KA, F.VA, F.kmean, F.Q, b, h, ch * 32, F.lane); }
    for (int u = gw; u < 1024; u += NGW) { const int b = 2 * F.grp + (u >> 9), hq = (u >> 6) & 7, ch = u & 63;
        sa_swa(F.Q, F.KB, F.VB, F.sinks, F.Q, b, hq, ch * 32, F.lane); }
}

namespace fa {
using bf16x8 = __attribute__((ext_vector_type(8))) short;
using s16x4 = __attribute__((ext_vector_type(4))) short;
using f32x16 = __attribute__((ext_vector_type(16))) float;
using u32x4 = __attribute__((ext_vector_type(4))) unsigned;
using f32x4 = __attribute__((ext_vector_type(4))) float;
constexpr int NW = 8, QBLK = 32, KVBLK = 64;
constexpr int SLOTB = 8192, LDS_K = 0, LDS_V = 3 * SLOTB, LDS_WS = 6 * SLOTB, LDS_OST = LDS_WS + NW * 256, LDS_QN = LDS_OST + NW * 4096, LDS_BYTES = LDS_QN + NW * 4096;
constexpr int QP = 1024;
#ifndef FA_THR
#define FA_THR 8
#endif
#define SBAR() __builtin_amdgcn_sched_barrier(0)
#define PIN(x) asm volatile("" : "+v"(x))
#define MFMA(a, b, c) __builtin_amdgcn_mfma_f32_32x32x16_bf16(a, b, c, 0, 0, 0)
#define WAIT_BAR(N) asm volatile("s_waitcnt vmcnt(" #N ") lgkmcnt(0)\n\ts_barrier" ::: "memory")
__device__ __forceinline__ int crow(int r, int hi) { return (r & 3) + 8 * (r >> 2) + 4 * hi; }
__device__ __forceinline__ unsigned cvtpk(float lo, float hi) { unsigned r; asm("v_cvt_pk_bf16_f32 %0, %1, %2" : "=v"(r) : "v"(lo), "v"(hi)); return r; }
__device__ __forceinline__ void glds16(const void* g, unsigned lds_base) {
    unsigned sv; asm volatile("s_mov_b32 %0, m0\n\ts_mov_b32 m0, %2\n\ts_nop 0\n\tglobal_load_lds_dwordx4 %1, off\n\ts_mov_b32 m0, %0" : "=&s"(sv) : "v"(g), "s"(lds_base) : "memory"); }
typedef __attribute__((address_space(3))) const char* lds_cptr;
typedef short v4i16_t __attribute__((ext_vector_type(4)));
__device__ __forceinline__ void kload2(bf16x8* kf, lds_cptr kp, int d0) { kf[2 * d0] = *(const __attribute__((address_space(3))) bf16x8*)(kp + d0 * 2048); kf[2 * d0 + 1] = *(const __attribute__((address_space(3))) bf16x8*)(kp + d0 * 2048 + 512); }
__device__ __forceinline__ s16x4 vtr(lds_cptr p) { return __builtin_bit_cast(s16x4, __builtin_amdgcn_ds_read_tr16_b64_v4i16((__attribute__((address_space(3))) v4i16_t*)p)); }
#define MX3(a, b, c) __builtin_fmaxf(__builtin_fmaxf((a), (b)), (c))
__device__ __forceinline__ float rowmax(const f32x16& p0, const f32x16& p1) {
    float a = MX3(p0[0], p0[1], p1[0]), b = MX3(p0[2], p0[3], p1[1]); a = MX3(a, p1[2], p1[3]);
#pragma unroll
    for (int r = 4; r < 16; r += 4) { a = MX3(a, p0[r], p0[r + 1]); b = MX3(b, p0[r + 2], p0[r + 3]); a = MX3(a, p1[r], p1[r + 1]); b = MX3(b, p1[r + 2], p1[r + 3]); }
    float m = __builtin_fmaxf(a, b); auto rr = __builtin_amdgcn_permlane32_swap(__float_as_uint(m), __float_as_uint(m), false, false);
    return __builtin_fmaxf(__uint_as_float(rr[0]), __uint_as_float(rr[1])); }
__device__ __forceinline__ void emask(f32x16& p0, f32x16& p1, int dq  , unsigned wd) {
#pragma unroll
    for (int r = 0; r < 16; ++r) { const int kv = (r & 3) + 8 * (r >> 2); if ((unsigned)(dq - kv) >= wd) p0[r] = -INFINITY; if ((unsigned)(dq - kv - 32) >= wd) p1[r] = -INFINITY; } }
__device__ __forceinline__ unsigned bf16bits(float f) { unsigned u = __float_as_uint(f); return (u + 0x7fffu + ((u >> 16) & 1u)) >> 16; }

struct AU {
    const bf16* Qw;
    bf16* Ow;
    const bf16* Kb;
    const bf16* Vb;
    int KP;
    int q0;
    int qrel0;
    int NT;
    int mode;
    unsigned wd;
    float slope2;
    float sink2;
    unsigned okmask;
    const float* km;
    int gj;
};
__device__ __forceinline__ int key_rel(const AU& u, int t) {
    if (u.mode == 0) { const int np = u.NT - 4; return t == 0 ? 0 : (t <= np ? 64 * (t - 1) - 64 * np : 64 * (t - np)); }
    return -64 * t;
}
__device__ __forceinline__ int attn_unit(const AU& u, const AU& n, bool has_next, bool pre, int s0, char* lds) {
    const int tid = threadIdx.x; int lane = tid & 63; asm volatile("" : "+v"(lane));
    const int r32 = lane & 31, hi = lane >> 5; const int wid = __builtin_amdgcn_readfirstlane(tid >> 6);
    const int NT = u.NT, KP = u.KP;
    const unsigned lds0 = (unsigned)(uintptr_t)lds; float* wsf = (float*)(lds + LDS_WS) + wid * 64;
    const bf16* ksrc = u.Kb + (long)lane * KP + wid * 8;
    const bf16* vsrc = u.Vb + (long)(16 * (wid & 3) + (lane >> 2)) * KP + (wid >> 2) * 32 + (lane & 3) * 8;
    const unsigned kdst = lds0 + LDS_K + wid * 1024, vdst = lds0 + LDS_V + wid * 1024;
#define KROW(t) ({ int r_ = u.q0 + key_rel(u, (t)); r_ < 0 ? 0 : r_; })
#define DMA_K(t, slot) glds16(ksrc + (long)KROW(t) * KP, (unsigned)__builtin_amdgcn_readfirstlane(kdst + (slot)))
#define DMA_V(t, slot) glds16(vsrc + (long)KROW(t) * KP, (unsigned)__builtin_amdgcn_readfirstlane(vdst + (slot)))
    const lds_cptr vp0 = (lds_cptr)lds + LDS_V + ((lane >> 4) & 1) * 32 + (lane & 3) * 8 + (4 * hi + ((lane & 15) >> 2)) * 64;
    const lds_cptr kp0 = (lds_cptr)lds + LDS_K + hi * 1024 + r32 * 16;
    const int sA = s0, sB = (sA == 2 * SLOTB) ? 0 : sA + SLOTB, sC = (sB == 2 * SLOTB) ? 0 : sB + SLOTB;
    const lds_cptr qn0 = (lds_cptr)lds + LDS_QN + wid * 4096;
    bf16x8 qr[4];
    if (!pre) {
        DMA_K(0, sA); DMA_V(0, sA); DMA_K(1, sB);
#pragma unroll
        for (int d0 = 0; d0 < 4; ++d0) qr[d0] = *reinterpret_cast<const bf16x8*>(&u.Qw[(long)r32 * QP + d0 * 16 + hi * 8]);
    } else {
        asm volatile("s_waitcnt vmcnt(7)" ::: "memory");
#pragma unroll
        for (int d0 = 0; d0 < 4; ++d0) qr[d0] = *(const __attribute__((address_space(3))) bf16x8*)(qn0 + r32 * 128 + d0 * 32 + hi * 16);
    }
    bf16x8 qaug, kaug0, kaug1;
    { const unsigned sh = bf16bits(u.slope2); const float rem = u.slope2 - __uint_as_float(sh << 16); const unsigned sl = bf16bits(rem);
      const unsigned Sh = bf16bits(64.f * __uint_as_float(sh << 16)), Sl = bf16bits(64.f * __uint_as_float(sl << 16));
      u32x4 w = {hi ? 0u : (sh | (sl << 16)), hi ? 0u : (Sh | (Sl << 16)), 0u, 0u}; qaug = __builtin_bit_cast(bf16x8, w);
      const unsigned k0b = bf16bits((float)r32), k1b = bf16bits((float)(r32 + 32));
      u32x4 a0 = {k0b | (k0b << 16), 0u, 0u, 0u}, a1 = {k1b | (k1b << 16), 0u, 0u, 0u}; kaug0 = __builtin_bit_cast(bf16x8, a0); kaug1 = __builtin_bit_cast(bf16x8, a1); }
#define SET_TILE(t) do { const unsigned tb_ = bf16bits((float)(key_rel(u, (t)) >> 6)); const unsigned tw_ = tb_ | (tb_ << 16); \
      u32x4 a0_ = __builtin_bit_cast(u32x4, kaug0), a1_ = __builtin_bit_cast(u32x4, kaug1); a0_[1] = tw_; a1_[1] = tw_; kaug0 = __builtin_bit_cast(bf16x8, a0_); kaug1 = __builtin_bit_cast(bf16x8, a1_); } while (0)
    unsigned okmask = u.okmask;
    if (u.gj >= 4) {
        float gs[7];
#pragma unroll
        for (int n = 0; n < 7; ++n) { gs[n] = -INFINITY;
            if (n < u.gj) { const float* km = u.km + 512 * n + 8 * hi; float sg = 0.f;
#pragma unroll
                for (int d0 = 0; d0 < 4; ++d0) { const f32x4 k0 = *(const f32x4*)(km + 16 * d0), k1 = *(const f32x4*)(km + 16 * d0 + 4);
#define QF(e) __uint_as_float(((unsigned)(unsigned short)qr[d0][e]) << 16)
                    sg = __builtin_fmaf(QF(0), k0.x, sg); sg = __builtin_fmaf(QF(1), k0.y, sg); sg = __builtin_fmaf(QF(2), k0.z, sg); sg = __builtin_fmaf(QF(3), k0.w, sg);
                    sg = __builtin_fmaf(QF(4), k1.x, sg); sg = __builtin_fmaf(QF(5), k1.y, sg); sg = __builtin_fmaf(QF(6), k1.z, sg); sg = __builtin_fmaf(QF(7), k1.w, sg);
#undef QF
                }
                sg += __shfl_xor(sg, 32); gs[n] = sg; } }
        unsigned ok = 1u | (7u << (NT - 3));
#pragma unroll
        for (int n = 0; n < 7; ++n) { int rank = 0;
#pragma unroll
            for (int k = 0; k < 7; ++k) if (k != n) rank += (gs[k] > gs[n] || (gs[k] == gs[n] && k < n)) ? 1 : 0;
            if (n < u.gj && rank < 3) ok |= 0xFu << (1 + 4 * n); }
        okmask = ok;
    }
    float mhat = 0.f, l_reg = 0.f; f32x16 o[2]; o[0] = f32x16{}; o[1] = f32x16{};
    const int qrel = u.qrel0 + r32; bool resc = false; const unsigned wd = u.wd;
    f32x16 cin; bool okp = true;
#define SETCIN(okv) do { const float cv_ = (okv) ? -mhat : -INFINITY; _Pragma("unroll") for (int r_ = 0; r_ < 16; ++r_) cin[r_] = cv_; PIN(cin); } while (0)
    f32x16 pA0, pA1, pB0, pB1; bf16x8 kf[8]; s16x4 vlo[8], vhi[8]; u32x4 pw0, pw1, pw2, pw3;
    int sl_prev = sA, sl_cur = sA, sl_next = sB;
#define ROT() do { sl_prev = sl_cur; sl_cur = sl_next; sl_next = (sl_next == 2 * SLOTB) ? 0 : sl_next + SLOTB; } while (0)
#define EX(v) __builtin_amdgcn_exp2f(v)
#define RESC() do { if (resc) { _Pragma("unroll") for (int d_ = 0; d_ < 2; ++d_) _Pragma("unroll") for (int r = 0; r < 16; ++r) o[d_][r] *= wsf[crow(r, hi)]; } } while (0)
    if (!pre) { DMA_K(2, sC); WAIT_BAR(3); } else { WAIT_BAR(7); }
    _Pragma("unroll") for (int d0 = 0; d0 < 4; ++d0) kload2(kf, kp0 + sA, d0);
    SET_TILE(0);
    pA0 = MFMA(kaug0, qaug, f32x16{}); pA1 = MFMA(kaug1, qaug, f32x16{});
    pA0 = MFMA(kf[0], qr[0], pA0); pA1 = MFMA(kf[1], qr[0], pA1); pA0 = MFMA(kf[2], qr[1], pA0); pA1 = MFMA(kf[3], qr[1], pA1);
    pA0 = MFMA(kf[4], qr[2], pA0); pA1 = MFMA(kf[5], qr[2], pA1); pA0 = MFMA(kf[6], qr[3], pA0); pA1 = MFMA(kf[7], qr[3], pA1);
    emask(pA0, pA1, qrel - key_rel(u, 0) - 4 * hi, wd);
    { const float rm = rowmax(pA0, pA1); mhat = rm;
#pragma unroll
      for (int r = 0; r < 16; ++r) { pA0[r] = EX(pA0[r] - rm); pA1[r] = EX(pA1[r] - rm); }
      SETCIN(true); }
    WAIT_BAR(0);
    DMA_K(3, sA); DMA_V(1, sB); ROT();
    _Pragma("unroll") for (int d0 = 0; d0 < 4; ++d0) kload2(kf, kp0 + sl_cur, d0);
    WAIT_BAR(2);
#define PKW(P, i) cvtpk(P[i], P[i + 1])
#define PAF(k) __builtin_bit_cast(bf16x8, pw##k)
#define VFR(i) (bf16x8){vlo[i][0], vlo[i][1], vlo[i][2], vlo[i][3], vhi[i][0], vhi[i][1], vhi[i][2], vhi[i][3]}
#define VRD(i) do { vlo[i] = vtr(vp_ + (((i) >> 2) * 4096 + ((i) & 3) * 1024)); vhi[i] = vtr(vp_ + (((i) >> 2) * 4096 + ((i) & 3) * 1024 + 512)); } while (0)
#define KRD(G, d0) do { if (G) { kload2(kf, kp0 + sl_next, d0); SBAR(); } } while (0)
#define GAPA(MF, a0, a1, a2, a3, W0, W1, PW) do { MF; sacc += a0; sacc += a1; sacc += a2; sacc += a3; W0; W1; PIN(PW); PIN(sacc); SBAR(); } while (0)
#define GAPB(MF, X, i) do { MF; X[i] = EX(X[i]); X[i + 1] = EX(X[i + 1]); X[i + 2] = EX(X[i + 2]); X[i + 3] = EX(X[i + 3]); PIN(X); SBAR(); } while (0)
#define STEP(C0, C1, P0, P1, t, MASK, GK, GV, GL) do { SBAR(); \
    const lds_cptr vp_ = vp0 + sl_prev; SET_TILE(t); \
    const bool ok_ = (okmask >> (t)) & 1u; \
    if (__any(ok_ != okp)) { SETCIN(ok_); okp = ok_; } \
    C0 = MFMA(kaug0, qaug, cin); C1 = MFMA(kaug1, qaug, cin); SBAR(); \
    VRD(0); SBAR(); float sacc = P0[0] + P0[1]; \
                    GAPA(C0 = MFMA(kf[0], qr[0], C0), P0[2], P0[3], P0[4], P0[5],     pw0[0] = PKW(P0, 0),  pw0[1] = PKW(P0, 2),  pw0); \
    VRD(4); SBAR(); GAPA(C1 = MFMA(kf[1], qr[0], C1), P0[6], P0[7], P0[8], P0[9],     pw0[2] = PKW(P0, 4),  pw0[3] = PKW(P0, 6),  pw0); \
    VRD(1); SBAR(); GAPA(C0 = MFMA(kf[2], qr[1], C0),    P0[10], P0[11], P0[12], P0[13], pw1[0] = PKW(P0, 8),  pw1[1] = PKW(P0, 10), pw1); \
    VRD(5); SBAR(); GAPA(C1 = MFMA(kf[3], qr[1], C1),    P0[14], P0[15], P1[0], P1[1],   pw1[2] = PKW(P0, 12), pw1[3] = PKW(P0, 14), pw1); \
    VRD(2); SBAR(); GAPA(C0 = MFMA(kf[4], qr[2], C0),    P1[2], P1[3], P1[4], P1[5],     pw2[0] = PKW(P1, 0),  pw2[1] = PKW(P1, 2),  pw2); \
    VRD(6); SBAR(); GAPA(C1 = MFMA(kf[5], qr[2], C1),    P1[6], P1[7], P1[8], P1[9],     pw2[2] = PKW(P1, 4),  pw2[3] = PKW(P1, 6),  pw2); \
    VRD(3); SBAR(); GAPA(C0 = MFMA(kf[6], qr[3], C0),    P1[10], P1[11], P1[12], P1[13], pw3[0] = PKW(P1, 8),  pw3[1] = PKW(P1, 10), pw3); \
    VRD(7); SBAR(); GAPA(C1 = MFMA(kf[7], qr[3], C1),    P1[14], P1[15], 0.f, 0.f,       pw3[2] = PKW(P1, 12), pw3[3] = PKW(P1, 14), pw3); \
    l_reg += sacc; \
    if (GK) DMA_K((t) + 3, sl_cur); if (GV) DMA_V((t) + 1, sl_next); \
    if (MASK) { if (u.mode == 1 || (t) > NT - 4) emask(C0, C1, qrel - key_rel(u, (t)) - 4 * hi, wd); }            \
    { const float rm = rowmax(C0, C1); resc = false;                                                    \
      if (__builtin_expect(__any(rm > (float)FA_THR), 0)) { const float dl = __builtin_fmaxf(rm, 0.f); mhat += dl; \
          _Pragma("unroll") for (int r = 0; r < 16; ++r) { C0[r] -= dl; C1[r] -= dl; } SETCIN(ok_); \
          const float f = __builtin_amdgcn_exp2f(-dl); l_reg *= f; if (hi == 0) wsf[r32] = f; resc = true; } } \
    SBAR(); \
    GAPB(o[0] = MFMA(PAF(0), VFR(0), o[0]), C0, 0);              GAPB(o[1] = MFMA(PAF(0), VFR(4), o[1]), C0, 4); \
    KRD(GL, 0); GAPB(o[0] = MFMA(PAF(1), VFR(1), o[0]), C0, 8);  KRD(GL, 1); GAPB(o[1] = MFMA(PAF(1), VFR(5), o[1]), C0, 12); \
    KRD(GL, 2); GAPB(o[0] = MFMA(PAF(2), VFR(2), o[0]), C1, 0);  KRD(GL, 3); GAPB(o[1] = MFMA(PAF(2), VFR(6), o[1]), C1, 4); \
    GAPB(o[0] = MFMA(PAF(3), VFR(3), o[0]), C1, 8);              GAPB(o[1] = MFMA(PAF(3), VFR(7), o[1]), C1, 12); \
    } while (0)
    int t = 1;
    for (; t + 5 < NT; t += 2) {
        STEP(pB0, pB1, pA0, pA1, t, false, true, true, true);     WAIT_BAR(2); RESC(); ROT();
        STEP(pA0, pA1, pB0, pB1, t + 1, false, true, true, true); WAIT_BAR(2); RESC(); ROT();
    }
#define ENDW(tt) do { if ((tt) + 3 < NT) { WAIT_BAR(2); } else if ((tt) + 2 < NT) { WAIT_BAR(1); } else { WAIT_BAR(0); } } while (0)
    for (; t + 1 < NT; t += 2) {
        STEP(pB0, pB1, pA0, pA1, t, true, (t + 3 < NT), (t + 1 < NT), (t + 1 < NT));         ENDW(t);     RESC(); ROT();
        STEP(pA0, pA1, pB0, pB1, t + 1, true, (t + 4 < NT), (t + 2 < NT), (t + 2 < NT));     ENDW(t + 1); RESC(); ROT();
    }
    int s_ret = 0;
    if (has_next) {
        const int n0 = sl_next, n1 = (n0 == 2 * SLOTB) ? 0 : n0 + SLOTB, n2 = (n1 == 2 * SLOTB) ? 0 : n1 + SLOTB; s_ret = n0;
        const bf16* ks2 = n.Kb + (long)lane * n.KP + wid * 8;
        const bf16* vs2 = n.Vb + (long)(16 * (wid & 3) + (lane >> 2)) * n.KP + (wid >> 2) * 32 + (lane & 3) * 8;
#define NROW(t) ({ int r_ = n.q0 + key_rel(n, (t)); r_ < 0 ? 0 : r_; })
        glds16(ks2 + (long)NROW(0) * n.KP, (unsigned)__builtin_amdgcn_readfirstlane(kdst + n0));
        const bf16* qs2 = n.Qw + (long)(lane >> 3) * QP + (lane & 7) * 8; const unsigned qdst = lds0 + LDS_QN + wid * 4096;
#pragma unroll
        for (int k = 0; k < 4; ++k) glds16(qs2 + (long)(8 * k) * QP, (unsigned)__builtin_amdgcn_readfirstlane(qdst + k * 1024));
        glds16(vs2 + (long)NROW(0) * n.KP, (unsigned)__builtin_amdgcn_readfirstlane(vdst + n0));
        glds16(ks2 + (long)NROW(1) * n.KP, (unsigned)__builtin_amdgcn_readfirstlane(kdst + n1));
        glds16(ks2 + (long)NROW(2) * n.KP, (unsigned)__builtin_amdgcn_readfirstlane(kdst + n2));
#undef NROW
    }
    STEP(pB0, pB1, pA0, pA1, NT - 1, true, false, false, false); RESC();
    { float sacc = pB0[0] + pB0[1];
#pragma unroll
      for (int r = 2; r < 16; ++r) sacc += pB0[r];
#pragma unroll
      for (int r = 0; r < 16; ++r) sacc += pB1[r];
      l_reg += sacc;
      pw0 = (u32x4){PKW(pB0, 0), PKW(pB0, 2), PKW(pB0, 4), PKW(pB0, 6)}; pw1 = (u32x4){PKW(pB0, 8), PKW(pB0, 10), PKW(pB0, 12), PKW(pB0, 14)};
      pw2 = (u32x4){PKW(pB1, 0), PKW(pB1, 2), PKW(pB1, 4), PKW(pB1, 6)}; pw3 = (u32x4){PKW(pB1, 8), PKW(pB1, 10), PKW(pB1, 12), PKW(pB1, 14)};
      const lds_cptr vp_ = vp0 + sl_cur; _Pragma("unroll") for (int i = 0; i < 8; ++i) VRD(i);
      o[0] = MFMA(PAF(0), VFR(0), o[0]); o[1] = MFMA(PAF(0), VFR(4), o[1]); o[0] = MFMA(PAF(1), VFR(1), o[0]); o[1] = MFMA(PAF(1), VFR(5), o[1]);
      o[0] = MFMA(PAF(2), VFR(2), o[0]); o[1] = MFMA(PAF(2), VFR(6), o[1]); o[0] = MFMA(PAF(3), VFR(3), o[0]); o[1] = MFMA(PAF(3), VFR(7), o[1]); }
    { auto rr = __builtin_amdgcn_permlane32_swap(__float_as_uint(l_reg), __float_as_uint(l_reg), false, false); l_reg = __uint_as_float(rr[0]) + __uint_as_float(rr[1]); }
    {
      const float sk = u.sink2 + u.slope2 * (float)qrel, mf = __builtin_fmaxf(mhat, sk), c = __builtin_amdgcn_exp2f(mhat - mf);
      const float lt = l_reg * c + __builtin_amdgcn_exp2f(sk - mf);
      if (hi == 0) wsf[32 + r32] = c * __builtin_amdgcn_rcpf(lt); }
    asm volatile("s_waitcnt lgkmcnt(0)" ::: "memory");
    float rli[16];
#pragma unroll
    for (int r = 0; r < 16; ++r) rli[r] = wsf[32 + crow(r, hi)];
    bf16* stg = (bf16*)(lds + LDS_OST) + wid * 2048;
    { int l2 = lane; asm volatile("" : "+v"(l2)); const int r32b = l2 & 31, hib = l2 >> 5;
#pragma unroll
    for (int r = 0; r < 16; ++r) { const int orow = crow(r, hib);
#pragma unroll
        for (int d0 = 0; d0 < 2; ++d0) stg[orow * 64 + d0 * 32 + r32b] = (bf16)bf16bits(o[d0][r] * rli[r]); }
    asm volatile("s_waitcnt lgkmcnt(0)" ::: "memory");
    const int srow = l2 >> 3, ch = l2 & 7; const u32x4* sp = (const u32x4*)(stg + srow * 64 + ch * 8); bf16* gp = u.Ow + (long)srow * QP + ch * 8;
#pragma unroll
    for (int i = 0; i < 4; ++i) *(u32x4*)(gp + (long)i * 8 * QP) = sp[i * 64]; }
    asm volatile("s_waitcnt lgkmcnt(0)\n\ts_barrier" ::: "memory");
    return s_ret;
#undef KROW
#undef DMA_K
#undef DMA_V
#undef SET_TILE
#undef SETCIN
#undef ROT
#undef EX
#undef RESC
#undef PKW
#undef PAF
#undef VFR
#undef VRD
#undef KRD
#undef ENDW
#undef GAPA
#undef GAPB
#undef STEP
}
#undef SBAR
#undef PIN
#undef MFMA
#undef WAIT_BAR
#undef MX3
}

__device__ __forceinline__ float bfbits2f(short s) { return __uint_as_float(((unsigned)(unsigned short)s) << 16); }
__device__ __forceinline__ fa::AU attn_make_unit(const Frame& F, bf16* O, int i, float sink2w) {
    const int wid = F.wave; fa::AU u;
    const bool moba = i < 4;
    const int p = F.vcu >> 1, bm = p >> 3, h = p & 7, half = F.vcu & 1, im = i & 3;
    const int j = half ? (im == 0 ? 6 : im == 1 ? 5 : im == 2 ? 2 : 1) : (im == 0 ? 7 : im == 1 ? 4 : im == 2 ? 3 : 0);
    const int k = i - 4, us = (k < 4) ? F.vcu * 4 + k : (F.vcu - 16) * 4 + (k - 2), bs = us >> 6, kvh = (us >> 5) & 1, c = us & 31, hq = kvh * 4 + (wid >> 1);
    const int b = moba ? bm : bs;
    const size_t rowbase = (size_t)b * SEQ;
    const size_t qoff = moba ? (rowbase + 256 * j + 32 * wid) * 1024 + h * 64 : (rowbase + 64 * c + 32 * (wid & 1)) * 1024 + 512 + hq * 64;
    u.Kb = moba ? F.KA + rowbase * 512 + h * 64 : F.KB + rowbase * 128 + kvh * 64;
    u.Vb = moba ? F.VA + rowbase * 512 + h * 64 : F.VB + rowbase * 128 + kvh * 64;
    u.KP = moba ? 512 : 128;
    u.q0 = moba ? 256 * j : 64 * c; u.qrel0 = moba ? 32 * wid : 32 * (wid & 1); u.NT = moba ? 4 * (j + 1) : 4; u.mode = moba ? 0 : 1; u.wd = moba ? 0x40000000u : 128u;
    u.slope2 = exp2f(-0.5f * (float)(moba ? h + 9 : hq + 1)) * pg8::kLog2e; u.sink2 = moba ? -INFINITY : sink2w;
    const unsigned okm = 1u | (7u << (4 * (j + 1) - 3)) | (j <= 3 ? ((1u << (4 * j)) - 1u) << 1 : 0u);
    const unsigned oks = (c >= 3) ? 0xFu : ((1u << (c + 1)) - 1u);
    u.okmask = moba ? okm : oks;
    u.km = F.kmean + ((size_t)(bm * 8) * 8 + h) * 64; u.gj = moba ? j : 0;
    u.Qw = F.Q + qoff; u.Ow = O + qoff;
    return u;
}
__device__ __forceinline__ void attn_fast_phase(Frame& F, char* lds, bf16* O) {
    const float sink2w = F.sinks[(((F.vcu * 4) >> 5) & 1) * 4 + (F.wave >> 1)] * pg8::kLog2e;
    const int nun = (F.li < 16) ? 6 : 10;
    fa::AU cur = attn_make_unit(F, O, 0, sink2w); int s0 = 0; bool pre = false;
    for (int i = 0; i < nun; ++i) {
        const bool has_next = i + 1 < nun;
        const fa::AU nxt = attn_make_unit(F, O, has_next ? i + 1 : i, sink2w);
        s0 = fa::attn_unit(cur, nxt, has_next, pre, s0, lds);
        pre = has_next; cur = nxt;
    }
}
#if defined(DBG_ATTN)
__device__ __forceinline__ void dbg_compare(Frame& F, const bf16* Od) {
    const int gt = F.li * NWAVES * 64 + F.tid, NGT = 32 * NWAVES * 64; float num = 0.f, den = 0.f;
    for (size_t i = gt; i < (size_t)GROWS * 64; i += NGT) { const size_t row = (size_t)F.grp * GROWS + (i >> 6), c8 = i & 63; const size_t off = row * 1024 + DBG_PART * 512 + c8 * 8;
        const v4u a = *(const GAS v4u*)(Od + off), r = *(const GAS v4u*)(F.Q + off);
#define DD(x) { const float a0 = __uint_as_float(a.x << 16), a1 = __uint_as_float(a.x & 0xffff0000u), r0 = __uint_as_float(r.x << 16), r1 = __uint_as_float(r.x & 0xffff0000u); num += (a0 - r0) * (a0 - r0) + (a1 - r1) * (a1 - r1); den += r0 * r0 + r1 * r1; }
        DD(x) DD(y) DD(z) DD(w)
#undef DD
    }
    num = wave_sum(num); den = wave_sum(den);
    if (F.lane == 0) { atomicAdd((float*)(F.ctl) + 8, num); atomicAdd((float*)(F.ctl) + 9, den); }
}
#endif

struct Args { const float* in[14]; float* out; unsigned char* ws; };
__global__ void __launch_bounds__(NWAVES * 64, 2) fwd_megakernel(Args args) {
    extern __shared__ __attribute__((aligned(16))) unsigned char lds[];
    Frame F;
    F.lds = (LAS unsigned char*)lds;
    F.MISC = (volatile LAS unsigned*)(F.lds + MISC_OFF);
    F.tid = threadIdx.x; F.lane = F.tid & 63; F.wave = __builtin_amdgcn_readfirstlane(F.tid >> 6);
    F.G = gridDim.x;
    unsigned char* ws = args.ws; F.ws = ws;
    F.ctl = (gu32*)(ws + WS_CTL);
    F.x = args.in[0]; F.norm_attn = args.in[1]; F.w_in = args.in[2]; F.qna = args.in[3]; F.kna = args.in[4]; F.qnb = args.in[5]; F.knb = args.in[6]; F.sinks = args.in[7];
    F.wba = args.in[8]; F.wbb = args.in[9]; F.w_out = args.in[10]; F.norm_mlp = args.in[11]; F.w_up = args.in[12]; F.w_down = args.in[13]; F.out = args.out;
    F.WinT = (bf16*)(ws + WS_WIN); F.WbrT = (bf16*)(ws + WS_WBR); F.WoT = (bf16*)(ws + WS_WO); F.WupT = (bf16*)(ws + WS_WUP); F.WdnT = (bf16*)(ws + WS_WDN);
    F.kmean = (float*)(ws + WS_CTL) + CW_KMEAN; F.rowsq = (float*)(ws + WS_CTL) + CW_ROWSQ;
    for (int u = F.tid; u < (LDS_BYTES - LDSCTL_OFF) / 4; u += NWAVES * 64) ((LAS unsigned*)(F.lds + LDSCTL_OFF))[u] = 0u;
    __syncthreads();
    XcdBarrier bar = xcd_barrier_post((unsigned*)(F.ctl + CW_BAR), F.MISC + 8);
    if (F.tid == 0) F.MISC[12] = xb_add((unsigned*)(F.ctl + CW_CENSUS) + 64 * bar.x, 1u);
    __syncthreads();
    const unsigned my_arrival = F.MISC[12];
#define GRID_BAR() xcd_barrier(bar)

#ifndef SKIP_P0
    p0_prologue(F);
#endif
    GRID_BAR();
    {   bool ok = (F.G == 256);
        for (int j = 0; j < 16; ++j) { const unsigned c = __hip_atomic_load((unsigned*)(F.ctl + CW_CENSUS) + 64 * j, RLX_AGENT); ok = ok && (c == (j < NGRP ? 32u : 0u)); }
        F.grouped = ok ? 1 : 0;
        if (ok) { F.grp = (int)bar.x; F.li = (int)my_arrival; }
        else    { F.grp = (int)blockIdx.x % NGRP; F.li = (int)blockIdx.x / NGRP; }
        F.grp = __builtin_amdgcn_readfirstlane(F.grp); F.li = __builtin_amdgcn_readfirstlane(F.li);
        F.vcu = F.grp * 32 + F.li; }
    const int vbid = F.li * NGRP + F.grp;
    F.Q = grp_ptr(ws, F.grp, GO_Q, 1024); F.KA = grp_ptr(ws, F.grp, GO_KA, 512); F.VA = grp_ptr(ws, F.grp, GO_VA, 512); F.KB = grp_ptr(ws, F.grp, GO_KB, 128); F.VB = grp_ptr(ws, F.grp, GO_VB, 128);
    F.GA = grp_ptr(ws, F.grp, GO_GA, 1024); F.GB = grp_ptr(ws, F.grp, GO_GB, 1024); F.HB = grp_ptr(ws, F.grp, GO_H, 4096); F.A2 = grp_ptr(ws, F.grp, GO_A2, 1024); F.XN = grp_ptr(ws, F.grp, GO_XN, 1024);
    GroupBar gbar{(unsigned*)(F.ctl + CW_GSUB) + 64 * F.grp, (unsigned*)(F.ctl + CW_GGEN) + 64 * F.grp, (unsigned*)(F.ctl + CW_BAR)};
#define GROUP_BAR() do { if (F.grouped) group_barrier(gbar); else xcd_barrier(bar); } while (0)
#ifndef SKIP_P1
    {   pg8::Gemm g{F.XN, F.WinT, M, NIN, DM}; pg8::StaticOrder S; S.init(M, NIN, F.G, vbid);
        pg8::EpiIn E{F.Q, F.KA, F.VA, F.KB, F.VB, F.GA, F.GB, F.qna, F.kna, F.qnb, F.knb, F.kmean};
        S.ilim = 8;
        pg8::gemm_phase<pg8::EpiIn, pg8::StaticOrder, true, true>(F.lds + RING_OFF, g, S, E);
        GROUP_BAR();
        if (F.li < 16) { S.ioff = 8; S.ilim = 1; pg8::gemm_phase<pg8::EpiIn, pg8::StaticOrder, true, true>(F.lds + RING_OFF, g, S, E); } }
#endif
#if defined(DBG_ATTN)
    attn_fast_phase(F, (char*)lds + RING_OFF, F.XN); GROUP_BAR(); attn_simple_phase(F); GROUP_BAR(); dbg_compare(F, F.XN);
#elif defined(SIMPLE_ATTN)
    attn_simple_phase(F);
#else
    attn_fast_phase(F, (char*)lds + RING_OFF, F.Q);
#endif
    GROUP_BAR();
#ifndef SKIP_P3
    {   pg8::Gemm g{F.Q, F.WbrT, M, DM, DM}; pg8::StaticOrder S; S.init(M, DM, F.G, vbid);
        pg8::EpiMix E{F.GA, F.GB, F.XN};
        pg8::gemm_phase<pg8::EpiMix, pg8::StaticOrder, true, true>(F.lds + RING_OFF, g, S, E); }
#endif
    GROUP_BAR();
#ifndef SKIP_P4
    {   pg8::Gemm g{F.XN, F.WoT, M, DM, DM}; pg8::StaticOrder S; S.init(M, DM, F.G, vbid);
        pg8::EpiX1 E{F.x, F.A2, F.rowsq};
        pg8::gemm_phase<pg8::EpiX1, pg8::StaticOrder, true, true>(F.lds + RING_OFF, g, S, E); }
#endif
    GROUP_BAR();
#ifndef SKIP_P5
    {   pg8::Gemm g{F.A2, F.WupT, M, FF, DM}; pg8::StaticOrder S; S.init(M, FF, F.G, vbid);
        pg8::EpiUp E{F.HB, F.rowsq, F.lds + STG_OFF};
        pg8::gemm_phase<pg8::EpiUp, pg8::StaticOrder, true, true>(F.lds + RING_OFF, g, S, E); }
#endif
    GROUP_BAR();
#ifndef SKIP_P6
    {   pg8::Gemm g{F.HB, F.WdnT, M, DM, FF}; pg8::StaticOrder S; S.init(M, DM, F.G, vbid);
#if defined(DBG_ATTN)
        const float dnum = ((const GAS float*)F.ctl)[8], dden = ((const GAS float*)F.ctl)[9];
        pg8::EpiDown E{F.A2, F.out, 1.0f + 100.0f * sqrtf(dnum / dden), F.lds + STG_OFF};
#else
        pg8::EpiDown E{F.A2, F.out, 1.0f, F.lds + STG_OFF};
#endif
        pg8::gemm_phase<pg8::EpiDown, pg8::StaticOrder, true, true>(F.lds + RING_OFF, g, S, E); }
#endif
}

extern "C" void kernel_launch(void* const* d_in, const int* in_sizes, int n_in, void* d_out, int out_size, void* d_ws, size_t ws_size, hipStream_t stream) {
    static int grid = 0;
    if (grid == 0) {
        if (n_in != 14 || in_sizes[0] != M * DM || out_size != M * DM || ws_size < WS_END) { fprintf(stderr, "kernel_launch: unexpected shapes: n_in %d, in0 %d, out %d, ws %zu (need %zu); nothing launched\n", n_in, n_in > 0 ? in_sizes[0] : -1, out_size, ws_size, (size_t)WS_END); grid = -1; return; }
        int dev = 0, cus = 0, per_cu = 0;
        if (hipGetDevice(&dev) != hipSuccess || hipDeviceGetAttribute(&cus, hipDeviceAttributeMultiprocessorCount, dev) != hipSuccess) { fprintf(stderr, "kernel_launch: device query failed\n"); grid = -1; return; }
        if (hipFuncSetAttribute((const void*)fwd_megakernel, hipFuncAttributeMaxDynamicSharedMemorySize, LDS_BYTES) != hipSuccess) { fprintf(stderr, "kernel_launch: hipFuncSetAttribute failed\n"); grid = -1; return; }
        if (hipOccupancyMaxActiveBlocksPerMultiprocessor(&per_cu, (const void*)fwd_megakernel, NWAVES * 64, LDS_BYTES) != hipSuccess || per_cu < 1)
            fprintf(stderr, "kernel_launch: note: occupancy query reports %d workgroups per CU\n", per_cu);
        (void)hipGetLastError();
        grid = cus;
    }
    if (grid < 0) return;
    if (hipMemsetAsync((char*)d_ws + WS_CTL, 0, CTL_ZERO_BYTES, stream) != hipSuccess) { fprintf(stderr, "kernel_launch: hipMemsetAsync failed\n"); return; }
    Args a{};
    for (int i = 0; i < 14; ++i) a.in[i] = (const float*)d_in[i];
    a.out = (float*)d_out; a.ws = (unsigned char*)d_ws;
    hipLaunchKernelGGL(fwd_megakernel, dim3(grid), dim3(NWAVES * 64), LDS_BYTES, stream, a);
    const hipError_t le = hipPeekAtLastError();
    if (le != hipSuccess) fprintf(stderr, "kernel_launch: launch failed: %s\n", hipGetErrorName(le));
}
```

```cpp
#include <hip/hip_runtime.h>
#include <cstdio>
#include <cstdint>
namespace pg8 {
#define PG8_LAS __attribute__((address_space(3)))
typedef unsigned short bf16_t;
typedef short bf16x8 __attribute__((ext_vector_type(8)));
typedef float f32x4 __attribute__((ext_vector_type(4)));
typedef unsigned u32x4 __attribute__((ext_vector_type(4)));
constexpr int BM = 256, BK = 64, HALF = 128, HTB = HALF * BK * 2  , STAGE_BYTES = 8 * HTB, NXCD = 8, WGM = 8;

__host__ __device__ __forceinline__ int lds_byte(int r, int c) { const int st = (r >> 4) * 2 + (c >> 5), rr = r & 15, cc = c & 31, ob = rr * 64 + cc * 2; return st * 1024 + (ob ^ (((ob >> 9) & 1) << 5)); }
__host__ __device__ __forceinline__ void stage_rc(int b, int& R, int& C) { const int st = b / 1024, sb = b % 1024, swz = sb ^ (((sb >> 9) & 1) << 5); R = (st >> 1) * 16 + swz / 64; C = (st & 1) * 32 + (swz % 64) / 2; }
__host__ __device__ __forceinline__ int perm32(int rho) { const int n = rho >> 4, i = rho & 15; return 8 * (i >> 2) + 4 * n + (i & 3); }

struct Unit { int pm, pn; };
struct Gemm { const bf16_t* A; const bf16_t* Bt; int M, N, K; };

struct StaticOrder {
    int nM, nN, nwg, G, c, ioff = 0, ilim = 1 << 30;
    __host__ __device__ void init(int M, int N, int G_, int c_) { nM = M / BM; nN = N / BM; nwg = nM * nN; G = G_; c = c_; }
    __host__ __device__ bool next(int i, Unit& u) const {
        if (i >= ilim) return false;
        const long L = (long)(i + ioff) * G + c; if (L >= nwg) return false;
        int wgid = (int)L; { const int q = nwg / NXCD, r = nwg % NXCD, xcd = wgid % NXCD, off = wgid / NXCD; wgid = (xcd < r ? xcd * (q + 1) : r * (q + 1) + (xcd - r) * q) + off; }
        const int nig = WGM * nN, gid = wgid / nig, fm = gid * WGM, gsz = (nM - fm) < WGM ? (nM - fm) : WGM;
        u.pm = fm + ((wgid % nig) % gsz); u.pn = (wgid % nig) / gsz; return true;
    }
    __device__ __forceinline__ void a_ready(const Unit&) const {}
    __device__ __forceinline__ void done(const Unit&) const {}
};

__device__ __forceinline__ unsigned cvt_pk_bf16(float lo, float hi) { unsigned r; asm volatile("v_cvt_pk_bf16_f32 %0, %1, %2" : "=v"(r) : "v"(lo), "v"(hi)); return r; }
typedef unsigned u32x2 __attribute__((ext_vector_type(2)));
__device__ __forceinline__ float bf_lo(unsigned w) { return __uint_as_float(w << 16); }
__device__ __forceinline__ float bf_hi(unsigned w) { return __uint_as_float(w & 0xffff0000u); }
constexpr float kLog2e = 1.4426950408889634f;
constexpr float kC2 = 0.125f * 1.4426950408889634f;

struct EpiIn {
    static constexpr bool PERM = true, AFTER_DRAIN = false; static constexpr int MID_TILE = 0;
    bf16_t *Q, *KA, *VA, *KB, *VB, *GR, *GB; const float *qna, *kna, *qnb, *knb; float* kmean;
    __device__ __forceinline__ void mid(f32x4 (&)[2][2][4][2], const Unit&, int, int, int, int) const {}
    __device__ __forceinline__ void operator()(const f32x4 (&acc)[2][2][4][2], const Unit& u, int wr, int wc, int fr, int fq) const {
        const int pn = u.pn;
        const int rowb = u.pm * BM + wr * 64 + fr;
        if (pn >= 9) {
            const int col = 128 * (pn - 9) + 32 * wc + 8 * fq;
#pragma unroll
            for (int ai = 0; ai < 2; ++ai)
#pragma unroll
                for (int m = 0; m < 4; ++m) { const size_t off = (size_t)(rowb + ai * HALF + m * 16) * 1024 + col;
                    f32x4 rt[2], gb[2];
#pragma unroll
                    for (int n = 0; n < 2; ++n)
#pragma unroll
                        for (int e = 0; e < 4; ++e) { const float ea = __builtin_amdgcn_exp2f(-kLog2e * acc[ai][0][m][n][e]), eb = __builtin_amdgcn_exp2f(-kLog2e * acc[ai][1][m][n][e]);
                            gb[n][e] = __builtin_fmaxf(__builtin_amdgcn_rcpf(1.0f + eb), 1e-20f); rt[n][e] = __builtin_fminf((1.0f + eb) * __builtin_amdgcn_rcpf(1.0f + ea), 1e20f); }
                    u32x4 w; w.x = cvt_pk_bf16(rt[0][0], rt[0][1]); w.y = cvt_pk_bf16(rt[0][2], rt[0][3]); w.z = cvt_pk_bf16(rt[1][0], rt[1][1]); w.w = cvt_pk_bf16(rt[1][2], rt[1][3]);
                    *(u32x4*)(GR + off) = w;
                    w.x = cvt_pk_bf16(gb[0][0], gb[0][1]); w.y = cvt_pk_bf16(gb[0][2], gb[0][3]); w.z = cvt_pk_bf16(gb[1][0], gb[1][1]); w.w = cvt_pk_bf16(gb[1][2], gb[1][3]);
                    *(u32x4*)(GB + off) = w; }
            return;
        }
        bf16_t* dst; int pitch; bool norm = false, km = false; float scale = 1.f; const float* gain = qna;
        if (pn < 2)       { dst = Q + (4 * pn + wc) * 64; pitch = 1024; norm = true; gain = qna; scale = kC2; }
        else if (pn < 4)  { dst = KA + (4 * (pn - 2) + wc) * 64; pitch = 512; norm = true; gain = kna; km = true; }
        else if (pn < 6)  { dst = VA + (4 * (pn - 4) + wc) * 64; pitch = 512; }
        else if (pn < 8)  { dst = Q + 512 + (4 * (pn - 6) + wc) * 64; pitch = 1024; norm = true; gain = qnb; scale = kC2; }
        else              { pitch = 128; if (wc < 2) { dst = KB + wc * 64; norm = true; gain = knb; } else { dst = VB + (wc - 2) * 64; } }
        f32x4 g[2][2], cs[2][2];
#pragma unroll
        for (int bj = 0; bj < 2; ++bj)
#pragma unroll
            for (int n = 0; n < 2; ++n) { g[bj][n] = norm ? *(const f32x4*)(gain + 32 * bj + 8 * fq + 4 * n) : (f32x4){1.f, 1.f, 1.f, 1.f}; cs[bj][n] = (f32x4){0.f, 0.f, 0.f, 0.f}; }
#pragma unroll
        for (int ai = 0; ai < 2; ++ai)
#pragma unroll
            for (int m = 0; m < 4; ++m) {
                const int row = rowb + ai * HALF + m * 16;
                f32x4 v[2][2];
#pragma unroll
                for (int bj = 0; bj < 2; ++bj)
#pragma unroll
                    for (int n = 0; n < 2; ++n) v[bj][n] = acc[ai][bj][m][n];
                if (norm) {
                    float ss = 0.f;
#pragma unroll
                    for (int bj = 0; bj < 2; ++bj)
#pragma unroll
                        for (int n = 0; n < 2; ++n) { const f32x4 x = v[bj][n]; ss += (x[0] * x[0] + x[1] * x[1]) + (x[2] * x[2] + x[3] * x[3]); }
                    ss += __shfl_xor(ss, 16); ss += __shfl_xor(ss, 32);
                    const float rs = __builtin_amdgcn_rsqf(ss * (1.0f / 64.0f) + 1e-6f) * scale;
#pragma unroll
                    for (int bj = 0; bj < 2; ++bj)
#pragma unroll
                        for (int n = 0; n < 2; ++n) v[bj][n] = v[bj][n] * rs * g[bj][n];
                }
                if (km) {
#pragma unroll
                    for (int bj = 0; bj < 2; ++bj)
#pragma unroll
                        for (int n = 0; n < 2; ++n) cs[bj][n] += v[bj][n];
                }
#pragma unroll
                for (int bj = 0; bj < 2; ++bj) {
                    u32x4 w; w.x = cvt_pk_bf16(v[bj][0][0], v[bj][0][1]); w.y = cvt_pk_bf16(v[bj][0][2], v[bj][0][3]); w.z = cvt_pk_bf16(v[bj][1][0], v[bj][1][1]); w.w = cvt_pk_bf16(v[bj][1][2], v[bj][1][3]);
                    *(u32x4*)(dst + (size_t)row * pitch + 32 * bj + 8 * fq) = w;
                }
            }
        if (km) {
            float* kmp = kmean + ((size_t)u.pm * 8 + (4 * (pn - 2) + wc)) * 64;
#pragma unroll
            for (int bj = 0; bj < 2; ++bj)
#pragma unroll
                for (int n = 0; n < 2; ++n)
#pragma unroll
                    for (int e = 0; e < 4; ++e) {
                        float s = cs[bj][n][e];
                        s += __shfl_xor(s, 1); s += __shfl_xor(s, 2); s += __shfl_xor(s, 4); s += __shfl_xor(s, 8);
                        if (fr == 0) atomicAdd(kmp + 32 * bj + 8 * fq + 4 * n + e, s * (1.0f / 256.0f));
                    }
        }
    }
};

struct EpiMix {
    static constexpr bool PERM = true, AFTER_DRAIN = false; static constexpr int MID_TILE = 8;
    const bf16_t *GR, *GB; bf16_t* MIX;
    __device__ __forceinline__ void mid(f32x4 (&acc)[2][2][4][2], const Unit& u, int wr, int wc, int fr, int fq) const {
        int rowb = u.pm * BM + wr * 64 + fr, col0 = u.pn * BM + wc * 32 + 8 * fq;
        asm volatile("" : "+v"(rowb), "+v"(col0));
        const bf16_t* base = GR + (size_t)rowb * 1024 + col0;
        u32x4 rt[2][4][2];
#pragma unroll
        for (int ai = 0; ai < 2; ++ai)
#pragma unroll
            for (int m = 0; m < 4; ++m)
#pragma unroll
                for (int bj = 0; bj < 2; ++bj) rt[ai][m][bj] = *(const u32x4*)(base + (size_t)(ai * HALF + m * 16) * 1024 + bj * HALF);
#pragma unroll
        for (int ai = 0; ai < 2; ++ai)
#pragma unroll
            for (int m = 0; m < 4; ++m)
#pragma unroll
                for (int bj = 0; bj < 2; ++bj) { const u32x4 a = rt[ai][m][bj];
                    acc[ai][bj][m][0] *= (f32x4){bf_lo(a.x), bf_hi(a.x), bf_lo(a.y), bf_hi(a.y)}; acc[ai][bj][m][1] *= (f32x4){bf_lo(a.z), bf_hi(a.z), bf_lo(a.w), bf_hi(a.w)}; }
    }
    __device__ __forceinline__ void operator()(const f32x4 (&acc)[2][2][4][2], const Unit& u, int wr, int wc, int fr, int fq) const {
        const int rowb = u.pm * BM + wr * 64 + fr, col0 = u.pn * BM + wc * 32 + 8 * fq;
        const bf16_t* base = GB + (size_t)rowb * 1024 + col0; bf16_t* ob = MIX + (size_t)rowb * 1024 + col0;
        u32x4 gt[2][4][2];
#pragma unroll
        for (int ai = 0; ai < 2; ++ai)
#pragma unroll
            for (int m = 0; m < 4; ++m)
#pragma unroll
                for (int bj = 0; bj < 2; ++bj) gt[ai][m][bj] = *(const u32x4*)(base + (size_t)(ai * HALF + m * 16) * 1024 + bj * HALF);
#pragma unroll
        for (int ai = 0; ai < 2; ++ai)
#pragma unroll
            for (int m = 0; m < 4; ++m)
#pragma unroll
                for (int bj = 0; bj < 2; ++bj) { const u32x4 b = gt[ai][m][bj];
                    const f32x4 v0 = acc[ai][bj][m][0], v1 = acc[ai][bj][m][1];
                    u32x4 w; w.x = cvt_pk_bf16(v0[0] * bf_lo(b.x), v0[1] * bf_hi(b.x)); w.y = cvt_pk_bf16(v0[2] * bf_lo(b.y), v0[3] * bf_hi(b.y));
                    w.z = cvt_pk_bf16(v1[0] * bf_lo(b.z), v1[1] * bf_hi(b.z)); w.w = cvt_pk_bf16(v1[2] * bf_lo(b.w), v1[3] * bf_hi(b.w));
                    *(u32x4*)(ob + (size_t)(ai * HALF + m * 16) * 1024 + bj * HALF) = w; }
    }
};

struct EpiX1 {
    static constexpr bool PERM = true, AFTER_DRAIN = false; static constexpr int MID_TILE = 0;
    const bf16_t* XN; const float* irs; const float* g1; bf16_t* X1; float* rowsq; PG8_LAS unsigned char* stg;
    __device__ __forceinline__ void mid(f32x4 (&)[2][2][4][2], const Unit&, int, int, int, int) const {}
    __device__ __forceinline__ void operator()(const f32x4 (&acc)[2][2][4][2], const Unit& u, int wr, int wc, int fr, int fq) const {
        const int rowb = u.pm * BM + wr * 64, colw = u.pn * BM + wc * 64;
        PG8_LAS unsigned char* sw = stg + (wr * 4 + wc) * 2048;
        const int lane = fq * 16 + fr, rr = lane >> 3, ch = lane & 7;
        u32x4 xv[2][4][2];
#pragma unroll
        for (int ai = 0; ai < 2; ++ai)
#pragma unroll
            for (int m = 0; m < 4; ++m)
#pragma unroll
                for (int bj = 0; bj < 2; ++bj) xv[ai][m][bj] = *(const u32x4*)(XN + (size_t)(rowb + fr + ai * HALF + m * 16) * 1024 + colw + 32 * bj + 8 * fq);
        f32x4 ig[2][2];
#pragma unroll
        for (int bj = 0; bj < 2; ++bj)
#pragma unroll
            for (int n = 0; n < 2; ++n) { const f32x4 gv = *(const f32x4*)(g1 + colw + 32 * bj + 8 * fq + 4 * n);
                ig[bj][n] = (f32x4){__builtin_amdgcn_rcpf(gv[0]), __builtin_amdgcn_rcpf(gv[1]), __builtin_amdgcn_rcpf(gv[2]), __builtin_amdgcn_rcpf(gv[3])}; }
#pragma unroll
        for (int ai = 0; ai < 2; ++ai)
#pragma unroll
            for (int m = 0; m < 4; ++m) { const int row0 = rowb + ai * HALF + m * 16; const float q = irs[row0 + fr]; float ss = 0.f;
#pragma unroll
                for (int bj = 0; bj < 2; ++bj) { const u32x4 a = xv[ai][m][bj];
                    const f32x4 x0 = (f32x4){bf_lo(a.x), bf_hi(a.x), bf_lo(a.y), bf_hi(a.y)} * q * ig[bj][0] + acc[ai][bj][m][0];
                    const f32x4 x1 = (f32x4){bf_lo(a.z), bf_hi(a.z), bf_lo(a.w), bf_hi(a.w)} * q * ig[bj][1] + acc[ai][bj][m][1];
                    ss += (x0[0] * x0[0] + x0[1] * x0[1]) + (x0[2] * x0[2] + x0[3] * x0[3]) + (x1[0] * x1[0] + x1[1] * x1[1]) + (x1[2] * x1[2] + x1[3] * x1[3]);
                    u32x4 w; w.x = cvt_pk_bf16(x0[0], x0[1]); w.y = cvt_pk_bf16(x0[2], x0[3]); w.z = cvt_pk_bf16(x1[0], x1[1]); w.w = cvt_pk_bf16(x1[2], x1[3]);
                    *(PG8_LAS u32x4*)(sw + fr * 128 + (((bj * 4 + fq) ^ (fr & 7)) << 4)) = w; }
                ss += __shfl_xor(ss, 16); ss += __shfl_xor(ss, 32);
                if (fq == 0) atomicAdd(rowsq + row0 + fr, ss);
                asm volatile("s_waitcnt lgkmcnt(0)" ::: "memory");
#pragma unroll
                for (int hh = 0; hh < 2; ++hh) { const int r2 = rr + 8 * hh;
                    const u32x4 w = *(const PG8_LAS u32x4*)(sw + r2 * 128 + ((ch ^ (r2 & 7)) << 4));
                    *(u32x4*)(X1 + (size_t)(row0 + r2) * 1024 + colw + ch * 8) = w; }
                asm volatile("s_waitcnt lgkmcnt(0)" ::: "memory"); }
    }
};

struct EpiUp {
    static constexpr bool PERM = true, AFTER_DRAIN = false; static constexpr int MID_TILE = 0;
    bf16_t* H; const float* rowsq; PG8_LAS unsigned char* stg;
    __device__ __forceinline__ void mid(f32x4 (&)[2][2][4][2], const Unit&, int, int, int, int) const {}
    __device__ __forceinline__ void operator()(const f32x4 (&acc)[2][2][4][2], const Unit& u, int wr, int wc, int fr, int fq) const {
        const int rowb = u.pm * BM + wr * 64, colw = u.pn * BM + wc * 64;
        PG8_LAS unsigned char* sw = stg + (wr * 4 + wc) * 2048;
        const int lane = fq * 16 + fr, rr = lane >> 3, ch = lane & 7;
#pragma unroll
        for (int ai = 0; ai < 2; ++ai)
#pragma unroll
            for (int m = 0; m < 4; ++m) { const int row0 = rowb + ai * HALF + m * 16;
                const float r = __builtin_amdgcn_rsqf(rowsq[row0 + fr] * (1.0f / 1024.0f) + 1e-6f);
#pragma unroll
                for (int bj = 0; bj < 2; ++bj) {
                    f32x4 v0 = acc[ai][bj][m][0] * r, v1 = acc[ai][bj][m][1] * r;
#pragma unroll
                    for (int e = 0; e < 4; ++e) { const float a = __builtin_fmaxf(v0[e], 0.f), b = __builtin_fmaxf(v1[e], 0.f); v0[e] = a * a; v1[e] = b * b; }
                    u32x4 w; w.x = cvt_pk_bf16(v0[0], v0[1]); w.y = cvt_pk_bf16(v0[2], v0[3]); w.z = cvt_pk_bf16(v1[0], v1[1]); w.w = cvt_pk_bf16(v1[2], v1[3]);
                    *(PG8_LAS u32x4*)(sw + fr * 128 + (((bj * 4 + fq) ^ (fr & 7)) << 4)) = w;
                }
                asm volatile("s_waitcnt lgkmcnt(0)" ::: "memory");
#pragma unroll
                for (int hh = 0; hh < 2; ++hh) { const int r2 = rr + 8 * hh;
                    const u32x4 w = *(const PG8_LAS u32x4*)(sw + r2 * 128 + ((ch ^ (r2 & 7)) << 4));
                    *(u32x4*)(H + (size_t)(row0 + r2) * 4096 + colw + ch * 8) = w; }
                asm volatile("s_waitcnt lgkmcnt(0)" ::: "memory");
            }
    }
};

struct EpiDown {
    static constexpr bool PERM = false, AFTER_DRAIN = false; static constexpr int MID_TILE = 0;
    const bf16_t* X1; float* out; float mul; PG8_LAS unsigned char* stg;
    __device__ __forceinline__ void mid(f32x4 (&)[2][2][4][2], const Unit&, int, int, int, int) const {}
    __device__ __forceinline__ void operator()(const f32x4 (&acc)[2][2][4][2], const Unit& u, int wr, int wc, int fr, int fq) const {
        const int rowb = u.pm * BM + wr * 64, col0 = u.pn * BM + wc * 32;
        PG8_LAS unsigned char* sw = stg + (wr * 4 + wc) * 2048;
        const int lane = fq * 16 + fr, rr = lane >> 3, ch = lane & 7;
        u32x2 xv[2][4][2][2];
#pragma unroll
        for (int ai = 0; ai < 2; ++ai)
#pragma unroll
            for (int m = 0; m < 4; ++m)
#pragma unroll
                for (int bj = 0; bj < 2; ++bj)
#pragma unroll
                    for (int n = 0; n < 2; ++n) xv[ai][m][bj][n] = *(const u32x2*)(X1 + (size_t)(rowb + fr + ai * HALF + m * 16) * 1024 + col0 + 4 * fq + bj * HALF + n * 16);
#pragma unroll
        for (int ai = 0; ai < 2; ++ai)
#pragma unroll
            for (int m = 0; m < 4; ++m)
#pragma unroll
                for (int bj = 0; bj < 2; ++bj) { const int row0 = rowb + ai * HALF + m * 16;
#pragma unroll
                    for (int n = 0; n < 2; ++n) { const u32x2 w = xv[ai][m][bj][n];
                        const f32x4 o = ((f32x4){bf_lo(w.x), bf_hi(w.x), bf_lo(w.y), bf_hi(w.y)} + acc[ai][bj][m][n]) * mul;
                        *(PG8_LAS f32x4*)(sw + fr * 128 + (((n * 4 + fq) ^ (fr & 7)) << 4)) = o; }
                    asm volatile("s_waitcnt lgkmcnt(0)" ::: "memory");
#pragma unroll
                    for (int hh = 0; hh < 2; ++hh) { const int r2 = rr + 8 * hh;
                        const f32x4 o = *(const PG8_LAS f32x4*)(sw + r2 * 128 + ((ch ^ (r2 & 7)) << 4));
                        *(f32x4*)(out + (size_t)(row0 + r2) * 1024 + col0 + bj * HALF + ch * 4) = o; }
                    asm volatile("s_waitcnt lgkmcnt(0)" ::: "memory"); }
    }
};

template <class Epi, class Sched, bool ALIGN_EPI = false, bool SP2 = false>
__device__ __forceinline__ void gemm_phase(PG8_LAS unsigned char* lds, const Gemm g, const Sched& S, const Epi& E) {
    int tid = threadIdx.x; asm volatile("" : "+v"(tid));
    const int wid = __builtin_amdgcn_readfirstlane(tid >> 6), lane = tid & 63, wr = wid >> 2, wc = wid & 3, fr = lane & 15, fq = lane >> 4;
    const int K = g.K, nt = K / BK;
    unsigned voffA[2], voffB[2];
#pragma unroll
    for (int i = 0; i < 2; ++i) { int R, C; stage_rc(tid * 16 + i * 8192, R, C); const int Rb = Epi::PERM ? ((R & ~31) + perm32(R & 31)) : R;
        voffA[i] = (unsigned)(R * K + C) * 2u; voffB[i] = (unsigned)(Rb * K + C) * 2u; }
    const size_t kstep = (size_t)(BK * 2);
    const size_t hstep = (size_t)HALF * K * 2;
    const size_t tstep = 2 * hstep;
    const unsigned ldsw = (unsigned)wid * 1024u;
    const int aoff = lds_byte(wr * 64 + fr, fq * 8), boff = lds_byte(wc * 32 + fr, fq * 8);
#define PG8_SA(b, h) (((b) * 2 + (h)) * HTB)
#define PG8_SB(b, h) ((4 + (b) * 2 + (h)) * HTB)
#define PG8_STAGE(bufoff, gbase, voff) do { _Pragma("unroll") for (int _i = 0; _i < 2; ++_i) \
        __builtin_amdgcn_global_load_lds((const unsigned*)((const char*)(gbase) + (voff)[_i]), (PG8_LAS unsigned*)(lds + (bufoff) + ldsw + _i * 8192), 16, 0, 0); } while (0)
#define PG8_LDA(dst, b, h) do { _Pragma("unroll") for (int m = 0; m < 4; ++m) _Pragma("unroll") for (int k = 0; k < 2; ++k) dst[m][k] = *(const PG8_LAS bf16x8*)(lds + PG8_SA(b, h) + aoff + m * 2048 + k * 1024); } while (0)
#define PG8_LDB(dst, b, h) do { _Pragma("unroll") for (int n = 0; n < 2; ++n) _Pragma("unroll") for (int k = 0; k < 2; ++k) dst[n][k] = *(const PG8_LAS bf16x8*)(lds + PG8_SB(b, h) + boff + n * 2048 + k * 1024); } while (0)
#define PG8_MMA(ai, bj, At, Bt) do { __builtin_amdgcn_s_setprio(1); _Pragma("unroll") for (int m = 0; m < 4; ++m) _Pragma("unroll") for (int n = 0; n < 2; ++n) _Pragma("unroll") for (int k = 0; k < 2; ++k) \
        acc[ai][bj][m][n] = __builtin_amdgcn_mfma_f32_16x16x32_bf16(Bt[n][k], At[m][k], acc[ai][bj][m][n], 0, 0, 0); __builtin_amdgcn_s_setprio(0); } while (0)
#define PG8_WAIT_V(n) asm volatile("s_waitcnt vmcnt(" #n ")" ::: "memory")
#define PG8_WAIT_L(n) asm volatile("s_waitcnt lgkmcnt(" #n ")" ::: "memory")
#define PG8_BAR __builtin_amdgcn_s_barrier()
#define PG8_SCHED __builtin_amdgcn_sched_barrier(0)
    Unit cur, nxt; int ui = 0;
    if (!S.next(0, cur)) return;
    f32x4 acc[2][2][4][2];
#pragma unroll
    for (int a = 0; a < 2; ++a)
#pragma unroll
        for (int b = 0; b < 2; ++b)
#pragma unroll
            for (int m = 0; m < 4; ++m)
#pragma unroll
                for (int n = 0; n < 2; ++n) acc[a][b][m][n] = (f32x4){0.f, 0.f, 0.f, 0.f};
    bf16x8 At[4][2], B0[2][2], B1[2][2];
    const char* cA = (const char*)g.A + (size_t)cur.pm * tstep; const char* cB = (const char*)g.Bt + (size_t)cur.pn * tstep;
    S.a_ready(cur);
    if constexpr (SP2) {
        PG8_STAGE(PG8_SB(0, 0), cB, voffB); PG8_STAGE(PG8_SB(0, 1), cB + hstep, voffB); PG8_STAGE(PG8_SA(0, 0), cA, voffA); PG8_STAGE(PG8_SA(0, 1), cA + hstep, voffA);
        if (wr == 1) PG8_BAR;
        PG8_WAIT_V(2); PG8_BAR;
        PG8_STAGE(PG8_SB(1, 0), cB + kstep, voffB); PG8_STAGE(PG8_SA(1, 0), cA + kstep, voffA); PG8_STAGE(PG8_SB(1, 1), cB + hstep + kstep, voffB);
        PG8_WAIT_V(6); PG8_BAR;
    } else {
        PG8_STAGE(PG8_SB(0, 0), cB, voffB); PG8_STAGE(PG8_SA(0, 0), cA, voffA); PG8_STAGE(PG8_SB(0, 1), cB + hstep, voffB); PG8_STAGE(PG8_SA(0, 1), cA + hstep, voffA);
        if (wr == 1) PG8_BAR;
        PG8_WAIT_V(4); PG8_BAR;
        PG8_STAGE(PG8_SB(1, 0), cB + kstep, voffB); PG8_STAGE(PG8_SA(1, 0), cA + kstep, voffA); PG8_STAGE(PG8_SB(1, 1), cB + hstep + kstep, voffB);
        PG8_WAIT_V(6); PG8_BAR;
    }
    for (;;) {
        const bool has_next = S.next(ui + 1, nxt);
        const char* nA = has_next ? (const char*)g.A + (size_t)nxt.pm * tstep : cA; const char* nB = has_next ? (const char*)g.Bt + (size_t)nxt.pn * tstep : cB;
        for (int t = 0; t < nt; t += 2) {
            if constexpr (Epi::MID_TILE > 0) { if (t == Epi::MID_TILE) { PG8_SCHED; E.mid(acc, cur, wr, wc, fr, fq); PG8_SCHED; } }
            const bool last = (t == nt - 2);
            const char* a1 = cA + (size_t)(t + 1) * kstep;
            const char* a2 = last ? nA : cA + (size_t)(t + 2) * kstep; const char* b2 = last ? nB : cB + (size_t)(t + 2) * kstep;
            const char* a3 = a2 + kstep; const char* b3 = b2 + kstep;
            if (last && has_next) S.a_ready(nxt);
            if constexpr (SP2) {
            PG8_LDB(B0, 0, 0); PG8_LDB(B1, 0, 1); PG8_SCHED; PG8_LDA(At, 0, 0); PG8_STAGE(PG8_SA(1, 1), a1 + hstep, voffA);
            PG8_WAIT_V(8); PG8_WAIT_L(0); PG8_BAR; PG8_MMA(0, 0, At, B0); PG8_MMA(0, 1, At, B1); PG8_BAR; PG8_SCHED;
            PG8_LDA(At, 0, 1); PG8_STAGE(PG8_SB(0, 0), b2, voffB); PG8_STAGE(PG8_SB(0, 1), b2 + hstep, voffB); PG8_STAGE(PG8_SA(0, 0), a2, voffA);
            PG8_WAIT_V(8); PG8_WAIT_L(0); PG8_BAR; PG8_MMA(1, 0, At, B0); PG8_MMA(1, 1, At, B1); PG8_BAR; PG8_SCHED;
            PG8_LDB(B0, 1, 0); PG8_LDB(B1, 1, 1); PG8_SCHED; PG8_LDA(At, 1, 0); PG8_STAGE(PG8_SA(0, 1), a2 + hstep, voffA);
            PG8_WAIT_V(8); PG8_WAIT_L(0); PG8_BAR; PG8_MMA(0, 0, At, B0); PG8_MMA(0, 1, At, B1); PG8_BAR; PG8_SCHED;
            PG8_LDA(At, 1, 1); PG8_STAGE(PG8_SB(1, 0), b3, voffB); PG8_STAGE(PG8_SB(1, 1), b3 + hstep, voffB); PG8_STAGE(PG8_SA(1, 0), a3, voffA);
            PG8_WAIT_V(8); PG8_WAIT_L(0); PG8_BAR; PG8_MMA(1, 0, At, B0); PG8_MMA(1, 1, At, B1); PG8_BAR; PG8_SCHED;
            } else {
            PG8_LDB(B0, 0, 0); PG8_SCHED; PG8_LDA(At, 0, 0); PG8_STAGE(PG8_SA(1, 1), a1 + hstep, voffA);
            PG8_WAIT_L(8); PG8_BAR; PG8_WAIT_L(0); PG8_MMA(0, 0, At, B0); PG8_BAR; PG8_SCHED;
            PG8_LDB(B1, 0, 1); PG8_STAGE(PG8_SB(0, 0), b2, voffB);
            PG8_BAR; PG8_WAIT_L(0); PG8_MMA(0, 1, At, B1); PG8_BAR;
            PG8_LDA(At, 0, 1); PG8_STAGE(PG8_SA(0, 0), a2, voffA);
            PG8_BAR; PG8_WAIT_L(0); PG8_MMA(1, 0, At, B0); PG8_BAR; PG8_SCHED;
            PG8_STAGE(PG8_SB(0, 1), b2 + hstep, voffB);
            PG8_WAIT_V(6); PG8_BAR; PG8_MMA(1, 1, At, B1); PG8_BAR;
            PG8_LDB(B0, 1, 0); PG8_SCHED; PG8_LDA(At, 1, 0); PG8_STAGE(PG8_SA(0, 1), a2 + hstep, voffA);
            PG8_WAIT_L(8); PG8_BAR; PG8_WAIT_L(0); PG8_MMA(0, 0, At, B0); PG8_BAR; PG8_SCHED;
            PG8_LDB(B1, 1, 1); PG8_STAGE(PG8_SB(1, 0), b3, voffB);
            PG8_BAR; PG8_WAIT_L(0); PG8_MMA(0, 1, At, B1); PG8_BAR;
            PG8_LDA(At, 1, 1); PG8_STAGE(PG8_SA(1, 0), a3, voffA);
            PG8_BAR; PG8_WAIT_L(0); PG8_MMA(1, 0, At, B0); PG8_BAR; PG8_SCHED;
            PG8_STAGE(PG8_SB(1, 1), b3 + hstep, voffB);
            PG8_WAIT_V(6); PG8_BAR; PG8_MMA(1, 1, At, B1); PG8_BAR;
            }
        }
        if constexpr (ALIGN_EPI) { if (wr == 0) PG8_BAR; }
        if constexpr (!Epi::AFTER_DRAIN) { E(acc, cur, wr, wc, fr, fq); S.done(cur); }
        if (!has_next) break;
#pragma unroll
        for (int a = 0; a < 2; ++a)
#pragma unroll
            for (int b = 0; b < 2; ++b)
#pragma unroll
                for (int m = 0; m < 4; ++m)
#pragma unroll
                    for (int n = 0; n < 2; ++n) acc[a][b][m][n] = (f32x4){0.f, 0.f, 0.f, 0.f};
        cur = nxt; cA = nA; cB = nB; ++ui;
        if constexpr (ALIGN_EPI) { if (wr == 1) PG8_BAR; }
    }
    PG8_WAIT_V(0);
    if constexpr (!ALIGN_EPI) { if (wr == 0) PG8_BAR; }
    PG8_BAR;
    if constexpr (Epi::AFTER_DRAIN) { E.fused(acc, cur, wr, wc, fr, fq, lds, wid, lane); S.done(cur); }
#undef PG8_SA
#undef PG8_SB
#undef PG8_STAGE
#undef PG8_LDA
#undef PG8_LDB
#undef PG8_MMA
#undef PG8_WAIT_V
#undef PG8_WAIT_L
#undef PG8_BAR
#undef PG8_SCHED
}
}
constexpr int NWAVES = 8;
constexpr int BATCH = 16, SEQ = 2048, DM = 1024, HD = 64, FF = 4096, NIN = 4352;
constexpr int M = BATCH * SEQ;
constexpr float EPS = 1e-6f;
constexpr size_t MiB = 1u << 20;
constexpr size_t WS_CTL = 0, CTL_ZERO_BYTES = 1 * MiB;
constexpr size_t WS_WIN = 2 * MiB, WS_WBR = 11 * MiB, WS_WO = 13 * MiB, WS_WUP = 15 * MiB, WS_WDN = 23 * MiB;
constexpr int NGRP = 8, GROWS = M / NGRP;
constexpr size_t WS_GRP0 = 32 * MiB, GRP_STRIDE = 58 * MiB;
constexpr size_t GO_Q = 0 * MiB;
constexpr size_t GO_KA = 8 * MiB, GO_VA = 12 * MiB;
constexpr size_t GO_KB = 16 * MiB, GO_VB = 17 * MiB;
constexpr size_t GO_GA = 18 * MiB, GO_GB = 26 * MiB;
constexpr size_t GO_H = 0 * MiB;
constexpr size_t GO_A2 = 34 * MiB;
constexpr size_t GO_XN = 42 * MiB;
constexpr size_t GO_MIX = 50 * MiB;
constexpr size_t WS_END = WS_GRP0 + NGRP * GRP_STRIDE;
static_assert(WS_WIN + (size_t)NIN * DM * 2 <= WS_WBR && WS_WDN + (size_t)DM * FF * 2 <= WS_GRP0 && GO_GB + (size_t)GROWS * DM * 2 <= GO_A2 && GO_H + (size_t)GROWS * FF * 2 <= GO_A2 && GO_XN + (size_t)GROWS * DM * 2 <= GO_MIX && GO_MIX + (size_t)GROWS * DM * 2 <= GRP_STRIDE && WS_END <= 512 * MiB, "d_ws map");
__device__ __forceinline__ unsigned short* grp_ptr(unsigned char* ws, int g, size_t off, int pitch_elems) { return (unsigned short*)(ws + WS_GRP0 + (size_t)g * GRP_STRIDE + off) - (size_t)g * GROWS * pitch_elems; }
constexpr int CW_TMO = 0, CW_CODE = 1;
constexpr int CW_BAR = 4096;
constexpr int CW_CENSUS = 8192;
constexpr int CW_GSUB = 9216, CW_GGEN = 10240;
constexpr int CW_KMEAN = 16384;
constexpr int CW_ROWSQ = CW_KMEAN + BATCH * 8 * 8 * 64;
constexpr int CW_IRS = CW_ROWSQ + M;
static_assert((CW_IRS + M) * 4 <= (int)CTL_ZERO_BYTES, "CTL words inside the memset region");
constexpr int RING_OFF = 0, RING_BYTES = 131072;
constexpr int LDSCTL_OFF = RING_BYTES, MISC_OFF = LDSCTL_OFF + 320;
constexpr int STG_OFF = RING_BYTES + 1024, STG_BYTES = 8 * 2048;
constexpr int LDS_BYTES = STG_OFF + STG_BYTES;
static_assert(MISC_OFF + 128 <= LDS_BYTES, "LDS map");

#define GAS __attribute__((address_space(1)))
#define LAS __attribute__((address_space(3)))
typedef unsigned short bf16;
typedef unsigned v4u __attribute__((ext_vector_type(4)));
typedef float f32x4 __attribute__((ext_vector_type(4)));
typedef short bf16x8 __attribute__((ext_vector_type(8)));
typedef GAS unsigned gu32;
typedef GAS unsigned long long gu64;
#define RLX_AGENT __ATOMIC_RELAXED, __HIP_MEMORY_SCOPE_AGENT
#define LDS_WAIT() asm volatile("s_waitcnt lgkmcnt(0)" ::: "memory")
#define VM_WAIT() asm volatile("s_waitcnt vmcnt(0)" ::: "memory")
__device__ __forceinline__ unsigned long long rt() { return __builtin_amdgcn_s_memrealtime(); }
__device__ __forceinline__ unsigned f2bf(float f) { unsigned u = __builtin_bit_cast(unsigned, f); return (u + 0x7fffu + ((u >> 16) & 1u)) >> 16; }
__device__ __forceinline__ unsigned pk2(float lo, float hi) { return f2bf(lo) | (f2bf(hi) << 16); }

#define XB_TMO      128
#define XB_XCNT(j)  (256  + 64 * (j))
#define XB_XSUB(j)  (1280 + 64 * (j))
#define XB_XGEN(j)  (2304 + 64 * (j))
#define XB_TOP      3328
#define XB_TOPGEN   3392
#define XCD_BAR_WORDS 3456
#define XB_SPIN_CAP (1u << 18)

__device__ __forceinline__ unsigned xb_ld(unsigned* p)              { return __hip_atomic_load(p, __ATOMIC_RELAXED, __HIP_MEMORY_SCOPE_AGENT); }
__device__ __forceinline__ unsigned xb_add(unsigned* p, unsigned v) { return __hip_atomic_fetch_add(p, v, __ATOMIC_RELAXED, __HIP_MEMORY_SCOPE_AGENT); }
__device__ __forceinline__ unsigned xb_xcc_id() { return (unsigned)__builtin_amdgcn_s_getreg((3 << 11) | 20) & 0xFu; }
#define XB_SPIN(cond, bar) do { unsigned _sp = 0; while (cond) { __builtin_amdgcn_s_sleep(1); \
    if ((++_sp & 255u) == 0u) { if (xb_ld(&(bar)[XB_TMO])) break; if (_sp > XB_SPIN_CAP) { atomicAdd(&(bar)[XB_TMO], 1u); break; } } } } while (0)

struct XcdBarrier {
    unsigned* bar; unsigned x;
    volatile LAS unsigned* st;
};

__device__ __forceinline__ XcdBarrier xcd_barrier_post(unsigned* bar, volatile LAS unsigned* st) {
    XcdBarrier b; b.bar = bar; b.x = xb_xcc_id(); b.st = st;
    if (threadIdx.x == 0) (void)xb_add(&bar[XB_XCNT(b.x)], 1u);
    return b;
}
__device__ __forceinline__ void xcd_barrier_complete(unsigned* bar, unsigned x, unsigned& nloc, unsigned& nx) {
    const unsigned G = gridDim.x * gridDim.y * gridDim.z;
    unsigned sum, cnt, mine, sp = 0u;
    for (;;) {
        sum = 0u; cnt = 0u; mine = 0u;
#pragma unroll
        for (unsigned j = 0; j < 16; ++j) { const unsigned c = xb_ld(&bar[XB_XCNT(j)]); sum += c; cnt += (c > 0u) ? 1u : 0u; mine = (j == x) ? c : mine; }
        if (sum == G) break;
        __builtin_amdgcn_s_sleep(1);
        if ((++sp & 255u) == 0u) { if (xb_ld(&bar[XB_TMO])) break; if (sp > XB_SPIN_CAP) { atomicAdd(&bar[XB_TMO], 1u); break; } }
    }
    nloc = mine > 0u ? mine : 1u; nx = cnt > 0u ? cnt : 1u;
}

__device__ __forceinline__ void xcd_barrier(const XcdBarrier& b) {
    asm volatile("s_waitcnt vmcnt(0)" ::: "memory");
    __syncthreads();
    if (threadIdx.x == 0) {
        unsigned* bar = b.bar;
        __builtin_amdgcn_s_waitcnt(0);
        unsigned nloc = b.st[0], nx = b.st[1];
        if (nloc == 0u) { xcd_barrier_complete(bar, b.x, nloc, nx); b.st[0] = nloc; b.st[1] = nx; }
        const unsigned old = xb_add(&bar[XB_XSUB(b.x)], 1u);
        const unsigned gen = old / nloc;
        if (old + 1u == (gen + 1u) * nloc) {
            __builtin_amdgcn_fence(__ATOMIC_RELEASE, "agent");
            asm volatile("s_waitcnt vmcnt(0)" ::: "memory");
            const unsigned og = xb_add(&bar[XB_TOP], 1u);
            const unsigned tg = og / nx;
            if (og + 1u == (tg + 1u) * nx) xb_add(&bar[XB_TOPGEN], 1u);
            else XB_SPIN(xb_ld(&bar[XB_TOPGEN]) == tg, bar);
            __builtin_amdgcn_fence(__ATOMIC_ACQUIRE, "agent");
            xb_add(&bar[XB_XGEN(b.x)], 1u);
            asm volatile("s_waitcnt vmcnt(0)" ::: "memory");
        } else {
            XB_SPIN(xb_ld(&bar[XB_XGEN(b.x)]) == gen, bar);
            __builtin_amdgcn_fence(__ATOMIC_ACQUIRE, "agent");
            asm volatile("s_waitcnt vmcnt(0)" ::: "memory");
        }
    }
    __syncthreads();
}

struct GroupBar { unsigned* sub; unsigned* gen; unsigned* bar; };
__device__ __forceinline__ void group_barrier(const GroupBar& g) {
    asm volatile("s_waitcnt vmcnt(0)" ::: "memory");
    __syncthreads();
    if (threadIdx.x == 0) {
        __builtin_amdgcn_s_waitcnt(0);
        const unsigned old = xb_add(g.sub, 1u), gen = old / 32u;
        if (old + 1u == (gen + 1u) * 32u) {
            __builtin_amdgcn_fence(__ATOMIC_RELEASE, "agent");
            asm volatile("s_waitcnt vmcnt(0)" ::: "memory");
            __builtin_amdgcn_fence(__ATOMIC_ACQUIRE, "agent");
            xb_add(g.gen, 1u);
            asm volatile("s_waitcnt vmcnt(0)" ::: "memory");
        } else {
            XB_SPIN(xb_ld(g.gen) == gen, g.bar);
            __builtin_amdgcn_fence(__ATOMIC_ACQUIRE, "agent");
            asm volatile("s_waitcnt vmcnt(0)" ::: "memory");
        }
    }
    __syncthreads();
}

struct Frame {
    LAS unsigned char* lds;
    volatile LAS unsigned* MISC;
    gu32* ctl;
    int tid, lane, wave;
    int vcu, G;
    int grp, li, grouped;
    unsigned char* ws;
    const float *x, *norm_attn, *w_in, *qna, *kna, *qnb, *knb, *sinks, *wba, *wbb, *w_out, *norm_mlp, *w_up, *w_down; float* out;
    bf16 *WinT, *WbrT, *WoT, *WupT, *WdnT;
    bf16 *Q, *KA, *VA, *KB, *VB, *GA, *GB, *HB, *A2, *XN, *MIX;
    float *kmean, *rowsq, *irs;
};

__device__ __forceinline__ float wave_sum(float v) {
#pragma unroll
    for (int o = 1; o < 64; o <<= 1) v += __shfl_xor(v, o);
    return v;
}
__device__ __forceinline__ void p0_transpose_item(const float* W, int N, bf16* WT, int ldt, int koff, int prow0, LAS float* scr, int k0, int n0, int lane, const float* kscale = nullptr) {
    float wv[32];
#pragma unroll
    for (int i = 0; i < 32; ++i) wv[i] = W[(size_t)(k0 + 2 * i + (lane >> 5)) * N + n0 + (lane & 31)];
    if (kscale) {
#pragma unroll
        for (int i = 0; i < 32; ++i) wv[i] *= kscale[k0 + 2 * i + (lane >> 5)];
    }
#pragma unroll
    for (int i = 0; i < 32; ++i) scr[(2 * i + (lane >> 5)) * 33 + (lane & 31)] = wv[i];
    LDS_WAIT(); asm volatile("" ::: "memory");
    const int c = lane & 7;
#pragma unroll
    for (int j = 0; j < 4; ++j) { const int n = (lane >> 3) + 8 * j; const LAS float* s = scr + (8 * c) * 33 + n;
        v4u o; o.x = pk2(s[0 * 33], s[1 * 33]); o.y = pk2(s[2 * 33], s[3 * 33]); o.z = pk2(s[4 * 33], s[5 * 33]); o.w = pk2(s[6 * 33], s[7 * 33]);
        *(GAS v4u*)(WT + (size_t)(prow0 + n) * ldt + koff + k0 + 8 * c) = o; }
    LDS_WAIT(); asm volatile("" ::: "memory");
}
__device__ __forceinline__ void rms_row_to_bf16(const Frame& F, const float* xrow, const float* gain, bf16* orow) {
    const GAS f32x4* xr = (const GAS f32x4*)xrow + F.lane; const f32x4* gr = (const f32x4*)gain + F.lane;
    f32x4 v[4]; float s = 0.f;
#pragma unroll
    for (int j = 0; j < 4; ++j) { v[j] = xr[64 * j]; s += (v[j].x * v[j].x + v[j].y * v[j].y) + (v[j].z * v[j].z + v[j].w * v[j].w); }
    const float rs = 1.0f / sqrtf(wave_sum(s) * (1.f / DM) + EPS);
    GAS unsigned long long* o8 = (GAS unsigned long long*)orow + F.lane;
#pragma unroll
    for (int j = 0; j < 4; ++j) { const f32x4 g = gr[64 * j]; o8[64 * j] = (unsigned long long)pk2(v[j].x * rs * g.x, v[j].y * rs * g.y) | ((unsigned long long)pk2(v[j].z * rs * g.z, v[j].w * rs * g.w) << 32); }
}
__device__ __forceinline__ void p0_prologue(Frame& F) {
    LAS float* scr = (LAS float*)(F.lds + RING_OFF + F.wave * 16384);
    const int gw = (int)blockIdx.x * NWAVES + F.wave, NGW = F.G * NWAVES;
    constexpr int I_IN = (DM / 64) * (NIN / 32), I_BR = (512 / 64) * (DM / 32), I_O = (DM / 64) * (DM / 32), I_UP = (DM / 64) * (FF / 32), I_DN = (FF / 64) * (DM / 32);
    constexpr int NITEMS = I_IN + 2 * I_BR + I_O + I_UP + I_DN;
    for (int it = gw; it < NITEMS; it += NGW) {
        int r = it;
        if (r < I_IN) { const int nblk = NIN / 32, kb = r / nblk, nb = r % nblk, n0 = 32 * nb, nt = n0 & 255;
            int prow0 = (n0 & ~255) + 128 * ((nt >> 5) & 1) + 32 * (nt >> 6);
            if (n0 >= 2304) { const int isb = n0 >= 3328 ? 1 : 0, c0 = n0 - (isb ? 3328 : 2304); prow0 = 256 * (9 + (c0 >> 7)) + 128 * isb + 32 * ((c0 & 127) >> 5); }
            p0_transpose_item(F.w_in, NIN, F.WinT, DM, 0, prow0, scr, 64 * kb, n0, F.lane); continue; } r -= I_IN;
        if (r < I_BR) { const int nblk = DM / 32, kb = r / nblk, nb = r % nblk; p0_transpose_item(F.wba, DM, F.WbrT, DM, 0, 32 * nb, scr, 64 * kb, 32 * nb, F.lane); continue; } r -= I_BR;
        if (r < I_BR) { const int nblk = DM / 32, kb = r / nblk, nb = r % nblk; p0_transpose_item(F.wbb, DM, F.WbrT, DM, 512, 32 * nb, scr, 64 * kb, 32 * nb, F.lane); continue; } r -= I_BR;
        if (r < I_O)  { const int nblk = DM / 32, kb = r / nblk, nb = r % nblk; const int n0 = 32 * nb, nt = n0 & 255; p0_transpose_item(F.w_out, DM, F.WoT, DM, 0, (n0 & ~255) + 128 * ((nt >> 5) & 1) + 32 * (nt >> 6), scr, 64 * kb, n0, F.lane); continue; } r -= I_O;
        if (r < I_UP) { const int nblk = FF / 32, kb = r / nblk, nb = r % nblk; const int n0 = 32 * nb, nt = n0 & 255; p0_transpose_item(F.w_up, FF, F.WupT, DM, 0, (n0 & ~255) + 128 * ((nt >> 5) & 1) + 32 * (nt >> 6), scr, 64 * kb, n0, F.lane, F.norm_mlp); continue; } r -= I_UP;
        { const int nblk = DM / 32, kb = r / nblk, nb = r % nblk; p0_transpose_item(F.w_down, DM, F.WdnT, FF, 0, 32 * nb, scr, 64 * kb, 32 * nb, F.lane); }
    }
    {
        const f32x4* gr = (const f32x4*)F.norm_attn + F.lane; f32x4 g[4];
#pragma unroll
        for (int j = 0; j < 4; ++j) g[j] = gr[64 * j];
        for (int m = gw; m < M; m += 2 * NGW) { const int m2 = m + NGW;
            const GAS f32x4* xa = (const GAS f32x4*)(F.x + (size_t)m * DM) + F.lane; const GAS f32x4* xb = (const GAS f32x4*)(F.x + (size_t)m2 * DM) + F.lane;
            f32x4 va[4], vb[4]; float sa = 0.f, sb = 0.f;
#pragma unroll
            for (int j = 0; j < 4; ++j) { va[j] = xa[64 * j]; vb[j] = xb[64 * j]; }
#pragma unroll
            for (int j = 0; j < 4; ++j) { sa += (va[j].x * va[j].x + va[j].y * va[j].y) + (va[j].z * va[j].z + va[j].w * va[j].w); sb += (vb[j].x * vb[j].x + vb[j].y * vb[j].y) + (vb[j].z * vb[j].z + vb[j].w * vb[j].w); }
#pragma unroll
            for (int o = 1; o < 64; o <<= 1) { sa += __shfl_xor(sa, o); sb += __shfl_xor(sb, o); }
            const float qa = sqrtf(sa * (1.f / DM) + EPS), qb = sqrtf(sb * (1.f / DM) + EPS); const float ra = 1.0f / qa, rb = 1.0f / qb;
            if (F.lane == 0) { F.irs[m] = qa; F.irs[m2] = qb; }
            GAS unsigned long long* oa = (GAS unsigned long long*)(grp_ptr(F.ws, m / GROWS, GO_XN, DM) + (size_t)m * DM) + F.lane;
            GAS unsigned long long* ob = (GAS unsigned long long*)(grp_ptr(F.ws, m2 / GROWS, GO_XN, DM) + (size_t)m2 * DM) + F.lane;
#pragma unroll
            for (int j = 0; j < 4; ++j) {
                oa[64 * j] = (unsigned long long)pk2(va[j].x * ra * g[j].x, va[j].y * ra * g[j].y) | ((unsigned long long)pk2(va[j].z * ra * g[j].z, va[j].w * ra * g[j].w) << 32);
                ob[64 * j] = (unsigned long long)pk2(vb[j].x * rb * g[j].x, vb[j].y * rb * g[j].y) | ((unsigned long long)pk2(vb[j].z * rb * g[j].z, vb[j].w * rb * g[j].w) << 32); }
        }
    }
}
__device__ __forceinline__ void sa_load32(const bf16* p, float (&d)[32]) {
#pragma unroll
    for (int i = 0; i < 4; ++i) { const v4u w = *(const GAS v4u*)(p + 8 * i);
        d[8 * i + 0] = __uint_as_float(w.x << 16); d[8 * i + 1] = __uint_as_float(w.x & 0xffff0000u); d[8 * i + 2] = __uint_as_float(w.y << 16); d[8 * i + 3] = __uint_as_float(w.y & 0xffff0000u);
        d[8 * i + 4] = __uint_as_float(w.z << 16); d[8 * i + 5] = __uint_as_float(w.z & 0xffff0000u); d[8 * i + 6] = __uint_as_float(w.w << 16); d[8 * i + 7] = __uint_as_float(w.w & 0xffff0000u); }
}
__device__ __forceinline__ void sa_store32(bf16* p, const float (&o)[32], float sc) {
#pragma unroll
    for (int i = 0; i < 4; ++i) { v4u w; w.x = pk2(o[8 * i] * sc, o[8 * i + 1] * sc); w.y = pk2(o[8 * i + 2] * sc, o[8 * i + 3] * sc); w.z = pk2(o[8 * i + 4] * sc, o[8 * i + 5] * sc); w.w = pk2(o[8 * i + 6] * sc, o[8 * i + 7] * sc);
        *(GAS v4u*)(p + 8 * i) = w; }
}
#define SA_KEY(KPTR, VPTR, BIAS, VALID) do { \
    float s_ = 0.f; \
    { float kv_[32]; sa_load32((KPTR) + dof, kv_); \
        _Pragma("unroll") for (int d_ = 0; d_ < 32; ++d_) s_ = __builtin_fmaf(q[d_], kv_[d_], s_); asm volatile("" ::: "memory"); } \
    s_ += __shfl_xor(s_, 1); \
    s_ += (BIAS); const bool ok_ = (VALID); const float se_ = ok_ ? s_ : -1e30f; \
    if (__any(se_ > m)) { const float mn_ = __builtin_fmaxf(m, se_); const float c_ = __builtin_amdgcn_exp2f(m - mn_); l *= c_; _Pragma("unroll") for (int d_ = 0; d_ < 32; ++d_) o[d_] *= c_; m = mn_; } \
    const float p_ = ok_ ? __builtin_amdgcn_exp2f(s_ - m) : 0.f; l += p_; \
    { float kv_[32]; sa_load32((VPTR) + dof, kv_); \
        _Pragma("unroll") for (int d_ = 0; d_ < 32; ++d_) o[d_] = __builtin_fmaf(p_, kv_[d_], o[d_]); asm volatile("" ::: "memory"); } } while (0)

__device__ __forceinline__ void sa_moba(const bf16* Q, const bf16* KA, const bf16* VA, const float* kmean, bf16* O, int b, int h, int t0, int lane) {
    const int dof = 32 * (lane & 1);
    const int t = t0 + (lane >> 1), own = t0 >> 8;
    float q[32]; sa_load32(Q + ((size_t)(b * SEQ + t)) * 1024 + h * 64 + dof, q);
    unsigned sel;
    if (own <= 3) sel = (1u << own) - 1u;
    else {
        float gs[7];
#pragma unroll
        for (int n = 0; n < 7; ++n) { gs[n] = -INFINITY;
            if (n < own) { const float* km = kmean + ((size_t)(b * 8 + n) * 8 + h) * 64 + dof; float s = 0.f;
#pragma unroll
                for (int d = 0; d < 32; d += 4) { const f32x4 kv = *(const GAS f32x4*)(km + d); s = __builtin_fmaf(q[d], kv.x, s); s = __builtin_fmaf(q[d + 1], kv.y, s); s = __builtin_fmaf(q[d + 2], kv.z, s); s = __builtin_fmaf(q[d + 3], kv.w, s); }
                s += __shfl_xor(s, 1);
                gs[n] = s; asm volatile("" ::: "memory"); } }
        sel = 0u;
#pragma unroll
        for (int n = 0; n < 7; ++n) { int rank = 0;
#pragma unroll
            for (int j = 0; j < 7; ++j) if (j != n) rank += (gs[j] > gs[n] || (gs[j] == gs[n] && j < n)) ? 1 : 0;
            if (n < own && rank < 3) sel |= 1u << n; }
    }
    const float slope2 = exp2f(-0.5f * (float)(h + 9)) * pg8::kLog2e;
    float m = -1e30f, l = 0.f, o[32];
#pragma unroll
    for (int d = 0; d < 32; ++d) o[d] = 0.f;
    for (int n = 0; n <= own; ++n) {
        const bool isown = (n == own), mine = isown || ((sel >> n) & 1u);
        if (!__any(mine)) continue;
        const int nk = isown ? (t0 + 32 - n * 256) : 256;
        for (int kk = 0; kk < nk; ++kk) { const int tk = n * 256 + kk; const size_t r = (size_t)(b * SEQ + tk) * 512 + h * 64;
            SA_KEY(KA + r, VA + r, -slope2 * (float)(t - tk), mine && (tk <= t)); }
    }
    sa_store32(O + ((size_t)(b * SEQ + t)) * 1024 + h * 64 + dof, o, 1.0f / l);
}
__device__ __forceinline__ void sa_swa(const bf16* Q, const bf16* KB, const bf16* VB, const float* sinks, bf16* O, int b, int hq, int t0, int lane) {
    const int dof = 32 * (lane & 1);
    const int t = t0 + (lane >> 1), kvh = hq >> 2;
    float q[32]; sa_load32(Q + ((size_t)(b * SEQ + t)) * 1024 + 512 + hq * 64 + dof, q);
    const float slope2 = exp2f(-0.5f * (float)(hq + 1)) * pg8::kLog2e, sink2 = sinks[hq] * pg8::kLog2e;
    float m = -1e30f, l = 0.f, o[32];
#pragma unroll
    for (int d = 0; d < 32; ++d) o[d] = 0.f;
    const int k0 = t0 - 127 > 0 ? t0 - 127 : 0;
    for (int tk = k0; tk < t0 + 32; ++tk) { const size_t r = (size_t)(b * SEQ + tk) * 128 + kvh * 64;
        SA_KEY(KB + r, VB + r, -slope2 * (float)(t - tk), (tk <= t) && (t - tk < 128)); }
    const float mf = __builtin_fmaxf(m, sink2), c = __builtin_amdgcn_exp2f(m - mf);
    l = l * c + __builtin_amdgcn_exp2f(sink2 - mf);
    sa_store32(O + ((size_t)(b * SEQ + t)) * 1024 + 512 + hq * 64 + dof, o, c / l);
}
__device__ __forceinline__ void attn_simple_phase(Frame& F) {
    const int gw = F.li * NWAVES + F.wave, NGW = 32 * NWAVES;
    int i = 0;
    for (int u = gw; u < 1024; u += NGW, ++i) { const int b = 2 * F.grp + (u >> 9), h = (u >> 6) & 7; int ch = u & 63; if (i & 1) ch = 63 - ch;
        sa_moba(F.Q, F.KA, F.VA, F.kmean, F.Q, b, h, ch * 32, F.lane); }
    for (int u = gw; u < 1024; u += NGW) { const int b = 2 * F.grp + (u >> 9), hq = (u >> 6) & 7, ch = u & 63;
        sa_swa(F.Q, F.KB, F.VB, F.sinks, F.Q, b, hq, ch * 32, F.lane); }
}

namespace fa {
using bf16x8 = __attribute__((ext_vector_type(8))) short;
using s16x4 = __attribute__((ext_vector_type(4))) short;
using f32x16 = __attribute__((ext_vector_type(16))) float;
using u32x4 = __attribute__((ext_vector_type(4))) unsigned;
using f32x4 = __attribute__((ext_vector_type(4))) float;
constexpr int NW = 8, QBLK = 32, KVBLK = 64;
constexpr int SLOTB = 8192, LDS_K = 0, LDS_V = 3 * SLOTB, LDS_WS = 6 * SLOTB, LDS_OST = LDS_WS + NW * 256, LDS_QN = LDS_OST + NW * 4096, LDS_BYTES = LDS_QN + NW * 4096;
constexpr int QP = 1024;
#ifndef FA_THR
#define FA_THR 8
#endif
#define SBAR() __builtin_amdgcn_sched_barrier(0)
#define PIN(x) asm volatile("" : "+v"(x))
#define MFMA(a, b, c) __builtin_amdgcn_mfma_f32_32x32x16_bf16(a, b, c, 0, 0, 0)
#define WAIT_BAR(N) asm volatile("s_waitcnt vmcnt(" #N ") lgkmcnt(0)\n\ts_barrier" ::: "memory")
__device__ __forceinline__ int crow(int r, int hi) { return (r & 3) + 8 * (r >> 2) + 4 * hi; }
__device__ __forceinline__ unsigned cvtpk(float lo, float hi) { unsigned r; asm("v_cvt_pk_bf16_f32 %0, %1, %2" : "=v"(r) : "v"(lo), "v"(hi)); return r; }
__device__ __forceinline__ void glds16(const void* g, unsigned lds_base) {
    unsigned sv; asm volatile("s_mov_b32 %0, m0\n\ts_mov_b32 m0, %2\n\ts_nop 0\n\tglobal_load_lds_dwordx4 %1, off\n\ts_mov_b32 m0, %0" : "=&s"(sv) : "v"(g), "s"(lds_base) : "memory"); }
typedef __attribute__((address_space(3))) const char* lds_cptr;
typedef short v4i16_t __attribute__((ext_vector_type(4)));
__device__ __forceinline__ void kload2(bf16x8* kf, lds_cptr kp, int d0) { kf[2 * d0] = *(const __attribute__((address_space(3))) bf16x8*)(kp + d0 * 2048); kf[2 * d0 + 1] = *(const __attribute__((address_space(3))) bf16x8*)(kp + d0 * 2048 + 512); }
__device__ __forceinline__ s16x4 vtr(lds_cptr p) { return __builtin_bit_cast(s16x4, __builtin_amdgcn_ds_read_tr16_b64_v4i16((__attribute__((address_space(3))) v4i16_t*)p)); }
#define MX3(a, b, c) __builtin_fmaxf(__builtin_fmaxf((a), (b)), (c))
__device__ __forceinline__ float rowmax(const f32x16& p0, const f32x16& p1) {
    float a = MX3(p0[0], p0[1], p1[0]), b = MX3(p0[2], p0[3], p1[1]); a = MX3(a, p1[2], p1[3]);
#pragma unroll
    for (int r = 4; r < 16; r += 4) { a = MX3(a, p0[r], p0[r + 1]); b = MX3(b, p0[r + 2], p0[r + 3]); a = MX3(a, p1[r], p1[r + 1]); b = MX3(b, p1[r + 2], p1[r + 3]); }
    float m = __builtin_fmaxf(a, b); auto rr = __builtin_amdgcn_permlane32_swap(__float_as_uint(m), __float_as_uint(m), false, false);
    return __builtin_fmaxf(__uint_as_float(rr[0]), __uint_as_float(rr[1])); }
__device__ __forceinline__ void emask(f32x16& p0, f32x16& p1, int dq  , unsigned wd) {
#pragma unroll
    for (int r = 0; r < 16; ++r) { const int kv = (r & 3) + 8 * (r >> 2); if ((unsigned)(dq - kv) >= wd) p0[r] = -INFINITY; if ((unsigned)(dq - kv - 32) >= wd) p1[r] = -INFINITY; } }
__device__ __forceinline__ unsigned bf16bits(float f) { unsigned u = __float_as_uint(f); return (u + 0x7fffu + ((u >> 16) & 1u)) >> 16; }

struct AU {
    const bf16* Qw;
    bf16* Ow;
    const bf16* Kb;
    const bf16* Vb;
    int KP;
    int q0;
    int qrel0;
    int NT;
    int mode;
    unsigned wd;
    float slope2;
    float sink2;
    unsigned okmask;
    const float* km;
    int gj;
};
__device__ __forceinline__ int key_rel(const AU& u, int t) {
    if (u.mode == 0) { const int np = u.NT - 4; return t == 0 ? 0 : (t <= np ? 64 * (t - 1) - 64 * np : 64 * (t - np)); }
    return -64 * t;
}
__device__ __forceinline__ int attn_unit(const AU& u, const AU& n, bool has_next, bool pre, int s0, char* lds) {
    const int tid = threadIdx.x; int lane = tid & 63; asm volatile("" : "+v"(lane));
    const int r32 = lane & 31, hi = lane >> 5; const int wid = __builtin_amdgcn_readfirstlane(tid >> 6);
    const int NT = u.NT, KP = u.KP;
    const unsigned lds0 = (unsigned)(uintptr_t)lds; float* wsf = (float*)(lds + LDS_WS) + wid * 64;
    const bf16* ksrc = u.Kb + (long)lane * KP + wid * 8;
    const bf16* vsrc = u.Vb + (long)(16 * (wid & 3) + (lane >> 2)) * KP + (wid >> 2) * 32 + (lane & 3) * 8;
    const unsigned kdst = lds0 + LDS_K + wid * 1024, vdst = lds0 + LDS_V + wid * 1024;
#define KROW(t) ({ int r_ = u.q0 + key_rel(u, (t)); r_ < 0 ? 0 : r_; })
#define DMA_K(t, slot) glds16(ksrc + (long)KROW(t) * KP, (unsigned)__builtin_amdgcn_readfirstlane(kdst + (slot)))
#define DMA_V(t, slot) glds16(vsrc + (long)KROW(t) * KP, (unsigned)__builtin_amdgcn_readfirstlane(vdst + (slot)))
    const lds_cptr vp0 = (lds_cptr)lds + LDS_V + ((lane >> 4) & 1) * 32 + (lane & 3) * 8 + (4 * hi + ((lane & 15) >> 2)) * 64;
    const lds_cptr kp0 = (lds_cptr)lds + LDS_K + hi * 1024 + r32 * 16;
    const int sA = s0, sB = (sA == 2 * SLOTB) ? 0 : sA + SLOTB, sC = (sB == 2 * SLOTB) ? 0 : sB + SLOTB;
    const lds_cptr qn0 = (lds_cptr)lds + LDS_QN + wid * 4096;
    bf16x8 qr[4];
    if (!pre) {
        DMA_K(0, sA); DMA_V(0, sA); DMA_K(1, sB);
#pragma unroll
        for (int d0 = 0; d0 < 4; ++d0) qr[d0] = *reinterpret_cast<const bf16x8*>(&u.Qw[(long)r32 * QP + d0 * 16 + hi * 8]);
    } else {
        asm volatile("s_waitcnt vmcnt(7)" ::: "memory");
#pragma unroll
        for (int d0 = 0; d0 < 4; ++d0) qr[d0] = *(const __attribute__((address_space(3))) bf16x8*)(qn0 + r32 * 128 + d0 * 32 + hi * 16);
    }
    bf16x8 qaug, kaug0, kaug1;
    { const unsigned sh = bf16bits(u.slope2); const float rem = u.slope2 - __uint_as_float(sh << 16); const unsigned sl = bf16bits(rem);
      const unsigned Sh = bf16bits(64.f * __uint_as_float(sh << 16)), Sl = bf16bits(64.f * __uint_as_float(sl << 16));
      u32x4 w = {hi ? 0u : (sh | (sl << 16)), hi ? 0u : (Sh | (Sl << 16)), 0u, 0u}; qaug = __builtin_bit_cast(bf16x8, w);
      const unsigned k0b = bf16bits((float)r32), k1b = bf16bits((float)(r32 + 32));
      u32x4 a0 = {k0b | (k0b << 16), 0u, 0u, 0u}, a1 = {k1b | (k1b << 16), 0u, 0u, 0u}; kaug0 = __builtin_bit_cast(bf16x8, a0); kaug1 = __builtin_bit_cast(bf16x8, a1); }
#define SET_TILE(t) do { const unsigned tb_ = bf16bits((float)(key_rel(u, (t)) >> 6)); const unsigned tw_ = tb_ | (tb_ << 16); \
      u32x4 a0_ = __builtin_bit_cast(u32x4, kaug0), a1_ = __builtin_bit_cast(u32x4, kaug1); a0_[1] = tw_; a1_[1] = tw_; kaug0 = __builtin_bit_cast(bf16x8, a0_); kaug1 = __builtin_bit_cast(bf16x8, a1_); } while (0)
    unsigned okmask = u.okmask;
    if (u.gj >= 4) {
        float gs[7];
#pragma unroll
        for (int n = 0; n < 7; ++n) { gs[n] = -INFINITY;
            if (n < u.gj) { const float* km = u.km + 512 * n + 8 * hi; float sg = 0.f;
#pragma unroll
                for (int d0 = 0; d0 < 4; ++d0) { const f32x4 k0 = *(const f32x4*)(km + 16 * d0), k1 = *(const f32x4*)(km + 16 * d0 + 4);
#define QF(e) __uint_as_float(((unsigned)(unsigned short)qr[d0][e]) << 16)
                    sg = __builtin_fmaf(QF(0), k0.x, sg); sg = __builtin_fmaf(QF(1), k0.y, sg); sg = __builtin_fmaf(QF(2), k0.z, sg); sg = __builtin_fmaf(QF(3), k0.w, sg);
                    sg = __builtin_fmaf(QF(4), k1.x, sg); sg = __builtin_fmaf(QF(5), k1.y, sg); sg = __builtin_fmaf(QF(6), k1.z, sg); sg = __builtin_fmaf(QF(7), k1.w, sg);
#undef QF
                }
                sg += __shfl_xor(sg, 32); gs[n] = sg; } }
        unsigned ok = 1u | (7u << (NT - 3));
#pragma unroll
        for (int n = 0; n < 7; ++n) { int rank = 0;
#pragma unroll
            for (int k = 0; k < 7; ++k) if (k != n) rank += (gs[k] > gs[n] || (gs[k] == gs[n] && k < n)) ? 1 : 0;
            if (n < u.gj && rank < 3) ok |= 0xFu << (1 + 4 * n); }
        okmask = ok;
    }
    float mhat = 0.f, l_reg = 0.f; f32x16 o[2]; o[0] = f32x16{}; o[1] = f32x16{};
    const int qrel = u.qrel0 + r32; bool resc = false; const unsigned wd = u.wd;
    f32x16 cin; bool okp = true;
#define SETCIN(okv) do { const float cv_ = (okv) ? -mhat : -INFINITY; _Pragma("unroll") for (int r_ = 0; r_ < 16; ++r_) cin[r_] = cv_; PIN(cin); } while (0)
    f32x16 pA0, pA1, pB0, pB1; bf16x8 kf[8]; s16x4 vlo[8], vhi[8]; u32x4 pw0, pw1, pw2, pw3;
    int sl_prev = sA, sl_cur = sA, sl_next = sB;
#define ROT() do { sl_prev = sl_cur; sl_cur = sl_next; sl_next = (sl_next == 2 * SLOTB) ? 0 : sl_next + SLOTB; } while (0)
#define EX(v) __builtin_amdgcn_exp2f(v)
#define RESC() do { if (resc) { _Pragma("unroll") for (int d_ = 0; d_ < 2; ++d_) _Pragma("unroll") for (int r = 0; r < 16; ++r) o[d_][r] *= wsf[crow(r, hi)]; } } while (0)
    if (!pre) { DMA_K(2, sC); WAIT_BAR(3); } else { WAIT_BAR(7); }
    _Pragma("unroll") for (int d0 = 0; d0 < 4; ++d0) kload2(kf, kp0 + sA, d0);
    SET_TILE(0);
    pA0 = MFMA(kaug0, qaug, f32x16{}); pA1 = MFMA(kaug1, qaug, f32x16{});
    pA0 = MFMA(kf[0], qr[0], pA0); pA1 = MFMA(kf[1], qr[0], pA1); pA0 = MFMA(kf[2], qr[1], pA0); pA1 = MFMA(kf[3], qr[1], pA1);
    pA0 = MFMA(kf[4], qr[2], pA0); pA1 = MFMA(kf[5], qr[2], pA1); pA0 = MFMA(kf[6], qr[3], pA0); pA1 = MFMA(kf[7], qr[3], pA1);
    emask(pA0, pA1, qrel - key_rel(u, 0) - 4 * hi, wd);
    { const float rm = rowmax(pA0, pA1); mhat = rm;
#pragma unroll
      for (int r = 0; r < 16; ++r) { pA0[r] = EX(pA0[r] - rm); pA1[r] = EX(pA1[r] - rm); }
      SETCIN(true); }
    WAIT_BAR(0);
    DMA_K(3, sA); DMA_V(1, sB); ROT();
    _Pragma("unroll") for (int d0 = 0; d0 < 4; ++d0) kload2(kf, kp0 + sl_cur, d0);
    WAIT_BAR(2);
#define PKW(P, i) cvtpk(P[i], P[i + 1])
#define PAF(k) __builtin_bit_cast(bf16x8, pw##k)
#define VFR(i) (bf16x8){vlo[i][0], vlo[i][1], vlo[i][2], vlo[i][3], vhi[i][0], vhi[i][1], vhi[i][2], vhi[i][3]}
#define VRD(i) do { vlo[i] = vtr(vp_ + (((i) >> 2) * 4096 + ((i) & 3) * 1024)); vhi[i] = vtr(vp_ + (((i) >> 2) * 4096 + ((i) & 3) * 1024 + 512)); } while (0)
#define KRD(G, d0) do { if (G) { kload2(kf, kp0 + sl_next, d0); SBAR(); } } while (0)
#define GAPA(MF, a0, a1, a2, a3, W0, W1, PW) do { MF; sacc += a0; sacc += a1; sacc += a2; sacc += a3; W0; W1; PIN(PW); PIN(sacc); SBAR(); } while (0)
#define GAPB(MF, X, i) do { MF; X[i] = EX(X[i]); X[i + 1] = EX(X[i + 1]); X[i + 2] = EX(X[i + 2]); X[i + 3] = EX(X[i + 3]); PIN(X); SBAR(); } while (0)
#define STEP(C0, C1, P0, P1, t, MASK, GK, GV, GL) do { SBAR(); \
    const lds_cptr vp_ = vp0 + sl_prev; SET_TILE(t); \
    const bool ok_ = (okmask >> (t)) & 1u; \
    if (__any(ok_ != okp)) { SETCIN(ok_); okp = ok_; } \
    C0 = MFMA(kaug0, qaug, cin); C1 = MFMA(kaug1, qaug, cin); SBAR(); \
    VRD(0); SBAR(); float sacc = P0[0] + P0[1]; \
                    GAPA(C0 = MFMA(kf[0], qr[0], C0), P0[2], P0[3], P0[4], P0[5],     pw0[0] = PKW(P0, 0),  pw0[1] = PKW(P0, 2),  pw0); \
    VRD(4); SBAR(); GAPA(C1 = MFMA(kf[1], qr[0], C1), P0[6], P0[7], P0[8], P0[9],     pw0[2] = PKW(P0, 4),  pw0[3] = PKW(P0, 6),  pw0); \
    VRD(1); SBAR(); GAPA(C0 = MFMA(kf[2], qr[1], C0),    P0[10], P0[11], P0[12], P0[13], pw1[0] = PKW(P0, 8),  pw1[1] = PKW(P0, 10), pw1); \
    VRD(5); SBAR(); GAPA(C1 = MFMA(kf[3], qr[1], C1),    P0[14], P0[15], P1[0], P1[1],   pw1[2] = PKW(P0, 12), pw1[3] = PKW(P0, 14), pw1); \
    VRD(2); SBAR(); GAPA(C0 = MFMA(kf[4], qr[2], C0),    P1[2], P1[3], P1[4], P1[5],     pw2[0] = PKW(P1, 0),  pw2[1] = PKW(P1, 2),  pw2); \
    VRD(6); SBAR(); GAPA(C1 = MFMA(kf[5], qr[2], C1),    P1[6], P1[7], P1[8], P1[9],     pw2[2] = PKW(P1, 4),  pw2[3] = PKW(P1, 6),  pw2); \
    VRD(3); SBAR(); GAPA(C0 = MFMA(kf[6], qr[3], C0),    P1[10], P1[11], P1[12], P1[13], pw3[0] = PKW(P1, 8),  pw3[1] = PKW(P1, 10), pw3); \
    VRD(7); SBAR(); GAPA(C1 = MFMA(kf[7], qr[3], C1),    P1[14], P1[15], 0.f, 0.f,       pw3[2] = PKW(P1, 12), pw3[3] = PKW(P1, 14), pw3); \
    l_reg += sacc; \
    if (GK) DMA_K((t) + 3, sl_cur); if (GV) DMA_V((t) + 1, sl_next); \
    if (MASK) { if (u.mode == 1 || (t) > NT - 4) emask(C0, C1, qrel - key_rel(u, (t)) - 4 * hi, wd); }            \
    { const float rm = rowmax(C0, C1); resc = false;                                                    \
      if (__builtin_expect(__any(rm > (float)FA_THR), 0)) { const float dl = __builtin_fmaxf(rm, 0.f); mhat += dl; \
          _Pragma("unroll") for (int r = 0; r < 16; ++r) { C0[r] -= dl; C1[r] -= dl; } SETCIN(ok_); \
          const float f = __builtin_amdgcn_exp2f(-dl); l_reg *= f; if (hi == 0) wsf[r32] = f; resc = true; } } \
    SBAR(); \
    GAPB(o[0] = MFMA(PAF(0), VFR(0), o[0]), C0, 0);              GAPB(o[1] = MFMA(PAF(0), VFR(4), o[1]), C0, 4); \
    KRD(GL, 0); GAPB(o[0] = MFMA(PAF(1), VFR(1), o[0]), C0, 8);  KRD(GL, 1); GAPB(o[1] = MFMA(PAF(1), VFR(5), o[1]), C0, 12); \
    KRD(GL, 2); GAPB(o[0] = MFMA(PAF(2), VFR(2), o[0]), C1, 0);  KRD(GL, 3); GAPB(o[1] = MFMA(PAF(2), VFR(6), o[1]), C1, 4); \
    GAPB(o[0] = MFMA(PAF(3), VFR(3), o[0]), C1, 8);              GAPB(o[1] = MFMA(PAF(3), VFR(7), o[1]), C1, 12); \
    } while (0)
    int t = 1;
    for (; t + 5 < NT; t += 2) {
        STEP(pB0, pB1, pA0, pA1, t, false, true, true, true);     WAIT_BAR(2); RESC(); ROT();
        STEP(pA0, pA1, pB0, pB1, t + 1, false, true, true, true); WAIT_BAR(2); RESC(); ROT();
    }
#define ENDW(tt) do { if ((tt) + 3 < NT) { WAIT_BAR(2); } else if ((tt) + 2 < NT) { WAIT_BAR(1); } else { WAIT_BAR(0); } } while (0)
    for (; t + 1 < NT; t += 2) {
        STEP(pB0, pB1, pA0, pA1, t, true, (t + 3 < NT), (t + 1 < NT), (t + 1 < NT));         ENDW(t);     RESC(); ROT();
        STEP(pA0, pA1, pB0, pB1, t + 1, true, (t + 4 < NT), (t + 2 < NT), (t + 2 < NT));     ENDW(t + 1); RESC(); ROT();
    }
    int s_ret = 0;
    if (has_next) {
        const int n0 = sl_next, n1 = (n0 == 2 * SLOTB) ? 0 : n0 + SLOTB, n2 = (n1 == 2 * SLOTB) ? 0 : n1 + SLOTB; s_ret = n0;
        const bf16* ks2 = n.Kb + (long)lane * n.KP + wid * 8;
        const bf16* vs2 = n.Vb + (long)(16 * (wid & 3) + (lane >> 2)) * n.KP + (wid >> 2) * 32 + (lane & 3) * 8;
#define NROW(t) ({ int r_ = n.q0 + key_rel(n, (t)); r_ < 0 ? 0 : r_; })
        glds16(ks2 + (long)NROW(0) * n.KP, (unsigned)__builtin_amdgcn_readfirstlane(kdst + n0));
        const bf16* qs2 = n.Qw + (long)(lane >> 3) * QP + (lane & 7) * 8; const unsigned qdst = lds0 + LDS_QN + wid * 4096;
#pragma unroll
        for (int k = 0; k < 4; ++k) glds16(qs2 + (long)(8 * k) * QP, (unsigned)__builtin_amdgcn_readfirstlane(qdst + k * 1024));
        glds16(vs2 + (long)NROW(0) * n.KP, (unsigned)__builtin_amdgcn_readfirstlane(vdst + n0));
        glds16(ks2 + (long)NROW(1) * n.KP, (unsigned)__builtin_amdgcn_readfirstlane(kdst + n1));
        glds16(ks2 + (long)NROW(2) * n.KP, (unsigned)__builtin_amdgcn_readfirstlane(kdst + n2));
#undef NROW
    }
    STEP(pB0, pB1, pA0, pA1, NT - 1, true, false, false, false); RESC();
    { float sacc = pB0[0] + pB0[1];
#pragma unroll
      for (int r = 2; r < 16; ++r) sacc += pB0[r];
#pragma unroll
      for (int r = 0; r < 16; ++r) sacc += pB1[r];
      l_reg += sacc;
      pw0 = (u32x4){PKW(pB0, 0), PKW(pB0, 2), PKW(pB0, 4), PKW(pB0, 6)}; pw1 = (u32x4){PKW(pB0, 8), PKW(pB0, 10), PKW(pB0, 12), PKW(pB0, 14)};
      pw2 = (u32x4){PKW(pB1, 0), PKW(pB1, 2), PKW(pB1, 4), PKW(pB1, 6)}; pw3 = (u32x4){PKW(pB1, 8), PKW(pB1, 10), PKW(pB1, 12), PKW(pB1, 14)};
      const lds_cptr vp_ = vp0 + sl_cur; _Pragma("unroll") for (int i = 0; i < 8; ++i) VRD(i);
      o[0] = MFMA(PAF(0), VFR(0), o[0]); o[1] = MFMA(PAF(0), VFR(4), o[1]); o[0] = MFMA(PAF(1), VFR(1), o[0]); o[1] = MFMA(PAF(1), VFR(5), o[1]);
      o[0] = MFMA(PAF(2), VFR(2), o[0]); o[1] = MFMA(PAF(2), VFR(6), o[1]); o[0] = MFMA(PAF(3), VFR(3), o[0]); o[1] = MFMA(PAF(3), VFR(7), o[1]); }
    { auto rr = __builtin_amdgcn_permlane32_swap(__float_as_uint(l_reg), __float_as_uint(l_reg), false, false); l_reg = __uint_as_float(rr[0]) + __uint_as_float(rr[1]); }
    {
      const float sk = u.sink2 + u.slope2 * (float)qrel, mf = __builtin_fmaxf(mhat, sk), c = __builtin_amdgcn_exp2f(mhat - mf);
      const float lt = l_reg * c + __builtin_amdgcn_exp2f(sk - mf);
      if (hi == 0) wsf[32 + r32] = c * __builtin_amdgcn_rcpf(lt); }
    asm volatile("s_waitcnt lgkmcnt(0)" ::: "memory");
    float rli[16];
#pragma unroll
    for (int r = 0; r < 16; ++r) rli[r] = wsf[32 + crow(r, hi)];
    bf16* stg = (bf16*)(lds + LDS_OST) + wid * 2048;
    { int l2 = lane; asm volatile("" : "+v"(l2)); const int r32b = l2 & 31, hib = l2 >> 5;
#pragma unroll
    for (int r = 0; r < 16; ++r) { const int orow = crow(r, hib);
#pragma unroll
        for (int d0 = 0; d0 < 2; ++d0) stg[orow * 64 + d0 * 32 + r32b] = (bf16)bf16bits(o[d0][r] * rli[r]); }
    asm volatile("s_waitcnt lgkmcnt(0)" ::: "memory");
    const int srow = l2 >> 3, ch = l2 & 7; const u32x4* sp = (const u32x4*)(stg + srow * 64 + ch * 8); bf16* gp = u.Ow + (long)srow * QP + ch * 8;
#pragma unroll
    for (int i = 0; i < 4; ++i) *(u32x4*)(gp + (long)i * 8 * QP) = sp[i * 64]; }
    asm volatile("s_waitcnt lgkmcnt(0)\n\ts_barrier" ::: "memory");
    return s_ret;
#undef KROW
#undef DMA_K
#undef DMA_V
#undef SET_TILE
#undef SETCIN
#undef ROT
#undef EX
#undef RESC
#undef PKW
#undef PAF
#undef VFR
#undef VRD
#undef KRD
#undef ENDW
#undef GAPA
#undef GAPB
#undef STEP
}
#undef SBAR
#undef PIN
#undef MFMA
#undef WAIT_BAR
#undef MX3
}

__device__ __forceinline__ float bfbits2f(short s) { return __uint_as_float(((unsigned)(unsigned short)s) << 16); }
__device__ __forceinline__ fa::AU attn_make_unit(const Frame& F, bf16* O, int i, float sink2w) {
    const int wid = F.wave; fa::AU u;
    const bool moba = i < 4;
    const int p = F.vcu >> 1, bm = p >> 3, h = p & 7, half = F.vcu & 1, im = i & 3;
    const int j = half ? (im == 0 ? 6 : im == 1 ? 5 : im == 2 ? 2 : 1) : (im == 0 ? 7 : im == 1 ? 4 : im == 2 ? 3 : 0);
    const int k = i - 4, us = (k < 4) ? F.vcu * 4 + k : (F.vcu - 16) * 4 + (k - 2), bs = us >> 6, kvh = (us >> 5) & 1, c = us & 31, hq = kvh * 4 + (wid >> 1);
    const int b = moba ? bm : bs;
    const size_t rowbase = (size_t)b * SEQ;
    const size_t qoff = moba ? (rowbase + 256 * j + 32 * wid) * 1024 + h * 64 : (rowbase + 64 * c + 32 * (wid & 1)) * 1024 + 512 + hq * 64;
    u.Kb = moba ? F.KA + rowbase * 512 + h * 64 : F.KB + rowbase * 128 + kvh * 64;
    u.Vb = moba ? F.VA + rowbase * 512 + h * 64 : F.VB + rowbase * 128 + kvh * 64;
    u.KP = moba ? 512 : 128;
    u.q0 = moba ? 256 * j : 64 * c; u.qrel0 = moba ? 32 * wid : 32 * (wid & 1); u.NT = moba ? 4 * (j + 1) : 4; u.mode = moba ? 0 : 1; u.wd = moba ? 0x40000000u : 128u;
    u.slope2 = exp2f(-0.5f * (float)(moba ? h + 9 : hq + 1)) * pg8::kLog2e; u.sink2 = moba ? -INFINITY : sink2w;
    const unsigned okm = 1u | (7u << (4 * (j + 1) - 3)) | (j <= 3 ? ((1u << (4 * j)) - 1u) << 1 : 0u);
    const unsigned oks = (c >= 3) ? 0xFu : ((1u << (c + 1)) - 1u);
    u.okmask = moba ? okm : oks;
    u.km = F.kmean + ((size_t)(bm * 8) * 8 + h) * 64; u.gj = moba ? j : 0;
    u.Qw = F.Q + qoff; u.Ow = O + qoff;
    return u;
}
__device__ __forceinline__ void attn_fast_phase(Frame& F, char* lds, bf16* O) {
    const float sink2w = F.sinks[(((F.vcu * 4) >> 5) & 1) * 4 + (F.wave >> 1)] * pg8::kLog2e;
    const int nun = (F.li < 16) ? 6 : 10;
    fa::AU cur = attn_make_unit(F, O, 0, sink2w); int s0 = 0; bool pre = false;
    for (int i = 0; i < nun; ++i) {
        const bool has_next = i + 1 < nun;
        const fa::AU nxt = attn_make_unit(F, O, has_next ? i + 1 : i, sink2w);
        s0 = fa::attn_unit(cur, nxt, has_next, pre, s0, lds);
        pre = has_next; cur = nxt;
    }
}
#if defined(DBG_ATTN)
__device__ __forceinline__ void dbg_compare(Frame& F, const bf16* Od) {
    const int gt = F.li * NWAVES * 64 + F.tid, NGT = 32 * NWAVES * 64; float num = 0.f, den = 0.f;
    for (size_t i = gt; i < (size_t)GROWS * 64; i += NGT) { const size_t row = (size_t)F.grp * GROWS + (i >> 6), c8 = i & 63; const size_t off = row * 1024 + DBG_PART * 512 + c8 * 8;
        const v4u a = *(const GAS v4u*)(Od + off), r = *(const GAS v4u*)(F.Q + off);
#define DD(x) { const float a0 = __uint_as_float(a.x << 16), a1 = __uint_as_float(a.x & 0xffff0000u), r0 = __uint_as_float(r.x << 16), r1 = __uint_as_float(r.x & 0xffff0000u); num += (a0 - r0) * (a0 - r0) + (a1 - r1) * (a1 - r1); den += r0 * r0 + r1 * r1; }
        DD(x) DD(y) DD(z) DD(w)
#undef DD
    }
    num = wave_sum(num); den = wave_sum(den);
    if (F.lane == 0) { atomicAdd((float*)(F.ctl) + 8, num); atomicAdd((float*)(F.ctl) + 9, den); }
}
#endif

struct Args { const float* in[14]; float* out; unsigned char* ws; };
__global__ void __launch_bounds__(NWAVES * 64, 2) fwd_megakernel(Args args) {
    extern __shared__ __attribute__((aligned(16))) unsigned char lds[];
    Frame F;
    F.lds = (LAS unsigned char*)lds;
    F.MISC = (volatile LAS unsigned*)(F.lds + MISC_OFF);
    F.tid = threadIdx.x; F.lane = F.tid & 63; F.wave = __builtin_amdgcn_readfirstlane(F.tid >> 6);
    F.G = gridDim.x;
    unsigned char* ws = args.ws; F.ws = ws;
    F.ctl = (gu32*)(ws + WS_CTL);
    F.x = args.in[0]; F.norm_attn = args.in[1]; F.w_in = args.in[2]; F.qna = args.in[3]; F.kna = args.in[4]; F.qnb = args.in[5]; F.knb = args.in[6]; F.sinks = args.in[7];
    F.wba = args.in[8]; F.wbb = args.in[9]; F.w_out = args.in[10]; F.norm_mlp = args.in[11]; F.w_up = args.in[12]; F.w_down = args.in[13]; F.out = args.out;
    F.WinT = (bf16*)(ws + WS_WIN); F.WbrT = (bf16*)(ws + WS_WBR); F.WoT = (bf16*)(ws + WS_WO); F.WupT = (bf16*)(ws + WS_WUP); F.WdnT = (bf16*)(ws + WS_WDN);
    F.kmean = (float*)(ws + WS_CTL) + CW_KMEAN; F.rowsq = (float*)(ws + WS_CTL) + CW_ROWSQ; F.irs = (float*)(ws + WS_CTL) + CW_IRS;
    for (int u = F.tid; u < (LDS_BYTES - LDSCTL_OFF) / 4; u += NWAVES * 64) ((LAS unsigned*)(F.lds + LDSCTL_OFF))[u] = 0u;
    __syncthreads();
    XcdBarrier bar = xcd_barrier_post((unsigned*)(F.ctl + CW_BAR), F.MISC + 8);
    if (F.tid == 0) F.MISC[12] = xb_add((unsigned*)(F.ctl + CW_CENSUS) + 64 * bar.x, 1u);
    __syncthreads();
    const unsigned my_arrival = F.MISC[12];
#define GRID_BAR() xcd_barrier(bar)

#ifndef SKIP_P0
    p0_prologue(F);
#endif
    GRID_BAR();
    {   bool ok = (F.G == 256);
        for (int j = 0; j < 16; ++j) { const unsigned c = __hip_atomic_load((unsigned*)(F.ctl + CW_CENSUS) + 64 * j, RLX_AGENT); ok = ok && (c == (j < NGRP ? 32u : 0u)); }
        F.grouped = ok ? 1 : 0;
        if (ok) { F.grp = (int)bar.x; F.li = (int)my_arrival; }
        else    { F.grp = (int)blockIdx.x % NGRP; F.li = (int)blockIdx.x / NGRP; }
        F.grp = __builtin_amdgcn_readfirstlane(F.grp); F.li = __builtin_amdgcn_readfirstlane(F.li);
        F.vcu = F.grp * 32 + F.li; }
    const int vbid = F.li * NGRP + F.grp;
    F.Q = grp_ptr(ws, F.grp, GO_Q, 1024); F.KA = grp_ptr(ws, F.grp, GO_KA, 512); F.VA = grp_ptr(ws, F.grp, GO_VA, 512); F.KB = grp_ptr(ws, F.grp, GO_KB, 128); F.VB = grp_ptr(ws, F.grp, GO_VB, 128);
    F.GA = grp_ptr(ws, F.grp, GO_GA, 1024); F.GB = grp_ptr(ws, F.grp, GO_GB, 1024); F.HB = grp_ptr(ws, F.grp, GO_H, 4096); F.A2 = grp_ptr(ws, F.grp, GO_A2, 1024); F.XN = grp_ptr(ws, F.grp, GO_XN, 1024); F.MIX = grp_ptr(ws, F.grp, GO_MIX, 1024);
    GroupBar gbar{(unsigned*)(F.ctl + CW_GSUB) + 64 * F.grp, (unsigned*)(F.ctl + CW_GGEN) + 64 * F.grp, (unsigned*)(F.ctl + CW_BAR)};
#define GROUP_BAR() do { if (F.grouped) group_barrier(gbar); else xcd_barrier(bar); } while (0)
#ifndef SKIP_P1
    {   pg8::Gemm g{F.XN, F.WinT, M, NIN, DM}; pg8::StaticOrder S; S.init(M, NIN, F.G, vbid);
        pg8::EpiIn E{F.Q, F.KA, F.VA, F.KB, F.VB, F.GA, F.GB, F.qna, F.kna, F.qnb, F.knb, F.kmean};
        S.ilim = 8;
        pg8::gemm_phase<pg8::EpiIn, pg8::StaticOrder, true, true>(F.lds + RING_OFF, g, S, E);
        GROUP_BAR();
        if (F.li < 16) { S.ioff = 8; S.ilim = 1; pg8::gemm_phase<pg8::EpiIn, pg8::StaticOrder, true, true>(F.lds + RING_OFF, g, S, E); } }
#endif
#if defined(DBG_ATTN)
    attn_fast_phase(F, (char*)lds + RING_OFF, F.MIX); GROUP_BAR(); attn_simple_phase(F); GROUP_BAR(); dbg_compare(F, F.MIX);
#elif defined(SIMPLE_ATTN)
    attn_simple_phase(F);
#else
    attn_fast_phase(F, (char*)lds + RING_OFF, F.Q);
#endif
    GROUP_BAR();
#ifndef SKIP_P3
    {   pg8::Gemm g{F.Q, F.WbrT, M, DM, DM}; pg8::StaticOrder S; S.init(M, DM, F.G, vbid);
        pg8::EpiMix E{F.GA, F.GB, F.MIX};
        pg8::gemm_phase<pg8::EpiMix, pg8::StaticOrder, true, true>(F.lds + RING_OFF, g, S, E); }
#endif
    GROUP_BAR();
#ifndef SKIP_P4
    {   pg8::Gemm g{F.MIX, F.WoT, M, DM, DM}; pg8::StaticOrder S; S.init(M, DM, F.G, vbid);
        pg8::EpiX1 E{F.XN, F.irs, F.norm_attn, F.A2, F.rowsq, F.lds + STG_OFF};
        pg8::gemm_phase<pg8::EpiX1, pg8::StaticOrder, true, true>(F.lds + RING_OFF, g, S, E); }
#endif
    GROUP_BAR();
#ifndef SKIP_P5
    {   pg8::Gemm g{F.A2, F.WupT, M, FF, DM}; pg8::StaticOrder S; S.init(M, FF, F.G, vbid);
        pg8::EpiUp E{F.HB, F.rowsq, F.lds + STG_OFF};
        pg8::gemm_phase<pg8::EpiUp, pg8::StaticOrder, true, true>(F.lds + RING_OFF, g, S, E); }
#endif
    GROUP_BAR();
#ifndef SKIP_P6
    {   pg8::Gemm g{F.HB, F.WdnT, M, DM, FF}; pg8::StaticOrder S; S.init(M, DM, F.G, vbid);
#if defined(DBG_ATTN)
        const float dnum = ((const GAS float*)F.ctl)[8], dden = ((const GAS float*)F.ctl)[9];
        pg8::EpiDown E{F.A2, F.out, 1.0f + 100.0f * sqrtf(dnum / dden), F.lds + STG_OFF};
#else
        pg8::EpiDown E{F.A2, F.out, 1.0f, F.lds + STG_OFF};
#endif
        pg8::gemm_phase<pg8::EpiDown, pg8::StaticOrder, true, true>(F.lds + RING_OFF, g, S, E); }
#endif
}

extern "C" void kernel_launch(void* const* d_in, const int* in_sizes, int n_in, void* d_out, int out_size, void* d_ws, size_t ws_size, hipStream_t stream) {
    static int grid = 0;
    if (grid == 0) {
        if (n_in != 14 || in_sizes[0] != M * DM || out_size != M * DM || ws_size < WS_END) { fprintf(stderr, "kernel_launch: unexpected shapes: n_in %d, in0 %d, out %d, ws %zu (need %zu); nothing launched\n", n_in, n_in > 0 ? in_sizes[0] : -1, out_size, ws_size, (size_t)WS_END); grid = -1; return; }
        int dev = 0, cus = 0, per_cu = 0;
        if (hipGetDevice(&dev) != hipSuccess || hipDeviceGetAttribute(&cus, hipDeviceAttributeMultiprocessorCount, dev) != hipSuccess) { fprintf(stderr, "kernel_launch: device query failed\n"); grid = -1; return; }
        if (hipFuncSetAttribute((const void*)fwd_megakernel, hipFuncAttributeMaxDynamicSharedMemorySize, LDS_BYTES) != hipSuccess) { fprintf(stderr, "kernel_launch: hipFuncSetAttribute failed\n"); grid = -1; return; }
        if (hipOccupancyMaxActiveBlocksPerMultiprocessor(&per_cu, (const void*)fwd_megakernel, NWAVES * 64, LDS_BYTES) != hipSuccess || per_cu < 1)
            fprintf(stderr, "kernel_launch: note: occupancy query reports %d workgroups per CU\n", per_cu);
        (void)hipGetLastError();
        grid = cus;
    }
    if (grid < 0) return;
    if (hipMemsetAsync((char*)d_ws + WS_CTL, 0, CTL_ZERO_BYTES, stream) != hipSuccess) { fprintf(stderr, "kernel_launch: hipMemsetAsync failed\n"); return; }
    Args a{};
    for (int i = 0; i < 14; ++i) a.in[i] = (const float*)d_in[i];
    a.out = (float*)d_out; a.ws = (unsigned char*)d_ws;
    hipLaunchKernelGGL(fwd_megakernel, dim3(grid), dim3(NWAVES * 64), LDS_BYTES, stream, a);
    const hipError_t le = hipPeekAtLastError();
    if (le != hipSuccess) fprintf(stderr, "kernel_launch: launch failed: %s\n", hipGetErrorName(le));
}
```

```cpp
#include <hip/hip_runtime.h>
#include <cstdio>
#include <cstdint>
namespace pg8 {
#define PG8_LAS __attribute__((address_space(3)))
typedef unsigned short bf16_t;
typedef short bf16x8 __attribute__((ext_vector_type(8)));
typedef float f32x4 __attribute__((ext_vector_type(4)));
typedef unsigned u32x4 __attribute__((ext_vector_type(4)));
constexpr int BM = 256, BK = 64, HALF = 128, HTB = HALF * BK * 2  , STAGE_BYTES = 8 * HTB, NXCD = 8, WGM = 8;

__host__ __device__ __forceinline__ int lds_byte(int r, int c) { const int st = (r >> 4) * 2 + (c >> 5), rr = r & 15, cc = c & 31, ob = rr * 64 + cc * 2; return st * 1024 + (ob ^ (((ob >> 9) & 1) << 5)); }
__host__ __device__ __forceinline__ void stage_rc(int b, int& R, int& C) { const int st = b / 1024, sb = b % 1024, swz = sb ^ (((sb >> 9) & 1) << 5); R = (st >> 1) * 16 + swz / 64; C = (st & 1) * 32 + (swz % 64) / 2; }
__host__ __device__ __forceinline__ int perm32(int rho) { const int n = rho >> 4, i = rho & 15; return 8 * (i >> 2) + 4 * n + (i & 3); }

struct Unit { int pm, pn; };
struct Gemm { const bf16_t* A; const bf16_t* Bt; int M, N, K; };

struct StaticOrder {
    int nM, nN, nwg, G, c, ioff = 0, ilim = 1 << 30;
    __host__ __device__ void init(int M, int N, int G_, int c_) { nM = M / BM; nN = N / BM; nwg = nM * nN; G = G_; c = c_; }
    __host__ __device__ bool next(int i, Unit& u) const {
        if (i >= ilim) return false;
        const long L = (long)(i + ioff) * G + c; if (L >= nwg) return false;
        int wgid = (int)L; { const int q = nwg / NXCD, r = nwg % NXCD, xcd = wgid % NXCD, off = wgid / NXCD; wgid = (xcd < r ? xcd * (q + 1) : r * (q + 1) + (xcd - r) * q) + off; }
        const int nig = WGM * nN, gid = wgid / nig, fm = gid * WGM, gsz = (nM - fm) < WGM ? (nM - fm) : WGM;
        u.pm = fm + ((wgid % nig) % gsz); u.pn = (wgid % nig) / gsz; return true;
    }
    __device__ __forceinline__ void a_ready(const Unit&) const {}
    __device__ __forceinline__ void done(const Unit&) const {}
};

__device__ __forceinline__ unsigned cvt_pk_bf16(float lo, float hi) { unsigned r; asm volatile("v_cvt_pk_bf16_f32 %0, %1, %2" : "=v"(r) : "v"(lo), "v"(hi)); return r; }
typedef unsigned u32x2 __attribute__((ext_vector_type(2)));
__device__ __forceinline__ float bf_lo(unsigned w) { return __uint_as_float(w << 16); }
__device__ __forceinline__ float bf_hi(unsigned w) { return __uint_as_float(w & 0xffff0000u); }
constexpr float kLog2e = 1.4426950408889634f;
constexpr float kC2 = 0.125f * 1.4426950408889634f;

struct EpiIn {
    static constexpr bool PERM = true, AFTER_DRAIN = false; static constexpr int MID_TILE = 0;
    bf16_t *Q, *KA, *VA, *KB, *VB, *GR, *GB; const float *qna, *kna, *qnb, *knb; float* kmean;
    __device__ __forceinline__ void mid(f32x4 (&)[2][2][4][2], const Unit&, int, int, int, int) const {}
    __device__ __forceinline__ void operator()(const f32x4 (&acc)[2][2][4][2], const Unit& u, int wr, int wc, int fr, int fq) const {
        const int pn = u.pn;
        const int rowb = u.pm * BM + wr * 64 + fr;
        if (pn >= 9) {
            const int col = 128 * (pn - 9) + 32 * wc + 8 * fq;
#pragma unroll
            for (int ai = 0; ai < 2; ++ai)
#pragma unroll
                for (int m = 0; m < 4; ++m) { const size_t off = (size_t)(rowb + ai * HALF + m * 16) * 1024 + col;
                    f32x4 rt[2], gb[2];
#pragma unroll
                    for (int n = 0; n < 2; ++n)
#pragma unroll
                        for (int e = 0; e < 4; ++e) { const float ea = __builtin_amdgcn_exp2f(-kLog2e * acc[ai][0][m][n][e]), eb = __builtin_amdgcn_exp2f(-kLog2e * acc[ai][1][m][n][e]);
                            gb[n][e] = __builtin_fmaxf(__builtin_amdgcn_rcpf(1.0f + eb), 1e-20f); rt[n][e] = __builtin_fminf((1.0f + eb) * __builtin_amdgcn_rcpf(1.0f + ea), 1e20f); }
                    u32x4 w; w.x = cvt_pk_bf16(rt[0][0], rt[0][1]); w.y = cvt_pk_bf16(rt[0][2], rt[0][3]); w.z = cvt_pk_bf16(rt[1][0], rt[1][1]); w.w = cvt_pk_bf16(rt[1][2], rt[1][3]);
                    *(u32x4*)(GR + off) = w;
                    w.x = cvt_pk_bf16(gb[0][0], gb[0][1]); w.y = cvt_pk_bf16(gb[0][2], gb[0][3]); w.z = cvt_pk_bf16(gb[1][0], gb[1][1]); w.w = cvt_pk_bf16(gb[1][2], gb[1][3]);
                    *(u32x4*)(GB + off) = w; }
            return;
        }
        bf16_t* dst; int pitch; bool norm = false, km = false; float scale = 1.f; const float* gain = qna;
        if (pn < 2)       { dst = Q + (4 * pn + wc) * 64; pitch = 1024; norm = true; gain = qna; scale = kC2; }
        else if (pn < 4)  { dst = KA + (4 * (pn - 2) + wc) * 64; pitch = 512; norm = true; gain = kna; km = true; }
        else if (pn < 6)  { dst = VA + (4 * (pn - 4) + wc) * 64; pitch = 512; }
        else if (pn < 8)  { dst = Q + 512 + (4 * (pn - 6) + wc) * 64; pitch = 1024; norm = true; gain = qnb; scale = kC2; }
        else              { pitch = 128; if (wc < 2) { dst = KB + wc * 64; norm = true; gain = knb; } else { dst = VB + (wc - 2) * 64; } }
        f32x4 g[2][2], cs[2][2];
#pragma unroll
        for (int bj = 0; bj < 2; ++bj)
#pragma unroll
            for (int n = 0; n < 2; ++n) { g[bj][n] = norm ? *(const f32x4*)(gain + 32 * bj + 8 * fq + 4 * n) : (f32x4){1.f, 1.f, 1.f, 1.f}; cs[bj][n] = (f32x4){0.f, 0.f, 0.f, 0.f}; }
#pragma unroll
        for (int ai = 0; ai < 2; ++ai)
#pragma unroll
            for (int m = 0; m < 4; ++m) {
                const int row = rowb + ai * HALF + m * 16;
                f32x4 v[2][2];
#pragma unroll
                for (int bj = 0; bj < 2; ++bj)
#pragma unroll
                    for (int n = 0; n < 2; ++n) v[bj][n] = acc[ai][bj][m][n];
                if (norm) {
                    float ss = 0.f;
#pragma unroll
                    for (int bj = 0; bj < 2; ++bj)
#pragma unroll
                        for (int n = 0; n < 2; ++n) { const f32x4 x = v[bj][n]; ss += (x[0] * x[0] + x[1] * x[1]) + (x[2] * x[2] + x[3] * x[3]); }
                    ss += __shfl_xor(ss, 16); ss += __shfl_xor(ss, 32);
                    const float rs = __builtin_amdgcn_rsqf(ss * (1.0f / 64.0f) + 1e-6f) * scale;
#pragma unroll
                    for (int bj = 0; bj < 2; ++bj)
#pragma unroll
                        for (int n = 0; n < 2; ++n) v[bj][n] = v[bj][n] * rs * g[bj][n];
                }
                if (km) {
#pragma unroll
                    for (int bj = 0; bj < 2; ++bj)
#pragma unroll
                        for (int n = 0; n < 2; ++n) cs[bj][n] += v[bj][n];
                }
#pragma unroll
                for (int bj = 0; bj < 2; ++bj) {
                    u32x4 w; w.x = cvt_pk_bf16(v[bj][0][0], v[bj][0][1]); w.y = cvt_pk_bf16(v[bj][0][2], v[bj][0][3]); w.z = cvt_pk_bf16(v[bj][1][0], v[bj][1][1]); w.w = cvt_pk_bf16(v[bj][1][2], v[bj][1][3]);
                    *(u32x4*)(dst + (size_t)row * pitch + 32 * bj + 8 * fq) = w;
                }
            }
        if (km) {
            float* kmp = kmean + ((size_t)u.pm * 8 + (4 * (pn - 2) + wc)) * 64;
#pragma unroll
            for (int bj = 0; bj < 2; ++bj)
#pragma unroll
                for (int n = 0; n < 2; ++n)
#pragma unroll
                    for (int e = 0; e < 4; ++e) {
                        float s = cs[bj][n][e];
                        s += __shfl_xor(s, 1); s += __shfl_xor(s, 2); s += __shfl_xor(s, 4); s += __shfl_xor(s, 8);
                        if (fr == 0) atomicAdd(kmp + 32 * bj + 8 * fq + 4 * n + e, s * (1.0f / 256.0f));
                    }
        }
    }
};

struct EpiMix {
    static constexpr bool PERM = true, AFTER_DRAIN = false; static constexpr int MID_TILE = 8;
    const bf16_t *GR, *GB; bf16_t* MIX;
    __device__ __forceinline__ void mid(f32x4 (&acc)[2][2][4][2], const Unit& u, int wr, int wc, int fr, int fq) const {
        int rowb = u.pm * BM + wr * 64 + fr, col0 = u.pn * BM + wc * 32 + 8 * fq;
        asm volatile("" : "+v"(rowb), "+v"(col0));
        const bf16_t* base = GR + (size_t)rowb * 1024 + col0;
        u32x4 rt[2][4][2];
#pragma unroll
        for (int ai = 0; ai < 2; ++ai)
#pragma unroll
            for (int m = 0; m < 4; ++m)
#pragma unroll
                for (int bj = 0; bj < 2; ++bj) rt[ai][m][bj] = *(const u32x4*)(base + (size_t)(ai * HALF + m * 16) * 1024 + bj * HALF);
#pragma unroll
        for (int ai = 0; ai < 2; ++ai)
#pragma unroll
            for (int m = 0; m < 4; ++m)
#pragma unroll
                for (int bj = 0; bj < 2; ++bj) { const u32x4 a = rt[ai][m][bj];
                    acc[ai][bj][m][0] *= (f32x4){bf_lo(a.x), bf_hi(a.x), bf_lo(a.y), bf_hi(a.y)}; acc[ai][bj][m][1] *= (f32x4){bf_lo(a.z), bf_hi(a.z), bf_lo(a.w), bf_hi(a.w)}; }
    }
    __device__ __forceinline__ void operator()(const f32x4 (&acc)[2][2][4][2], const Unit& u, int wr, int wc, int fr, int fq) const {
        const int rowb = u.pm * BM + wr * 64 + fr, col0 = u.pn * BM + wc * 32 + 8 * fq;
        const bf16_t* base = GB + (size_t)rowb * 1024 + col0; bf16_t* ob = MIX + (size_t)rowb * 1024 + col0;
        u32x4 gt[2][4][2];
#pragma unroll
        for (int ai = 0; ai < 2; ++ai)
#pragma unroll
            for (int m = 0; m < 4; ++m)
#pragma unroll
                for (int bj = 0; bj < 2; ++bj) gt[ai][m][bj] = *(const u32x4*)(base + (size_t)(ai * HALF + m * 16) * 1024 + bj * HALF);
#pragma unroll
        for (int ai = 0; ai < 2; ++ai)
#pragma unroll
            for (int m = 0; m < 4; ++m)
#pragma unroll
                for (int bj = 0; bj < 2; ++bj) { const u32x4 b = gt[ai][m][bj];
                    const f32x4 v0 = acc[ai][bj][m][0], v1 = acc[ai][bj][m][1];
                    u32x4 w; w.x = cvt_pk_bf16(v0[0] * bf_lo(b.x), v0[1] * bf_hi(b.x)); w.y = cvt_pk_bf16(v0[2] * bf_lo(b.y), v0[3] * bf_hi(b.y));
                    w.z = cvt_pk_bf16(v1[0] * bf_lo(b.z), v1[1] * bf_hi(b.z)); w.w = cvt_pk_bf16(v1[2] * bf_lo(b.w), v1[3] * bf_hi(b.w));
                    *(u32x4*)(ob + (size_t)(ai * HALF + m * 16) * 1024 + bj * HALF) = w; }
    }
};

struct EpiX1 {
    static constexpr bool PERM = true, AFTER_DRAIN = false; static constexpr int MID_TILE = 0;
    const bf16_t* XN; const float* irs; const float* g1; bf16_t* X1; float* rowsq; PG8_LAS unsigned char* stg;
    __device__ __forceinline__ void mid(f32x4 (&)[2][2][4][2], const Unit&, int, int, int, int) const {}
    __device__ __forceinline__ void operator()(const f32x4 (&acc)[2][2][4][2], const Unit& u, int wr, int wc, int fr, int fq) const {
        const int rowb = u.pm * BM + wr * 64, colw = u.pn * BM + wc * 64;
        PG8_LAS unsigned char* sw = stg + (wr * 4 + wc) * 2048;
        const int lane = fq * 16 + fr, rr = lane >> 3, ch = lane & 7;
        u32x4 xv[2][4][2];
#pragma unroll
        for (int ai = 0; ai < 2; ++ai)
#pragma unroll
            for (int m = 0; m < 4; ++m)
#pragma unroll
                for (int bj = 0; bj < 2; ++bj) xv[ai][m][bj] = *(const u32x4*)(XN + (size_t)(rowb + fr + ai * HALF + m * 16) * 1024 + colw + 32 * bj + 8 * fq);
        f32x4 ig[2][2];
#pragma unroll
        for (int bj = 0; bj < 2; ++bj)
#pragma unroll
            for (int n = 0; n < 2; ++n) { const f32x4 gv = *(const f32x4*)(g1 + colw + 32 * bj + 8 * fq + 4 * n);
                ig[bj][n] = (f32x4){__builtin_amdgcn_rcpf(gv[0]), __builtin_amdgcn_rcpf(gv[1]), __builtin_amdgcn_rcpf(gv[2]), __builtin_amdgcn_rcpf(gv[3])}; }
#pragma unroll
        for (int ai = 0; ai < 2; ++ai)
#pragma unroll
            for (int m = 0; m < 4; ++m) { const int row0 = rowb + ai * HALF + m * 16; const float q = irs[row0 + fr]; float ss = 0.f;
#pragma unroll
                for (int bj = 0; bj < 2; ++bj) { const u32x4 a = xv[ai][m][bj];
                    const f32x4 x0 = (f32x4){bf_lo(a.x), bf_hi(a.x), bf_lo(a.y), bf_hi(a.y)} * q * ig[bj][0] + acc[ai][bj][m][0];
                    const f32x4 x1 = (f32x4){bf_lo(a.z), bf_hi(a.z), bf_lo(a.w), bf_hi(a.w)} * q * ig[bj][1] + acc[ai][bj][m][1];
                    ss += (x0[0] * x0[0] + x0[1] * x0[1]) + (x0[2] * x0[2] + x0[3] * x0[3]) + (x1[0] * x1[0] + x1[1] * x1[1]) + (x1[2] * x1[2] + x1[3] * x1[3]);
                    u32x4 w; w.x = cvt_pk_bf16(x0[0], x0[1]); w.y = cvt_pk_bf16(x0[2], x0[3]); w.z = cvt_pk_bf16(x1[0], x1[1]); w.w = cvt_pk_bf16(x1[2], x1[3]);
                    *(PG8_LAS u32x4*)(sw + fr * 128 + (((bj * 4 + fq) ^ (fr & 7)) << 4)) = w; }
                ss += __shfl_xor(ss, 16); ss += __shfl_xor(ss, 32);
                if (fq == 0) atomicAdd(rowsq + row0 + fr, ss);
                asm volatile("s_waitcnt lgkmcnt(0)" ::: "memory");
#pragma unroll
                for (int hh = 0; hh < 2; ++hh) { const int r2 = rr + 8 * hh;
                    const u32x4 w = *(const PG8_LAS u32x4*)(sw + r2 * 128 + ((ch ^ (r2 & 7)) << 4));
                    *(u32x4*)(X1 + (size_t)(row0 + r2) * 1024 + colw + ch * 8) = w; }
                asm volatile("s_waitcnt lgkmcnt(0)" ::: "memory"); }
    }
};

struct EpiUp {
    static constexpr bool PERM = true, AFTER_DRAIN = false; static constexpr int MID_TILE = 0;
    bf16_t* H; const float* rowsq; PG8_LAS unsigned char* stg;
    __device__ __forceinline__ void mid(f32x4 (&)[2][2][4][2], const Unit&, int, int, int, int) const {}
    __device__ __forceinline__ void operator()(const f32x4 (&acc)[2][2][4][2], const Unit& u, int wr, int wc, int fr, int fq) const {
        const int rowb = u.pm * BM + wr * 64, colw = u.pn * BM + wc * 64;
        PG8_LAS unsigned char* sw = stg + (wr * 4 + wc) * 2048;
        const int lane = fq * 16 + fr, rr = lane >> 3, ch = lane & 7;
#pragma unroll
        for (int ai = 0; ai < 2; ++ai)
#pragma unroll
            for (int m = 0; m < 4; ++m) { const int row0 = rowb + ai * HALF + m * 16;
                const float r = __builtin_amdgcn_rsqf(rowsq[row0 + fr] * (1.0f / 1024.0f) + 1e-6f);
#pragma unroll
                for (int bj = 0; bj < 2; ++bj) {
                    f32x4 v0 = acc[ai][bj][m][0] * r, v1 = acc[ai][bj][m][1] * r;
#pragma unroll
                    for (int e = 0; e < 4; ++e) { const float a = __builtin_fmaxf(v0[e], 0.f), b = __builtin_fmaxf(v1[e], 0.f); v0[e] = a * a; v1[e] = b * b; }
                    u32x4 w; w.x = cvt_pk_bf16(v0[0], v0[1]); w.y = cvt_pk_bf16(v0[2], v0[3]); w.z = cvt_pk_bf16(v1[0], v1[1]); w.w = cvt_pk_bf16(v1[2], v1[3]);
                    *(PG8_LAS u32x4*)(sw + fr * 128 + (((bj * 4 + fq) ^ (fr & 7)) << 4)) = w;
                }
                asm volatile("s_waitcnt lgkmcnt(0)" ::: "memory");
#pragma unroll
                for (int hh = 0; hh < 2; ++hh) { const int r2 = rr + 8 * hh;
                    const u32x4 w = *(const PG8_LAS u32x4*)(sw + r2 * 128 + ((ch ^ (r2 & 7)) << 4));
                    *(u32x4*)(H + (size_t)(row0 + r2) * 4096 + colw + ch * 8) = w; }
                asm volatile("s_waitcnt lgkmcnt(0)" ::: "memory");
            }
    }
};

struct EpiDown {
    static constexpr bool PERM = false, AFTER_DRAIN = false; static constexpr int MID_TILE = 0;
    const bf16_t* X1; float* out; float mul; PG8_LAS unsigned char* stg;
    __device__ __forceinline__ void mid(f32x4 (&)[2][2][4][2], const Unit&, int, int, int, int) const {}
    __device__ __forceinline__ void operator()(const f32x4 (&acc)[2][2][4][2], const Unit& u, int wr, int wc, int fr, int fq) const {
        const int rowb = u.pm * BM + wr * 64, col0 = u.pn * BM + wc * 32;
        PG8_LAS unsigned char* sw = stg + (wr * 4 + wc) * 2048;
        const int lane = fq * 16 + fr, rr = lane >> 3, ch = lane & 7;
        u32x2 xv[2][4][2][2];
#pragma unroll
        for (int ai = 0; ai < 2; ++ai)
#pragma unroll
            for (int m = 0; m < 4; ++m)
#pragma unroll
                for (int bj = 0; bj < 2; ++bj)
#pragma unroll
                    for (int n = 0; n < 2; ++n) xv[ai][m][bj][n] = *(const u32x2*)(X1 + (size_t)(rowb + fr + ai * HALF + m * 16) * 1024 + col0 + 4 * fq + bj * HALF + n * 16);
#pragma unroll
        for (int ai = 0; ai < 2; ++ai)
#pragma unroll
            for (int m = 0; m < 4; ++m)
#pragma unroll
                for (int bj = 0; bj < 2; ++bj) { const int row0 = rowb + ai * HALF + m * 16;
#pragma unroll
                    for (int n = 0; n < 2; ++n) { const u32x2 w = xv[ai][m][bj][n];
                        const f32x4 o = ((f32x4){bf_lo(w.x), bf_hi(w.x), bf_lo(w.y), bf_hi(w.y)} + acc[ai][bj][m][n]) * mul;
                        *(PG8_LAS f32x4*)(sw + fr * 128 + (((n * 4 + fq) ^ (fr & 7)) << 4)) = o; }
                    asm volatile("s_waitcnt lgkmcnt(0)" ::: "memory");
#pragma unroll
                    for (int hh = 0; hh < 2; ++hh) { const int r2 = rr + 8 * hh;
                        const f32x4 o = *(const PG8_LAS f32x4*)(sw + r2 * 128 + ((ch ^ (r2 & 7)) << 4));
                        *(f32x4*)(out + (size_t)(row0 + r2) * 1024 + col0 + bj * HALF + ch * 4) = o; }
                    asm volatile("s_waitcnt lgkmcnt(0)" ::: "memory"); }
    }
};

template <class Epi, class Sched, bool ALIGN_EPI = false, bool SP2 = false>
__device__ __forceinline__ void gemm_phase(PG8_LAS unsigned char* lds, const Gemm g, const Sched& S, const Epi& E) {
    int tid = threadIdx.x; asm volatile("" : "+v"(tid));
    const int wid = __builtin_amdgcn_readfirstlane(tid >> 6), lane = tid & 63, wr = wid >> 2, wc = wid & 3, fr = lane & 15, fq = lane >> 4;
    const int K = g.K, nt = K / BK;
    unsigned voffA[2], voffB[2];
#pragma unroll
    for (int i = 0; i < 2; ++i) { int R, C; stage_rc(tid * 16 + i * 8192, R, C); const int Rb = Epi::PERM ? ((R & ~31) + perm32(R & 31)) : R;
        voffA[i] = (unsigned)(R * K + C) * 2u; voffB[i] = (unsigned)(Rb * K + C) * 2u; }
    const size_t kstep = (size_t)(BK * 2);
    const size_t hstep = (size_t)HALF * K * 2;
    const size_t tstep = 2 * hstep;
    const unsigned ldsw = (unsigned)wid * 1024u;
    const int aoff = lds_byte(wr * 64 + fr, fq * 8), boff = lds_byte(wc * 32 + fr, fq * 8);
#define PG8_SA(b, h) (((b) * 2 + (h)) * HTB)
#define PG8_SB(b, h) ((4 + (b) * 2 + (h)) * HTB)
#define PG8_STAGE(bufoff, gbase, voff) do { _Pragma("unroll") for (int _i = 0; _i < 2; ++_i) \
        __builtin_amdgcn_global_load_lds((const unsigned*)((const char*)(gbase) + (voff)[_i]), (PG8_LAS unsigned*)(lds + (bufoff) + ldsw + _i * 8192), 16, 0, 0); } while (0)
#define PG8_LDA(dst, b, h) do { _Pragma("unroll") for (int m = 0; m < 4; ++m) _Pragma("unroll") for (int k = 0; k < 2; ++k) dst[m][k] = *(const PG8_LAS bf16x8*)(lds + PG8_SA(b, h) + aoff + m * 2048 + k * 1024); } while (0)
#define PG8_LDB(dst, b, h) do { _Pragma("unroll") for (int n = 0; n < 2; ++n) _Pragma("unroll") for (int k = 0; k < 2; ++k) dst[n][k] = *(const PG8_LAS bf16x8*)(lds + PG8_SB(b, h) + boff + n * 2048 + k * 1024); } while (0)
#define PG8_MMA(ai, bj, At, Bt) do { __builtin_amdgcn_s_setprio(1); _Pragma("unroll") for (int m = 0; m < 4; ++m) _Pragma("unroll") for (int n = 0; n < 2; ++n) _Pragma("unroll") for (int k = 0; k < 2; ++k) \
        acc[ai][bj][m][n] = __builtin_amdgcn_mfma_f32_16x16x32_bf16(Bt[n][k], At[m][k], acc[ai][bj][m][n], 0, 0, 0); __builtin_amdgcn_s_setprio(0); } while (0)
#define PG8_WAIT_V(n) asm volatile("s_waitcnt vmcnt(" #n ")" ::: "memory")
#define PG8_WAIT_L(n) asm volatile("s_waitcnt lgkmcnt(" #n ")" ::: "memory")
#define PG8_BAR __builtin_amdgcn_s_barrier()
#define PG8_SCHED __builtin_amdgcn_sched_barrier(0)
    Unit cur, nxt; int ui = 0;
    if (!S.next(0, cur)) return;
    f32x4 acc[2][2][4][2];
#pragma unroll
    for (int a = 0; a < 2; ++a)
#pragma unroll
        for (int b = 0; b < 2; ++b)
#pragma unroll
            for (int m = 0; m < 4; ++m)
#pragma unroll
                for (int n = 0; n < 2; ++n) acc[a][b][m][n] = (f32x4){0.f, 0.f, 0.f, 0.f};
    bf16x8 At[4][2], B0[2][2], B1[2][2];
    const char* cA = (const char*)g.A + (size_t)cur.pm * tstep; const char* cB = (const char*)g.Bt + (size_t)cur.pn * tstep;
    S.a_ready(cur);
    if constexpr (SP2) {
        PG8_STAGE(PG8_SB(0, 0), cB, voffB); PG8_STAGE(PG8_SB(0, 1), cB + hstep, voffB); PG8_STAGE(PG8_SA(0, 0), cA, voffA); PG8_STAGE(PG8_SA(0, 1), cA + hstep, voffA);
        if (wr == 1) PG8_BAR;
        PG8_WAIT_V(2); PG8_BAR;
        PG8_STAGE(PG8_SB(1, 0), cB + kstep, voffB); PG8_STAGE(PG8_SA(1, 0), cA + kstep, voffA); PG8_STAGE(PG8_SB(1, 1), cB + hstep + kstep, voffB);
        PG8_WAIT_V(6); PG8_BAR;
    } else {
        PG8_STAGE(PG8_SB(0, 0), cB, voffB); PG8_STAGE(PG8_SA(0, 0), cA, voffA); PG8_STAGE(PG8_SB(0, 1), cB + hstep, voffB); PG8_STAGE(PG8_SA(0, 1), cA + hstep, voffA);
        if (wr == 1) PG8_BAR;
        PG8_WAIT_V(4); PG8_BAR;
        PG8_STAGE(PG8_SB(1, 0), cB + kstep, voffB); PG8_STAGE(PG8_SA(1, 0), cA + kstep, voffA); PG8_STAGE(PG8_SB(1, 1), cB + hstep + kstep, voffB);
        PG8_WAIT_V(6); PG8_BAR;
    }
    for (;;) {
        const bool has_next = S.next(ui + 1, nxt);
        const char* nA = has_next ? (const char*)g.A + (size_t)nxt.pm * tstep : cA; const char* nB = has_next ? (const char*)g.Bt + (size_t)nxt.pn * tstep : cB;
        for (int t = 0; t < nt; t += 2) {
            if constexpr (Epi::MID_TILE > 0) { if (t == Epi::MID_TILE) { PG8_SCHED; E.mid(acc, cur, wr, wc, fr, fq); PG8_SCHED; } }
            const bool last = (t == nt - 2);
            const char* a1 = cA + (size_t)(t + 1) * kstep;
            const char* a2 = last ? nA : cA + (size_t)(t + 2) * kstep; const char* b2 = last ? nB : cB + (size_t)(t + 2) * kstep;
            const char* a3 = a2 + kstep; const char* b3 = b2 + kstep;
            if (last && has_next) S.a_ready(nxt);
            if constexpr (SP2) {
            PG8_LDB(B0, 0, 0); PG8_LDB(B1, 0, 1); PG8_SCHED; PG8_LDA(At, 0, 0); PG8_STAGE(PG8_SA(1, 1), a1 + hstep, voffA);
            PG8_WAIT_V(8); PG8_WAIT_L(0); PG8_BAR; PG8_MMA(0, 0, At, B0); PG8_MMA(0, 1, At, B1); PG8_BAR; PG8_SCHED;
            PG8_LDA(At, 0, 1); PG8_STAGE(PG8_SB(0, 0), b2, voffB); PG8_STAGE(PG8_SB(0, 1), b2 + hstep, voffB); PG8_STAGE(PG8_SA(0, 0), a2, voffA);
            PG8_WAIT_V(8); PG8_WAIT_L(0); PG8_BAR; PG8_MMA(1, 0, At, B0); PG8_MMA(1, 1, At, B1); PG8_BAR; PG8_SCHED;
            PG8_LDB(B0, 1, 0); PG8_LDB(B1, 1, 1); PG8_SCHED; PG8_LDA(At, 1, 0); PG8_STAGE(PG8_SA(0, 1), a2 + hstep, voffA);
            PG8_WAIT_V(8); PG8_WAIT_L(0); PG8_BAR; PG8_MMA(0, 0, At, B0); PG8_MMA(0, 1, At, B1); PG8_BAR; PG8_SCHED;
            PG8_LDA(At, 1, 1); PG8_STAGE(PG8_SB(1, 0), b3, voffB); PG8_STAGE(PG8_SB(1, 1), b3 + hstep, voffB); PG8_STAGE(PG8_SA(1, 0), a3, voffA);
            PG8_WAIT_V(8); PG8_WAIT_L(0); PG8_BAR; PG8_MMA(1, 0, At, B0); PG8_MMA(1, 1, At, B1); PG8_BAR; PG8_SCHED;
            } else {
            PG8_LDB(B0, 0, 0); PG8_SCHED; PG8_LDA(At, 0, 0); PG8_STAGE(PG8_SA(1, 1), a1 + hstep, voffA);
            PG8_WAIT_L(8); PG8_BAR; PG8_WAIT_L(0); PG8_MMA(0, 0, At, B0); PG8_BAR; PG8_SCHED;
            PG8_LDB(B1, 0, 1); PG8_STAGE(PG8_SB(0, 0), b2, voffB);
            PG8_BAR; PG8_WAIT_L(0); PG8_MMA(0, 1, At, B1); PG8_BAR;
            PG8_LDA(At, 0, 1); PG8_STAGE(PG8_SA(0, 0), a2, voffA);
            PG8_BAR; PG8_WAIT_L(0); PG8_MMA(1, 0, At, B0); PG8_BAR; PG8_SCHED;
            PG8_STAGE(PG8_SB(0, 1), b2 + hstep, voffB);
            PG8_WAIT_V(6); PG8_BAR; PG8_MMA(1, 1, At, B1); PG8_BAR;
            PG8_LDB(B0, 1, 0); PG8_SCHED; PG8_LDA(At, 1, 0); PG8_STAGE(PG8_SA(0, 1), a2 + hstep, voffA);
            PG8_WAIT_L(8); PG8_BAR; PG8_WAIT_L(0); PG8_MMA(0, 0, At, B0); PG8_BAR; PG8_SCHED;
            PG8_LDB(B1, 1, 1); PG8_STAGE(PG8_SB(1, 0), b3, voffB);
            PG8_BAR; PG8_WAIT_L(0); PG8_MMA(0, 1, At, B1); PG8_BAR;
            PG8_LDA(At, 1, 1); PG8_STAGE(PG8_SA(1, 0), a3, voffA);
            PG8_BAR; PG8_WAIT_L(0); PG8_MMA(1, 0, At, B0); PG8_BAR; PG8_SCHED;
            PG8_STAGE(PG8_SB(1, 1), b3 + hstep, voffB);
            PG8_WAIT_V(6); PG8_BAR; PG8_MMA(1, 1, At, B1); PG8_BAR;
            }
        }
        if constexpr (ALIGN_EPI) { if (wr == 0) PG8_BAR; }
        if constexpr (!Epi::AFTER_DRAIN) { E(acc, cur, wr, wc, fr, fq); S.done(cur); }
        if (!has_next) break;
#pragma unroll
        for (int a = 0; a < 2; ++a)
#pragma unroll
            for (int b = 0; b < 2; ++b)
#pragma unroll
                for (int m = 0; m < 4; ++m)
#pragma unroll
                    for (int n = 0; n < 2; ++n) acc[a][b][m][n] = (f32x4){0.f, 0.f, 0.f, 0.f};
        cur = nxt; cA = nA; cB = nB; ++ui;
        if constexpr (ALIGN_EPI) { if (wr == 1) PG8_BAR; }
    }
    PG8_WAIT_V(0);
    if constexpr (!ALIGN_EPI) { if (wr == 0) PG8_BAR; }
    PG8_BAR;
    if constexpr (Epi::AFTER_DRAIN) { E.fused(acc, cur, wr, wc, fr, fq, lds, wid, lane); S.done(cur); }
#undef PG8_SA
#undef PG8_SB
#undef PG8_STAGE
#undef PG8_LDA
#undef PG8_LDB
#undef PG8_MMA
#undef PG8_WAIT_V
#undef PG8_WAIT_L
#undef PG8_BAR
#undef PG8_SCHED
}
}
constexpr int NWAVES = 8;
constexpr int BATCH = 16, SEQ = 2048, DM = 1024, HD = 64, FF = 4096, NIN = 4352;
constexpr int M = BATCH * SEQ;
constexpr float EPS = 1e-6f;
constexpr size_t MiB = 1u << 20;
constexpr size_t WS_CTL = 0, CTL_ZERO_BYTES = 1 * MiB;
constexpr size_t WS_WIN = 2 * MiB, WS_WBR = 11 * MiB, WS_WO = 13 * MiB, WS_WUP = 15 * MiB, WS_WDN = 23 * MiB;
constexpr int NGRP = 8, GROWS = M / NGRP;
constexpr size_t WS_GRP0 = 32 * MiB, GRP_STRIDE = 58 * MiB;
constexpr size_t GO_Q = 0 * MiB;
constexpr size_t GO_KA = 8 * MiB, GO_VA = 12 * MiB;
constexpr size_t GO_KB = 16 * MiB, GO_VB = 17 * MiB;
constexpr size_t GO_GA = 18 * MiB, GO_GB = 26 * MiB;
constexpr size_t GO_H = 0 * MiB;
constexpr size_t GO_A2 = 34 * MiB;
constexpr size_t GO_XN = 42 * MiB;
constexpr size_t GO_MIX = 50 * MiB;
constexpr size_t WS_END = WS_GRP0 + NGRP * GRP_STRIDE;
static_assert(WS_WIN + (size_t)NIN * DM * 2 <= WS_WBR && WS_WDN + (size_t)DM * FF * 2 <= WS_GRP0 && GO_GB + (size_t)GROWS * DM * 2 <= GO_A2 && GO_H + (size_t)GROWS * FF * 2 <= GO_A2 && GO_XN + (size_t)GROWS * DM * 2 <= GO_MIX && GO_MIX + (size_t)GROWS * DM * 2 <= GRP_STRIDE && WS_END <= 512 * MiB, "d_ws map");
__device__ __forceinline__ unsigned short* grp_ptr(unsigned char* ws, int g, size_t off, int pitch_elems) { return (unsigned short*)(ws + WS_GRP0 + (size_t)g * GRP_STRIDE + off) - (size_t)g * GROWS * pitch_elems; }
constexpr int CW_TMO = 0, CW_CODE = 1;
constexpr int CW_BAR = 4096;
constexpr int CW_CENSUS = 8192;
constexpr int CW_GSUB = 9216, CW_GGEN = 10240;
constexpr int CW_KMEAN = 16384;
constexpr int CW_ROWSQ = CW_KMEAN + BATCH * 8 * 8 * 64;
constexpr int CW_IRS = CW_ROWSQ + M;
static_assert((CW_IRS + M) * 4 <= (int)CTL_ZERO_BYTES, "CTL words inside the memset region");
constexpr int RING_OFF = 0, RING_BYTES = 131072;
constexpr int LDSCTL_OFF = RING_BYTES, MISC_OFF = LDSCTL_OFF + 320;
constexpr int STG_OFF = RING_BYTES + 1024, STG_BYTES = 8 * 2048;
constexpr int LDS_BYTES = STG_OFF + STG_BYTES;
static_assert(MISC_OFF + 128 <= LDS_BYTES, "LDS map");

#define GAS __attribute__((address_space(1)))
#define LAS __attribute__((address_space(3)))
typedef unsigned short bf16;
typedef unsigned v4u __attribute__((ext_vector_type(4)));
typedef float f32x4 __attribute__((ext_vector_type(4)));
typedef short bf16x8 __attribute__((ext_vector_type(8)));
typedef GAS unsigned gu32;
typedef GAS unsigned long long gu64;
#define RLX_AGENT __ATOMIC_RELAXED, __HIP_MEMORY_SCOPE_AGENT
#define LDS_WAIT() asm volatile("s_waitcnt lgkmcnt(0)" ::: "memory")
#define VM_WAIT() asm volatile("s_waitcnt vmcnt(0)" ::: "memory")
__device__ __forceinline__ unsigned long long rt() { return __builtin_amdgcn_s_memrealtime(); }
__device__ __forceinline__ unsigned f2bf(float f) { unsigned u = __builtin_bit_cast(unsigned, f); return (u + 0x7fffu + ((u >> 16) & 1u)) >> 16; }
__device__ __forceinline__ unsigned pk2(float lo, float hi) { return f2bf(lo) | (f2bf(hi) << 16); }

#define XB_TMO      128
#define XB_XCNT(j)  (256  + 64 * (j))
#define XB_XSUB(j)  (1280 + 64 * (j))
#define XB_XGEN(j)  (2304 + 64 * (j))
#define XB_TOP      3328
#define XB_TOPGEN   3392
#define XCD_BAR_WORDS 3456
#define XB_SPIN_CAP (1u << 18)

__device__ __forceinline__ unsigned xb_ld(unsigned* p)              { return __hip_atomic_load(p, __ATOMIC_RELAXED, __HIP_MEMORY_SCOPE_AGENT); }
__device__ __forceinline__ unsigned xb_add(unsigned* p, unsigned v) { return __hip_atomic_fetch_add(p, v, __ATOMIC_RELAXED, __HIP_MEMORY_SCOPE_AGENT); }
__device__ __forceinline__ unsigned xb_xcc_id() { return (unsigned)__builtin_amdgcn_s_getreg((3 << 11) | 20) & 0xFu; }
#define XB_SPIN(cond, bar) do { unsigned _sp = 0; while (cond) { __builtin_amdgcn_s_sleep(1); \
    if ((++_sp & 255u) == 0u) { if (xb_ld(&(bar)[XB_TMO])) break; if (_sp > XB_SPIN_CAP) { atomicAdd(&(bar)[XB_TMO], 1u); break; } } } } while (0)

struct XcdBarrier {
    unsigned* bar; unsigned x;
    volatile LAS unsigned* st;
};

__device__ __forceinline__ XcdBarrier xcd_barrier_post(unsigned* bar, volatile LAS unsigned* st) {
    XcdBarrier b; b.bar = bar; b.x = xb_xcc_id(); b.st = st;
    if (threadIdx.x == 0) (void)xb_add(&bar[XB_XCNT(b.x)], 1u);
    return b;
}
__device__ __forceinline__ void xcd_barrier_complete(unsigned* bar, unsigned x, unsigned& nloc, unsigned& nx) {
    const unsigned G = gridDim.x * gridDim.y * gridDim.z;
    unsigned sum, cnt, mine, sp = 0u;
    for (;;) {
        sum = 0u; cnt = 0u; mine = 0u;
#pragma unroll
        for (unsigned j = 0; j < 16; ++j) { const unsigned c = xb_ld(&bar[XB_XCNT(j)]); sum += c; cnt += (c > 0u) ? 1u : 0u; mine = (j == x) ? c : mine; }
        if (sum == G) break;
        __builtin_amdgcn_s_sleep(1);
        if ((++sp & 255u) == 0u) { if (xb_ld(&bar[XB_TMO])) break; if (sp > XB_SPIN_CAP) { atomicAdd(&bar[XB_TMO], 1u); break; } }
    }
    nloc = mine > 0u ? mine : 1u; nx = cnt > 0u ? cnt : 1u;
}

__device__ __forceinline__ void xcd_barrier(const XcdBarrier& b) {
    asm volatile("s_waitcnt vmcnt(0)" ::: "memory");
    __syncthreads();
    if (threadIdx.x == 0) {
        unsigned* bar = b.bar;
        __builtin_amdgcn_s_waitcnt(0);
        unsigned nloc = b.st[0], nx = b.st[1];
        if (nloc == 0u) { xcd_barrier_complete(bar, b.x, nloc, nx); b.st[0] = nloc; b.st[1] = nx; }
        const unsigned old = xb_add(&bar[XB_XSUB(b.x)], 1u);
        const unsigned gen = old / nloc;
        if (old + 1u == (gen + 1u) * nloc) {
            __builtin_amdgcn_fence(__ATOMIC_RELEASE, "agent");
            asm volatile("s_waitcnt vmcnt(0)" ::: "memory");
            const unsigned og = xb_add(&bar[XB_TOP], 1u);
            const unsigned tg = og / nx;
            if (og + 1u == (tg + 1u) * nx) xb_add(&bar[XB_TOPGEN], 1u);
            else XB_SPIN(xb_ld(&bar[XB_TOPGEN]) == tg, bar);
            __builtin_amdgcn_fence(__ATOMIC_ACQUIRE, "agent");
            xb_add(&bar[XB_XGEN(b.x)], 1u);
            asm volatile("s_waitcnt vmcnt(0)" ::: "memory");
        } else {
            XB_SPIN(xb_ld(&bar[XB_XGEN(b.x)]) == gen, bar);
            __builtin_amdgcn_fence(__ATOMIC_ACQUIRE, "agent");
            asm volatile("s_waitcnt vmcnt(0)" ::: "memory");
        }
    }
    __syncthreads();
}

struct GroupBar { unsigned* sub; unsigned* gen; unsigned* bar; };
__device__ __forceinline__ void group_barrier(const GroupBar& g) {
    asm volatile("s_waitcnt vmcnt(0)" ::: "memory");
    __syncthreads();
    if (threadIdx.x == 0) {
        __builtin_amdgcn_s_waitcnt(0);
        const unsigned old = xb_add(g.sub, 1u), gen = old / 32u;
        if (old + 1u == (gen + 1u) * 32u) {
            __builtin_amdgcn_fence(__ATOMIC_RELEASE, "agent");
            asm volatile("s_waitcnt vmcnt(0)" ::: "memory");
            __builtin_amdgcn_fence(__ATOMIC_ACQUIRE, "agent");
            xb_add(g.gen, 1u);
            asm volatile("s_waitcnt vmcnt(0)" ::: "memory");
        } else {
            XB_SPIN(xb_ld(g.gen) == gen, g.bar);
            __builtin_amdgcn_fence(__ATOMIC_ACQUIRE, "agent");
            asm volatile("s_waitcnt vmcnt(0)" ::: "memory");
        }
    }
    __syncthreads();
}

struct Frame {
    LAS unsigned char* lds;
    volatile LAS unsigned* MISC;
    gu32* ctl;
    int tid, lane, wave;
    int vcu, G;
    int grp, li, grouped;
    unsigned char* ws;
    const float *x, *norm_attn, *w_in, *qna, *kna, *qnb, *knb, *sinks, *wba, *wbb, *w_out, *norm_mlp, *w_up, *w_down; float* out;
    bf16 *WinT, *WbrT, *WoT, *WupT, *WdnT;
    bf16 *Q, *KA, *VA, *KB, *VB, *GA, *GB, *HB, *A2, *XN, *MIX;
    float *kmean, *rowsq, *irs;
};

__device__ __forceinline__ float wave_sum(float v) {
#pragma unroll
    for (int o = 1; o < 64; o <<= 1) v += __shfl_xor(v, o);
    return v;
}
__device__ __forceinline__ void p0_transpose_item(const float* W, int N, bf16* WT, int ldt, int koff, int prow0, LAS float* scr, int k0, int n0, int lane, const float* kscale = nullptr) {
    float wv[32];
#pragma unroll
    for (int i = 0; i < 32; ++i) wv[i] = W[(size_t)(k0 + 2 * i + (lane >> 5)) * N + n0 + (lane & 31)];
    if (kscale) {
#pragma unroll
        for (int i = 0; i < 32; ++i) wv[i] *= kscale[k0 + 2 * i + (lane >> 5)];
    }
#pragma unroll
    for (int i = 0; i < 32; ++i) scr[(2 * i + (lane >> 5)) * 33 + (lane & 31)] = wv[i];
    LDS_WAIT(); asm volatile("" ::: "memory");
    const int c = lane & 7;
#pragma unroll
    for (int j = 0; j < 4; ++j) { const int n = (lane >> 3) + 8 * j; const LAS float* s = scr + (8 * c) * 33 + n;
        v4u o; o.x = pk2(s[0 * 33], s[1 * 33]); o.y = pk2(s[2 * 33], s[3 * 33]); o.z = pk2(s[4 * 33], s[5 * 33]); o.w = pk2(s[6 * 33], s[7 * 33]);
        *(GAS v4u*)(WT + (size_t)(prow0 + n) * ldt + koff + k0 + 8 * c) = o; }
    LDS_WAIT(); asm volatile("" ::: "memory");
}
__device__ __forceinline__ void rms_row_to_bf16(const Frame& F, const float* xrow, const float* gain, bf16* orow) {
    const GAS f32x4* xr = (const GAS f32x4*)xrow + F.lane; const f32x4* gr = (const f32x4*)gain + F.lane;
    f32x4 v[4]; float s = 0.f;
#pragma unroll
    for (int j = 0; j < 4; ++j) { v[j] = xr[64 * j]; s += (v[j].x * v[j].x + v[j].y * v[j].y) + (v[j].z * v[j].z + v[j].w * v[j].w); }
    const float rs = 1.0f / sqrtf(wave_sum(s) * (1.f / DM) + EPS);
    GAS unsigned long long* o8 = (GAS unsigned long long*)orow + F.lane;
#pragma unroll
    for (int j = 0; j < 4; ++j) { const f32x4 g = gr[64 * j]; o8[64 * j] = (unsigned long long)pk2(v[j].x * rs * g.x, v[j].y * rs * g.y) | ((unsigned long long)pk2(v[j].z * rs * g.z, v[j].w * rs * g.w) << 32); }
}
__device__ __forceinline__ void p0_prologue(Frame& F) {
    LAS float* scr = (LAS float*)(F.lds + RING_OFF + F.wave * 16384);
    const int gw = (int)blockIdx.x * NWAVES + F.wave, NGW = F.G * NWAVES;
    constexpr int I_IN = (DM / 64) * (NIN / 32), I_BR = (512 / 64) * (DM / 32), I_O = (DM / 64) * (DM / 32), I_UP = (DM / 64) * (FF / 32), I_DN = (FF / 64) * (DM / 32);
    constexpr int NITEMS = I_IN + 2 * I_BR + I_O + I_UP + I_DN;
    for (int it = gw; it < NITEMS; it += NGW) {
        int r = it;
        if (r < I_IN) { const int nblk = NIN / 32, kb = r / nblk, nb = r % nblk, n0 = 32 * nb, nt = n0 & 255;
            int prow0 = (n0 & ~255) + 128 * ((nt >> 5) & 1) + 32 * (nt >> 6);
            if (n0 >= 2304) { const int isb = n0 >= 3328 ? 1 : 0, c0 = n0 - (isb ? 3328 : 2304); prow0 = 256 * (9 + (c0 >> 7)) + 128 * isb + 32 * ((c0 & 127) >> 5); }
            p0_transpose_item(F.w_in, NIN, F.WinT, DM, 0, prow0, scr, 64 * kb, n0, F.lane); continue; } r -= I_IN;
        if (r < I_BR) { const int nblk = DM / 32, kb = r / nblk, nb = r % nblk; p0_transpose_item(F.wba, DM, F.WbrT, DM, 0, 32 * nb, scr, 64 * kb, 32 * nb, F.lane); continue; } r -= I_BR;
        if (r < I_BR) { const int nblk = DM / 32, kb = r / nblk, nb = r % nblk; p0_transpose_item(F.wbb, DM, F.WbrT, DM, 512, 32 * nb, scr, 64 * kb, 32 * nb, F.lane); continue; } r -= I_BR;
        if (r < I_O)  { const int nblk = DM / 32, kb = r / nblk, nb = r % nblk; const int n0 = 32 * nb, nt = n0 & 255; p0_transpose_item(F.w_out, DM, F.WoT, DM, 0, (n0 & ~255) + 128 * ((nt >> 5) & 1) + 32 * (nt >> 6), scr, 64 * kb, n0, F.lane); continue; } r -= I_O;
        if (r < I_UP) { const int nblk = FF / 32, kb = r / nblk, nb = r % nblk; const int n0 = 32 * nb, nt = n0 & 255; p0_transpose_item(F.w_up, FF, F.WupT, DM, 0, (n0 & ~255) + 128 * ((nt >> 5) & 1) + 32 * (nt >> 6), scr, 64 * kb, n0, F.lane, F.norm_mlp); continue; } r -= I_UP;
        { const int nblk = DM / 32, kb = r / nblk, nb = r % nblk; p0_transpose_item(F.w_down, DM, F.WdnT, FF, 0, 32 * nb, scr, 64 * kb, 32 * nb, F.lane); }
    }
    {
        const f32x4* gr = (const f32x4*)F.norm_attn + F.lane; f32x4 g[4];
#pragma unroll
        for (int j = 0; j < 4; ++j) g[j] = gr[64 * j];
        for (int m = gw; m < M; m += 2 * NGW) { const int m2 = m + NGW;
            const GAS f32x4* xa = (const GAS f32x4*)(F.x + (size_t)m * DM) + F.lane; const GAS f32x4* xb = (const GAS f32x4*)(F.x + (size_t)m2 * DM) + F.lane;
            f32x4 va[4], vb[4]; float sa = 0.f, sb = 0.f;
#pragma unroll
            for (int j = 0; j < 4; ++j) { va[j] = xa[64 * j]; vb[j] = xb[64 * j]; }
#pragma unroll
            for (int j = 0; j < 4; ++j) { sa += (va[j].x * va[j].x + va[j].y * va[j].y) + (va[j].z * va[j].z + va[j].w * va[j].w); sb += (vb[j].x * vb[j].x + vb[j].y * vb[j].y) + (vb[j].z * vb[j].z + vb[j].w * vb[j].w); }
#pragma unroll
            for (int o = 1; o < 64; o <<= 1) { sa += __shfl_xor(sa, o); sb += __shfl_xor(sb, o); }
            const float qa = sqrtf(sa * (1.f / DM) + EPS), qb = sqrtf(sb * (1.f / DM) + EPS); const float ra = 1.0f / qa, rb = 1.0f / qb;
            if (F.lane == 0) { F.irs[m] = qa; F.irs[m2] = qb; }
            GAS unsigned long long* oa = (GAS unsigned long long*)(grp_ptr(F.ws, m / GROWS, GO_XN, DM) + (size_t)m * DM) + F.lane;
            GAS unsigned long long* ob = (GAS unsigned long long*)(grp_ptr(F.ws, m2 / GROWS, GO_XN, DM) + (size_t)m2 * DM) + F.lane;
#pragma unroll
            for (int j = 0; j < 4; ++j) {
                oa[64 * j] = (unsigned long long)pk2(va[j].x * ra * g[j].x, va[j].y * ra * g[j].y) | ((unsigned long long)pk2(va[j].z * ra * g[j].z, va[j].w * ra * g[j].w) << 32);
                ob[64 * j] = (unsigned long long)pk2(vb[j].x * rb * g[j].x, vb[j].y * rb * g[j].y) | ((unsigned long long)pk2(vb[j].z * rb * g[j].z, vb[j].w * rb * g[j].w) << 32); }
        }
    }
}
__device__ __forceinline__ void sa_load32(const bf16* p, float (&d)[32]) {
#pragma unroll
    for (int i = 0; i < 4; ++i) { const v4u w = *(const GAS v4u*)(p + 8 * i);
        d[8 * i + 0] = __uint_as_float(w.x << 16); d[8 * i + 1] = __uint_as_float(w.x & 0xffff0000u); d[8 * i + 2] = __uint_as_float(w.y << 16); d[8 * i + 3] = __uint_as_float(w.y & 0xffff0000u);
        d[8 * i + 4] = __uint_as_float(w.z << 16); d[8 * i + 5] = __uint_as_float(w.z & 0xffff0000u); d[8 * i + 6] = __uint_as_float(w.w << 16); d[8 * i + 7] = __uint_as_float(w.w & 0xffff0000u); }
}
__device__ __forceinline__ void sa_store32(bf16* p, const float (&o)[32], float sc) {
#pragma unroll
    for (int i = 0; i < 4; ++i) { v4u w; w.x = pk2(o[8 * i] * sc, o[8 * i + 1] * sc); w.y = pk2(o[8 * i + 2] * sc, o[8 * i + 3] * sc); w.z = pk2(o[8 * i + 4] * sc, o[8 * i + 5] * sc); w.w = pk2(o[8 * i + 6] * sc, o[8 * i + 7] * sc);
        *(GAS v4u*)(p + 8 * i) = w; }
}
#define SA_KEY(KPTR, VPTR, BIAS, VALID) do { \
    float s_ = 0.f; \
    { float kv_[32]; sa_load32((KPTR) + dof, kv_); \
        _Pragma("unroll") for (int d_ = 0; d_ < 32; ++d_) s_ = __builtin_fmaf(q[d_], kv_[d_], s_); asm volatile("" ::: "memory"); } \
    s_ += __shfl_xor(s_, 1); \
    s_ += (BIAS); const bool ok_ = (VALID); const float se_ = ok_ ? s_ : -1e30f; \
    if (__any(se_ > m)) { const float mn_ = __builtin_fmaxf(m, se_); const float c_ = __builtin_amdgcn_exp2f(m - mn_); l *= c_; _Pragma("unroll") for (int d_ = 0; d_ < 32; ++d_) o[d_] *= c_; m = mn_; } \
    const float p_ = ok_ ? __builtin_amdgcn_exp2f(s_ - m) : 0.f; l += p_; \
    { float kv_[32]; sa_load32((VPTR) + dof, kv_); \
        _Pragma("unroll") for (int d_ = 0; d_ < 32; ++d_) o[d_] = __builtin_fmaf(p_, kv_[d_], o[d_]); asm volatile("" ::: "memory"); } } while (0)

__device__ __forceinline__ void sa_moba(const bf16* Q, const bf16* KA, const bf16* VA, const float* kmean, bf16* O, int b, int h, int t0, int lane) {
    const int dof = 32 * (lane & 1);
    const int t = t0 + (lane >> 1), own = t0 >> 8;
    float q[32]; sa_load32(Q + ((size_t)(b * SEQ + t)) * 1024 + h * 64 + dof, q);
    unsigned sel;
    if (own <= 3) sel = (1u << own) - 1u;
    else {
        float gs[7];
#pragma unroll
        for (int n = 0; n < 7; ++n) { gs[n] = -INFINITY;
            if (n < own) { const float* km = kmean + ((size_t)(b * 8 + n) * 8 + h) * 64 + dof; float s = 0.f;
#pragma unroll
                for (int d = 0; d < 32; d += 4) { const f32x4 kv = *(const GAS f32x4*)(km + d); s = __builtin_fmaf(q[d], kv.x, s); s = __builtin_fmaf(q[d + 1], kv.y, s); s = __builtin_fmaf(q[d + 2], kv.z, s); s = __builtin_fmaf(q[d + 3], kv.w, s); }
                s += __shfl_xor(s, 1);
                gs[n] = s; asm volatile("" ::: "memory"); } }
        sel = 0u;
#pragma unroll
        for (int n = 0; n < 7; ++n) { int rank = 0;
#pragma unroll
            for (int j = 0; j < 7; ++j) if (j != n) rank += (gs[j] > gs[n] || (gs[j] == gs[n] && j < n)) ? 1 : 0;
            if (n < own && rank < 3) sel |= 1u << n; }
    }
    const float slope2 = exp2f(-0.5f * (float)(h + 9)) * pg8::kLog2e;
    float m = -1e30f, l = 0.f, o[32];
#pragma unroll
    for (int d = 0; d < 32; ++d) o[d] = 0.f;
    for (int n = 0; n <= own; ++n) {
        const bool isown = (n == own), mine = isown || ((sel >> n) & 1u);
        if (!__any(mine)) continue;
        const int nk = isown ? (t0 + 32 - n * 256) : 256;
        for (int kk = 0; kk < nk; ++kk) { const int tk = n * 256 + kk; const size_t r = (size_t)(b * SEQ + tk) * 512 + h * 64;
            SA_KEY(KA + r, VA + r, -slope2 * (float)(t - tk), mine && (tk <= t)); }
    }
    sa_store32(O + ((size_t)(b * SEQ + t)) * 1024 + h * 64 + dof, o, 1.0f / l);
}
__device__ __forceinline__ void sa_swa(const bf16* Q, const bf16* KB, const bf16* VB, const float* sinks, bf16* O, int b, int hq, int t0, int lane) {
    const int dof = 32 * (lane & 1);
    const int t = t0 + (lane >> 1), kvh = hq >> 2;
    float q[32]; sa_load32(Q + ((size_t)(b * SEQ + t)) * 1024 + 512 + hq * 64 + dof, q);
    const float slope2 = exp2f(-0.5f * (float)(hq + 1)) * pg8::kLog2e, sink2 = sinks[hq] * pg8::kLog2e;
    float m = -1e30f, l = 0.f, o[32];
#pragma unroll
    for (int d = 0; d < 32; ++d) o[d] = 0.f;
    const int k0 = t0 - 127 > 0 ? t0 - 127 : 0;
    for (int tk = k0; tk < t0 + 32; ++tk) { const size_t r = (size_t)(b * SEQ + tk) * 128 + kvh * 64;
        SA_KEY(KB + r, VB + r, -slope2 * (float)(t - tk), (tk <= t) && (t - tk < 128)); }
    const float mf = __builtin_fmaxf(m, sink2), c = __builtin_amdgcn_exp2f(m - mf);
    l = l * c + __builtin_amdgcn_exp2f(sink2 - mf);
    sa_store32(O + ((size_t)(b * SEQ + t)) * 1024 + 512 + hq * 64 + dof, o, c / l);
}
__device__ __forceinline__ void attn_simple_phase(Frame& F) {
    const int gw = F.li * NWAVES + F.wave, NGW = 32 * NWAVES;
    int i = 0;
    for (int u = gw; u < 1024; u += NGW, ++i) { const int b = 2 * F.grp + (u >> 9), h = (u >> 6) & 7; int ch = u & 63; if (i & 1) ch = 63 - ch;
        sa_moba(F.Q, F.KA, F.VA, F.kmean, F.Q, b, h, ch * 32, F.lane); }
    for (int u = gw; u < 1024; u += NGW) { const int b = 2 * F.grp + (u >> 9), hq = (u >> 6) & 7, ch = u & 63;
        sa_swa(F.Q, F.KB, F.VB, F.sinks, F.Q, b, hq, ch * 32, F.lane); }
}

namespace fa {
using bf16x8 = __attribute__((ext_vector_type(8))) short;
using s16x4 = __attribute__((ext_vector_type(4))) short;
using f32x16 = __attribute__((ext_vector_type(16))) float;
using u32x4 = __attribute__((ext_vector_type(4))) unsigned;
using f32x4 = __attribute__((ext_vector_type(4))) float;
constexpr int NW = 8, QBLK = 32, KVBLK = 64;
constexpr int SLOTB = 8192, LDS_K = 0, LDS_V = 3 * SLOTB, LDS_WS = 6 * SLOTB, LDS_OST = LDS_WS + NW * 256, LDS_QN = LDS_OST + NW * 4096, LDS_BYTES = LDS_QN + NW * 4096;
constexpr int QP = 1024;
#ifndef FA_THR
#define FA_THR 8
#endif
#define SBAR() __builtin_amdgcn_sched_barrier(0)
#define PIN(x) asm volatile("" : "+v"(x))
#define MFMA(a, b, c) __builtin_amdgcn_mfma_f32_32x32x16_bf16(a, b, c, 0, 0, 0)
#define WAIT_BAR(N) asm volatile("s_waitcnt vmcnt(" #N ") lgkmcnt(0)\n\ts_barrier" ::: "memory")
__device__ __forceinline__ int crow(int r, int hi) { return (r & 3) + 8 * (r >> 2) + 4 * hi; }
__device__ __forceinline__ unsigned cvtpk(float lo, float hi) { unsigned r; asm("v_cvt_pk_bf16_f32 %0, %1, %2" : "=v"(r) : "v"(lo), "v"(hi)); return r; }
__device__ __forceinline__ void glds16(const void* g, unsigned lds_base) {
    unsigned sv; asm volatile("s_mov_b32 %0, m0\n\ts_mov_b32 m0, %2\n\ts_nop 0\n\tglobal_load_lds_dwordx4 %1, off\n\ts_mov_b32 m0, %0" : "=&s"(sv) : "v"(g), "s"(lds_base) : "memory"); }
typedef __attribute__((address_space(3))) const char* lds_cptr;
typedef short v4i16_t __attribute__((ext_vector_type(4)));
__device__ __forceinline__ void kload2(bf16x8* kf, lds_cptr kp, int d0) { kf[2 * d0] = *(const __attribute__((address_space(3))) bf16x8*)(kp + d0 * 2048); kf[2 * d0 + 1] = *(const __attribute__((address_space(3))) bf16x8*)(kp + d0 * 2048 + 512); }
__device__ __forceinline__ s16x4 vtr(lds_cptr p) { return __builtin_bit_cast(s16x4, __builtin_amdgcn_ds_read_tr16_b64_v4i16((__attribute__((address_space(3))) v4i16_t*)p)); }
#define MX3(a, b, c) __builtin_fmaxf(__builtin_fmaxf((a), (b)), (c))
__device__ __forceinline__ float rowmax(const f32x16& p0, const f32x16& p1) {
    float a = MX3(p0[0], p0[1], p1[0]), b = MX3(p0[2], p0[3], p1[1]); a = MX3(a, p1[2], p1[3]);
#pragma unroll
    for (int r = 4; r < 16; r += 4) { a = MX3(a, p0[r], p0[r + 1]); b = MX3(b, p0[r + 2], p0[r + 3]); a = MX3(a, p1[r], p1[r + 1]); b = MX3(b, p1[r + 2], p1[r + 3]); }
    float m = __builtin_fmaxf(a, b); auto rr = __builtin_amdgcn_permlane32_swap(__float_as_uint(m), __float_as_uint(m), false, false);
    return __builtin_fmaxf(__uint_as_float(rr[0]), __uint_as_float(rr[1])); }
__device__ __forceinline__ void emask(f32x16& p0, f32x16& p1, int dq  , unsigned wd) {
#pragma unroll
    for (int r = 0; r < 16; ++r) { const int kv = (r & 3) + 8 * (r >> 2); if ((unsigned)(dq - kv) >= wd) p0[r] = -INFINITY; if ((unsigned)(dq - kv - 32) >= wd) p1[r] = -INFINITY; } }
__device__ __forceinline__ unsigned bf16bits(float f) { unsigned u = __float_as_uint(f); return (u + 0x7fffu + ((u >> 16) & 1u)) >> 16; }

struct AU {
    const bf16* Qw;
    bf16* Ow;
    const bf16* Kb;
    const bf16* Vb;
    int KP;
    int q0;
    int qrel0;
    int NT;
    int mode;
    unsigned wd;
    float slope2;
    float sink2;
    unsigned okmask;
    const float* km;
    int gj;
};
__device__ __forceinline__ int key_rel(const AU& u, int t) {
    if (u.mode == 0) { const int np = u.NT - 4; return t == 0 ? 0 : (t <= np ? 64 * (t - 1) - 64 * np : 64 * (t - np)); }
    return -64 * t;
}
__device__ __forceinline__ int attn_unit(const AU& u, const AU& n, bool has_next, bool pre, int s0, char* lds) {
    const int tid = threadIdx.x; int lane = tid & 63; asm volatile("" : "+v"(lane));
    const int r32 = lane & 31, hi = lane >> 5; const int wid = __builtin_amdgcn_readfirstlane(tid >> 6);
    const int NT = u.NT, KP = u.KP;
    const unsigned lds0 = (unsigned)(uintptr_t)lds; float* wsf = (float*)(lds + LDS_WS) + wid * 64;
    const bf16* ksrc = u.Kb + (long)lane * KP + wid * 8;
    const bf16* vsrc = u.Vb + (long)(16 * (wid & 3) + (lane >> 2)) * KP + (wid >> 2) * 32 + (lane & 3) * 8;
    const unsigned kdst = lds0 + LDS_K + wid * 1024, vdst = lds0 + LDS_V + wid * 1024;
#define KROW(t) ({ int r_ = u.q0 + key_rel(u, (t)); r_ < 0 ? 0 : r_; })
#define DMA_K(t, slot) glds16(ksrc + (long)KROW(t) * KP, (unsigned)__builtin_amdgcn_readfirstlane(kdst + (slot)))
#define DMA_V(t, slot) glds16(vsrc + (long)KROW(t) * KP, (unsigned)__builtin_amdgcn_readfirstlane(vdst + (slot)))
    const lds_cptr vp0 = (lds_cptr)lds + LDS_V + ((lane >> 4) & 1) * 32 + (lane & 3) * 8 + (4 * hi + ((lane & 15) >> 2)) * 64;
    const lds_cptr kp0 = (lds_cptr)lds + LDS_K + hi * 1024 + r32 * 16;
    const int sA = s0, sB = (sA == 2 * SLOTB) ? 0 : sA + SLOTB, sC = (sB == 2 * SLOTB) ? 0 : sB + SLOTB;
    const lds_cptr qn0 = (lds_cptr)lds + LDS_QN + wid * 4096;
    bf16x8 qr[4];
    if (!pre) {
        DMA_K(0, sA); DMA_V(0, sA); DMA_K(1, sB);
#pragma unroll
        for (int d0 = 0; d0 < 4; ++d0) qr[d0] = *reinterpret_cast<const bf16x8*>(&u.Qw[(long)r32 * QP + d0 * 16 + hi * 8]);
    } else {
        asm volatile("s_waitcnt vmcnt(7)" ::: "memory");
#pragma unroll
        for (int d0 = 0; d0 < 4; ++d0) qr[d0] = *(const __attribute__((address_space(3))) bf16x8*)(qn0 + r32 * 128 + d0 * 32 + hi * 16);
    }
    bf16x8 qaug, kaug0, kaug1;
    { const unsigned sh = bf16bits(u.slope2); const float rem = u.slope2 - __uint_as_float(sh << 16); const unsigned sl = bf16bits(rem);
      const unsigned Sh = bf16bits(64.f * __uint_as_float(sh << 16)), Sl = bf16bits(64.f * __uint_as_float(sl << 16));
      u32x4 w = {hi ? 0u : (sh | (sl << 16)), hi ? 0u : (Sh | (Sl << 16)), 0u, 0u}; qaug = __builtin_bit_cast(bf16x8, w);
      const unsigned k0b = bf16bits((float)r32), k1b = bf16bits((float)(r32 + 32));
      u32x4 a0 = {k0b | (k0b << 16), 0u, 0u, 0u}, a1 = {k1b | (k1b << 16), 0u, 0u, 0u}; kaug0 = __builtin_bit_cast(bf16x8, a0); kaug1 = __builtin_bit_cast(bf16x8, a1); }
#define SET_TILE(t) do { const unsigned tb_ = bf16bits((float)(key_rel(u, (t)) >> 6)); const unsigned tw_ = tb_ | (tb_ << 16); \
      u32x4 a0_ = __builtin_bit_cast(u32x4, kaug0), a1_ = __builtin_bit_cast(u32x4, kaug1); a0_[1] = tw_; a1_[1] = tw_; kaug0 = __builtin_bit_cast(bf16x8, a0_); kaug1 = __builtin_bit_cast(bf16x8, a1_); } while (0)
    unsigned okmask = u.okmask;
    if (u.gj >= 4) {
        float gs[7];
#pragma unroll
        for (int n = 0; n < 7; ++n) { gs[n] = -INFINITY;
            if (n < u.gj) { const float* km = u.km + 512 * n + 8 * hi; float sg = 0.f;
#pragma unroll
                for (int d0 = 0; d0 < 4; ++d0) { const f32x4 k0 = *(const f32x4*)(km + 16 * d0), k1 = *(const f32x4*)(km + 16 * d0 + 4);
#define QF(e) __uint_as_float(((unsigned)(unsigned short)qr[d0][e]) << 16)
                    sg = __builtin_fmaf(QF(0), k0.x, sg); sg = __builtin_fmaf(QF(1), k0.y, sg); sg = __builtin_fmaf(QF(2), k0.z, sg); sg = __builtin_fmaf(QF(3), k0.w, sg);
                    sg = __builtin_fmaf(QF(4), k1.x, sg); sg = __builtin_fmaf(QF(5), k1.y, sg); sg = __builtin_fmaf(QF(6), k1.z, sg); sg = __builtin_fmaf(QF(7), k1.w, sg);
#undef QF
                }
                sg += __shfl_xor(sg, 32); gs[n] = sg; } }
        unsigned ok = 1u | (7u << (NT - 3));
#pragma unroll
        for (int n = 0; n < 7; ++n) { int rank = 0;
#pragma unroll
            for (int k = 0; k < 7; ++k) if (k != n) rank += (gs[k] > gs[n] || (gs[k] == gs[n] && k < n)) ? 1 : 0;
            if (n < u.gj && rank < 3) ok |= 0xFu << (1 + 4 * n); }
        okmask = ok;
    }
    float mhat = 0.f, l_reg = 0.f; f32x16 o[2]; o[0] = f32x16{}; o[1] = f32x16{};
    const int qrel = u.qrel0 + r32; bool resc = false; const unsigned wd = u.wd;
    f32x16 cin; bool okp = true;
#define SETCIN(okv) do { const float cv_ = (okv) ? -mhat : -INFINITY; _Pragma("unroll") for (int r_ = 0; r_ < 16; ++r_) cin[r_] = cv_; PIN(cin); } while (0)
    f32x16 pA0, pA1, pB0, pB1; bf16x8 kf[8]; s16x4 vlo[8], vhi[8]; u32x4 pw0, pw1, pw2, pw3;
    int sl_prev = sA, sl_cur = sA, sl_next = sB;
#define ROT() do { sl_prev = sl_cur; sl_cur = sl_next; sl_next = (sl_next == 2 * SLOTB) ? 0 : sl_next + SLOTB; } while (0)
#define EX(v) __builtin_amdgcn_exp2f(v)
#define RESC() do { if (resc) { _Pragma("unroll") for (int d_ = 0; d_ < 2; ++d_) _Pragma("unroll") for (int r = 0; r < 16; ++r) o[d_][r] *= wsf[crow(r, hi)]; } } while (0)
    if (!pre) { DMA_K(2, sC); WAIT_BAR(3); } else { WAIT_BAR(7); }
    _Pragma("unroll") for (int d0 = 0; d0 < 4; ++d0) kload2(kf, kp0 + sA, d0);
    SET_TILE(0);
    pA0 = MFMA(kaug0, qaug, f32x16{}); pA1 = MFMA(kaug1, qaug, f32x16{});
    pA0 = MFMA(kf[0], qr[0], pA0); pA1 = MFMA(kf[1], qr[0], pA1); pA0 = MFMA(kf[2], qr[1], pA0); pA1 = MFMA(kf[3], qr[1], pA1);
    pA0 = MFMA(kf[4], qr[2], pA0); pA1 = MFMA(kf[5], qr[2], pA1); pA0 = MFMA(kf[6], qr[3], pA0); pA1 = MFMA(kf[7], qr[3], pA1);
    emask(pA0, pA1, qrel - key_rel(u, 0) - 4 * hi, wd);
    { const float rm = rowmax(pA0, pA1); mhat = rm;
#pragma unroll
      for (int r = 0; r < 16; ++r) { pA0[r] = EX(pA0[r] - rm); pA1[r] = EX(pA1[r] - rm); }
      SETCIN(true); }
    WAIT_BAR(0);
    if (NT > 3) DMA_K(3, sA);
    DMA_V(1, sB); ROT();
    _Pragma("unroll") for (int d0 = 0; d0 < 4; ++d0) kload2(kf, kp0 + sl_cur, d0);
    WAIT_BAR(2);
#define PKW(P, i) cvtpk(P[i], P[i + 1])
#define PAF(k) __builtin_bit_cast(bf16x8, pw##k)
#define VFR(i) (bf16x8){vlo[i][0], vlo[i][1], vlo[i][2], vlo[i][3], vhi[i][0], vhi[i][1], vhi[i][2], vhi[i][3]}
#define VRD(i) do { vlo[i] = vtr(vp_ + (((i) >> 2) * 4096 + ((i) & 3) * 1024)); vhi[i] = vtr(vp_ + (((i) >> 2) * 4096 + ((i) & 3) * 1024 + 512)); } while (0)
#define KRD(G, d0) do { if (G) { kload2(kf, kp0 + sl_next, d0); SBAR(); } } while (0)
#define GAPA(MF, a0, a1, a2, a3, W0, W1, PW) do { MF; sacc += a0; sacc += a1; sacc += a2; sacc += a3; W0; W1; PIN(PW); PIN(sacc); SBAR(); } while (0)
#define GAPB(MF, X, i) do { MF; X[i] = EX(X[i]); X[i + 1] = EX(X[i + 1]); X[i + 2] = EX(X[i + 2]); X[i + 3] = EX(X[i + 3]); PIN(X); SBAR(); } while (0)
#define STEP(C0, C1, P0, P1, t, MASK, GK, GV, GL) do { SBAR(); \
    const lds_cptr vp_ = vp0 + sl_prev; SET_TILE(t); \
    const bool ok_ = (okmask >> (t)) & 1u; \
    if (__any(ok_ != okp)) { SETCIN(ok_); okp = ok_; } \
    C0 = MFMA(kaug0, qaug, cin); C1 = MFMA(kaug1, qaug, cin); SBAR(); \
    VRD(0); SBAR(); float sacc = P0[0] + P0[1]; \
                    GAPA(C0 = MFMA(kf[0], qr[0], C0), P0[2], P0[3], P0[4], P0[5],     pw0[0] = PKW(P0, 0),  pw0[1] = PKW(P0, 2),  pw0); \
    VRD(4); SBAR(); GAPA(C1 = MFMA(kf[1], qr[0], C1), P0[6], P0[7], P0[8], P0[9],     pw0[2] = PKW(P0, 4),  pw0[3] = PKW(P0, 6),  pw0); \
    VRD(1); SBAR(); GAPA(C0 = MFMA(kf[2], qr[1], C0),    P0[10], P0[11], P0[12], P0[13], pw1[0] = PKW(P0, 8),  pw1[1] = PKW(P0, 10), pw1); \
    VRD(5); SBAR(); GAPA(C1 = MFMA(kf[3], qr[1], C1),    P0[14], P0[15], P1[0], P1[1],   pw1[2] = PKW(P0, 12), pw1[3] = PKW(P0, 14), pw1); \
    VRD(2); SBAR(); GAPA(C0 = MFMA(kf[4], qr[2], C0),    P1[2], P1[3], P1[4], P1[5],     pw2[0] = PKW(P1, 0),  pw2[1] = PKW(P1, 2),  pw2); \
    VRD(6); SBAR(); GAPA(C1 = MFMA(kf[5], qr[2], C1),    P1[6], P1[7], P1[8], P1[9],     pw2[2] = PKW(P1, 4),  pw2[3] = PKW(P1, 6),  pw2); \
    VRD(3); SBAR(); GAPA(C0 = MFMA(kf[6], qr[3], C0),    P1[10], P1[11], P1[12], P1[13], pw3[0] = PKW(P1, 8),  pw3[1] = PKW(P1, 10), pw3); \
    VRD(7); SBAR(); GAPA(C1 = MFMA(kf[7], qr[3], C1),    P1[14], P1[15], 0.f, 0.f,       pw3[2] = PKW(P1, 12), pw3[3] = PKW(P1, 14), pw3); \
    l_reg += sacc; \
    if (GK) DMA_K((t) + 3, sl_cur); if (GV) DMA_V((t) + 1, sl_next); \
    if (MASK) { if (u.mode == 1 || (t) > NT - 4) emask(C0, C1, qrel - key_rel(u, (t)) - 4 * hi, wd); }            \
    { const float rm = rowmax(C0, C1); resc = false;                                                    \
      if (__builtin_expect(__any(rm > (float)FA_THR), 0)) { const float dl = __builtin_fmaxf(rm, 0.f); mhat += dl; \
          _Pragma("unroll") for (int r = 0; r < 16; ++r) { C0[r] -= dl; C1[r] -= dl; } SETCIN(ok_); \
          const float f = __builtin_amdgcn_exp2f(-dl); l_reg *= f; if (hi == 0) wsf[r32] = f; resc = true; } } \
    SBAR(); \
    GAPB(o[0] = MFMA(PAF(0), VFR(0), o[0]), C0, 0);              GAPB(o[1] = MFMA(PAF(0), VFR(4), o[1]), C0, 4); \
    KRD(GL, 0); GAPB(o[0] = MFMA(PAF(1), VFR(1), o[0]), C0, 8);  KRD(GL, 1); GAPB(o[1] = MFMA(PAF(1), VFR(5), o[1]), C0, 12); \
    KRD(GL, 2); GAPB(o[0] = MFMA(PAF(2), VFR(2), o[0]), C1, 0);  KRD(GL, 3); GAPB(o[1] = MFMA(PAF(2), VFR(6), o[1]), C1, 4); \
    GAPB(o[0] = MFMA(PAF(3), VFR(3), o[0]), C1, 8);              GAPB(o[1] = MFMA(PAF(3), VFR(7), o[1]), C1, 12); \
    } while (0)
    int t = 1;
#define ENDW(tt) do { if ((tt) + 3 < NT) { WAIT_BAR(2); } else if ((tt) + 2 < NT) { WAIT_BAR(1); } else { WAIT_BAR(0); } } while (0)
    if (NT & 1) {
        STEP(pB0, pB1, pA0, pA1, 1, true, (4 < NT), (2 < NT), (2 < NT)); ENDW(1); RESC(); ROT();
        pA0 = pB0; pA1 = pB1; t = 2;
    }
    for (; t + 5 < NT; t += 2) {
        STEP(pB0, pB1, pA0, pA1, t, false, true, true, true);     WAIT_BAR(2); RESC(); ROT();
        STEP(pA0, pA1, pB0, pB1, t + 1, false, true, true, true); WAIT_BAR(2); RESC(); ROT();
    }
    for (; t + 2 < NT; t += 2) {
        STEP(pB0, pB1, pA0, pA1, t, true, (t + 3 < NT), (t + 1 < NT), (t + 1 < NT));         ENDW(t);     RESC(); ROT();
        STEP(pA0, pA1, pB0, pB1, t + 1, true, (t + 4 < NT), (t + 2 < NT), (t + 2 < NT));     ENDW(t + 1); RESC(); ROT();
    }
    int s_ret = 0;
#define NROW(t) ({ int r_ = n.q0 + key_rel(n, (t)); r_ < 0 ? 0 : r_; })
#define PREFETCH_NEXT() do { if (has_next) { \
        const int n0 = sl_next, n1 = (n0 == 2 * SLOTB) ? 0 : n0 + SLOTB, n2 = (n1 == 2 * SLOTB) ? 0 : n1 + SLOTB; s_ret = n0; \
        const bf16* ks2 = n.Kb + (long)lane * n.KP + wid * 8; \
        const bf16* vs2 = n.Vb + (long)(16 * (wid & 3) + (lane >> 2)) * n.KP + (wid >> 2) * 32 + (lane & 3) * 8; \
        glds16(ks2 + (long)NROW(0) * n.KP, (unsigned)__builtin_amdgcn_readfirstlane(kdst + n0)); \
        const bf16* qs2 = n.Qw + (long)(lane >> 3) * QP + (lane & 7) * 8; const unsigned qdst = lds0 + LDS_QN + wid * 4096; \
        _Pragma("unroll") for (int k = 0; k < 4; ++k) glds16(qs2 + (long)(8 * k) * QP, (unsigned)__builtin_amdgcn_readfirstlane(qdst + k * 1024)); \
        glds16(vs2 + (long)NROW(0) * n.KP, (unsigned)__builtin_amdgcn_readfirstlane(vdst + n0)); \
        glds16(ks2 + (long)NROW(1) * n.KP, (unsigned)__builtin_amdgcn_readfirstlane(kdst + n1)); \
        glds16(ks2 + (long)NROW(2) * n.KP, (unsigned)__builtin_amdgcn_readfirstlane(kdst + n2)); } } while (0)
#define DRAIN(PX0, PX1) do { float sacc = PX0[0] + PX0[1]; \
      _Pragma("unroll") for (int r = 2; r < 16; ++r) sacc += PX0[r]; \
      _Pragma("unroll") for (int r = 0; r < 16; ++r) sacc += PX1[r]; \
      l_reg += sacc; \
      pw0 = (u32x4){PKW(PX0, 0), PKW(PX0, 2), PKW(PX0, 4), PKW(PX0, 6)}; pw1 = (u32x4){PKW(PX0, 8), PKW(PX0, 10), PKW(PX0, 12), PKW(PX0, 14)}; \
      pw2 = (u32x4){PKW(PX1, 0), PKW(PX1, 2), PKW(PX1, 4), PKW(PX1, 6)}; pw3 = (u32x4){PKW(PX1, 8), PKW(PX1, 10), PKW(PX1, 12), PKW(PX1, 14)}; \
      const lds_cptr vp_ = vp0 + sl_cur; _Pragma("unroll") for (int i = 0; i < 8; ++i) VRD(i); \
      o[0] = MFMA(PAF(0), VFR(0), o[0]); o[1] = MFMA(PAF(0), VFR(4), o[1]); o[0] = MFMA(PAF(1), VFR(1), o[0]); o[1] = MFMA(PAF(1), VFR(5), o[1]); \
      o[0] = MFMA(PAF(2), VFR(2), o[0]); o[1] = MFMA(PAF(2), VFR(6), o[1]); o[0] = MFMA(PAF(3), VFR(3), o[0]); o[1] = MFMA(PAF(3), VFR(7), o[1]); } while (0)
    PREFETCH_NEXT();
    STEP(pB0, pB1, pA0, pA1, NT - 1, true, false, false, false); RESC();
    DRAIN(pB0, pB1);
#undef NROW
#undef PREFETCH_NEXT
#undef DRAIN
    { auto rr = __builtin_amdgcn_permlane32_swap(__float_as_uint(l_reg), __float_as_uint(l_reg), false, false); l_reg = __uint_as_float(rr[0]) + __uint_as_float(rr[1]); }
    {
      const float sk = u.sink2 + u.slope2 * (float)qrel, mf = __builtin_fmaxf(mhat, sk), c = __builtin_amdgcn_exp2f(mhat - mf);
      const float lt = l_reg * c + __builtin_amdgcn_exp2f(sk - mf);
      if (hi == 0) wsf[32 + r32] = c * __builtin_amdgcn_rcpf(lt); }
    asm volatile("s_waitcnt lgkmcnt(0)" ::: "memory");
    float rli[16];
#pragma unroll
    for (int r = 0; r < 16; ++r) rli[r] = wsf[32 + crow(r, hi)];
    bf16* stg = (bf16*)(lds + LDS_OST) + wid * 2048;
    { int l2 = lane; asm volatile("" : "+v"(l2)); const int r32b = l2 & 31, hib = l2 >> 5;
#pragma unroll
    for (int r = 0; r < 16; ++r) { const int orow = crow(r, hib);
#pragma unroll
        for (int d0 = 0; d0 < 2; ++d0) stg[orow * 64 + d0 * 32 + r32b] = (bf16)bf16bits(o[d0][r] * rli[r]); }
    asm volatile("s_waitcnt lgkmcnt(0)" ::: "memory");
    const int srow = l2 >> 3, ch = l2 & 7; const u32x4* sp = (const u32x4*)(stg + srow * 64 + ch * 8); bf16* gp = u.Ow + (long)srow * QP + ch * 8;
#pragma unroll
    for (int i = 0; i < 4; ++i) *(u32x4*)(gp + (long)i * 8 * QP) = sp[i * 64]; }
    asm volatile("s_waitcnt lgkmcnt(0)\n\ts_barrier" ::: "memory");
    return s_ret;
#undef KROW
#undef DMA_K
#undef DMA_V
#undef SET_TILE
#undef SETCIN
#undef ROT
#undef EX
#undef RESC
#undef PKW
#undef PAF
#undef VFR
#undef VRD
#undef KRD
#undef ENDW
#undef GAPA
#undef GAPB
#undef STEP
}
#undef SBAR
#undef PIN
#undef MFMA
#undef WAIT_BAR
#undef MX3
}

__device__ __forceinline__ float bfbits2f(short s) { return __uint_as_float(((unsigned)(unsigned short)s) << 16); }
__device__ __forceinline__ fa::AU attn_make_unit(const Frame& F, bf16* O, int i, float sink2w) {
    const int wid = F.wave; fa::AU u;
    const bool moba = i < 4;
    const int p = F.vcu >> 1, bm = p >> 3, h = p & 7, half = F.vcu & 1, im = i & 3;
    const int j = half ? (im == 0 ? 6 : im == 1 ? 5 : im == 2 ? 2 : 1) : (im == 0 ? 7 : im == 1 ? 4 : im == 2 ? 3 : 0);
    const int k = i - 4, us = (k < 4) ? F.vcu * 4 + k : (F.vcu - 16) * 4 + (k - 2), bs = us >> 6, kvh = (us >> 5) & 1, c = us & 31, hq = kvh * 4 + (wid >> 1);
    const int b = moba ? bm : bs;
    const size_t rowbase = (size_t)b * SEQ;
    const size_t qoff = moba ? (rowbase + 256 * j + 32 * wid) * 1024 + h * 64 : (rowbase + 64 * c + 32 * (wid & 1)) * 1024 + 512 + hq * 64;
    u.Kb = moba ? F.KA + rowbase * 512 + h * 64 : F.KB + rowbase * 128 + kvh * 64;
    u.Vb = moba ? F.VA + rowbase * 512 + h * 64 : F.VB + rowbase * 128 + kvh * 64;
    u.KP = moba ? 512 : 128;
    u.q0 = moba ? 256 * j : 64 * c; u.qrel0 = moba ? 32 * wid : 32 * (wid & 1); u.NT = moba ? 4 * (j + 1) : 3; u.mode = moba ? 0 : 1; u.wd = moba ? 0x40000000u : 128u;
    u.slope2 = exp2f(-0.5f * (float)(moba ? h + 9 : hq + 1)) * pg8::kLog2e; u.sink2 = moba ? -INFINITY : sink2w;
    const unsigned okm = 1u | (7u << (4 * (j + 1) - 3)) | (j <= 3 ? ((1u << (4 * j)) - 1u) << 1 : 0u);
    const unsigned oks = (c >= 2) ? 0x7u : ((1u << (c + 1)) - 1u);
    u.okmask = moba ? okm : oks;
    u.km = F.kmean + ((size_t)(bm * 8) * 8 + h) * 64; u.gj = moba ? j : 0;
    u.Qw = F.Q + qoff; u.Ow = O + qoff;
    return u;
}
__device__ __forceinline__ void attn_fast_phase(Frame& F, char* lds, bf16* O) {
    const float sink2w = F.sinks[(((F.vcu * 4) >> 5) & 1) * 4 + (F.wave >> 1)] * pg8::kLog2e;
    const int nun = (F.li < 16) ? 6 : 10;
    fa::AU cur = attn_make_unit(F, O, 0, sink2w); int s0 = 0; bool pre = false;
    for (int i = 0; i < nun; ++i) {
        const bool has_next = i + 1 < nun;
        const fa::AU nxt = attn_make_unit(F, O, has_next ? i + 1 : i, sink2w);
        s0 = fa::attn_unit(cur, nxt, has_next, pre, s0, lds);
        pre = has_next; cur = nxt;
    }
}
#if defined(DBG_ATTN)
__device__ __forceinline__ void dbg_compare(Frame& F, const bf16* Od) {
    const int gt = F.li * NWAVES * 64 + F.tid, NGT = 32 * NWAVES * 64; float num = 0.f, den = 0.f;
    for (size_t i = gt; i < (size_t)GROWS * 64; i += NGT) { const size_t row = (size_t)F.grp * GROWS + (i >> 6), c8 = i & 63; const size_t off = row * 1024 + DBG_PART * 512 + c8 * 8;
        const v4u a = *(const GAS v4u*)(Od + off), r = *(const GAS v4u*)(F.Q + off);
#define DD(x) { const float a0 = __uint_as_float(a.x << 16), a1 = __uint_as_float(a.x & 0xffff0000u), r0 = __uint_as_float(r.x << 16), r1 = __uint_as_float(r.x & 0xffff0000u); num += (a0 - r0) * (a0 - r0) + (a1 - r1) * (a1 - r1); den += r0 * r0 + r1 * r1; }
        DD(x) DD(y) DD(z) DD(w)
#undef DD
    }
    num = wave_sum(num); den = wave_sum(den);
    if (F.lane == 0) { atomicAdd((float*)(F.ctl) + 8, num); atomicAdd((float*)(F.ctl) + 9, den); }
}
#endif

struct Args { const float* in[14]; float* out; unsigned char* ws; };
__global__ void __launch_bounds__(NWAVES * 64, 2) fwd_megakernel(Args args) {
    extern __shared__ __attribute__((aligned(16))) unsigned char lds[];
    Frame F;
    F.lds = (LAS unsigned char*)lds;
    F.MISC = (volatile LAS unsigned*)(F.lds + MISC_OFF);
    F.tid = threadIdx.x; F.lane = F.tid & 63; F.wave = __builtin_amdgcn_readfirstlane(F.tid >> 6);
    F.G = gridDim.x;
    unsigned char* ws = args.ws; F.ws = ws;
    F.ctl = (gu32*)(ws + WS_CTL);
    F.x = args.in[0]; F.norm_attn = args.in[1]; F.w_in = args.in[2]; F.qna = args.in[3]; F.kna = args.in[4]; F.qnb = args.in[5]; F.knb = args.in[6]; F.sinks = args.in[7];
    F.wba = args.in[8]; F.wbb = args.in[9]; F.w_out = args.in[10]; F.norm_mlp = args.in[11]; F.w_up = args.in[12]; F.w_down = args.in[13]; F.out = args.out;
    F.WinT = (bf16*)(ws + WS_WIN); F.WbrT = (bf16*)(ws + WS_WBR); F.WoT = (bf16*)(ws + WS_WO); F.WupT = (bf16*)(ws + WS_WUP); F.WdnT = (bf16*)(ws + WS_WDN);
    F.kmean = (float*)(ws + WS_CTL) + CW_KMEAN; F.rowsq = (float*)(ws + WS_CTL) + CW_ROWSQ; F.irs = (float*)(ws + WS_CTL) + CW_IRS;
    for (int u = F.tid; u < (LDS_BYTES - LDSCTL_OFF) / 4; u += NWAVES * 64) ((LAS unsigned*)(F.lds + LDSCTL_OFF))[u] = 0u;
    __syncthreads();
    XcdBarrier bar = xcd_barrier_post((unsigned*)(F.ctl + CW_BAR), F.MISC + 8);
    if (F.tid == 0) F.MISC[12] = xb_add((unsigned*)(F.ctl + CW_CENSUS) + 64 * bar.x, 1u);
    __syncthreads();
    const unsigned my_arrival = F.MISC[12];
#define GRID_BAR() xcd_barrier(bar)

#ifndef SKIP_P0
    p0_prologue(F);
#endif
    GRID_BAR();
    {   bool ok = (F.G == 256);
        for (int j = 0; j < 16; ++j) { const unsigned c = __hip_atomic_load((unsigned*)(F.ctl + CW_CENSUS) + 64 * j, RLX_AGENT); ok = ok && (c == (j < NGRP ? 32u : 0u)); }
        F.grouped = ok ? 1 : 0;
        if (ok) { F.grp = (int)bar.x; F.li = (int)my_arrival; }
        else    { F.grp = (int)blockIdx.x % NGRP; F.li = (int)blockIdx.x / NGRP; }
        F.grp = __builtin_amdgcn_readfirstlane(F.grp); F.li = __builtin_amdgcn_readfirstlane(F.li);
        F.vcu = F.grp * 32 + F.li; }
    const int vbid = F.li * NGRP + F.grp;
    F.Q = grp_ptr(ws, F.grp, GO_Q, 1024); F.KA = grp_ptr(ws, F.grp, GO_KA, 512); F.VA = grp_ptr(ws, F.grp, GO_VA, 512); F.KB = grp_ptr(ws, F.grp, GO_KB, 128); F.VB = grp_ptr(ws, F.grp, GO_VB, 128);
    F.GA = grp_ptr(ws, F.grp, GO_GA, 1024); F.GB = grp_ptr(ws, F.grp, GO_GB, 1024); F.HB = grp_ptr(ws, F.grp, GO_H, 4096); F.A2 = grp_ptr(ws, F.grp, GO_A2, 1024); F.XN = grp_ptr(ws, F.grp, GO_XN, 1024); F.MIX = grp_ptr(ws, F.grp, GO_MIX, 1024);
    GroupBar gbar{(unsigned*)(F.ctl + CW_GSUB) + 64 * F.grp, (unsigned*)(F.ctl + CW_GGEN) + 64 * F.grp, (unsigned*)(F.ctl + CW_BAR)};
#define GROUP_BAR() do { if (F.grouped) group_barrier(gbar); else xcd_barrier(bar); } while (0)
#ifndef SKIP_P1
    {   pg8::Gemm g{F.XN, F.WinT, M, NIN, DM}; pg8::StaticOrder S; S.init(M, NIN, F.G, vbid);
        pg8::EpiIn E{F.Q, F.KA, F.VA, F.KB, F.VB, F.GA, F.GB, F.qna, F.kna, F.qnb, F.knb, F.kmean};
        S.ilim = 8;
        pg8::gemm_phase<pg8::EpiIn, pg8::StaticOrder, true, true>(F.lds + RING_OFF, g, S, E);
        GROUP_BAR();
        if (F.li < 16) { S.ioff = 8; S.ilim = 1; pg8::gemm_phase<pg8::EpiIn, pg8::StaticOrder, true, true>(F.lds + RING_OFF, g, S, E); } }
#endif
#if defined(DBG_ATTN)
    attn_fast_phase(F, (char*)lds + RING_OFF, F.MIX); GROUP_BAR(); attn_simple_phase(F); GROUP_BAR(); dbg_compare(F, F.MIX);
#elif defined(SIMPLE_ATTN)
    attn_simple_phase(F);
#else
    attn_fast_phase(F, (char*)lds + RING_OFF, F.Q);
#endif
    GROUP_BAR();
#ifndef SKIP_P3
    {   pg8::Gemm g{F.Q, F.WbrT, M, DM, DM}; pg8::StaticOrder S; S.init(M, DM, F.G, vbid);
        pg8::EpiMix E{F.GA, F.GB, F.MIX};
        pg8::gemm_phase<pg8::EpiMix, pg8::StaticOrder, true, true>(F.lds + RING_OFF, g, S, E); }
#endif
    GROUP_BAR();
#ifndef SKIP_P4
    {   pg8::Gemm g{F.MIX, F.WoT, M, DM, DM}; pg8::StaticOrder S; S.init(M, DM, F.G, vbid);
        pg8::EpiX1 E{F.XN, F.irs, F.norm_attn, F.A2, F.rowsq, F.lds + STG_OFF};
        pg8::gemm_phase<pg8::EpiX1, pg8::StaticOrder, true, true>(F.lds + RING_OFF, g, S, E); }
#endif
    GROUP_BAR();
#ifndef SKIP_P5
    {   pg8::Gemm g{F.A2, F.WupT, M, FF, DM}; pg8::StaticOrder S; S.init(M, FF, F.G, vbid);
        pg8::EpiUp E{F.HB, F.rowsq, F.lds + STG_OFF};
        pg8::gemm_phase<pg8::EpiUp, pg8::StaticOrder, true, true>(F.lds + RING_OFF, g, S, E); }
#endif
    GROUP_BAR();
#ifndef SKIP_P6
    {   pg8::Gemm g{F.HB, F.WdnT, M, DM, FF}; pg8::StaticOrder S; S.init(M, DM, F.G, vbid);
#if defined(DBG_ATTN)
        const float dnum = ((const GAS float*)F.ctl)[8], dden = ((const GAS float*)F.ctl)[9];
        pg8::EpiDown E{F.A2, F.out, 1.0f + 100.0f * sqrtf(dnum / dden), F.lds + STG_OFF};
#else
        pg8::EpiDown E{F.A2, F.out, 1.0f, F.lds + STG_OFF};
#endif
        pg8::gemm_phase<pg8::EpiDown, pg8::StaticOrder, true, true>(F.lds + RING_OFF, g, S, E); }
#endif
}

extern "C" void kernel_launch(void* const* d_in, const int* in_sizes, int n_in, void* d_out, int out_size, void* d_ws, size_t ws_size, hipStream_t stream) {
    static int grid = 0;
    if (grid == 0) {
        if (n_in != 14 || in_sizes[0] != M * DM || out_size != M * DM || ws_size < WS_END) { fprintf(stderr, "kernel_launch: unexpected shapes: n_in %d, in0 %d, out %d, ws %zu (need %zu); nothing launched\n", n_in, n_in > 0 ? in_sizes[0] : -1, out_size, ws_size, (size_t)WS_END); grid = -1; return; }
        int dev = 0, cus = 0, per_cu = 0;
        if (hipGetDevice(&dev) != hipSuccess || hipDeviceGetAttribute(&cus, hipDeviceAttributeMultiprocessorCount, dev) != hipSuccess) { fprintf(stderr, "kernel_launch: device query failed\n"); grid = -1; return; }
        if (hipFuncSetAttribute((const void*)fwd_megakernel, hipFuncAttributeMaxDynamicSharedMemorySize, LDS_BYTES) != hipSuccess) { fprintf(stderr, "kernel_launch: hipFuncSetAttribute failed\n"); grid = -1; return; }
        if (hipOccupancyMaxActiveBlocksPerMultiprocessor(&per_cu, (const void*)fwd_megakernel, NWAVES * 64, LDS_BYTES) != hipSuccess || per_cu < 1)
            fprintf(stderr, "kernel_launch: note: occupancy query reports %d workgroups per CU\n", per_cu);
        (void)hipGetLastError();
        grid = cus;
    }
    if (grid < 0) return;
    if (hipMemsetAsync((char*)d_ws + WS_CTL, 0, CTL_ZERO_BYTES, stream) != hipSuccess) { fprintf(stderr, "kernel_launch: hipMemsetAsync failed\n"); return; }
    Args a{};
    for (int i = 0; i < 14; ++i) a.in[i] = (const float*)d_in[i];
    a.out = (float*)d_out; a.ws = (unsigned char*)d_ws;
    hipLaunchKernelGGL(fwd_megakernel, dim3(grid), dim3(NWAVES * 64), LDS_BYTES, stream, a);
    const hipError_t le = hipPeekAtLastError();
    if (le != hipSuccess) fprintf(stderr, "kernel_launch: launch failed: %s\n", hipGetErrorName(le));
}
```
